# Optimizing an MI355X kernel written in HIP

```python
import jax, jax.numpy as jnp
from jax import lax
import numpy as np

D_MODEL = 1024
BATCH = 8
SEQ = 4096
DEPTH = 4

GRID_W = 64
CTX_LEN = 256
HEAD_DIM = 64
A_HEADS = 8
A_KV_HEADS = 2
B_HEADS = 8
Q_BLOCK = 128
NA_ROWS_MAX = 8
NA_COLS = 16
ROPE_THETA = 10000.0
GLA_HEADS = 4
GLA_DK = D_MODEL // 2
GLA_DV = D_MODEL
GLA_GATE_RANK = 16
GLA_GATE_NORM = 16.0
GLA_CHUNK = 64
N_EXPERTS = 16
EC_CAPACITY = 2
EXPERT_FF = 1024
N_EVEN = (DEPTH + 1) // 2
N_ODD = DEPTH // 2
ATTN_SIZES = (A_HEADS * HEAD_DIM, A_KV_HEADS * HEAD_DIM, A_KV_HEADS * HEAD_DIM, B_HEADS * HEAD_DIM, B_HEADS * HEAD_DIM, B_HEADS * HEAD_DIM)
ATTN_HEADS = (A_HEADS, A_KV_HEADS, A_KV_HEADS, B_HEADS, B_HEADS, B_HEADS)
ATTN_IN = A_HEADS * HEAD_DIM + 2 * A_KV_HEADS * HEAD_DIM + 3 * B_HEADS * HEAD_DIM
ATTN_MIX = (A_HEADS + B_HEADS) * HEAD_DIM
GLA_SIZES = (GLA_DK, GLA_DK, GLA_DV, GLA_DV, GLA_GATE_RANK, GLA_GATE_RANK)
GLA_IN = 2 * GLA_DK + 2 * GLA_DV + 2 * GLA_GATE_RANK
EPS = 1e-6

kernel_name = 'hybrid_gqa_natten_gla_ecmoe_prefix'


def rms_norm(x, g):
    xf = x.astype(jnp.float32)
    y = xf * lax.rsqrt(jnp.mean(xf * xf, axis=-1, keepdims=True) + EPS)
    return (y * g.astype(jnp.float32)).astype(x.dtype)


def split_cols(p, sizes):
    out, start = [], 0
    for s in sizes:
        out.append(p[..., start:start + s])
        start += s
    return out


def to_heads(a, n):
    return a.reshape(a.shape[:-1] + (n, a.shape[-1] // n))


def axial_rope_tables(n):
    half = HEAD_DIM // 2
    t = jnp.arange(n, dtype=jnp.int32)
    inv = ROPE_THETA ** (-jnp.arange(0, half, 2, dtype=jnp.float32) / half)
    def tab(pos):
        ang = pos.astype(jnp.float32)[:, None] * inv[None, :]
        ang = jnp.concatenate([ang, ang], axis=-1)
        return jnp.cos(ang)[:, None, :], jnp.sin(ang)[:, None, :]
    cos_r, sin_r = tab(t // GRID_W)
    cos_c, sin_c = tab(t % GRID_W)
    return cos_r, sin_r, cos_c, sin_c


def apply_axial_rope(x, tables):
    cos_r, sin_r, cos_c, sin_c = tables
    half = x.shape[-1] // 2
    def rot(u, cos, sin):
        u1, u2 = jnp.split(u, 2, axis=-1)
        return u * cos + jnp.concatenate([-u2, u1], axis=-1) * sin
    xf = x.astype(jnp.float32)
    y = jnp.concatenate([rot(xf[..., :half], cos_r, sin_r), rot(xf[..., half:], cos_c, sin_c)], axis=-1)
    return y.astype(x.dtype)


def gqa_softmax(q, k, v):
    b, t, hq, dh = q.shape
    hk = k.shape[2]
    qg = q.reshape(b, t, hk, hq // hk, dh)
    s = jnp.einsum('btkgd,bskd->bkgts', qg, k).astype(jnp.float32) * (dh ** -0.5)
    p = jax.nn.softmax(s, axis=-1).astype(v.dtype)
    o = jnp.einsum('bkgts,bskd->btkgd', p, v)
    return o.reshape(b, t, hq, dh)


def neighbourhood_attention(q, k, v, k_ctx, v_ctx, rpb):
    b, n, h, dh = q.shape
    rows = n // GRID_W
    wr = min(NA_ROWS_MAX, rows)
    wc = NA_COLS
    qg = q.reshape(b, rows, GRID_W, h, dh)
    kg = k.reshape(b, rows, GRID_W, h, dh)
    vg = v.reshape(b, rows, GRID_W, h, dh)
    col = np.arange(GRID_W)
    col_idx = np.clip(col - wc // 2, 0, GRID_W - wc)[:, None] + np.arange(wc)[None, :]
    dc_idx = col_idx - col[:, None] + (NA_COLS - 1)
    scale = dh ** -0.5
    def row_block(args):
        r, q_r = args
        rs = jnp.clip(r - wr // 2, 0, rows - wr)
        k_win = lax.dynamic_slice_in_dim(kg, rs, wr, axis=1)[:, :, col_idx]
        v_win = lax.dynamic_slice_in_dim(vg, rs, wr, axis=1)[:, :, col_idx]
        dr_idx = rs + jnp.arange(wr) - r + (NA_ROWS_MAX - 1)
        bias = rpb[:, dr_idx[:, None, None], dc_idx[None, :, :]].transpose(0, 2, 1, 3)
        s_win = jnp.einsum('bwhd,biwjhd->bhwij', q_r, k_win).astype(jnp.float32) * scale + bias.astype(jnp.float32)
        s_ctx = jnp.einsum('bwhd,blhd->bhwl', q_r, k_ctx).astype(jnp.float32) * scale
        s = jnp.concatenate([s_win.reshape(b, h, GRID_W, wr * wc), s_ctx], axis=-1)
        p = jax.nn.softmax(s, axis=-1).astype(v.dtype)
        p_win = p[..., :wr * wc].reshape(b, h, GRID_W, wr, wc)
        p_ctx = p[..., wr * wc:]
        return jnp.einsum('bhwij,biwjhd->bwhd', p_win, v_win) + jnp.einsum('bhwl,blhd->bwhd', p_ctx, v_ctx)
    out = lax.map(row_block, (jnp.arange(rows, dtype=jnp.int32), qg.transpose(1, 0, 2, 3, 4)))
    return out.transpose(1, 0, 2, 3, 4).reshape(b, n, h, dh)


def attn_mixer(u, uc, w_in, w_out, qa_g, ka_g, qb_g, kb_g, rpb, rope, need_ctx_out):
    def project(hh):
        qa, ka, va, qb, kb, vb = [to_heads(p, nh) for p, nh in zip(split_cols(hh @ w_in, ATTN_SIZES), ATTN_HEADS)]
        return rms_norm(qa, qa_g), rms_norm(ka, ka_g), va, rms_norm(qb, qb_g), rms_norm(kb, kb_g), vb
    qa, ka, va, qb, kb, vb = project(u)
    cqa, cka, cva, cqb, ckb, cvb = project(uc)
    qa = apply_axial_rope(qa, rope)
    ka = apply_axial_rope(ka, rope)
    b, n = u.shape[0], u.shape[1]
    k_all = jnp.concatenate([ka, cka], axis=1)
    v_all = jnp.concatenate([va, cva], axis=1)
    q_blocks = qa.reshape(b, n // Q_BLOCK, Q_BLOCK, A_HEADS, HEAD_DIM).transpose(1, 0, 2, 3, 4)
    oa = lax.map(lambda qi: gqa_softmax(qi, k_all, v_all), q_blocks)
    oa = oa.transpose(1, 0, 2, 3, 4).reshape(b, n, A_HEADS * HEAD_DIM)
    ob = neighbourhood_attention(qb, kb, vb, ckb, cvb, rpb).reshape(b, n, B_HEADS * HEAD_DIM)
    y = jnp.concatenate([oa, ob], axis=-1) @ w_out
    yc = None
    if need_ctx_out:
        l = uc.shape[1]
        coa = gqa_softmax(cqa, cka, cva).reshape(b, l, A_HEADS * HEAD_DIM)
        cob = gqa_softmax(cqb, ckb, cvb).reshape(b, l, B_HEADS * HEAD_DIM)
        yc = jnp.concatenate([coa, cob], axis=-1) @ w_out
    return y, yc


def gla_chunked(q, k, v, g, s0):
    b, t, h, dk = q.shape
    dv = v.shape[-1]
    n = t // GLA_CHUNK
    def chunks(a):
        return a.astype(jnp.float32).reshape(b, n, GLA_CHUNK, h, a.shape[-1]).transpose(1, 0, 3, 2, 4)
    qc = chunks(q) * (dk ** -0.5)
    kc, vc, gc = chunks(k), chunks(v), chunks(g)
    cum = jnp.cumsum(gc, axis=3)
    cum_last = cum[:, :, :, -1:, :]
    q_dec = qc * jnp.exp(cum)
    k_inv = kc * jnp.exp(-cum)
    k_state = kc * jnp.exp(cum_last - cum)
    mask = jnp.tril(jnp.ones((GLA_CHUNK, GLA_CHUNK), dtype=bool))
    a_intra = jnp.where(mask, jnp.einsum('nbhid,nbhjd->nbhij', q_dec, k_inv), 0.0)
    o_intra = jnp.einsum('nbhij,nbhje->nbhie', a_intra, vc)
    def step(s, xs):
        q_d, k_s, v_c, c_last = xs
        o_inter = jnp.einsum('bhid,bhde->bhie', q_d, s)
        s = s * jnp.swapaxes(jnp.exp(c_last), -1, -2) + jnp.einsum('bhjd,bhje->bhde', k_s, v_c)
        return s, o_inter
    s_fin, o_inter = lax.scan(step, s0, (q_dec, k_state, vc, cum_last))
    o = (o_intra + o_inter).transpose(1, 0, 3, 2, 4).reshape(b, t, h, dv)
    return o.astype(v.dtype), s_fin


def gla_final_state(k, v, g):
    cum = jnp.cumsum(g.astype(jnp.float32), axis=1)
    kd = k.astype(jnp.float32) * jnp.exp(cum[:, -1:] - cum)
    return jnp.einsum('bthd,bthe->bhde', kd, v.astype(jnp.float32))


def gla_mixer(u, uc, w_in, gk_w_f, gk_b_f, gk_w_b, gk_b_b, onorm_g, w_out, need_ctx_out):
    def project(hh):
        q, k, v, og, zf, zb = split_cols(hh @ w_in, GLA_SIZES)
        gf = jax.nn.log_sigmoid((zf @ gk_w_f + gk_b_f).astype(jnp.float32)) / GLA_GATE_NORM
        gb = jax.nn.log_sigmoid((zb @ gk_w_b + gk_b_b).astype(jnp.float32)) / GLA_GATE_NORM
        return (to_heads(q, GLA_HEADS), to_heads(k, GLA_HEADS), to_heads(v, GLA_HEADS), og,
                to_heads(gf, GLA_HEADS), to_heads(gb, GLA_HEADS))
    def merge(o_f, o_b, og):
        o = rms_norm(o_f + o_b, onorm_g)
        o = o.reshape(o.shape[:2] + (GLA_DV,)) * jax.nn.silu(og)
        return o @ w_out
    flip = lambda a: a[:, ::-1]
    cq, ck, cv, cog, cgf, cgb = project(uc)
    q, k, v, og, gf, gb = project(u)
    b = u.shape[0]
    yc = None
    if need_ctx_out:
        s0 = jnp.zeros((b, GLA_HEADS, GLA_DK // GLA_HEADS, GLA_DV // GLA_HEADS), jnp.float32)
        co_f, s_f = gla_chunked(cq, ck, cv, cgf, s0)
        co_b, s_b = gla_chunked(flip(cq), flip(ck), flip(cv), flip(cgb), s0)
        yc = merge(co_f, flip(co_b), cog)
    else:
        s_f = gla_final_state(ck, cv, cgf)
        s_b = gla_final_state(flip(ck), flip(cv), flip(cgb))
    o_f, _ = gla_chunked(q, k, v, gf, s_f)
    o_b, _ = gla_chunked(flip(q), flip(k), flip(v), flip(gb), s_b)
    return merge(o_f, flip(o_b), og), yc


def expert_choice_ffn(hh, w_router, w_gate, w_up, w_down):
    b, n, d = hh.shape
    cap = EC_CAPACITY * n // N_EXPERTS
    aff = jax.nn.softmax((hh @ w_router).astype(jnp.float32), axis=-1)
    gate, idx = lax.top_k(aff.transpose(0, 2, 1), cap)
    xg = jax.vmap(lambda hb, ib: hb[ib])(hh, idx)
    a = jnp.einsum('becd,edf->becf', xg, w_gate)
    up = jnp.einsum('becd,edf->becf', xg, w_up)
    y = jnp.einsum('becf,efd->becd', jax.nn.silu(a) * up, w_down) * gate[..., None].astype(hh.dtype)
    return jax.vmap(lambda yb, ib: jnp.zeros((n, d), hh.dtype).at[ib.reshape(-1)].add(yb.reshape(-1, d)))(y, idx)


def setup_inputs(seed: int = 0):
    key = jax.random.key(seed)
    ks = jax.random.split(key, 26)
    f32 = jnp.float32
    def w(k, shape, fan_in, g=1.0):
        return jax.random.normal(k, shape, f32) * (g * fan_in ** -0.5)
    def gain(k, shape):
        return 1.0 + 0.02 * jax.random.normal(k, shape, f32)
    def small(k, shape, s):
        return s * jax.random.normal(k, shape, f32)
    return {
        'x': jax.random.normal(ks[0], (BATCH, SEQ, D_MODEL), f32),
        'c': jax.random.normal(ks[1], (BATCH, D_MODEL), f32),
        'ctx': jax.random.normal(ks[2], (BATCH, CTX_LEN, D_MODEL), f32),
        'c_ctx': jax.random.normal(ks[3], (D_MODEL,), f32),
        'ada_w': w(ks[4], (DEPTH, D_MODEL, 6 * D_MODEL), D_MODEL, 0.5),
        'ada_b': small(ks[5], (DEPTH, 6 * D_MODEL), 0.02),
        'norm1_g': gain(ks[6], (DEPTH, D_MODEL)),
        'norm2_g': gain(ks[7], (DEPTH, D_MODEL)),
        'attn_w_in': w(ks[8], (N_EVEN, D_MODEL, ATTN_IN), D_MODEL),
        'attn_w_out': w(ks[9], (N_EVEN, ATTN_MIX, D_MODEL), ATTN_MIX),
        'a_q_norm': gain(ks[10], (N_EVEN, HEAD_DIM)),
        'a_k_norm': gain(ks[11], (N_EVEN, HEAD_DIM)),
        'b_q_norm': gain(ks[12], (N_EVEN, HEAD_DIM)),
        'b_k_norm': gain(ks[13], (N_EVEN, HEAD_DIM)),
        'na_rpb': small(ks[14], (N_EVEN, B_HEADS, 2 * NA_ROWS_MAX - 1, 2 * NA_COLS - 1), 0.1),
        'gla_w_in': w(ks[15], (N_ODD, D_MODEL, GLA_IN), D_MODEL),
        'gla_gk_w_f': w(ks[16], (N_ODD, GLA_GATE_RANK, GLA_DK), GLA_GATE_RANK),
        'gla_gk_b_f': small(ks[17], (N_ODD, GLA_DK), 0.1),
        'gla_gk_w_b': w(ks[18], (N_ODD, GLA_GATE_RANK, GLA_DK), GLA_GATE_RANK),
        'gla_gk_b_b': small(ks[19], (N_ODD, GLA_DK), 0.1),
        'gla_o_norm': gain(ks[20], (N_ODD, GLA_DV // GLA_HEADS)),
        'gla_w_out': w(ks[21], (N_ODD, GLA_DV, D_MODEL), GLA_DV),
        'moe_router': w(ks[22], (DEPTH, D_MODEL, N_EXPERTS), D_MODEL),
        'moe_w_gate': w(ks[23], (DEPTH, N_EXPERTS, D_MODEL, EXPERT_FF), D_MODEL),
        'moe_w_up': w(ks[24], (DEPTH, N_EXPERTS, D_MODEL, EXPERT_FF), D_MODEL),
        'moe_w_down': w(ks[25], (DEPTH, N_EXPERTS, EXPERT_FF, D_MODEL), EXPERT_FF),
    }


def reference(x, c, ctx, c_ctx, ada_w, ada_b, norm1_g, norm2_g, attn_w_in, attn_w_out,
              a_q_norm, a_k_norm, b_q_norm, b_k_norm, na_rpb, gla_w_in, gla_gk_w_f, gla_gk_b_f,
              gla_gk_w_b, gla_gk_b_b, gla_o_norm, gla_w_out, moe_router, moe_w_gate, moe_w_up, moe_w_down):
    n = x.shape[1]
    rope = axial_rope_tables(n)
    s_lat = jax.nn.silu(c)
    s_ctx = jax.nn.silu(c_ctx)[None, :]
    h, hc = x, ctx
    for layer in range(DEPTH):
        last = layer == DEPTH - 1
        i = layer // 2
        m = jnp.split((s_lat @ ada_w[layer] + ada_b[layer])[:, None, :], 6, axis=-1)
        mc = jnp.split((s_ctx @ ada_w[layer] + ada_b[layer])[:, None, :], 6, axis=-1)
        u = rms_norm(h, norm1_g[layer]) * (1 + m[1]) + m[0]
        uc = rms_norm(hc, norm1_g[layer]) * (1 + mc[1]) + mc[0]
        if layer % 2 == 0:
            y, yc = attn_mixer(u, uc, attn_w_in[i], attn_w_out[i], a_q_norm[i], a_k_norm[i],
                               b_q_norm[i], b_k_norm[i], na_rpb[i], rope, not last)
        else:
            y, yc = gla_mixer(u, uc, gla_w_in[i], gla_gk_w_f[i], gla_gk_b_f[i], gla_gk_w_b[i],
                              gla_gk_b_b[i], gla_o_norm[i], gla_w_out[i], not last)
        h = h + m[2] * y
        u = rms_norm(h, norm2_g[layer]) * (1 + m[4]) + m[3]
        h = h + m[5] * expert_choice_ffn(u, moe_router[layer], moe_w_gate[layer], moe_w_up[layer], moe_w_down[layer])
        if not last:
            hc = hc + mc[2] * yc
            uc = rms_norm(hc, norm2_g[layer]) * (1 + mc[4]) + mc[3]
            hc = hc + mc[5] * expert_choice_ffn(uc, moe_router[layer], moe_w_gate[layer], moe_w_up[layer], moe_w_down[layer])
    return h
```

```cpp
#include <hip/hip_runtime.h>
#include <stdint.h>
#include <math.h>
#include <cstdio>

#ifndef DUP_MASK
#define DUP_MASK 0
#endif

namespace {
#define LAS __attribute__((address_space(3)))
#define GAS __attribute__((address_space(1)))
typedef unsigned short bf16_t;
typedef short bf16x8 __attribute__((ext_vector_type(8)));
typedef float f32x4 __attribute__((ext_vector_type(4)));
typedef unsigned u32x4 __attribute__((ext_vector_type(4)));
typedef unsigned u32x2 __attribute__((ext_vector_type(2)));

constexpr int D = 1024, NB = 8, SEQ = 4096, CTXL = 256, RPB = 4352, NR = NB * RPB;
constexpr int NSLOT_LAT = 65536, NSLOT = 69632;
constexpr int NTHR = 512, NWAVES = 8;
constexpr size_t MiB = 1u << 20;
constexpr size_t WS_CTL = 0, CTL_ZERO_BYTES = 1 * MiB;
constexpr size_t WS_MODS = 2 * MiB;
constexpr size_t WS_ROPE = 3 * MiB;
constexpr size_t WS_AFF = 12 * MiB;
constexpr size_t WS_POS = 15 * MiB;
constexpr size_t WS_IDX = 18 * MiB;
constexpr size_t WS_GATE = 19 * MiB;
constexpr size_t WS_Z = 20 * MiB;
constexpr size_t WS_U = 32 * MiB;
constexpr size_t WS_B1 = 100 * MiB;
constexpr size_t WS_B2 = 304 * MiB;
constexpr size_t WS_HB = WS_B2 + 136 * MiB;
constexpr size_t WS_W = 508 * MiB;
constexpr size_t W_ATTN_IN = WS_W, W_ATTN_OUT = WS_W + 9 * MiB, W_GLA_IN = WS_W + 13 * MiB, W_GLA_OUT = WS_W + 26 * MiB, W_MOE_UP = WS_W + 30 * MiB, W_MOE_DN = WS_W + 286 * MiB;
constexpr size_t WS_GQD = WS_U;
constexpr size_t WS_GKS = WS_W + 414 * MiB;
constexpr size_t WS_GA = WS_GKS + 68 * MiB;
constexpr size_t WS_GCL = WS_GA + 34 * MiB;
constexpr size_t WS_END = WS_GCL + 3 * MiB;
constexpr float EPS = 1e-6f;
constexpr int LDS_BYTES = 147456;
constexpr int RING_BYTES = 131072, MISC_OFF = RING_BYTES + 320;

struct P {
    const float *x, *c, *ctx, *c_ctx, *ada_w, *ada_b, *norm1_g, *norm2_g, *attn_w_in, *attn_w_out,
        *a_q_norm, *a_k_norm, *b_q_norm, *b_k_norm, *na_rpb, *gla_w_in, *gk_w_f, *gk_b_f, *gk_w_b, *gk_b_b,
        *gla_o_norm, *gla_w_out, *moe_router, *moe_w_gate, *moe_w_up, *moe_w_down;
    float* out; unsigned char* ws;
    int ph_lo, ph_hi, seg, pad;
};

__device__ __forceinline__ float bf2f(bf16_t v) { return __uint_as_float(((unsigned)v) << 16); }
__device__ __forceinline__ unsigned f2bf(float f) { unsigned u = __float_as_uint(f); return (u + 0x7fffu + ((u >> 16) & 1u)) >> 16; }
__device__ __forceinline__ unsigned pk2(float lo, float hi) { return f2bf(lo) | (f2bf(hi) << 16); }
__device__ __forceinline__ int hw_tid() {
    int t; asm volatile("v_mbcnt_lo_u32_b32 %0, -1, 0\n\tv_mbcnt_hi_u32_b32 %0, -1, %0" : "=v"(t)); return t;
}
template <int X> __device__ __forceinline__ float swz_xor(float v) { return __uint_as_float((unsigned)__builtin_amdgcn_ds_swizzle((int)__float_as_uint(v), (X << 10) | 0x1f)); }
__device__ __forceinline__ float wave_sum(float v) {
    v += swz_xor<1>(v); v += swz_xor<2>(v); v += swz_xor<4>(v); v += swz_xor<8>(v); v += swz_xor<16>(v);
    auto rr = __builtin_amdgcn_permlane32_swap(__float_as_uint(v), __float_as_uint(v), false, false);
    return __uint_as_float(rr[0]) + __uint_as_float(rr[1]);
}
__device__ __forceinline__ float silu_f(float x) { return x / (1.f + __expf(-x)); }
__device__ __forceinline__ int mod_row(int row) { const int b = row / RPB, t = row - b * RPB; return t < SEQ ? b : 8; }

namespace pg8 {
constexpr int BM = 256, BK = 64, HALF = 128, HTB = HALF * BK * 2, STAGE_BYTES = 8 * HTB, NXCD = 8, WGM = 8;
__device__ __forceinline__ int lds_byte(int r, int c) { const int st = (r >> 4) * 2 + (c >> 5), rr = r & 15, cc = c & 31, ob = rr * 64 + cc * 2; return st * 1024 + (ob ^ (((ob >> 9) & 1) << 5)); }
__device__ __forceinline__ void stage_rc(int b, int& R, int& C) { const int st = b / 1024, sb = b % 1024, swz = sb ^ (((sb >> 9) & 1) << 5); R = (st >> 1) * 16 + swz / 64; C = (st & 1) * 32 + (swz % 64) / 2; }
__device__ __forceinline__ int perm32(int rho) { const int n = rho >> 4, i = rho & 15; return 8 * (i >> 2) + 4 * n + (i & 3); }
struct Unit { int pm, pn; };
struct Gemm { const bf16_t* A; const bf16_t* Bt; int M, N; const int* gather; size_t bgroup; };
struct StaticOrder {
    int nM, nN, nwg, G, c, skip17;
    __device__ void init(int M, int N, int G_, int c_, int skip17_ = 0) { nM = M / BM; nN = N / BM; nwg = nM * nN; G = G_; c = c_; skip17 = skip17_; }
    __device__ bool next(int i, Unit& u) const {
        const long L = (long)i * G + c; if (L >= nwg) return false;
        int wgid = (int)L; { const int q = nwg / NXCD, r = nwg % NXCD, xcd = wgid % NXCD, off = wgid / NXCD; wgid = (xcd < r ? xcd * (q + 1) : r * (q + 1) + (xcd - r) * q) + off; }
        const int nig = WGM * nN, gid = wgid / nig, fm = gid * WGM, gsz = (nM - fm) < WGM ? (nM - fm) : WGM;
        u.pm = fm + ((wgid % nig) % gsz); u.pn = (wgid % nig) / gsz; if (skip17) u.pm += u.pm >> 4; return true;
    }
};
typedef float f32x2_t_ __attribute__((ext_vector_type(2))); typedef __bf16 bf16x2_t_ __attribute__((ext_vector_type(2)));
__device__ __forceinline__ unsigned cvt_pk_bf16(float lo, float hi) { f32x2_t_ v = {lo, hi}; bf16x2_t_ b = __builtin_convertvector(v, bf16x2_t_); return __builtin_bit_cast(unsigned, b); }
__device__ __forceinline__ int expert_of_tile(int pm) { return pm < 256 ? (pm >> 4) : (pm - 256); }

struct EpiBf16 {
    static constexpr bool PERM = true;
    bf16_t* O; int ldc; const float* rowscale;
    __device__ __forceinline__ void operator()(const f32x4 (&acc)[2][2][4][2], const Unit& u, int wr, int wc, int fr, int fq) const {
        const int row0 = u.pm * BM + wr * 64 + fr, col0 = u.pn * BM + wc * 32 + 8 * fq;
#pragma unroll
        for (int ai = 0; ai < 2; ++ai)
#pragma unroll
            for (int m = 0; m < 4; ++m) { bf16_t* rowp = O + (size_t)(row0 + ai * HALF + m * 16) * ldc + col0;
                const float rsc = rowscale ? rowscale[row0 + ai * HALF + m * 16] : 1.f;
#pragma unroll
                for (int bj = 0; bj < 2; ++bj) { const f32x4 v0 = acc[ai][bj][m][0] * rsc, v1 = acc[ai][bj][m][1] * rsc;
                    u32x4 w; w.x = cvt_pk_bf16(v0[0], v0[1]); w.y = cvt_pk_bf16(v0[2], v0[3]); w.z = cvt_pk_bf16(v1[0], v1[1]); w.w = cvt_pk_bf16(v1[2], v1[3]);
                    *(u32x4*)(rowp + bj * HALF) = w; } }
    }
};
struct EpiQKV {
    static constexpr bool PERM = true;
    bf16_t* O; const float* qkg; const float* rope;
    __device__ __forceinline__ void operator()(const f32x4 (&acc)[2][2][4][2], const Unit& u, int wr, int wc, int fr, int fq) const {
        const int sg = 4 * u.pn + wc;
        const int b = u.pm / 17, tt = u.pm - b * 17;
        const int row0 = u.pm * BM + wr * 64 + fr, col0 = sg * 64 + 8 * fq;
        const bool is_q = sg < 8 || (sg >= 12 && sg < 20), is_v = sg == 10 || sg == 11 || sg >= 28;
        const bool do_rope = sg < 10 && tt < 16;
        const float* gp = qkg + 64 * (sg < 8 ? 0 : (sg < 10 ? 1 : (sg < 20 ? 2 : 3)));
        const float qsc = is_q ? 0.18033688011112042f : 1.f;
        const int lane_hi = fq >> 1;
#pragma unroll
        for (int ai = 0; ai < 2; ++ai)
#pragma unroll
            for (int m = 0; m < 4; ++m) {
                f32x4 v[2][2];
                float ss = 0.f;
#pragma unroll
                for (int bj = 0; bj < 2; ++bj)
#pragma unroll
                    for (int n = 0; n < 2; ++n) { v[bj][n] = acc[ai][bj][m][n]; ss += (v[bj][n][0] * v[bj][n][0] + v[bj][n][1] * v[bj][n][1]) + (v[bj][n][2] * v[bj][n][2] + v[bj][n][3] * v[bj][n][3]); }
                if (!is_v) {
                    ss += swz_xor<16>(ss);
                    { auto rr = __builtin_amdgcn_permlane32_swap(__float_as_uint(ss), __float_as_uint(ss), false, false); ss = __uint_as_float(rr[0]) + __uint_as_float(rr[1]); }
                    const float rs = rsqrtf(ss * (1.f / 64.f) + EPS) * qsc;
                    const float* gpl = gp + 8 * fq; asm volatile("" : "+v"(gpl));
#pragma unroll
                    for (int bj = 0; bj < 2; ++bj)
#pragma unroll
                        for (int n = 0; n < 2; ++n) v[bj][n] = v[bj][n] * rs * *(const f32x4*)(gpl + 32 * bj + 4 * n);
                    if (do_rope) {
                        const int posr = tt * 4 + 2 * ai + wr, posc = 16 * m + fr;
#pragma unroll
                        for (int bj = 0; bj < 2; ++bj) {
                            const float* tb = rope + (bj ? posc : posr) * 16 + 8 * (fq & 1);
#pragma unroll
                            for (int n = 0; n < 2; ++n) {
                                const f32x4 cs = *(const f32x4*)(tb + 4 * n), sn = *(const f32x4*)(tb + 1024 + 4 * n);
                                f32x4 ot;
#pragma unroll
                                for (int e = 0; e < 4; ++e) { auto rr = __builtin_amdgcn_permlane32_swap(__float_as_uint(v[bj][n][e]), __float_as_uint(v[bj][n][e]), false, false);
                                    const float other = __uint_as_float(lane_hi ? rr[0] : rr[1]); ot[e] = lane_hi ? other : -other; }
                                v[bj][n] = v[bj][n] * cs + ot * sn;
                            }
                        }
                    }
                }
                bf16_t* rowp = O + (size_t)(row0 + ai * HALF + m * 16) * 2304 + col0;
#pragma unroll
                for (int bj = 0; bj < 2; ++bj) { u32x4 w; w.x = cvt_pk_bf16(v[bj][0][0], v[bj][0][1]); w.y = cvt_pk_bf16(v[bj][0][2], v[bj][0][3]); w.z = cvt_pk_bf16(v[bj][1][0], v[bj][1][1]); w.w = cvt_pk_bf16(v[bj][1][2], v[bj][1][3]);
                    *(u32x4*)(rowp + 32 * bj) = w; }
            }
    }
};
struct EpiGlaIn {
    static constexpr bool PERM = true;
    bf16_t* O; float* Z;
    __device__ __forceinline__ void operator()(const f32x4 (&acc)[2][2][4][2], const Unit& u, int wr, int wc, int fr, int fq) const {
        const int row0 = u.pm * BM + wr * 64 + fr;
        if (u.pn < 12) {
            const int col0 = u.pn * BM + wc * 32 + 8 * fq;
#pragma unroll
            for (int ai = 0; ai < 2; ++ai)
#pragma unroll
                for (int m = 0; m < 4; ++m) { bf16_t* rowp = O + (size_t)(row0 + ai * HALF + m * 16) * 3072 + col0;
#pragma unroll
                    for (int bj = 0; bj < 2; ++bj) { const f32x4 v0 = acc[ai][bj][m][0], v1 = acc[ai][bj][m][1];
                        u32x4 w; w.x = cvt_pk_bf16(v0[0], v0[1]); w.y = cvt_pk_bf16(v0[2], v0[3]); w.z = cvt_pk_bf16(v1[0], v1[1]); w.w = cvt_pk_bf16(v1[2], v1[3]);
                        *(u32x4*)(rowp + bj * HALF) = w; } }
        } else if (wc == 0) {
#pragma unroll
            for (int ai = 0; ai < 2; ++ai)
#pragma unroll
                for (int m = 0; m < 4; ++m) { float* zp = Z + (size_t)(row0 + ai * HALF + m * 16) * 32 + 8 * fq;
                    *(f32x4*)(zp) = acc[ai][0][m][0]; *(f32x4*)(zp + 4) = acc[ai][0][m][1]; }
        }
    }
};
struct EpiResid {
    static constexpr bool PERM = true;
    bf16_t* hb; const float* mods_l; const float* slat; const float* sctx;
    __device__ __forceinline__ void operator()(const f32x4 (&acc)[2][2][4][2], const Unit& u, int wr, int wc, int fr, int fq) const {
        const int b = u.pm / 17, tt = u.pm - b * 17;
        const int mr = tt < 16 ? b : 8;
        const int col0 = u.pn * BM + wc * 32 + 8 * fq;
        bf16_t* base = hb + (size_t)(u.pm * BM + wr * 64 + fr) * D + col0;
        const float* g2 = mods_l + (size_t)mr * 6144 + 2 * 1024 + col0;
        f32x4 gv[2][2];
#pragma unroll
        for (int bj = 0; bj < 2; ++bj)
#pragma unroll
            for (int n = 0; n < 2; ++n) gv[bj][n] = *(const f32x4*)(g2 + bj * HALF + n * 4);
        if (slat != nullptr) {
            const float* sbase = (tt < 16 ? slat + (size_t)(b * SEQ + tt * 256) * D : sctx + (size_t)(b * CTXL) * D) + (size_t)(wr * 64 + fr) * D + col0;
#pragma unroll
            for (int ai = 0; ai < 2; ++ai) {
                f32x4 hv[4][2][2];
#pragma unroll
                for (int m = 0; m < 4; ++m) { const float* rowp = sbase + (size_t)(ai * HALF + m * 16) * D;
#pragma unroll
                    for (int bj = 0; bj < 2; ++bj)
#pragma unroll
                        for (int n = 0; n < 2; ++n) hv[m][bj][n] = *(const f32x4*)(rowp + bj * HALF + n * 4); }
#pragma unroll
                for (int m = 0; m < 4; ++m) { bf16_t* rowp = base + (size_t)(ai * HALF + m * 16) * D;
#pragma unroll
                    for (int bj = 0; bj < 2; ++bj) { const f32x4 r0 = hv[m][bj][0] + gv[bj][0] * acc[ai][bj][m][0], r1 = hv[m][bj][1] + gv[bj][1] * acc[ai][bj][m][1];
                        *(u32x4*)(rowp + bj * HALF) = (u32x4){cvt_pk_bf16(r0[0], r0[1]), cvt_pk_bf16(r0[2], r0[3]), cvt_pk_bf16(r1[0], r1[1]), cvt_pk_bf16(r1[2], r1[3])}; } }
            }
        } else {
#pragma unroll
            for (int ai = 0; ai < 2; ++ai) {
                u32x4 hv[4][2];
#pragma unroll
                for (int m = 0; m < 4; ++m) { const bf16_t* rowp = base + (size_t)(ai * HALF + m * 16) * D;
#pragma unroll
                    for (int bj = 0; bj < 2; ++bj) hv[m][bj] = *(const u32x4*)(rowp + bj * HALF); }
#pragma unroll
                for (int m = 0; m < 4; ++m) { bf16_t* rowp = base + (size_t)(ai * HALF + m * 16) * D;
#pragma unroll
                    for (int bj = 0; bj < 2; ++bj) { const u32x4 t = hv[m][bj];
                        const f32x4 h0 = (f32x4){__uint_as_float(t.x << 16), __uint_as_float(t.x & 0xffff0000u), __uint_as_float(t.y << 16), __uint_as_float(t.y & 0xffff0000u)};
                        const f32x4 h1 = (f32x4){__uint_as_float(t.z << 16), __uint_as_float(t.z & 0xffff0000u), __uint_as_float(t.w << 16), __uint_as_float(t.w & 0xffff0000u)};
                        const f32x4 r0 = h0 + gv[bj][0] * acc[ai][bj][m][0], r1 = h1 + gv[bj][1] * acc[ai][bj][m][1];
                        *(u32x4*)(rowp + bj * HALF) = (u32x4){cvt_pk_bf16(r0[0], r0[1]), cvt_pk_bf16(r0[2], r0[3]), cvt_pk_bf16(r1[0], r1[1]), cvt_pk_bf16(r1[2], r1[3])}; } }
            }
        }
    }
};
struct EpiSwiGLU {
    static constexpr bool PERM = true;
    bf16_t* O;
    __device__ __forceinline__ void operator()(const f32x4 (&acc)[2][2][4][2], const Unit& u, int wr, int wc, int fr, int fq) const {
        const int row0 = u.pm * BM + wr * 64 + fr, col0 = u.pn * HALF + wc * 32 + 8 * fq;
#pragma unroll
        for (int ai = 0; ai < 2; ++ai)
#pragma unroll
            for (int m = 0; m < 4; ++m) { bf16_t* rowp = O + (size_t)(row0 + ai * HALF + m * 16) * 1024 + col0;
                float r[8];
#pragma unroll
                for (int n = 0; n < 2; ++n)
#pragma unroll
                    for (int e = 0; e < 4; ++e) { const float g = acc[ai][0][m][n][e], up = acc[ai][1][m][n][e]; r[n * 4 + e] = g * __builtin_amdgcn_rcpf(1.f + __expf(-g)) * up; }
                u32x4 w; w.x = cvt_pk_bf16(r[0], r[1]); w.y = cvt_pk_bf16(r[2], r[3]); w.z = cvt_pk_bf16(r[4], r[5]); w.w = cvt_pk_bf16(r[6], r[7]);
                *(u32x4*)rowp = w; }
    }
};

__device__ __forceinline__ void glds16_s(const char* sbase, unsigned voff, unsigned lds_dst) { unsigned keep;
    asm volatile("s_nop 4\n\ts_mov_b32 %0, m0\n\ts_mov_b32 m0, %3\n\ts_nop 0\n\tglobal_load_lds_dwordx4 %1, %2\n\ts_mov_b32 m0, %0" : "=&s"(keep) : "v"(voff), "s"(sbase), "s"(lds_dst) : "memory"); }
template <class Epi, bool GATHER, bool GROUPED>
__device__ __forceinline__ void gemm_phase(LAS unsigned char* lds, const Gemm g, const StaticOrder& S, const Epi& E, const int wv_) {
    const int tid = (wv_ << 6) | hw_tid();
    const int wid = wv_, lane = tid & 63, wr = wid >> 2, wc = wid & 3, fr = lane & 15, fq = lane >> 4;
    constexpr int K = 1024, nt = K / BK;
    unsigned voffA[2], voffB[2];
#pragma unroll
    for (int i = 0; i < 2; ++i) { int R, C; stage_rc(tid * 16 + i * 8192, R, C); const int Rb = Epi::PERM ? ((R & ~31) + perm32(R & 31)) : R;
        voffA[i] = (unsigned)(R * K + C) * 2u; voffB[i] = (unsigned)(Rb * K + C) * 2u; }
#define PG8_RA(i) ((int)(voffA[i] >> 11))
#define PG8_CA(i) (voffA[i] & 2047u)
    constexpr size_t kstep = (size_t)(BK * 2);
    constexpr size_t hstep = (size_t)HALF * K * 2;
    constexpr size_t tstep = 2 * hstep;
    const unsigned ldsw = (unsigned)wid * 1024u, lds0 = (unsigned)(size_t)lds;
    const int aoff = lds_byte(wr * 64 + fr, fq * 8), boff = lds_byte(wc * 32 + fr, fq * 8);
#define PG8_SA(b, h) (((b) * 2 + (h)) * HTB)
#define PG8_SB(b, h) ((4 + (b) * 2 + (h)) * HTB)
#define PG8_STAGE_B(bufoff, gbase) do { _Pragma("unroll") for (int _i = 0; _i < 2; ++_i) \
        glds16_s((const char*)(gbase), voffB[_i], lds0 + (unsigned)(bufoff) + ldsw + (unsigned)(_i * 8192)); } while (0)
#define PG8_STAGE_A(bufoff, kp, h, O) do { _Pragma("unroll") for (int _i = 0; _i < 2; ++_i) { \
        if (GATHER) glds16_s((const char*)(kp), (O)[h][_i], lds0 + (unsigned)(bufoff) + ldsw + (unsigned)(_i * 8192)); \
        else glds16_s((const char*)(kp) + (size_t)(h) * hstep, voffA[_i], lds0 + (unsigned)(bufoff) + ldsw + (unsigned)(_i * 8192)); } } while (0)
#define PG8_LDA(dst, b, h) do { _Pragma("unroll") for (int m = 0; m < 4; ++m) _Pragma("unroll") for (int k = 0; k < 2; ++k) dst[m][k] = *(const LAS bf16x8*)(lds + PG8_SA(b, h) + aoff + m * 2048 + k * 1024); } while (0)
#define PG8_LDB(dst, b, h) do { _Pragma("unroll") for (int n = 0; n < 2; ++n) _Pragma("unroll") for (int k = 0; k < 2; ++k) dst[n][k] = *(const LAS bf16x8*)(lds + PG8_SB(b, h) + boff + n * 2048 + k * 1024); } while (0)
#define PG8_MMA(ai, bj, At, Bt) do { __builtin_amdgcn_s_setprio(1); _Pragma("unroll") for (int m = 0; m < 4; ++m) _Pragma("unroll") for (int n = 0; n < 2; ++n) _Pragma("unroll") for (int k = 0; k < 2; ++k) \
        acc[ai][bj][m][n] = __builtin_amdgcn_mfma_f32_16x16x32_bf16(Bt[n][k], At[m][k], acc[ai][bj][m][n], 0, 0, 0); __builtin_amdgcn_s_setprio(0); } while (0)
#define PG8_WAIT_V(n) asm volatile("s_waitcnt vmcnt(" #n ")" ::: "memory")
#define PG8_WAIT_L(n) asm volatile("s_waitcnt lgkmcnt(" #n ")" ::: "memory")
#define PG8_BAR __builtin_amdgcn_s_barrier()
#define PG8_SCHED __builtin_amdgcn_sched_barrier(0)
#define PG8_BOF(u) ((const char*)g.Bt + (GROUPED ? (size_t)expert_of_tile((u).pm) * g.bgroup : (size_t)0) + (size_t)(u).pn * tstep)
#define PG8_AOF(u) (GATHER ? (const char*)g.A : (const char*)g.A + (size_t)(u).pm * tstep)
    Unit cur, nxt; int ui = 0;
    if (!S.next(0, cur)) return;
    unsigned oc[2][2], on[2][2]; unsigned rn[2];
#pragma unroll
    for (int h = 0; h < 2; ++h)
#pragma unroll
        for (int i = 0; i < 2; ++i) { oc[h][i] = 0u; on[h][i] = 0u; rn[h] = 0u; }
    if (GATHER) {
#pragma unroll
        for (int h = 0; h < 2; ++h)
#pragma unroll
            for (int i = 0; i < 2; ++i) { int row = g.gather[cur.pm * BM + h * HALF + PG8_RA(i)]; row = row < 0 ? 0 : (row >= NR ? NR - 1 : row); oc[h][i] = (unsigned)row * (unsigned)(K * 2) + PG8_CA(i); }
    }
    f32x4 acc[2][2][4][2];
#pragma unroll
    for (int a = 0; a < 2; ++a)
#pragma unroll
        for (int b = 0; b < 2; ++b)
#pragma unroll
            for (int m = 0; m < 4; ++m)
#pragma unroll
                for (int n = 0; n < 2; ++n) acc[a][b][m][n] = (f32x4){0.f, 0.f, 0.f, 0.f};
    bf16x8 At[4][2], B0[2][2], B1[2][2];
    const char* cA = PG8_AOF(cur); const char* cB = PG8_BOF(cur);
    PG8_STAGE_B(PG8_SB(0, 0), cB); PG8_STAGE_B(PG8_SB(0, 1), cB + hstep); PG8_STAGE_A(PG8_SA(0, 0), cA, 0, oc); PG8_STAGE_A(PG8_SA(0, 1), cA, 1, oc);
    if (wr == 1) PG8_BAR;
    PG8_WAIT_V(2); PG8_BAR;
    PG8_STAGE_B(PG8_SB(1, 0), cB + kstep); PG8_STAGE_A(PG8_SA(1, 0), cA + kstep, 0, oc); PG8_STAGE_B(PG8_SB(1, 1), cB + hstep + kstep);
    PG8_WAIT_V(6); PG8_BAR;
#define PG8_KBODY(LAST, O2) do { \
            const char* a1 = cA + (size_t)(t + 1) * kstep; \
            const char* a2 = (LAST) ? nA : cA + (size_t)(t + 2) * kstep; const char* b2 = (LAST) ? nB : cB + (size_t)(t + 2) * kstep; \
            const char* a3 = a2 + kstep; const char* b3 = b2 + kstep; \
            PG8_LDB(B0, 0, 0); PG8_LDB(B1, 0, 1); PG8_SCHED; PG8_LDA(At, 0, 0); PG8_STAGE_A(PG8_SA(1, 1), a1, 1, oc); \
            PG8_WAIT_V(8); PG8_WAIT_L(0); PG8_BAR; PG8_MMA(0, 0, At, B0); PG8_MMA(0, 1, At, B1); PG8_BAR; PG8_SCHED; \
            PG8_LDA(At, 0, 1); PG8_STAGE_B(PG8_SB(0, 0), b2); PG8_STAGE_B(PG8_SB(0, 1), b2 + hstep); PG8_STAGE_A(PG8_SA(0, 0), a2, 0, O2); \
            PG8_WAIT_V(8); PG8_WAIT_L(0); PG8_BAR; PG8_MMA(1, 0, At, B0); PG8_MMA(1, 1, At, B1); PG8_BAR; PG8_SCHED; \
            PG8_LDB(B0, 1, 0); PG8_LDB(B1, 1, 1); PG8_SCHED; PG8_LDA(At, 1, 0); PG8_STAGE_A(PG8_SA(0, 1), a2, 1, O2); \
            PG8_WAIT_V(8); PG8_WAIT_L(0); PG8_BAR; PG8_MMA(0, 0, At, B0); PG8_MMA(0, 1, At, B1); PG8_BAR; PG8_SCHED; \
            PG8_LDA(At, 1, 1); PG8_STAGE_B(PG8_SB(1, 0), b3); PG8_STAGE_B(PG8_SB(1, 1), b3 + hstep); PG8_STAGE_A(PG8_SA(1, 0), a3, 0, O2); \
            PG8_WAIT_V(8); PG8_WAIT_L(0); PG8_BAR; PG8_MMA(1, 0, At, B0); PG8_MMA(1, 1, At, B1); PG8_BAR; PG8_SCHED; \
        } while (0)
    for (;;) {
        const bool has_next = S.next(ui + 1, nxt);
        const char* nA = has_next ? PG8_AOF(nxt) : cA; const char* nB = has_next ? PG8_BOF(nxt) : cB;
        if (GATHER && has_next) {
            const int t2 = (wv_ << 6) | hw_tid();
            int R0, C0, R1, C1; stage_rc(t2 * 16, R0, C0); stage_rc(t2 * 16 + 8192, R1, C1);
            const int* gp = g.gather + nxt.pm * BM;
            rn[0] = ((unsigned)gp[R0] & 0xffffu) | ((unsigned)gp[R1] << 16); rn[1] = ((unsigned)gp[HALF + R0] & 0xffffu) | ((unsigned)gp[HALF + R1] << 16);
        }
        int t = 0;
#pragma unroll 1
        for (; t < nt - 2; t += 2) PG8_KBODY(false, oc);
        if (GATHER) {
#pragma unroll
            for (int h = 0; h < 2; ++h)
#pragma unroll
                for (int i = 0; i < 2; ++i) { int row = (int)(i ? (rn[h] >> 16) : (rn[h] & 0xffffu)); row = row >= NR ? NR - 1 : row; on[h][i] = has_next ? (unsigned)row * (unsigned)(K * 2) + (oc[h][i] & 2047u) : oc[h][i]; }
        }
        PG8_KBODY(true, on);
        if (wr == 0) PG8_BAR;
        { const int l2 = hw_tid(); E(acc, cur, wr, wc, l2 & 15, l2 >> 4); }
        if (!has_next) break;
#pragma unroll
        for (int a = 0; a < 2; ++a)
#pragma unroll
            for (int b = 0; b < 2; ++b)
#pragma unroll
                for (int m = 0; m < 4; ++m)
#pragma unroll
                    for (int n = 0; n < 2; ++n) acc[a][b][m][n] = (f32x4){0.f, 0.f, 0.f, 0.f};
        cur = nxt; cA = nA; cB = nB; ++ui;
        if (GATHER) {
#pragma unroll
            for (int h = 0; h < 2; ++h)
#pragma unroll
                for (int i = 0; i < 2; ++i) oc[h][i] = on[h][i];
        }
        if (wr == 1) PG8_BAR;
    }
    PG8_WAIT_V(0);
    PG8_BAR;
#undef PG8_KBODY
#undef PG8_RA
#undef PG8_CA
#undef PG8_SA
#undef PG8_SB
#undef PG8_STAGE_A
#undef PG8_STAGE_B
#undef PG8_LDA
#undef PG8_LDB
#undef PG8_MMA
#undef PG8_WAIT_V
#undef PG8_WAIT_L
#undef PG8_BAR
#undef PG8_SCHED
#undef PG8_BOF
#undef PG8_AOF
}
}

#define XB_TMO      128
#define XB_XCNT(j)  (256  + 64 * (j))
#define XB_XSUB(j)  (1280 + 64 * (j))
#define XB_XGEN(j)  (2304 + 64 * (j))
#define XB_TOP      3328
#define XB_TOPGEN   3392
#define XCD_BAR_WORDS 3456
#define XB_SPIN_CAP (1u << 22)
__device__ __forceinline__ unsigned xb_ld(unsigned* p)              { return __hip_atomic_load(p, __ATOMIC_RELAXED, __HIP_MEMORY_SCOPE_AGENT); }
__device__ __forceinline__ unsigned xb_add(unsigned* p, unsigned v) { return __hip_atomic_fetch_add(p, v, __ATOMIC_RELAXED, __HIP_MEMORY_SCOPE_AGENT); }
__device__ __forceinline__ unsigned xb_xcc_id() { return (unsigned)__builtin_amdgcn_s_getreg((3 << 11) | 20) & 0xFu; }
#define XB_SPIN(cond, bar) do { unsigned _sp = 0; while (cond) { __builtin_amdgcn_s_sleep(1); \
    if ((++_sp & 255u) == 0u) { if (xb_ld(&(bar)[XB_TMO])) break; if (_sp > XB_SPIN_CAP) { atomicAdd(&(bar)[XB_TMO], 1u); break; } } } } while (0)
struct XcdBarrier { unsigned* bar; unsigned x; volatile LAS unsigned* st; };
__device__ __forceinline__ XcdBarrier xcd_barrier_post(unsigned* bar, volatile LAS unsigned* st) {
    XcdBarrier b; b.bar = bar; b.x = xb_xcc_id(); b.st = st;
    if (threadIdx.x == 0) (void)xb_add(&bar[XB_XCNT(b.x)], 1u);
    return b;
}
__device__ __forceinline__ void xcd_barrier_complete(unsigned* bar, unsigned x, unsigned& nloc, unsigned& nx) {
    const unsigned G = gridDim.x * gridDim.y * gridDim.z;
    unsigned sum, cnt, mine, sp = 0u;
    for (;;) {
        sum = 0u; cnt = 0u; mine = 0u;
#pragma unroll
        for (unsigned j = 0; j < 16; ++j) { const unsigned c = xb_ld(&bar[XB_XCNT(j)]); sum += c; cnt += (c > 0u) ? 1u : 0u; mine = (j == x) ? c : mine; }
        if (sum == G) break;
        __builtin_amdgcn_s_sleep(1);
        if ((++sp & 255u) == 0u) { if (xb_ld(&bar[XB_TMO])) break; if (sp > XB_SPIN_CAP) { atomicAdd(&bar[XB_TMO], 1u); break; } }
    }
    nloc = mine > 0u ? mine : 1u; nx = cnt > 0u ? cnt : 1u;
}
__device__ __forceinline__ void xcd_barrier(const XcdBarrier& b, const int wv_) {
    asm volatile("s_waitcnt vmcnt(0)" ::: "memory");
    __syncthreads();
    if (wv_ == 0 && hw_tid() == 0) {
        unsigned* bar = b.bar; asm volatile("" : "+s"(bar));
        __builtin_amdgcn_s_waitcnt(0);
        unsigned nloc = b.st[0], nx = b.st[1];
        if (nloc == 0u) { xcd_barrier_complete(bar, b.x, nloc, nx); b.st[0] = nloc; b.st[1] = nx; }
        const unsigned old = xb_add(&bar[XB_XSUB(b.x)], 1u);
        const unsigned gen = old / nloc;
        if (old + 1u == (gen + 1u) * nloc) {
            __builtin_amdgcn_fence(__ATOMIC_RELEASE, "agent");
            asm volatile("s_waitcnt vmcnt(0)" ::: "memory");
            const unsigned og = xb_add(&bar[XB_TOP], 1u);
            const unsigned tg = og / nx;
            if (og + 1u == (tg + 1u) * nx) xb_add(&bar[XB_TOPGEN], 1u);
            else XB_SPIN(xb_ld(&bar[XB_TOPGEN]) == tg, bar);
            __builtin_amdgcn_fence(__ATOMIC_ACQUIRE, "agent");
            xb_add(&bar[XB_XGEN(b.x)], 1u);
            asm volatile("s_waitcnt vmcnt(0)" ::: "memory");
        } else {
            XB_SPIN(xb_ld(&bar[XB_XGEN(b.x)]) == gen, bar);
            __builtin_amdgcn_fence(__ATOMIC_ACQUIRE, "agent");
            asm volatile("s_waitcnt vmcnt(0)" ::: "memory");
        }
    }
    __syncthreads();
}

__device__ __forceinline__ void p0_transpose_item(const float* W, int N, int kb, int n0, bf16_t* WTrow0  , LAS float* scr, int lane) {
    const int k0 = 64 * kb;
#pragma unroll 8
    for (int i = 0; i < 32; ++i) { const int kk = 2 * i + (lane >> 5); scr[kk * 33 + (lane & 31)] = W[(size_t)(k0 + kk) * N + n0 + (lane & 31)]; }
    asm volatile("s_waitcnt lgkmcnt(0)" ::: "memory");
    const int c = lane & 7;
#pragma unroll
    for (int j = 0; j < 4; ++j) { const int n = (lane >> 3) + 8 * j; const LAS float* s = scr + (8 * c) * 33 + n;
        u32x4 o; o.x = pk2(s[0 * 33], s[1 * 33]); o.y = pk2(s[2 * 33], s[3 * 33]); o.z = pk2(s[4 * 33], s[5 * 33]); o.w = pk2(s[6 * 33], s[7 * 33]);
        *(u32x4*)(WTrow0 + (size_t)n * 1024 + k0 + 8 * c) = o; }
    asm volatile("s_waitcnt lgkmcnt(0)" ::: "memory");
}
constexpr int MOE_ITEMS = 48 * 512, MOE_ALL = 4 * MOE_ITEMS;
constexpr int MOE_PRO = 6144, WIN_B = 224 * 8 * 4, WIN_C = 128 * 8 * 5, WIN_D = 128 * 8 * 7, WIN_E = 192 * 8 * 5;
__device__ __forceinline__ int win_capA(int layer) { return (layer & 1) ? 24 * 8 * 10 : 56 * 8 * 10; }
__device__ __forceinline__ int win_layer_start(int layer) {
    const int full_even = 56 * 8 * 10 + WIN_B + WIN_C + WIN_D + WIN_E, full_odd = 24 * 8 * 10 + WIN_B + WIN_C + WIN_D + WIN_E;
    return MOE_PRO + (layer > 0 ? full_even : 0) + (layer > 1 ? full_odd : 0) + (layer > 2 ? full_even : 0);
}
__device__ __forceinline__ void moe_item_decode(const P& p, unsigned char* ws, int layer, int q, const float*& src, bf16_t*& dst) {
    const int mat = q >> 9, rr = q & 511, kb = rr >> 5, n0 = (rr & 31) * 32, kind = mat >> 4, le = layer * 16 + (mat & 15);
    if (kind < 2) {
        src = (kind == 0 ? p.moe_w_gate : p.moe_w_up) + (size_t)le * 1024 * 1024 + (size_t)(64 * kb) * 1024 + n0;
        dst = (bf16_t*)(ws + W_MOE_UP) + (size_t)le * 2048 * 1024 + (size_t)((n0 >> 7) * 256 + (n0 & 127) + kind * 128) * 1024 + 64 * kb;
    } else {
        src = p.moe_w_down + (size_t)le * 1024 * 1024 + (size_t)(64 * kb) * 1024 + n0;
        dst = (bf16_t*)(ws + W_MOE_DN) + (size_t)le * 1024 * 1024 + (size_t)n0 * 1024 + 64 * kb;
    }
}
constexpr int X_GLA = 16 * 97 + 16 * 32, X_ATT = 16 * 72 + 16 * 32;
constexpr int X0 = MOE_ITEMS, X1 = X0 + X_GLA, X2 = X1 + MOE_ITEMS, X3 = X2 + X_ATT, X4 = X3 + MOE_ITEMS, X5 = X4 + X_GLA, EXT_ALL = X5 + MOE_ITEMS;
__device__ __forceinline__ void small_item_decode(const P& p, unsigned char* ws, bool gla, int i, int r, const float*& src, int& pitch, bf16_t*& dst) {
    if (gla) {
        if (r < 16 * 97) { const int kb = r / 97, nb = r % 97; pitch = 3104; src = p.gla_w_in + (size_t)i * 1024 * 3104 + (size_t)(64 * kb) * 3104 + nb * 32;
            dst = (bf16_t*)(ws + W_GLA_IN) + (size_t)i * 3328 * 1024 + (size_t)(nb * 32) * 1024 + 64 * kb; }
        else { r -= 16 * 97; const int kb = r / 32, nb = r % 32; pitch = 1024; src = p.gla_w_out + (size_t)i * 1024 * 1024 + (size_t)(64 * kb) * 1024 + nb * 32;
            dst = (bf16_t*)(ws + W_GLA_OUT) + (size_t)i * 1024 * 1024 + (size_t)(nb * 32) * 1024 + 64 * kb; }
    } else {
        if (r < 16 * 72) { const int kb = r / 72, nb = r % 72, n0 = nb * 32, drow = (n0 & ~255) + 128 * ((n0 >> 5) & 1) + 32 * ((n0 >> 6) & 3);
            pitch = 2304; src = p.attn_w_in + (size_t)i * 1024 * 2304 + (size_t)(64 * kb) * 2304 + n0;
            dst = (bf16_t*)(ws + W_ATTN_IN) + (size_t)i * 2304 * 1024 + (size_t)drow * 1024 + 64 * kb; }
        else { r -= 16 * 72; const int kb = r / 32, nb = r % 32; pitch = 1024; src = p.attn_w_out + (size_t)i * 1024 * 1024 + (size_t)(64 * kb) * 1024 + nb * 32;
            dst = (bf16_t*)(ws + W_ATTN_OUT) + (size_t)i * 1024 * 1024 + (size_t)(nb * 32) * 1024 + 64 * kb; }
    }
}
__device__ __forceinline__ void ext_item_decode(const P& p, unsigned char* ws, int h, const float*& src, int& pitch, bf16_t*& dst) {
    pitch = 1024;
    if (h < X0) moe_item_decode(p, ws, 0, h, src, dst);
    else if (h < X1) small_item_decode(p, ws, true, 0, h - X0, src, pitch, dst);
    else if (h < X2) moe_item_decode(p, ws, 1, h - X1, src, dst);
    else if (h < X3) small_item_decode(p, ws, false, 1, h - X2, src, pitch, dst);
    else if (h < X4) moe_item_decode(p, ws, 2, h - X3, src, dst);
    else if (h < X5) small_item_decode(p, ws, true, 1, h - X4, src, pitch, dst);
    else moe_item_decode(p, ws, 3, h - X5, src, dst);
}
__device__ __forceinline__ void moe_convert_win(const P& p, LAS unsigned char* lds, int g0, int npw, int gend, const int wv_) {
    unsigned char* ws = p.ws; asm volatile("" : "+s"(ws));
    const int lane = hw_tid();
    LAS float* scr = (LAS float*)(lds + wv_ * 16384);
    float va[32], vb[32]; bf16_t* da; bf16_t* db;
    int g = g0 + wv_;
    if (gend > EXT_ALL) gend = EXT_ALL;
    if (g < gend) { const float* sa; int pa; ext_item_decode(p, ws, g, sa, pa, da); sa += (size_t)(lane >> 5) * pa + (lane & 31);
#pragma unroll
        for (int i = 0; i < 32; ++i) va[i] = sa[(size_t)(2 * i) * pa]; }
#pragma unroll 1
    for (int k = 0; k < npw; ++k, g += 8) {
        if (g >= gend) break;
        const bool more = k + 1 < npw && g + 8 < gend;
        if (more) { const float* sb; int pb; ext_item_decode(p, ws, g + 8, sb, pb, db); sb += (size_t)(lane >> 5) * pb + (lane & 31);
#pragma unroll
            for (int i = 0; i < 32; ++i) vb[i] = sb[(size_t)(2 * i) * pb]; }
#pragma unroll
        for (int i = 0; i < 32; ++i) scr[(2 * i + (lane >> 5)) * 33 + (lane & 31)] = va[i];
        asm volatile("s_waitcnt lgkmcnt(0)" ::: "memory");
        const int c = lane & 7;
#pragma unroll
        for (int j = 0; j < 4; ++j) { const int n = (lane >> 3) + 8 * j; const LAS float* s2 = scr + (8 * c) * 33 + n;
            u32x4 o; o.x = pk2(s2[0 * 33], s2[1 * 33]); o.y = pk2(s2[2 * 33], s2[3 * 33]); o.z = pk2(s2[4 * 33], s2[5 * 33]); o.w = pk2(s2[6 * 33], s2[7 * 33]);
            *(u32x4*)(da + (size_t)n * 1024 + 8 * c) = o; }
        asm volatile("s_waitcnt lgkmcnt(0)" ::: "memory");
        if (more) {
#pragma unroll
            for (int i = 0; i < 32; ++i) va[i] = vb[i];
            da = db; }
    }
}
__device__ __forceinline__ void moe_window(const P& p, LAS unsigned char* lds, int layer, int kind, int blk, const int wv_) {
    const int capA = win_capA(layer), s0 = win_layer_start(layer);
    int start, cap, npw;
    if (kind == 0) { start = s0; cap = capA; npw = 10; }
    else if (kind == 1) { start = s0 + capA; cap = WIN_B; npw = 4; }
    else if (kind == 2) { start = s0 + capA + (layer < 3 ? WIN_B : 0); cap = WIN_C; npw = 5; }
    else if (kind == 3) { start = s0 + capA + WIN_B + WIN_C; cap = WIN_D; npw = 7; }
    else { start = s0 + capA + WIN_B + WIN_C + WIN_D; cap = WIN_E; npw = 5; }
    moe_convert_win(p, lds, start + blk * 8 * npw, npw, start + cap, wv_);
}
__device__ __forceinline__ void phase_prologue(const P& p, LAS unsigned char* lds, int vcu, int G, const int wv_) {
    unsigned char* ws = p.ws; asm volatile("" : "+s"(ws));
    const int tid = (wv_ << 6) | hw_tid();
    const int lane = tid & 63, wave = wv_;
    LAS float* scr = (LAS float*)(lds + wave * 16384);
    const int gw = vcu * NWAVES + wave, NGW = G * NWAVES;
    const int NITEMS = X_ATT + (G == 256 ? MOE_PRO : EXT_ALL);
    for (int it = gw; it < NITEMS; it += NGW) {
        const float* src_; bf16_t* dst_; int pitch_;
        if (it < X_ATT) small_item_decode(p, ws, false, 0, it, src_, pitch_, dst_);
        else ext_item_decode(p, ws, it - X_ATT, src_, pitch_, dst_);
        p0_transpose_item(src_, pitch_, 0, 0, dst_, scr, lane);
    }
    for (int it = gw; it < 2 * 224; it += NGW) { const int i = it / 224, rr = 3104 + it % 224; u32x4* dst = (u32x4*)((bf16_t*)(ws + W_GLA_IN) + (size_t)i * 3328 * 1024 + (size_t)rr * 1024);
        dst[lane] = (u32x4){0u, 0u, 0u, 0u}; dst[lane + 64] = (u32x4){0u, 0u, 0u, 0u}; }
    __syncthreads();
    {
        LAS float* s = (LAS float*)lds;
        LAS float* red = (LAS float*)(lds + 9 * 1024 * 4);
        for (int i = tid; i < 9 * 1024; i += NTHR) { const int r = i >> 10, k = i & 1023; const float v = r < 8 ? p.c[r * 1024 + k] : p.c_ctx[k]; s[i] = v / (1.f + expf(-v)); }
        __syncthreads();
        float* mods = (float*)(ws + WS_MODS);
        for (int u = vcu; u < 384; u += G) {
            const int l = u / 96, cb = u % 96, cl = tid & 63, ks = tid >> 6, col = cb * 64 + cl;
            float acc[9];
#pragma unroll
            for (int r = 0; r < 9; ++r) acc[r] = 0.f;
            const float* w = p.ada_w + (size_t)l * 1024 * 6144 + col;
            for (int k = ks * 128; k < ks * 128 + 128; ++k) { const float wv = w[(size_t)k * 6144];
#pragma unroll
                for (int r = 0; r < 9; ++r) acc[r] += s[r * 1024 + k] * wv; }
#pragma unroll
            for (int r = 0; r < 9; ++r) red[(ks * 9 + r) * 64 + cl] = acc[r];
            __syncthreads();
            for (int i = tid; i < 9 * 64; i += NTHR) { const int r = i >> 6, c2 = i & 63; float v = 0.f;
#pragma unroll
                for (int q = 0; q < 8; ++q) v += red[(q * 9 + r) * 64 + c2];
                const int cc = cb * 64 + c2, chunk = cc >> 10; v += p.ada_b[l * 6144 + cc];
                if (chunk == 1) v = p.norm1_g[l * 1024 + (cc & 1023)] * (1.f + v); else if (chunk == 4) v = p.norm2_g[l * 1024 + (cc & 1023)] * (1.f + v);
                mods[(size_t)(l * 9 + r) * 6144 + cc] = v; }
            __syncthreads();
        }
    }
    if (vcu == 1 % G) { float* qkg = (float*)(ws + WS_ROPE + 16384);
        for (int i = tid; i < 512; i += NTHR) { const int l = i >> 8, ty = (i >> 6) & 3, d = i & 63; const float* src = ty == 0 ? p.a_q_norm : (ty == 1 ? p.a_k_norm : (ty == 2 ? p.b_q_norm : p.b_k_norm)); qkg[i] = src[l * 64 + d]; } }
    if (vcu == 0) { float* tab = (float*)(ws + WS_ROPE);
        for (int i = tid; i < 1024; i += NTHR) { const int pos = i >> 4, j = i & 15; const float inv = powf(10000.f, -(float)j / 16.f); const float a = (float)pos * inv; tab[i] = cosf(a); tab[1024 + i] = sinf(a); } }
}

template <int WHICH> __device__ __forceinline__ void phase_norm(const P& p, int layer, LAS unsigned char* lds, int vcu, int G, const int wv_, const bool lat_only = false) {
    unsigned char* ws = p.ws; asm volatile("" : "+s"(ws));
    const int lane = hw_tid(), tid = (wv_ << 6) | lane, wave = wv_;
    constexpr int NRW = 2;
    const float* mods = (const float*)(ws + WS_MODS);
    constexpr int UT_PITCH = 2064;
    LAS unsigned char* ut_hi = lds; LAS unsigned char* ut_lo = lds + 16 * UT_PITCH; LAS float* rpart0 = (LAS float*)(lds + 32 * UT_PITCH);
    int rstepi = 0;
    bf16x8 wfh[4], wfl[4];
    if (WHICH == 2) {
        const float* rwt = p.moe_router + (size_t)layer * 1024 * 16;
        const int fr = lane & 15, fq = lane >> 4;
#pragma unroll
        for (int ks = 0; ks < 4; ++ks) {
            float wv[8];
#pragma unroll
            for (int i = 0; i < 8; ++i) wv[i] = rwt[(size_t)(128 * wave + 32 * ks + 8 * fq + i) * 16 + fr];
            unsigned hh[4], ll[4];
#pragma unroll
            for (int i = 0; i < 4; ++i) { const unsigned h0 = f2bf(wv[2 * i]), h1 = f2bf(wv[2 * i + 1]); hh[i] = h0 | (h1 << 16);
                ll[i] = pk2(wv[2 * i] - __uint_as_float(h0 << 16), wv[2 * i + 1] - __uint_as_float(h1 << 16)); }
            wfh[ks] = __builtin_bit_cast(bf16x8, (u32x4){hh[0], hh[1], hh[2], hh[3]}); wfl[ks] = __builtin_bit_cast(bf16x8, (u32x4){ll[0], ll[1], ll[2], ll[3]});
        }
    }
    const int nrows = (WHICH == 3 || lat_only) ? NB * SEQ : NR;
    constexpr bool COMB = WHICH == 3 || WHICH == 1;
    f32x4 vn[NRW][4]; u32x2 vnb[NRW][4]; int slotn[NRW];
#define NORM_ROWMAP(rr_) do { if (WHICH == 3 || lat_only) { const int b_ = (rr_) / SEQ, t_ = (rr_) - b_ * SEQ; (rr_) = b_ * RPB + t_; } } while (0)
#define NORM_LOAD(r0_, V_, S_) do { _Pragma("unroll") for (int q = 0; q < NRW; ++q) { int rr = (r0_) + q; NORM_ROWMAP(rr); const int b = rr / RPB, t = rr - b * RPB; \
            if constexpr (WHICH == 0) { const float* src = t < SEQ ? p.x + (size_t)(b * SEQ + t) * D : p.ctx + (size_t)(b * CTXL + (t - SEQ)) * D; \
                _Pragma("unroll") for (int j = 0; j < 4; ++j) V_[q][j] = ((const GAS f32x4*)src)[lane + 64 * j]; } \
            else { const bf16_t* src = (const bf16_t*)(ws + WS_HB) + (size_t)rr * D; (void)b; (void)t; \
                _Pragma("unroll") for (int j = 0; j < 4; ++j) V_##b[q][j] = ((const GAS u32x2*)src)[lane + 64 * j]; } \
            if (COMB) S_[q] = lane < 16 ? ((const GAS int*)(ws + WS_POS))[(size_t)rr * 16 + lane] : -1; } } while (0)
    constexpr int rstep = NWAVES * NRW;
    const int ngrp = nrows / rstep;
    int r0 = (int)(((long)vcu * ngrp) / G) * rstep + wave * NRW;
    const int rend = (int)(((long)(vcu + 1) * ngrp) / G) * rstep;
    int mr_cur = -1; f32x4 shv[4], scv[4], m5v[4];
#pragma unroll
    for (int j = 0; j < 4; ++j) { shv[j] = (f32x4){0.f, 0.f, 0.f, 0.f}; scv[j] = shv[j]; m5v[j] = shv[j]; }
    if (r0 < rend) NORM_LOAD(r0, vn, slotn);
    for (; r0 < rend; r0 += rstep) {
        int row[NRW], mr[NRW]; f32x4 v[NRW][4]; int slot[NRW];
#pragma unroll
        for (int q = 0; q < NRW; ++q) {
            int rr = r0 + q; NORM_ROWMAP(rr);
            row[q] = rr;
            const int b = rr / RPB, t = rr - b * RPB;
            mr[q] = t < SEQ ? b : 8;
            slot[q] = slotn[q];
#pragma unroll
            for (int j = 0; j < 4; ++j) {
                if constexpr (WHICH == 0) v[q][j] = vn[q][j];
                else { const u32x2 t2 = vnb[q][j]; v[q][j] = (f32x4){__uint_as_float(t2.x << 16), __uint_as_float(t2.x & 0xffff0000u), __uint_as_float(t2.y << 16), __uint_as_float(t2.y & 0xffff0000u)}; }
            }
        }
        if (mr[0] != mr_cur) {
            mr_cur = mr[0];
            if (WHICH != 3) { const float* shift = mods + (size_t)(layer * 9 + mr_cur) * 6144 + (WHICH <= 1 ? 0 : 3) * 1024;
#pragma unroll
                for (int j = 0; j < 4; ++j) { shv[j] = ((const GAS f32x4*)shift)[lane + 64 * j]; scv[j] = ((const GAS f32x4*)(shift + 1024))[lane + 64 * j]; } }
            if (WHICH == 1 || WHICH == 3) { const float* m5 = mods + (size_t)((WHICH == 3 ? 3 : layer - 1) * 9 + mr_cur) * 6144 + 5 * 1024;
#pragma unroll
                for (int j = 0; j < 4; ++j) m5v[j] = ((const GAS f32x4*)m5)[lane + 64 * j]; }
#pragma unroll
            for (int j = 0; j < 4; ++j) asm volatile("" : "+v"(shv[j]), "+v"(scv[j]), "+v"(m5v[j]));
        }
        if (r0 + rstep < rend) NORM_LOAD(r0 + rstep, vn, slotn);
        if (WHICH == 1 || WHICH == 3) {
            const int pl = WHICH == 3 ? 3 : layer - 1;
            const float* gatev = (const float*)(ws + WS_GATE);
            const bf16_t* Y = (const bf16_t*)(ws + WS_B2);
#pragma unroll
            for (int q = 0; q < NRW; ++q) { if (slot[q] >= NSLOT) slot[q] = -1; }
            unsigned long long mskq[NRW]; int sl4[NRW][4]; u32x2 yv4[NRW][4][4];
#pragma unroll
            for (int q = 0; q < NRW; ++q) { mskq[q] = __ballot(slot[q] >= 0);
#pragma unroll
                for (int i = 0; i < 4; ++i) { sl4[q][i] = -1;
                    if (mskq[q]) { const int e = __builtin_ctzll(mskq[q]); mskq[q] &= mskq[q] - 1; sl4[q][i] = __builtin_amdgcn_readlane(slot[q], e); } } }
#pragma unroll
            for (int q = 0; q < NRW; ++q)
#pragma unroll
                for (int i = 0; i < 4; ++i) if (sl4[q][i] >= 0) { const bf16_t* yr = Y + (size_t)sl4[q][i] * 1024;
#pragma unroll
                    for (int j = 0; j < 4; ++j) yv4[q][i][j] = ((const GAS u32x2*)yr)[lane + 64 * j]; }
#pragma unroll
            for (int q = 0; q < NRW; ++q) {
                f32x4 acc[4];
#pragma unroll
                for (int j = 0; j < 4; ++j) acc[j] = (f32x4){0.f, 0.f, 0.f, 0.f};
#pragma unroll
                for (int i = 0; i < 4; ++i) if (sl4[q][i] >= 0) {
#pragma unroll
                    for (int j = 0; j < 4; ++j) { const u32x2 yv = yv4[q][i][j];
                        acc[j][0] += __uint_as_float(yv.x << 16); acc[j][1] += __uint_as_float(yv.x & 0xffff0000u); acc[j][2] += __uint_as_float(yv.y << 16); acc[j][3] += __uint_as_float(yv.y & 0xffff0000u); } }
                unsigned long long msk = mskq[q];
                while (msk) {
                    const int e = __builtin_ctzll(msk); msk &= msk - 1;
                    const int sl = __builtin_amdgcn_readlane(slot[q], e);
                    const bf16_t* yr = Y + (size_t)sl * 1024;
#pragma unroll
                    for (int j = 0; j < 4; ++j) { const u32x2 yv = ((const GAS u32x2*)yr)[lane + 64 * j];
                        acc[j][0] += __uint_as_float(yv.x << 16); acc[j][1] += __uint_as_float(yv.x & 0xffff0000u); acc[j][2] += __uint_as_float(yv.y << 16); acc[j][3] += __uint_as_float(yv.y & 0xffff0000u); }
                }
#pragma unroll
                for (int j = 0; j < 4; ++j) v[q][j] = v[q][j] + m5v[j] * acc[j];
            }
        }
        if (WHICH == 1) {
#pragma unroll
            for (int q = 0; q < NRW; ++q) { bf16_t* hb = (bf16_t*)(ws + WS_HB) + (size_t)row[q] * D;
#pragma unroll
                for (int j = 0; j < 4; ++j) ((GAS u32x2*)hb)[lane + 64 * j] = (u32x2){pg8::cvt_pk_bf16(v[q][j][0], v[q][j][1]), pg8::cvt_pk_bf16(v[q][j][2], v[q][j][3])}; }
        }
        if (WHICH == 3) {
#pragma unroll
            for (int q = 0; q < NRW; ++q) { const int b = row[q] / RPB, t = row[q] - b * RPB; float* orow = p.out + (size_t)(b * SEQ + t) * D;
#pragma unroll
                for (int j = 0; j < 4; ++j) ((GAS f32x4*)orow)[lane + 64 * j] = v[q][j]; }
        }
        if (WHICH == 3) continue;
        {
            float rs[NRW];
#pragma unroll
            for (int q = 0; q < NRW; ++q) {
                float ss = 0.f;
#pragma unroll
                for (int j = 0; j < 4; ++j) ss += v[q][j][0] * v[q][j][0] + v[q][j][1] * v[q][j][1] + v[q][j][2] * v[q][j][2] + v[q][j][3] * v[q][j][3];
                ss = wave_sum(ss);
                rs[q] = rsqrtf(ss * (1.f / 1024.f) + EPS);
            }
#pragma unroll
            for (int j = 0; j < 4; ++j) {
                const f32x4 sh = shv[j], sc = scv[j];
#pragma unroll
                for (int q = 0; q < NRW; ++q) {
                    v[q][j] = v[q][j] * rs[q] * sc + sh;
                    u32x2 o; o.x = pg8::cvt_pk_bf16(v[q][j][0], v[q][j][1]); o.y = pg8::cvt_pk_bf16(v[q][j][2], v[q][j][3]);
                    ((GAS u32x2*)((bf16_t*)(ws + WS_U) + (size_t)row[q] * 1024))[lane + 64 * j] = o;
                }
            }
        }
        if (WHICH == 2) {
#pragma unroll
            for (int q = 0; q < NRW; ++q) {
                LAS unsigned char* th = ut_hi + (wave * 2 + q) * UT_PITCH; LAS unsigned char* tl = ut_lo + (wave * 2 + q) * UT_PITCH;
#pragma unroll
                for (int j = 0; j < 4; ++j) {
                    const unsigned h01 = pg8::cvt_pk_bf16(v[q][j][0], v[q][j][1]), h23 = pg8::cvt_pk_bf16(v[q][j][2], v[q][j][3]);
                    const float l0 = v[q][j][0] - __uint_as_float(h01 << 16), l1 = v[q][j][1] - __uint_as_float(h01 & 0xffff0000u), l2 = v[q][j][2] - __uint_as_float(h23 << 16), l3 = v[q][j][3] - __uint_as_float(h23 & 0xffff0000u);
                    *(LAS u32x2*)(th + (lane + 64 * j) * 8) = (u32x2){h01, h23};
                    *(LAS u32x2*)(tl + (lane + 64 * j) * 8) = (u32x2){pg8::cvt_pk_bf16(l0, l1), pg8::cvt_pk_bf16(l2, l3)};
                }
            }
            __syncthreads();
            {
                const int fr = lane & 15, fq = lane >> 4;
                bf16x8 xh[4], xl[4];
#pragma unroll
                for (int ks = 0; ks < 4; ++ks) { xh[ks] = *(const LAS bf16x8*)(ut_hi + fr * UT_PITCH + (128 * wave + 32 * ks + 8 * fq) * 2); xl[ks] = *(const LAS bf16x8*)(ut_lo + fr * UT_PITCH + (128 * wave + 32 * ks + 8 * fq) * 2); }
                f32x4 pc = (f32x4){0.f, 0.f, 0.f, 0.f};
#pragma unroll
                for (int ks = 0; ks < 4; ++ks) { pc = __builtin_amdgcn_mfma_f32_16x16x32_bf16(wfh[ks], xh[ks], pc, 0, 0, 0); pc = __builtin_amdgcn_mfma_f32_16x16x32_bf16(wfl[ks], xh[ks], pc, 0, 0, 0); pc = __builtin_amdgcn_mfma_f32_16x16x32_bf16(wfh[ks], xl[ks], pc, 0, 0, 0); }
                *(LAS f32x4*)(rpart0 + (rstepi & 1) * 2048 + (wave * 16 + fr) * 16 + 4 * fq) = pc;
            }
            __syncthreads();
            if (tid < 256) {
                const int rr_ = tid >> 4, ee = tid & 15;
                float x = 0.f;
#pragma unroll
                for (int w8 = 0; w8 < 8; ++w8) x += rpart0[(rstepi & 1) * 2048 + (w8 * 16 + rr_) * 16 + ee];
                float mx = x; mx = fmaxf(mx, swz_xor<1>(mx)); mx = fmaxf(mx, swz_xor<2>(mx)); mx = fmaxf(mx, swz_xor<4>(mx)); mx = fmaxf(mx, swz_xor<8>(mx));
                const float ex = expf(x - mx);
                float sm = ex; sm += swz_xor<1>(sm); sm += swz_xor<2>(sm); sm += swz_xor<4>(sm); sm += swz_xor<8>(sm);
                int grow = (r0 - wave * NRW) + rr_;
                NORM_ROWMAP(grow);
                ((GAS float*)(ws + WS_AFF))[(size_t)grow * 16 + ee] = ex / sm;
            }
            ++rstepi;
        }
    }
    if (WHICH == 2) __syncthreads();
#undef NORM_ROWMAP
#undef NORM_LOAD
}

__device__ __forceinline__ void phase_qkprep(const P& p, int layer, int vcu, int G, const int wv_) {
    unsigned char* ws = p.ws; asm volatile("" : "+s"(ws));
    const int tid = (wv_ << 6) | hw_tid();
    const int lane = tid & 63, wave = wv_;
    const int li = layer >> 1;
    const float* tab = (const float*)(ws + WS_ROPE);
    for (int wid = vcu * NWAVES + wave; wid < NR * 26; wid += G * NWAVES) {
        const int row = wid / 26, hs = wid - row * 26;
        int col; const float* g; bool rope;
        if (hs < 8) { col = hs * 64; g = p.a_q_norm + li * 64; rope = true; }
        else if (hs < 10) { col = 512 + (hs - 8) * 64; g = p.a_k_norm + li * 64; rope = true; }
        else if (hs < 18) { col = 768 + (hs - 10) * 64; g = p.b_q_norm + li * 64; rope = false; }
        else { col = 1280 + (hs - 18) * 64; g = p.b_k_norm + li * 64; rope = false; }
        bf16_t* q = (bf16_t*)(ws + WS_B1) + (size_t)row * 2304 + col;
        const float x = bf2f(q[lane]);
        const float ss = wave_sum(x * x);
        float y = x * rsqrtf(ss * (1.f / 64.f) + EPS) * g[lane];
        const int b = row / RPB, t = row - b * RPB;
        if (rope && t < SEQ) {
            const int half = lane >> 5, j = lane & 31;
            const int pos = half == 0 ? (t >> 6) : (t & 63);
            const float cs = tab[pos * 16 + (j & 15)], sn = tab[1024 + pos * 16 + (j & 15)];
            const float other = swz_xor<16>(y);
            y = y * cs + (j < 16 ? -other : other) * sn;
        }
        if (hs < 8 || (hs >= 10 && hs < 18)) y *= 0.18033688011112042f;
        q[lane] = (bf16_t)f2bf(y);
    }
}

namespace attn_body {
using bf16=unsigned short;
using bf16x8=__attribute__((ext_vector_type(8)))short;
using s16x4=__attribute__((ext_vector_type(4)))short;
using f32x16=__attribute__((ext_vector_type(16)))float;
using u32x4=__attribute__((ext_vector_type(4)))unsigned;
constexpr int D=64;
constexpr int NW=8,QBLK=32,QB=QBLK*NW,KVBLK=64;
__device__ __forceinline__ int crow(int r,int hi){return (r&3)+8*(r>>2)+4*hi;}
#define SBAR() __builtin_amdgcn_sched_barrier(0)
#define CINIT (MODE==1?f32x16{}:negm)
struct NaArgs { int ctx_row0, win_row0, r0, wr0; };
constexpr int LDS_NAT_OFF = 86016;
__device__ __forceinline__ void na_mask(f32x16&p0,f32x16&p1,int j,const NaArgs&na,const char*shm,int wid,int r32,int hi,float mhat){
  const float NEG=-INFINITY;
  const int r=na.r0+(wid>>1), c=32*(wid&1)+r32;
  int rs=r-4; rs=rs<0?0:(rs>56?56:rs);
  int cs=c-8; cs=cs<0?0:(cs>48?48:cs);
  const int kr=na.wr0+j, di=kr-rs;
  if(di<0||di>=8){
    #pragma unroll
    for(int q=0;q<16;++q){p0[q]=NEG;p1[q]=NEG;}
  } else {
    const int dr=kr-r+7;
    const float*T=reinterpret_cast<const float*>(shm+LDS_NAT_OFF)+dr*128+63-c+4*hi;
    const int a=4*hi-cs;
    #pragma unroll
    for(int q=0;q<16;++q){ const int kc0=(q&3)+8*(q>>2);
      const float b0=T[kc0], b1=T[kc0+32];
      p0[q]=((unsigned)(a+kc0)<16u)?p0[q]+(b0-mhat):NEG; p1[q]=((unsigned)(a+kc0+32)<16u)?p1[q]+(b1-mhat):NEG;
      if((q&1)==1) SBAR(); }
  }
}
constexpr int NSLOT=3, SLOTB=8192;
constexpr int LDS_K=0, LDS_V=NSLOT*SLOTB, LDS_WS=2*NSLOT*SLOTB, LDS_OST=LDS_WS+NW*64*4, LDS_BYTES=LDS_OST+NW*4096;
constexpr float C2=0.125f*1.4426950408889634f;
__device__ __forceinline__ void glds16(const void*gsrc,unsigned lds_dst){unsigned keep;
  asm volatile("s_mov_b32 %0, m0\n\ts_mov_b32 m0, %2\n\ts_nop 0\n\tglobal_load_lds_dwordx4 %1, off\n\ts_mov_b32 m0, %0":"=&s"(keep):"v"(gsrc),"s"(lds_dst):"memory");}
__device__ __forceinline__ float max3f(float a,float b,float c){float r;asm("v_max3_f32 %0, %1, %2, %3":"=v"(r):"v"(a),"v"(b),"v"(c));return r;}
__device__ __forceinline__ float max2f(float a,float b){float r;asm("v_max_f32_e32 %0, %1, %2":"=v"(r):"v"(a),"v"(b));return r;}
__device__ __forceinline__ float fadd_s(float a,float b){float r;asm("v_add_f32_e32 %0, %1, %2":"=v"(r):"v"(a),"v"(b));return r;}
__device__ __forceinline__ float fsub_s(float a,float b){float r;asm("v_sub_f32_e32 %0, %1, %2":"=v"(r):"v"(a),"v"(b));return r;}
typedef float f32x2_t __attribute__((ext_vector_type(2))); typedef __bf16 bf16x2_t __attribute__((ext_vector_type(2)));
__device__ __forceinline__ unsigned cvtpk_s(float lo,float hi){f32x2_t v={lo,hi};bf16x2_t b=__builtin_convertvector(v,bf16x2_t);return __builtin_bit_cast(unsigned,b);}
#define WAIT_BAR(N) asm volatile("s_waitcnt vmcnt(" #N ") lgkmcnt(0)\n\ts_barrier":::"memory")

__device__ __forceinline__ void qkt(f32x16&p0,f32x16&p1,const char*Kslot,const bf16x8*qr,const f32x16&negm,int r32,int hi){
  const char*kb=Kslot+hi*1024+r32*16;
  #pragma unroll
  for(int d0=0;d0<4;++d0){
    const bf16x8 b0=*reinterpret_cast<const bf16x8*>(kb+d0*2048);
    const bf16x8 b1=*reinterpret_cast<const bf16x8*>(kb+d0*2048+512);
    if(d0==0){p0=__builtin_amdgcn_mfma_f32_32x32x16_bf16(b0,qr[0],negm,0,0,0);p1=__builtin_amdgcn_mfma_f32_32x32x16_bf16(b1,qr[0],negm,0,0,0);}
    else{p0=__builtin_amdgcn_mfma_f32_32x32x16_bf16(b0,qr[d0],p0,0,0,0);p1=__builtin_amdgcn_mfma_f32_32x32x16_bf16(b1,qr[d0],p1,0,0,0);}}
}
typedef __attribute__((address_space(3))) const char* lds_cptr;
typedef short v4i16_t __attribute__((ext_vector_type(4)));
__device__ __forceinline__ void kload8(bf16x8*kf,lds_cptr kp){
  kf[0]=*(const __attribute__((address_space(3))) bf16x8*)(kp);      kf[1]=*(const __attribute__((address_space(3))) bf16x8*)(kp+512);
  kf[2]=*(const __attribute__((address_space(3))) bf16x8*)(kp+2048); kf[3]=*(const __attribute__((address_space(3))) bf16x8*)(kp+2560);
  kf[4]=*(const __attribute__((address_space(3))) bf16x8*)(kp+4096); kf[5]=*(const __attribute__((address_space(3))) bf16x8*)(kp+4608);
  kf[6]=*(const __attribute__((address_space(3))) bf16x8*)(kp+6144); kf[7]=*(const __attribute__((address_space(3))) bf16x8*)(kp+6656);
}
__device__ __forceinline__ void kload2(bf16x8*kf,lds_cptr kp,int j){ kf[2*j]=*(const __attribute__((address_space(3))) bf16x8*)(kp+j*2048); kf[2*j+1]=*(const __attribute__((address_space(3))) bf16x8*)(kp+j*2048+512); }
__device__ __forceinline__ s16x4 vtr(lds_cptr p){ return __builtin_bit_cast(s16x4,__builtin_amdgcn_ds_read_tr16_b64_v4i16((__attribute__((address_space(3))) v4i16_t*)p)); }
__device__ __forceinline__ float rowmax(const f32x16&p0,const f32x16&p1){
  float a=max3f(p0[0],p0[1],p1[0]),b=max3f(p0[2],p0[3],p1[1]);a=max3f(a,p1[2],p1[3]);
  #pragma unroll
  for(int r=4;r<16;r+=4){a=max3f(a,p0[r],p0[r+1]);b=max3f(b,p0[r+2],p0[r+3]);a=max3f(a,p1[r],p1[r+1]);b=max3f(b,p1[r+2],p1[r+3]);}
  const float m=max2f(a,b);
  auto rr=__builtin_amdgcn_permlane32_swap(__float_as_uint(m),__float_as_uint(m),false,false);
  return max2f(__uint_as_float(rr[0]),__uint_as_float(rr[1]));
}
__device__ __forceinline__ void pv(f32x16*o,int vb,bf16x8 pa0,bf16x8 pa1,bf16x8 pa2,bf16x8 pa3){
  #pragma unroll
  for(int d0=0;d0<2;++d0){s16x4 lo[4],hi[4];
    #pragma unroll
    for(int ks=0;ks<4;++ks){
      asm volatile("ds_read_b64_tr_b16 %0,%1 offset:%c2":"=&v"(lo[ks]):"v"(vb),"i"(d0*4096+ks*1024):"memory");
      asm volatile("ds_read_b64_tr_b16 %0,%1 offset:%c2":"=&v"(hi[ks]):"v"(vb),"i"(d0*4096+ks*1024+512):"memory");}
    asm volatile("s_waitcnt lgkmcnt(0)":::"memory");SBAR();
    #define PK(k) (bf16x8){lo[k][0],lo[k][1],lo[k][2],lo[k][3],hi[k][0],hi[k][1],hi[k][2],hi[k][3]}
    o[d0]=__builtin_amdgcn_mfma_f32_32x32x16_bf16(pa0,PK(0),o[d0],0,0,0);
    o[d0]=__builtin_amdgcn_mfma_f32_32x32x16_bf16(pa1,PK(1),o[d0],0,0,0);
    o[d0]=__builtin_amdgcn_mfma_f32_32x32x16_bf16(pa2,PK(2),o[d0],0,0,0);
    o[d0]=__builtin_amdgcn_mfma_f32_32x32x16_bf16(pa3,PK(3),o[d0],0,0,0);
    #undef PK
  }
}

#ifndef ATTN_STORE16
#define ATTN_STORE16(p,v) (*(u32x4*)(p)=(v))
#endif
template<int THRL,int QP,int OP,int MODE> __device__ __forceinline__ void attn_unit(const bf16*Qu,const bf16*__restrict__ Kh,const bf16*__restrict__ Vh,bf16*Ou,const int NT,char*shm,const int wid,const int lane,const NaArgs na){
  const int r32=lane&31,hi=lane>>5;
  const bf16*Qw=Qu+(long)(wid*QBLK)*QP;
  const unsigned lds0=(unsigned)(uintptr_t)shm;
  float*wsf=(float*)(shm+LDS_WS)+wid*64;
  const bf16*ksrc=Kh+(long)lane*QP+wid*8;
  const bf16*vsrc=Vh+(long)(16*(wid&3)+(lane>>2))*QP+(wid>>2)*32+(lane&3)*8;
  const unsigned kdst=lds0+LDS_K+wid*1024, vdst=lds0+LDS_V+wid*1024;
  #define TROW(t) (MODE==0?(long)(t)*KVBLK:((t)<4?(long)na.ctx_row0+(long)(t)*KVBLK:(long)na.win_row0+(long)((t)-4)*KVBLK))
  #define DMA_K(t,slot) glds16(ksrc+TROW(t)*QP,(unsigned)__builtin_amdgcn_readfirstlane(kdst+(slot)))
  #define DMA_V(t,slot) glds16(vsrc+TROW(t)*QP,(unsigned)__builtin_amdgcn_readfirstlane(vdst+(slot)))
  const int vb0=(int)(lds0+LDS_V)+((lane>>4)&1)*32+(lane&3)*8+(4*hi+((lane&15)>>2))*64;
  const char*Kbase=shm+LDS_K; bf16x8 kf[8];
  const lds_cptr shm3=(lds_cptr)shm; const lds_cptr kp0=shm3+LDS_K+hi*1024+r32*16; const lds_cptr vp0=shm3+LDS_V+((lane>>4)&1)*32+(lane&3)*8+(4*hi+((lane&15)>>2))*64;
  DMA_K(0,0);DMA_V(0,0);DMA_K(1,SLOTB);
  bf16x8 qr[4];
  #pragma unroll
  for(int d0=0;d0<4;++d0)qr[d0]=*reinterpret_cast<const bf16x8*>(&Qw[(long)r32*QP+d0*16+hi*8]);
  float mhat=0.f,l_reg=0.f;f32x16 o[2],negm; { float z_=0.f; asm volatile("":"+v"(z_));
    _Pragma("unroll") for(int r=0;r<16;++r){o[0][r]=z_;o[1][r]=z_;negm[r]=z_;} } if(MODE==0)asm volatile("":"+v"(negm));
  #define CMASK(P0,P1,t) do{ if(MODE==1){ if((t)>=4) na_mask(P0,P1,(t)-4,na,shm,wid,r32,hi,mhat); else { _Pragma("unroll") for(int r_=0;r_<16;++r_){P0[r_]-=mhat;P1[r_]-=mhat;} } } }while(0)
  bool resc=false;
  #define START(P0,P1) do{ const float rm=rowmax(P0,P1); resc=false; \
    { const float dl=rm; mhat=fadd_s(mhat,dl); \
      _Pragma("unroll") for(int r=0;r<16;++r){P0[r]=fsub_s(P0[r],dl);P1[r]=fsub_s(P1[r],dl);} \
      if(MODE==0){ _Pragma("unroll") for(int r=0;r<16;++r)negm[r]=-mhat; asm volatile("":"+v"(negm)); } } \
    _Pragma("unroll") for(int r=0;r<16;++r)P0[r]=__builtin_amdgcn_exp2f(P0[r]); }while(0)
  #define RESC() do{ if(resc){ asm volatile("s_waitcnt lgkmcnt(0)":::"memory"); \
      _Pragma("unroll") for(int d_=0;d_<2;++d_) _Pragma("unroll") for(int r=0;r<16;++r)o[d_][r]*=wsf[crow(r,hi)]; } }while(0)
  f32x16 pA0,pA1,pB0,pB1;
  int sl_prev=0,sl_cur=0,sl_next=SLOTB;
  #define ROT() do{sl_prev=sl_cur;sl_cur=sl_next;sl_next=(sl_next==(NSLOT-1)*SLOTB)?0:sl_next+SLOTB;}while(0)
  DMA_K(2,2*SLOTB);
  WAIT_BAR(3);
  qkt(pA0,pA1,Kbase,qr,CINIT,r32,hi);asm volatile("s_nop 15\n\ts_nop 7":"+v"(pA0),"+v"(pA1));CMASK(pA0,pA1,0);
  START(pA0,pA1);
  _Pragma("unroll") for(int r=0;r<16;++r)pA1[r]=__builtin_amdgcn_exp2f(pA1[r]);
  WAIT_BAR(0);
  DMA_K(3,0);DMA_V(1,SLOTB);
  ROT();
  kload8(kf,kp0+sl_cur);
  WAIT_BAR(2);
  s16x4 vlo[8],vhi[8]; u32x4 pw0,pw1,pw2,pw3;
  #define PKW(P,B) cvtpk_s(P[B],P[B+1])
  #define PAF(k) __builtin_bit_cast(bf16x8,pw##k)
  #define VFR(i) (bf16x8){vlo[i][0],vlo[i][1],vlo[i][2],vlo[i][3],vhi[i][0],vhi[i][1],vhi[i][2],vhi[i][3]}
  #define PIN(x) asm volatile("":"+v"(x))
  #define MX3(a,b,c) __builtin_fmaxf(__builtin_fmaxf((a),(b)),(c))
  #define GAPA(MF,A0,A1,A2,A3,W0,W1,PW) do{ MF; sacc+=A0; sacc+=A1; sacc+=A2; sacc+=A3; PIN(sacc); W0; W1; PIN(PW); SBAR(); }while(0)
  #define EX(v) __builtin_amdgcn_exp2f(v)
  #define GAPB(MF,X,B) do{ MF; X[B]=EX(X[B]); X[B+1]=EX(X[B+1]); X[B+2]=EX(X[B+2]); X[B+3]=EX(X[B+3]); PIN(X); SBAR(); }while(0)
  #define VRD(i) do{ vlo[i]=vtr(vp_+(((i)>>2)*4096+((i)&3)*1024)); vhi[i]=vtr(vp_+(((i)>>2)*4096+((i)&3)*1024+512)); }while(0)
  #define KRD(G,j) do{ if(G){ kload2(kf,kp0+sl_next,j); SBAR(); } }while(0)
  #define STEP(C0,C1,P0,P1,t,GK,GV,GL) do{ SBAR(); \
    const lds_cptr vp_=vp0+sl_prev; \
    VRD(0); SBAR(); float sacc=(P0[0]+P0[1]); \
    GAPA(C0=__builtin_amdgcn_mfma_f32_32x32x16_bf16(kf[0],qr[0],CINIT,0,0,0), P0[2],P0[3],P0[4],P0[5],     pw0[0]=PKW(P0,0), pw0[1]=PKW(P0,2), pw0); \
    VRD(4); SBAR(); GAPA(C1=__builtin_amdgcn_mfma_f32_32x32x16_bf16(kf[1],qr[0],CINIT,0,0,0), P0[6],P0[7],P0[8],P0[9],     pw0[2]=PKW(P0,4), pw0[3]=PKW(P0,6), pw0); \
    VRD(1); SBAR(); GAPA(C0=__builtin_amdgcn_mfma_f32_32x32x16_bf16(kf[2],qr[1],C0,0,0,0),   P0[10],P0[11],P0[12],P0[13], pw1[0]=PKW(P0,8), pw1[1]=PKW(P0,10), pw1); \
    VRD(5); SBAR(); GAPA(C1=__builtin_amdgcn_mfma_f32_32x32x16_bf16(kf[3],qr[1],C1,0,0,0),   P0[14],P0[15],P1[0],P1[1],   pw1[2]=PKW(P0,12),pw1[3]=PKW(P0,14), pw1); \
    VRD(2); SBAR(); GAPA(C0=__builtin_amdgcn_mfma_f32_32x32x16_bf16(kf[4],qr[2],C0,0,0,0),   P1[2],P1[3],P1[4],P1[5],     pw2[0]=PKW(P1,0), pw2[1]=PKW(P1,2), pw2); \
    VRD(6); SBAR(); GAPA(C1=__builtin_amdgcn_mfma_f32_32x32x16_bf16(kf[5],qr[2],C1,0,0,0),   P1[6],P1[7],P1[8],P1[9],     pw2[2]=PKW(P1,4), pw2[3]=PKW(P1,6), pw2); \
    VRD(3); SBAR(); GAPA(C0=__builtin_amdgcn_mfma_f32_32x32x16_bf16(kf[6],qr[3],C0,0,0,0),   P1[10],P1[11],P1[12],P1[13], pw3[0]=PKW(P1,8), pw3[1]=PKW(P1,10), pw3); \
    VRD(7); SBAR(); GAPA(C1=__builtin_amdgcn_mfma_f32_32x32x16_bf16(kf[7],qr[3],C1,0,0,0),   P1[14],P1[15],0.f,0.f,       pw3[2]=PKW(P1,12),pw3[3]=PKW(P1,14), pw3); \
    l_reg+=sacc; \
    if(GK){DMA_K((t)+3,sl_cur);} if(GV){DMA_V((t)+1,sl_next);} \
    CMASK(C0,C1,t); \
    { float a=MX3(C0[0],C0[1],C1[0]),b=MX3(C0[2],C0[3],C1[1]); a=MX3(a,C1[2],C1[3]); \
      _Pragma("unroll") for(int r=4;r<16;r+=4){a=MX3(a,C0[r],C0[r+1]);b=MX3(b,C0[r+2],C0[r+3]);a=MX3(a,C1[r],C1[r+1]);b=MX3(b,C1[r+2],C1[r+3]);} \
      float rm=__builtin_fmaxf(a,b); { auto rr=__builtin_amdgcn_permlane32_swap(__float_as_uint(rm),__float_as_uint(rm),false,false); rm=__builtin_fmaxf(__uint_as_float(rr[0]),__uint_as_float(rr[1])); } \
      resc=false; \
      if(__builtin_expect(__any(rm>(float)THRL),0)){ const float dl=__builtin_fmaxf(rm,0.f); mhat+=dl; \
        _Pragma("unroll") for(int r=0;r<16;++r){C0[r]-=dl;C1[r]-=dl;} \
        if(MODE==0){ _Pragma("unroll") for(int r=0;r<16;++r)negm[r]=-mhat; asm volatile("":"+v"(negm)); } \
        const float f=__builtin_amdgcn_exp2f(-dl); l_reg*=f; if(hi==0)wsf[r32]=f; resc=true; } } \
    SBAR(); \
    GAPB(o[0]=__builtin_amdgcn_mfma_f32_32x32x16_bf16(PAF(0),VFR(0),o[0],0,0,0), C0,0); \
    GAPB(o[1]=__builtin_amdgcn_mfma_f32_32x32x16_bf16(PAF(0),VFR(4),o[1],0,0,0), C0,4); \
    KRD(GL,0); GAPB(o[0]=__builtin_amdgcn_mfma_f32_32x32x16_bf16(PAF(1),VFR(1),o[0],0,0,0), C0,8); \
    KRD(GL,1); GAPB(o[1]=__builtin_amdgcn_mfma_f32_32x32x16_bf16(PAF(1),VFR(5),o[1],0,0,0), C0,12); \
    KRD(GL,2); GAPB(o[0]=__builtin_amdgcn_mfma_f32_32x32x16_bf16(PAF(2),VFR(2),o[0],0,0,0), C1,0); \
    KRD(GL,3); GAPB(o[1]=__builtin_amdgcn_mfma_f32_32x32x16_bf16(PAF(2),VFR(6),o[1],0,0,0), C1,4); \
    GAPB(o[0]=__builtin_amdgcn_mfma_f32_32x32x16_bf16(PAF(3),VFR(3),o[0],0,0,0), C1,8); \
    GAPB(o[1]=__builtin_amdgcn_mfma_f32_32x32x16_bf16(PAF(3),VFR(7),o[1],0,0,0), C1,12); \
    }while(0)
  int t=1;
  for(;t+5<NT;t+=2){
    STEP(pB0,pB1,pA0,pA1,t,true,true,true);     WAIT_BAR(2); RESC(); ROT();
    STEP(pA0,pA1,pB0,pB1,t+1,true,true,true);   WAIT_BAR(2); RESC(); ROT();
  }
  #define ENDW(tt) do{ if((tt)+3<NT){WAIT_BAR(2);} else if((tt)+2<NT){WAIT_BAR(1);} else {WAIT_BAR(0);} }while(0)
  for(;t+1<NT;t+=2){
    STEP(pB0,pB1,pA0,pA1,t,(t+3<NT),(t+1<NT),(t+1<NT));       ENDW(t);   RESC(); ROT();
    STEP(pA0,pA1,pB0,pB1,t+1,(t+4<NT),(t+2<NT),(t+2<NT));     ENDW(t+1); RESC(); ROT();
  }
  STEP(pB0,pB1,pA0,pA1,NT-1,false,false,false); RESC();
  { float sacc=pB0[0]+pB0[1]; _Pragma("unroll") for(int r=2;r<16;++r)sacc+=pB0[r]; _Pragma("unroll") for(int r=0;r<16;++r)sacc+=pB1[r]; l_reg+=sacc;
    pw0=(u32x4){PKW(pB0,0),PKW(pB0,2),PKW(pB0,4),PKW(pB0,6)};pw1=(u32x4){PKW(pB0,8),PKW(pB0,10),PKW(pB0,12),PKW(pB0,14)};pw2=(u32x4){PKW(pB1,0),PKW(pB1,2),PKW(pB1,4),PKW(pB1,6)};pw3=(u32x4){PKW(pB1,8),PKW(pB1,10),PKW(pB1,12),PKW(pB1,14)};
    SBAR(); pv(o,vb0+sl_cur,PAF(0),PAF(1),PAF(2),PAF(3)); }
  #undef PKW
  #undef PAF
  #undef VFR
  #undef PIN
  #undef MX3
  #undef GAPA
  #undef GAPB
  #undef EX
  #undef VRD
  #undef KRD
  #undef STEP
  #undef ENDW
  {auto rr=__builtin_amdgcn_permlane32_swap(__float_as_uint(l_reg),__float_as_uint(l_reg),false,false);l_reg=__uint_as_float(rr[0])+__uint_as_float(rr[1]);}
  if(hi==0)wsf[32+r32]=l_reg;asm volatile("s_waitcnt lgkmcnt(0)":::"memory");
  float rli[16];
  #pragma unroll
  for(int r=0;r<16;++r)rli[r]=__builtin_amdgcn_rcpf(wsf[32+crow(r,hi)]);
  bf16*Ow=Ou+(long)(wid*QBLK)*OP;
  { bf16*stg=(bf16*)(shm+LDS_OST)+wid*2048;
    #pragma unroll
    for(int r=0;r<16;++r){const int orow=crow(r,hi);
      #pragma unroll
      for(int d0=0;d0<2;++d0)stg[orow*64+d0*32+r32]=(bf16)f2bf(o[d0][r]*rli[r]);}
    asm volatile("s_waitcnt lgkmcnt(0)":::"memory");
    #pragma unroll
    for(int i=0;i<4;++i){const int row=i*8+(lane>>3),ch=lane&7; const u32x4 v=*(const u32x4*)(stg+row*64+ch*8); ATTN_STORE16(Ow+(long)row*OP+ch*8,v);} }
  asm volatile("s_waitcnt lgkmcnt(0)\n\ts_barrier":::"memory");
  #undef DMA_K
  #undef DMA_V
  #undef TROW
  #undef CMASK
  #undef START
  #undef RESC
  #undef ROT
}
#undef SBAR
#undef WAIT_BAR
}

__device__ __forceinline__ void phase_attn_dense(const P& p, char* shm, int vcu, int G, const int wv_) {
    unsigned char* ws = p.ws; asm volatile("" : "+s"(ws));
    const int lane = hw_tid();
    const attn_body::bf16* QKV = (const attn_body::bf16*)(ws + WS_B1);
    attn_body::bf16* O = (attn_body::bf16*)(ws + WS_B2);
    const attn_body::NaArgs na{0, 0, 0, 0};
    for (int L = vcu; L < 1024 + 128; L += G) {
        size_t qo, ko, vo, oo; int ntile;
        if (L < 1024) {
            const int i = L >> 8, v = L & 255, xcd = v >> 5, j = v & 31;
            const int grp = 2 * xcd + (i >> 1), b = grp >> 1, kvh = grp & 1, u = (i & 1) * 32 + j, h = kvh * 4 + (u >> 4), qb = u & 15;
            const size_t rb = (size_t)b * RPB;
            qo = (rb + qb * 256) * 2304 + 64 * h; ko = rb * 2304 + 512 + 64 * kvh; vo = rb * 2304 + 640 + 64 * kvh; oo = (rb + qb * 256) * 1024 + 64 * h; ntile = 68;
        } else {
            const int u = L - 1024, typ = u >> 6, b = (u >> 3) & 7, h = u & 7;
            const size_t rc = (size_t)b * RPB + SEQ;
            const int qcol = typ ? 768 + 64 * h : 64 * h, kcol = typ ? 1280 + 64 * h : 512 + 64 * (h >> 2), vcol = typ ? 1792 + 64 * h : 640 + 64 * (h >> 2), ocol = typ ? 512 + 64 * h : 64 * h;
            qo = rc * 2304 + qcol; ko = rc * 2304 + kcol; vo = rc * 2304 + vcol; oo = rc * 1024 + ocol; ntile = 4;
        }
        attn_body::attn_unit<8, 2304, 1024, 0>(QKV + qo, QKV + ko, QKV + vo, O + oo, ntile, shm, wv_, lane, na);
    }
}

__device__ __forceinline__ void phase_attn_na(const P& p, int layer, char* shm, int vcu, int G, const int wv_) {
    unsigned char* ws = p.ws; asm volatile("" : "+s"(ws));
    const int lane = hw_tid(), tid = (wv_ << 6) | lane;
    const attn_body::bf16* QKV = (const attn_body::bf16*)(ws + WS_B1);
    attn_body::bf16* O = (attn_body::bf16*)(ws + WS_B2);
    float* T = (float*)(shm + attn_body::LDS_NAT_OFF);
    for (int L = vcu; L < 1024; L += G) {
        const int i = L >> 8, v = L & 255, xcd = v >> 5, j = v & 31;
        const int grp = (i * 8 + xcd) * 2 + (j >> 4), rblk = j & 15, b = grp >> 3, h = grp & 7;
        const float* rpb = p.na_rpb + (size_t)((layer >> 1) * 8 + h) * 15 * 31;
        for (int e = tid; e < 15 * 128; e += NTHR) { const int dr = e >> 7, d = (e & 127) - 63; T[e] = (d >= -15 && d <= 15) ? rpb[dr * 31 + d + 15] * 1.4426950408889634f : -INFINITY; }
        const int r0 = rblk * 4; int wr0 = r0 - 4; wr0 = wr0 < 0 ? 0 : (wr0 > 52 ? 52 : wr0);
        const size_t rb = (size_t)b * RPB;
        const attn_body::NaArgs na{SEQ, wr0 * 64, r0, wr0};
        attn_body::attn_unit<8, 2304, 1024, 1>(QKV + (rb + r0 * 64) * 2304 + 768 + 64 * h, QKV + rb * 2304 + 1280 + 64 * h, QKV + rb * 2304 + 1792 + 64 * h, O + (rb + r0 * 64) * 1024 + 512 + 64 * h, 16, shm, wv_, lane, na);
    }
}

__device__ __forceinline__ int gla_o256(int row, int ch) { return row * 256 + ((ch ^ (row & 15)) << 4); }
__device__ __forceinline__ int gla_o128(int row, int ch) { return (row >> 1) * 256 + (((((row & 1) << 3) | ch) ^ ((row >> 1) & 7)) << 4); }
__device__ __forceinline__ int gla_task(int b, int h, int dir, int s) { return ((b * 4 + h) * 2 + dir) * 68 + s; }
__device__ __forceinline__ int gla_rowc(int b, int dir, int s) { return b * RPB + (s < 4 ? SEQ + 64 * (dir ? 3 - s : s) : 64 * (dir ? 67 - s : s - 4)); }

__device__ __forceinline__ void phase_gla_pre(const P& p, int layer, LAS unsigned char* lds, int vcu, int G, const int wv_) {
    unsigned char* ws = p.ws; asm volatile("" : "+s"(ws));
    const int lane = hw_tid(), tid = (wv_ << 6) | lane, fr = lane & 15, fq = lane >> 4;
    constexpr int L_QD = 0, L_KI = 16384, L_KST = 32768, L_A = 49152, L_SB = 57344, SB_BYTES = 36864, SB_K = 16384, SB_Z = 32768, L_CL = RING_BYTES + 8192;
    static_assert(L_SB + 2 * SB_BYTES <= RING_BYTES && L_CL + 512 <= LDS_BYTES, "gla pre LDS map");
    LAS unsigned char* qd = lds + L_QD; LAS unsigned char* ki = lds + L_KI; LAS unsigned char* ksT = lds + L_KST; LAS unsigned char* Al = lds + L_A;
    LAS float* cls = (LAS float*)(lds + L_CL);
    const unsigned lds0 = (unsigned)(size_t)lds;
    const int li = layer >> 1;
    const bf16_t* X = (const bf16_t*)(ws + WS_B1);
    const float* Z = (const float*)(ws + WS_Z);
    const int pd = 16 * wv_ + fr;
#define GLAP_TASK(i_, bhd_, s_) const int bhd_ = ((i_) & 255) >> 2, s_ = 17 * ((i_) & 3) + ((i_) >> 8)
#define GLAP_DMA(i_, buf_) do { GLAP_TASK((i_), bhd__, s__); const int dir__ = bhd__ & 1, h__ = (bhd__ >> 1) & 3, b__ = bhd__ >> 3; const int rc_ = gla_rowc(b__, dir__, s__); \
        const unsigned sb_ = lds0 + L_SB + (unsigned)(buf_) * SB_BYTES; \
        _Pragma("unroll") for (int jj = 0; jj < 4; ++jj) { const int j = 4 * wv_ + jj;        \
            pg8::glds16_s((const char*)(X + (size_t)(rc_ + 4 * (j & 15)) * 3072 + h__ * 128 + (j >> 4) * 512), (unsigned)((lane >> 4) * 6144 + (((lane & 15) ^ (2 * (j & 3))) << 4)), sb_ + (unsigned)j * 1024u); } \
        if (wv_ < 4) pg8::glds16_s((const char*)(Z + (size_t)(rc_ + 16 * wv_) * 32 + dir__ * 16), (unsigned)((lane >> 2) * 128 + (lane & 3) * 16), sb_ + SB_Z + (unsigned)wv_ * 1024u); } while (0)
    int ti = vcu, kk_ = 0;
    if (ti < 4352) GLAP_DMA(ti, 0);
    int bhd_cur = -1; bf16x8 wx1 = (bf16x8){0, 0, 0, 0, 0, 0, 0, 0}, wx2 = wx1; float gbias = 0.f;
    for (; ti < 4352; ti += G, ++kk_) {
        GLAP_TASK(ti, bhd, s_chunk);
        const int dir = bhd & 1, h = (bhd >> 1) & 3, t = bhd * 68 + s_chunk;
        if (bhd != bhd_cur) {
            bhd_cur = bhd;
            const float* gw = (dir ? p.gk_w_b : p.gk_w_f) + (size_t)li * 16 * 512 + h * 128 + pd + (size_t)(8 * (fq & 1)) * 512;
            float wv8[8];
#pragma unroll
            for (int e = 0; e < 8; ++e) wv8[e] = gw[e * 512];
            gbias = ((dir ? p.gk_b_b : p.gk_b_f) + li * 512)[h * 128 + pd];
            unsigned hh[4], ll[4];
#pragma unroll
            for (int e = 0; e < 4; ++e) { hh[e] = pg8::cvt_pk_bf16(wv8[2 * e], wv8[2 * e + 1]);
                ll[e] = pg8::cvt_pk_bf16(wv8[2 * e] - __uint_as_float(hh[e] << 16), wv8[2 * e + 1] - __uint_as_float(hh[e] & 0xffff0000u)); if (fq >= 2) ll[e] = 0u; }
            wx1 = __builtin_bit_cast(bf16x8, (u32x4){hh[0], hh[1], hh[2], hh[3]}); wx2 = __builtin_bit_cast(bf16x8, (u32x4){ll[0], ll[1], ll[2], ll[3]});
        }
        if (kk_ == 0) asm volatile("s_waitcnt vmcnt(0)" ::: "memory"); else asm volatile("s_waitcnt vmcnt(5)" ::: "memory");
        __syncthreads();
        if (ti + G < 4352) GLAP_DMA(ti + G, (kk_ + 1) & 1);
        LAS unsigned char* sb = lds + L_SB + (kk_ & 1) * SB_BYTES;
        {
            float c[16];
#pragma unroll
            for (int T = 0; T < 4; ++T) {
                const LAS f32x4* zp = (const LAS f32x4*)(sb + SB_Z + (16 * T + fr) * 64 + (fq & 1) * 32);
                const f32x4 za = zp[0], zb = zp[1];
                unsigned zy[4];
#pragma unroll
                for (int e = 0; e < 4; ++e) { const float z0 = e < 2 ? za[2 * e] : zb[2 * e - 4], z1 = e < 2 ? za[2 * e + 1] : zb[2 * e - 3];
                    const unsigned hz = pg8::cvt_pk_bf16(z0, z1), lz = pg8::cvt_pk_bf16(z0 - __uint_as_float(hz << 16), z1 - __uint_as_float(hz & 0xffff0000u)); zy[e] = fq < 2 ? hz : lz; }
                const bf16x8 zf = __builtin_bit_cast(bf16x8, (u32x4){zy[0], zy[1], zy[2], zy[3]});
                f32x4 xa = (f32x4){gbias, gbias, gbias, gbias};
                xa = __builtin_amdgcn_mfma_f32_16x16x32_bf16(zf, wx1, xa, 0, 0, 0);
                xa = __builtin_amdgcn_mfma_f32_16x16x32_bf16(zf, wx2, xa, 0, 0, 0);
#pragma unroll
                for (int i = 0; i < 4; ++i) { const float x = xa[i];
                    const float l = __builtin_amdgcn_logf(1.f + __builtin_amdgcn_exp2f(-fabsf(x) * 1.4426950408889634f));
                    c[4 * T + i] = (fminf(x, 0.f) * 1.4426950408889634f - l) * (1.f / 16.f); }
            }
            float cl = 0.f;
            if (dir == 0) {
#pragma unroll
                for (int T = 0; T < 4; ++T) {
                    c[4 * T + 1] += c[4 * T]; c[4 * T + 2] += c[4 * T + 1]; c[4 * T + 3] += c[4 * T + 2];
                    const float R = c[4 * T + 3];
                    const float p1 = swz_xor<16>(R), pair = R + p1;
                    auto rr = __builtin_amdgcn_permlane32_swap(__float_as_uint(pair), __float_as_uint(pair), false, false);
                    const float q = __uint_as_float(fq >= 2 ? rr[0] : rr[1]);
                    const float ex = ((fq & 1) ? p1 : 0.f) + ((fq & 2) ? q : 0.f) + cl;
#pragma unroll
                    for (int i = 0; i < 4; ++i) c[4 * T + i] += ex;
                    cl += pair + q;
                }
            } else {
#pragma unroll
                for (int T = 3; T >= 0; --T) {
                    c[4 * T + 2] += c[4 * T + 3]; c[4 * T + 1] += c[4 * T + 2]; c[4 * T] += c[4 * T + 1];
                    const float R = c[4 * T];
                    const float p1 = swz_xor<16>(R), pair = R + p1;
                    auto rr = __builtin_amdgcn_permlane32_swap(__float_as_uint(pair), __float_as_uint(pair), false, false);
                    const float q = __uint_as_float(fq >= 2 ? rr[0] : rr[1]);
                    const float ex = ((fq & 1) ? 0.f : p1) + ((fq & 2) ? 0.f : q) + cl;
#pragma unroll
                    for (int i = 0; i < 4; ++i) c[4 * T + i] += ex;
                    cl += pair + q;
                }
            }
            if (fq == 0) cls[pd] = cl;
            const float qs = 0.08838834764831845f, ecl = __builtin_amdgcn_exp2f(cl);
            const int dch = pd >> 3, dlo = (pd & 7) * 2;
            const LAS unsigned char* qsrc = sb + fq * 1024 + ((dch ^ (2 * fq)) << 4) + dlo;
#pragma unroll
            for (int T = 0; T < 4; ++T) {
                unsigned kw[2];
#pragma unroll
                for (int i = 0; i < 4; i += 2) {
                    const int n = 4 * T + i;
                    const float c0 = c[n], c1 = c[n + 1];
                    const float e0 = __builtin_amdgcn_exp2f(c0), e1 = __builtin_amdgcn_exp2f(c1);
                    const float r0 = __builtin_amdgcn_rcpf(e0), r1 = __builtin_amdgcn_rcpf(e1);
                    const float q0 = bf2f(*(const LAS bf16_t*)(qsrc + 4096 * T + 256 * i)), q1 = bf2f(*(const LAS bf16_t*)(qsrc + 4096 * T + 256 * (i + 1)));
                    const float k0 = bf2f(*(const LAS bf16_t*)(qsrc + SB_K + 4096 * T + 256 * i)), k1 = bf2f(*(const LAS bf16_t*)(qsrc + SB_K + 4096 * T + 256 * (i + 1)));
                    const int tk0 = 16 * T + 4 * fq + i;
                    const unsigned qq = pg8::cvt_pk_bf16(q0 * qs * e0, q1 * qs * e1), kk2 = pg8::cvt_pk_bf16(k0 * r0, k1 * r1);
                    *(LAS bf16_t*)(qd + gla_o256(tk0, dch) + dlo) = (bf16_t)(qq & 0xffffu); *(LAS bf16_t*)(qd + gla_o256(tk0 + 1, dch) + dlo) = (bf16_t)(qq >> 16);
                    *(LAS bf16_t*)(ki + gla_o256(tk0, dch) + dlo) = (bf16_t)(kk2 & 0xffffu); *(LAS bf16_t*)(ki + gla_o256(tk0 + 1, dch) + dlo) = (bf16_t)(kk2 >> 16);
                    kw[i >> 1] = pg8::cvt_pk_bf16(k0 * (ecl * r0), k1 * (ecl * r1));
                }
                *(LAS u32x2*)(ksT + gla_o128(pd, 2 * T + (fq >> 1)) + (fq & 1) * 8) = (u32x2){kw[0], kw[1]};
            }
        }
        __syncthreads();
        {
            const int it = wv_ >> 1;
            f32x4 a2[2] = {(f32x4){0.f, 0.f, 0.f, 0.f}, (f32x4){0.f, 0.f, 0.f, 0.f}};
#pragma unroll
            for (int kk = 0; kk < 4; ++kk) {
                const bf16x8 xa = *(const LAS bf16x8*)(qd + gla_o256(16 * it + fr, 4 * kk + fq));
#pragma unroll
                for (int jj = 0; jj < 2; ++jj) { const int jt = 2 * (wv_ & 1) + jj;
                    const bf16x8 yb = *(const LAS bf16x8*)(ki + gla_o256(16 * jt + fr, 4 * kk + fq));
                    a2[jj] = __builtin_amdgcn_mfma_f32_16x16x32_bf16(yb, xa, a2[jj], 0, 0, 0); }
            }
#pragma unroll
            for (int jj = 0; jj < 2; ++jj) { const int jt = 2 * (wv_ & 1) + jj; const int i = 16 * it + fr, j0 = 16 * jt + 4 * fq;
                float m4[4];
#pragma unroll
                for (int cc = 0; cc < 4; ++cc) { const int j = j0 + cc; const bool keep = dir ? (j >= i) : (j <= i); m4[cc] = keep ? a2[jj][cc] : 0.f; }
                *(LAS u32x2*)(Al + gla_o128(i, j0 >> 3) + (j0 & 7) * 2) = (u32x2){pg8::cvt_pk_bf16(m4[0], m4[1]), pg8::cvt_pk_bf16(m4[2], m4[3])}; }
        }
        __syncthreads();
        {
            GAS u32x4* gq = (GAS u32x4*)(ws + WS_GQD + (size_t)t * 16384); GAS u32x4* gk = (GAS u32x4*)(ws + WS_GKS + (size_t)t * 16384); GAS u32x4* ga = (GAS u32x4*)(ws + WS_GA + (size_t)t * 8192); GAS u32x4* gc = (GAS u32x4*)(ws + WS_GCL + (size_t)t * 512);
            gq[tid] = *(const LAS u32x4*)(qd + tid * 16); gq[tid + 512] = *(const LAS u32x4*)(qd + (tid + 512) * 16);
            gk[tid] = *(const LAS u32x4*)(ksT + tid * 16); gk[tid + 512] = *(const LAS u32x4*)(ksT + (tid + 512) * 16);
            ga[tid] = *(const LAS u32x4*)(Al + tid * 16);
            if (tid < 32) gc[tid] = *(const LAS u32x4*)((LAS unsigned char*)cls + tid * 16);
        }
        __syncthreads();
    }
    asm volatile("s_waitcnt vmcnt(0)" ::: "memory");
#undef GLAP_DMA
#undef GLAP_TASK
}

__device__ __forceinline__ void phase_gla_scan(const P& p, int layer, LAS unsigned char* lds, int vcu, int G, const int wv_) {
    unsigned char* ws = p.ws; asm volatile("" : "+s"(ws));
    const int lane = hw_tid(), tid = (wv_ << 6) | lane, fr = lane & 15, fq = lane >> 4;
    constexpr int B_QD = 0, B_KST = 16384, B_A = 32768, B_V = 40960, B_CL = 49152, BUF = 50176, L_ST = 2 * BUF;
    static_assert(L_ST + 16384 <= RING_BYTES, "gla scan LDS map");
    LAS unsigned char* ST = lds + L_ST;
    const unsigned lds0 = (unsigned)(size_t)lds;
    const bf16_t* X = (const bf16_t*)(ws + WS_B1);
    for (int u = vcu; u < 256; u += G) {
        const int b = u >> 5, h = (u >> 3) & 3, dir = (u >> 2) & 1, sl = u & 3;
        bf16_t* O = (bf16_t*)(ws + WS_B2) + (dir ? (size_t)68 * MiB / 2 : 0);
        const int tk0 = gla_task(b, h, dir, 0);
        f32x4 sacc[4];
#pragma unroll
        for (int et = 0; et < 4; ++et) sacc[et] = (f32x4){0.f, 0.f, 0.f, 0.f};
        for (int e = tid; e < 4096; e += NTHR) ((LAS unsigned*)ST)[e] = 0u;
#define GLAS_DMA(s_) do { const int s__ = (s_); const unsigned bo_ = lds0 + (unsigned)((s__ & 1) * BUF); const size_t tk_ = (size_t)(tk0 + s__); const unsigned lo_ = (unsigned)lane * 16u; \
            pg8::glds16_s((const char*)(ws + WS_GQD) + tk_ * 16384 + (2 * wv_) * 1024, lo_, bo_ + B_QD + (2 * wv_) * 1024); pg8::glds16_s((const char*)(ws + WS_GQD) + tk_ * 16384 + (2 * wv_ + 1) * 1024, lo_, bo_ + B_QD + (2 * wv_ + 1) * 1024); \
            pg8::glds16_s((const char*)(ws + WS_GKS) + tk_ * 16384 + (2 * wv_) * 1024, lo_, bo_ + B_KST + (2 * wv_) * 1024); pg8::glds16_s((const char*)(ws + WS_GKS) + tk_ * 16384 + (2 * wv_ + 1) * 1024, lo_, bo_ + B_KST + (2 * wv_ + 1) * 1024); \
            pg8::glds16_s((const char*)(ws + WS_GA) + tk_ * 8192 + wv_ * 1024, lo_, bo_ + B_A + wv_ * 1024); \
            pg8::glds16_s((const char*)(X + (size_t)(gla_rowc(b, dir, s__) + 8 * wv_) * 3072 + 1024 + h * 256 + sl * 64), (unsigned)((lane >> 3) * 6144 + (((lane & 7) ^ (2 * (((lane >> 4) & 1) | ((wv_ & 1) << 1)))) << 4)), bo_ + B_V + wv_ * 1024); \
            if (wv_ == 0 && lane < 32) pg8::glds16_s((const char*)(ws + WS_GCL) + tk_ * 512, lo_, bo_ + B_CL); } while (0)
        GLAS_DMA(0); GLAS_DMA(1);
        __syncthreads();
#pragma unroll 1
        for (int s = 0; s < 68; ++s) {
            LAS unsigned char* bq = lds + (s & 1) * BUF;
            const int rowc = gla_rowc(b, dir, s);
            if (s == 0) asm volatile("s_waitcnt vmcnt(6)" ::: "memory");
            else if (s == 1) { if (wv_ == 0) asm volatile("s_waitcnt vmcnt(9)" ::: "memory"); else asm volatile("s_waitcnt vmcnt(8)" ::: "memory"); }
            else if (s + 1 < 68) { if (wv_ == 0) asm volatile("s_waitcnt vmcnt(11)" ::: "memory"); else asm volatile("s_waitcnt vmcnt(10)" ::: "memory"); }
            else asm volatile("s_waitcnt vmcnt(4)" ::: "memory");
            __syncthreads();
            {
                const int it = wv_ >> 1, e0 = 2 * (wv_ & 1);
                bf16x8 fa[2], fq4[4], fv[2][4], fs[4][2], fk[2];
                typedef short s4v __attribute__((ext_vector_type(4)));
                const int tq = fr >> 2, tp = fr & 3, fx = ((tq >> 1) & 1) | ((fq & 1) << 1);
                LAS unsigned char* vb = bq + B_V + (8 * fq + tq) * 128 + tp * 8;
#pragma unroll
                for (int kk = 0; kk < 2; ++kk) { fa[kk] = *(const LAS bf16x8*)(bq + B_A + gla_o128(16 * it + fr, 4 * kk + fq)); fk[kk] = *(const LAS bf16x8*)(bq + B_KST + gla_o128(16 * wv_ + fr, 4 * kk + fq));
#pragma unroll
                    for (int et = 0; et < 4; ++et) { LAS unsigned char* va = vb + kk * 4096 + ((et ^ fx) << 5);
                        const s4v lo4 = __builtin_amdgcn_ds_read_tr16_b64_v4i16((LAS s4v*)va), hi4 = __builtin_amdgcn_ds_read_tr16_b64_v4i16((LAS s4v*)(va + 512));
                        fv[kk][et] = __builtin_shufflevector(lo4, hi4, 0, 1, 2, 3, 4, 5, 6, 7); }
 }
#pragma unroll
                for (int kk = 0; kk < 4; ++kk) { fq4[kk] = *(const LAS bf16x8*)(bq + B_QD + gla_o256(16 * it + fr, 4 * kk + fq));
#pragma unroll
                    for (int jj = 0; jj < 2; ++jj) fs[kk][jj] = *(const LAS bf16x8*)(ST + gla_o256(16 * (e0 + jj) + fr, 4 * kk + fq)); }
                const f32x4 clv = *(const LAS f32x4*)(bq + B_CL + (16 * wv_ + 4 * fq) * 4);
                asm volatile("s_waitcnt lgkmcnt(0)" ::: "memory");
                __syncthreads();
                if (s + 2 < 68) GLAS_DMA(s + 2);
                f32x4 o2[2] = {(f32x4){0.f, 0.f, 0.f, 0.f}, (f32x4){0.f, 0.f, 0.f, 0.f}};
                if (wv_ & 1) {
#pragma unroll
                    for (int kk = 0; kk < 2; ++kk)
#pragma unroll
                        for (int jj = 0; jj < 2; ++jj) o2[jj] = __builtin_amdgcn_mfma_f32_16x16x32_bf16(fv[kk][2 + jj], fa[kk], o2[jj], 0, 0, 0);
                } else {
#pragma unroll
                    for (int kk = 0; kk < 2; ++kk)
#pragma unroll
                        for (int jj = 0; jj < 2; ++jj) o2[jj] = __builtin_amdgcn_mfma_f32_16x16x32_bf16(fv[kk][jj], fa[kk], o2[jj], 0, 0, 0);
                }
#pragma unroll
                for (int kk = 0; kk < 4; ++kk)
#pragma unroll
                    for (int jj = 0; jj < 2; ++jj) o2[jj] = __builtin_amdgcn_mfma_f32_16x16x32_bf16(fs[kk][jj], fq4[kk], o2[jj], 0, 0, 0);
                const f32x4 dec = (f32x4){__builtin_amdgcn_exp2f(clv[0]), __builtin_amdgcn_exp2f(clv[1]), __builtin_amdgcn_exp2f(clv[2]), __builtin_amdgcn_exp2f(clv[3])};
#pragma unroll
                for (int et = 0; et < 4; ++et) sacc[et] = sacc[et] * dec;
#pragma unroll
                for (int kk = 0; kk < 2; ++kk)
#pragma unroll
                    for (int et = 0; et < 4; ++et) sacc[et] = __builtin_amdgcn_mfma_f32_16x16x32_bf16(fk[kk], fv[kk][et], sacc[et], 0, 0, 0);
#pragma unroll
                for (int jj = 0; jj < 2; ++jj) { const int et = e0 + jj;
                    *(GAS u32x2*)(O + (size_t)(rowc + 16 * it + fr) * 1024 + h * 256 + sl * 64 + 16 * et + 4 * fq) = (u32x2){pg8::cvt_pk_bf16(o2[jj][0], o2[jj][1]), pg8::cvt_pk_bf16(o2[jj][2], o2[jj][3])}; }
            }
#pragma unroll
            for (int et = 0; et < 4; ++et) { const int d0 = 16 * wv_ + 4 * fq; *(LAS u32x2*)(ST + gla_o256(16 * et + fr, d0 >> 3) + (d0 & 7) * 2) = (u32x2){pg8::cvt_pk_bf16(sacc[et][0], sacc[et][1]), pg8::cvt_pk_bf16(sacc[et][2], sacc[et][3])}; }
        }
        __syncthreads();
#undef GLAS_DMA
    }
}

__device__ __forceinline__ void phase_gla_merge(const P& p, int layer, int vcu, int G, const int wv_) {
    unsigned char* ws = p.ws; asm volatile("" : "+s"(ws));
    const int lane = hw_tid(), wave = wv_;
    constexpr int NRW = 4;
    const bf16_t* OF = (const bf16_t*)(ws + WS_B2); const bf16_t* OB = OF + (size_t)68 * MiB / 2; bf16_t* O = (bf16_t*)(ws + WS_B2);
    const bf16_t* X = (const bf16_t*)(ws + WS_B1);
    const f32x4 gn = *(const f32x4*)(p.gla_o_norm + (layer >> 1) * 256 + lane * 4);
    for (int r0 = (vcu * NWAVES + wave) * NRW; r0 < NR; r0 += G * NWAVES * NRW) {
        u32x2 a[NRW][4], bb[NRW][4], og[NRW][4];
#pragma unroll
        for (int q = 0; q < NRW; ++q)
#pragma unroll
            for (int h = 0; h < 4; ++h) { const size_t i0 = (size_t)(r0 + q) * 1024 + h * 256 + lane * 4;
                a[q][h] = *(const u32x2*)(OF + i0); bb[q][h] = *(const u32x2*)(OB + i0); og[q][h] = *(const u32x2*)(X + (size_t)(r0 + q) * 3072 + 2048 + h * 256 + lane * 4); }
#pragma unroll
        for (int q = 0; q < NRW; ++q)
#pragma unroll
            for (int h = 0; h < 4; ++h) {
                float x[4];
                x[0] = __uint_as_float(a[q][h].x << 16) + __uint_as_float(bb[q][h].x << 16); x[1] = __uint_as_float(a[q][h].x & 0xffff0000u) + __uint_as_float(bb[q][h].x & 0xffff0000u);
                x[2] = __uint_as_float(a[q][h].y << 16) + __uint_as_float(bb[q][h].y << 16); x[3] = __uint_as_float(a[q][h].y & 0xffff0000u) + __uint_as_float(bb[q][h].y & 0xffff0000u);
                const float ss = wave_sum((x[0] * x[0] + x[1] * x[1]) + (x[2] * x[2] + x[3] * x[3]));
                const float rs = rsqrtf(ss * (1.f / 256.f) + EPS);
                const float ogf[4] = {__uint_as_float(og[q][h].x << 16), __uint_as_float(og[q][h].x & 0xffff0000u), __uint_as_float(og[q][h].y << 16), __uint_as_float(og[q][h].y & 0xffff0000u)};
                float r[4];
#pragma unroll
                for (int j = 0; j < 4; ++j) r[j] = x[j] * rs * gn[j] * silu_f(ogf[j]);
                *(u32x2*)(O + (size_t)(r0 + q) * 1024 + h * 256 + lane * 4) = (u32x2){pk2(r[0], r[1]), pk2(r[2], r[3])};
            }
    }
}

__device__ __forceinline__ int wave_sum_i(int v) {
    v += __builtin_amdgcn_ds_swizzle(v, (1 << 10) | 0x1f); v += __builtin_amdgcn_ds_swizzle(v, (2 << 10) | 0x1f); v += __builtin_amdgcn_ds_swizzle(v, (4 << 10) | 0x1f);
    v += __builtin_amdgcn_ds_swizzle(v, (8 << 10) | 0x1f); v += __builtin_amdgcn_ds_swizzle(v, (16 << 10) | 0x1f);
    auto rr = __builtin_amdgcn_permlane32_swap((unsigned)v, (unsigned)v, false, false);
    return (int)(rr[0] + rr[1]);
}
__device__ __forceinline__ void phase_topk(const P& p, LAS unsigned char* lds, int vcu, int G, const int wv_, const int nunits) {
    unsigned char* ws = p.ws; asm volatile("" : "+s"(ws));
    const int lane = hw_tid(), tid = (wv_ << 6) | lane;
    LAS int* red = (LAS int*)lds;
    const float* aff = (const float*)(ws + WS_AFF);
    int* idx = (int*)(ws + WS_IDX); float* gatev = (float*)(ws + WS_GATE); int* pos = (int*)(ws + WS_POS);
    for (int u = vcu; u < nunits; u += G) {
        const int s = u >> 4, e = u & 15, b = s & 7;
        const int n = s < 8 ? SEQ : CTXL, cap = n / 8;
        const int row0 = b * RPB + (s < 8 ? 0 : SEQ);
        unsigned key[8];
#pragma unroll
        for (int k = 0; k < 8; ++k) { const int i = tid * 8 + k; key[k] = i < n ? (__float_as_uint(aff[(size_t)(row0 + i) * 16 + e]) | 0x80000000u) : 0u; }
        unsigned T = 0u;
#pragma unroll 1
        for (int lo = 30; lo >= 0; lo -= 2) {
            const unsigned c1 = T | (1u << lo), c2 = T | (2u << lo), c3 = T | (3u << lo);
            int c = 0;
#pragma unroll
            for (int k = 0; k < 8; ++k) c += (key[k] >= c1 ? 1 : 0) + (key[k] >= c2 ? (1 << 10) : 0) + (key[k] >= c3 ? (1 << 20) : 0);
            c = wave_sum_i(c);
            LAS int* rb = red + ((lo >> 1) & 1) * 8;
            if (lane == 0) rb[wv_] = c;
            __syncthreads();
            int t1 = 0, t2 = 0, t3 = 0;
#pragma unroll
            for (int q = 0; q < 8; ++q) { const int v = rb[q]; t1 += v & 1023; t2 += (v >> 10) & 1023; t3 += (v >> 20) & 1023; }
            T = t3 >= cap ? c3 : (t2 >= cap ? c2 : (t1 >= cap ? c1 : T));
        }
        int mine = 0;
#pragma unroll
        for (int k = 0; k < 8; ++k) mine += (key[k] > T ? 1 : 0) + (key[k] == T ? 0x10000 : 0);
        int inc = mine;
#pragma unroll
        for (int o = 1; o < 64; o <<= 1) { const int t2 = __builtin_amdgcn_ds_bpermute(((lane - o) & 63) << 2, inc); if (lane >= o) inc += t2; }
        __syncthreads();
        if (lane == 63) red[16 + wv_] = inc;
        __syncthreads();
        int base = 0, total = 0;
#pragma unroll
        for (int q = 0; q < 8; ++q) { const int t2 = red[16 + q]; total += t2; if (q < wv_) base += t2; }
        int ex = base + inc - mine;
        const int m = total & 0xffff;
        const int slot0 = (s < 8 ? 0 : NSLOT_LAT) + (e * 8 + b) * cap;
#pragma unroll
        for (int k = 0; k < 8; ++k) {
            const int i = tid * 8 + k;
            if (i < n) {
                const int g = ex & 0xffff, q = ex >> 16;
                int sl = -1;
                if (key[k] > T) sl = g; else if (key[k] == T && m + q < cap) sl = m + q;
                const int row = row0 + i;
                if (sl >= 0) { idx[slot0 + sl] = row; gatev[slot0 + sl] = __uint_as_float(key[k] & 0x7fffffffu); }
                pos[(size_t)row * 16 + e] = sl >= 0 ? slot0 + sl : -1;
                ex += (key[k] > T ? 1 : 0) + (key[k] == T ? 0x10000 : 0);
            }
        }
        __syncthreads();
    }
}

constexpr int N_PHASES = 38;
__global__ void __launch_bounds__(NTHR, 2) mega_fwd(P p) {
    extern __shared__ __attribute__((aligned(16))) unsigned char lds_raw[];
    LAS unsigned char* lds = (LAS unsigned char*)lds_raw;
    volatile LAS unsigned* MISC = (volatile LAS unsigned*)(lds + MISC_OFF);
    const int tid = threadIdx.x;
    const int wv0 = __builtin_amdgcn_readfirstlane(tid >> 6);
    const int G = gridDim.x; const int bx0 = blockIdx.x;
    const int vcu0 = (G % 8 == 0) ? (bx0 % 8) * (G / 8) + bx0 / 8 : bx0;
    for (int u = tid; u < (LDS_BYTES - RING_BYTES) / 4; u += NTHR) ((LAS unsigned*)(lds + RING_BYTES))[u] = 0u;
    __syncthreads();
    const int lo = p.ph_lo, hi = p.ph_hi;
    unsigned* barw = (unsigned*)(p.ws + WS_CTL) + 4096 + p.seg * XCD_BAR_WORDS;
    XcdBarrier bar; bar.bar = barw; bar.x = 0; bar.st = MISC + 8;
    if (hi - lo > 1) bar = xcd_barrier_post(barw, MISC + 8);
#define IN(k) (lo <= (k) && (k) < hi)
#define SEAM(k) do { if ((k) + 1 < hi) xcd_barrier(bar, wv0); } while (0)
    if (IN(0)) { for (int rep_ = 0; rep_ < ((DUP_MASK >> 0) & 1) + 1; ++rep_) { phase_prologue(p, lds, vcu0, G, wv0); } SEAM(0); }
#pragma unroll 1
    for (int layer = 0; layer < 4; ++layer) {
        const int base = 1 + 9 * layer, li = layer >> 1;
        int bx = bx0, vcu = vcu0, wv = wv0; unsigned char* ws = p.ws; asm volatile("" : "+s"(bx), "+s"(vcu), "+s"(ws), "+s"(wv));
        if (IN(base + 0)) { if (layer == 0) phase_norm<0>(p, layer, lds, vcu, G, wv); else phase_norm<1>(p, layer, lds, vcu, G, wv); SEAM(base + 0); }
        if ((layer & 1) == 0) {
            if (IN(base + 1)) {
                pg8::Gemm g{(const bf16_t*)(ws + WS_U), (const bf16_t*)(ws + W_ATTN_IN) + (size_t)li * 2304 * 1024, NR, 2304, nullptr, 0};
                pg8::StaticOrder S; S.init(NR, 2304, G, bx);
                pg8::EpiQKV E{(bf16_t*)(ws + WS_B1), (const float*)(ws + WS_ROPE + 16384) + li * 256, (const float*)(ws + WS_ROPE)};
                for (int rep_ = 0; rep_ < ((DUP_MASK >> 1) & 1) + 1; ++rep_) { pg8::gemm_phase<pg8::EpiQKV, false, false>(lds, g, S, E, wv); }
                if (G == 256 && bx >= 200) moe_window(p, lds, layer, 0, bx - 200, wv);
                SEAM(base + 1);
            }
            if (IN(base + 3)) { for (int rep_ = 0; rep_ < ((DUP_MASK >> 2) & 1) + 1; ++rep_) { phase_attn_dense(p, (char*)lds_raw, vcu, G, wv); phase_attn_na(p, layer, (char*)lds_raw, vcu, G, wv); } SEAM(base + 3); }
        } else {
            if (IN(base + 1)) {
                pg8::Gemm g{(const bf16_t*)(ws + WS_U), (const bf16_t*)(ws + W_GLA_IN) + (size_t)li * 3328 * 1024, NR, 3328, nullptr, 0};
                pg8::StaticOrder S; S.init(NR, 3328, G, bx);
                pg8::EpiGlaIn E{(bf16_t*)(ws + WS_B1), (float*)(ws + WS_Z)};
                for (int rep_ = 0; rep_ < ((DUP_MASK >> 1) & 1) + 1; ++rep_) { pg8::gemm_phase<pg8::EpiGlaIn, false, false>(lds, g, S, E, wv); }
                if (G == 256 && bx >= 232) moe_window(p, lds, layer, 0, bx - 232, wv);
                SEAM(base + 1);
            }
            if (IN(base + 2)) { for (int rep_ = 0; rep_ < ((DUP_MASK >> 3) & 1) + 1; ++rep_) { phase_gla_pre(p, layer, lds, vcu, G, wv); } xcd_barrier(bar, wv0); phase_gla_scan(p, layer, lds, vcu, G, wv); SEAM(base + 2); }
            if (IN(base + 3)) { for (int rep_ = 0; rep_ < ((DUP_MASK >> 4) & 1) + 1; ++rep_) { phase_gla_merge(p, layer, vcu, G, wv); } SEAM(base + 3); }
        }
        if (IN(base + 4)) {
            const bf16_t* A = (const bf16_t*)(ws + WS_B2);
            const bf16_t* Bt = (layer & 1) ? (const bf16_t*)(ws + W_GLA_OUT) + (size_t)li * 1024 * 1024 : (const bf16_t*)(ws + W_ATTN_OUT) + (size_t)li * 1024 * 1024;
            pg8::Gemm g{A, Bt, NR, 1024, nullptr, 0};
            pg8::StaticOrder S; if (layer == 3) S.init(NB * SEQ, 1024, G, bx, 1); else S.init(NR, 1024, G, bx);
            pg8::EpiResid E{(bf16_t*)(ws + WS_HB), (const float*)(ws + WS_MODS) + (size_t)layer * 9 * 6144, layer == 0 ? p.x : nullptr, layer == 0 ? p.ctx : nullptr};
            pg8::gemm_phase<pg8::EpiResid, false, false>(lds, g, S, E, wv);
            if (layer < 3 && G == 256 && bx >= 32) moe_window(p, lds, layer, 1, bx - 32, wv);
            SEAM(base + 4);
        }
        if (IN(base + 5)) { for (int rep_ = 0; rep_ < ((DUP_MASK >> 5) & 1) + 1; ++rep_) { phase_norm<2>(p, layer, lds, vcu, G, wv, layer == 3); } SEAM(base + 5); }
        if (IN(base + 6)) { for (int rep_ = 0; rep_ < ((DUP_MASK >> 6) & 1) + 1; ++rep_) { phase_topk(p, lds, vcu, G, wv, layer == 3 ? 128 : 256); }
            if (G == 256 && vcu >= 128) moe_window(p, lds, layer, 2, vcu - 128, wv);        SEAM(base + 6); }
        if (IN(base + 7)) {
            pg8::Gemm g{(const bf16_t*)(ws + WS_U), (const bf16_t*)(ws + W_MOE_UP) + (size_t)layer * 16 * 2048 * 1024, NSLOT, 2048, (const int*)(ws + WS_IDX), (size_t)2048 * 1024 * 2};
            pg8::StaticOrder S; S.init(layer == 3 ? NSLOT_LAT : NSLOT, 2048, G, bx);
            pg8::EpiSwiGLU E{(bf16_t*)(ws + WS_B1)};
            for (int rep_ = 0; rep_ < ((DUP_MASK >> 7) & 1) + 1; ++rep_) { pg8::gemm_phase<pg8::EpiSwiGLU, true, true>(lds, g, S, E, wv); }
            if (layer < 3 && G == 256 && bx >= 128) moe_window(p, lds, layer, 3, bx - 128, wv);
            SEAM(base + 7);
        }
        if (IN(base + 8)) {
            pg8::Gemm g{(const bf16_t*)(ws + WS_B1), (const bf16_t*)(ws + W_MOE_DN) + (size_t)layer * 16 * 1024 * 1024, NSLOT, 1024, nullptr, (size_t)1024 * 1024 * 2};
            pg8::StaticOrder S; S.init(layer == 3 ? NSLOT_LAT : NSLOT, 1024, G, bx);
            pg8::EpiBf16 E{(bf16_t*)(ws + WS_B2), 1024, (const float*)(ws + WS_GATE)};
            for (int rep_ = 0; rep_ < ((DUP_MASK >> 8) & 1) + 1; ++rep_) { pg8::gemm_phase<pg8::EpiBf16, false, true>(lds, g, S, E, wv); }
            if (layer < 3 && G == 256 && bx >= 64) moe_window(p, lds, layer, 4, bx - 64, wv);
            SEAM(base + 8);
        }
    }
    if (IN(37)) phase_norm<3>(p, 3, lds, vcu0, G, wv0);
#undef IN
#undef SEAM
}
}

extern "C" void kernel_launch(void* const* d_in, const int* in_sizes, int n_in, void* d_out, int out_size, void* d_ws, size_t ws_size, hipStream_t stream) {
    static int grid = 0;
    if (grid == 0) {
        if (ws_size < WS_END) { fprintf(stderr, "kernel_launch: workspace too small: %zu < %zu\n", ws_size, (size_t)WS_END); grid = -1; return; }
        int dev = 0, cus = 0;
        if (hipGetDevice(&dev) != hipSuccess || hipDeviceGetAttribute(&cus, hipDeviceAttributeMultiprocessorCount, dev) != hipSuccess) { grid = -1; return; }
        if (hipFuncSetAttribute((const void*)mega_fwd, hipFuncAttributeMaxDynamicSharedMemorySize, LDS_BYTES) != hipSuccess) { fprintf(stderr, "kernel_launch: hipFuncSetAttribute failed\n"); grid = -1; return; }
        int per_cu = 0;
        if (hipOccupancyMaxActiveBlocksPerMultiprocessor(&per_cu, (const void*)mega_fwd, NTHR, LDS_BYTES) != hipSuccess || per_cu < 1) fprintf(stderr, "kernel_launch: occupancy query reports %d\n", per_cu);
        (void)hipGetLastError();
        grid = cus;
    }
    if (grid < 0) return;
    (void)hipMemsetAsync((char*)d_ws + WS_CTL, 0, CTL_ZERO_BYTES, stream);
    P p{};
    const float** pp = (const float**)&p;
    for (int i = 0; i < 26; ++i) pp[i] = (const float*)d_in[i];
    p.out = (float*)d_out; p.ws = (unsigned char*)d_ws;
    p.ph_lo = 0; p.ph_hi = N_PHASES; p.seg = 0;
    hipLaunchKernelGGL(mega_fwd, dim3(grid), dim3(NTHR), LDS_BYTES, stream, p);
}
```

```cpp
#include <hip/hip_runtime.h>
#include <stdint.h>
#include <math.h>
#include <cstdio>

#ifndef DUP_MASK
#define DUP_MASK 0
#endif

namespace {
#define LAS __attribute__((address_space(3)))
#define GAS __attribute__((address_space(1)))
typedef unsigned short bf16_t;
typedef short bf16x8 __attribute__((ext_vector_type(8)));
typedef float f32x4 __attribute__((ext_vector_type(4)));
typedef unsigned u32x4 __attribute__((ext_vector_type(4)));
typedef unsigned u32x2 __attribute__((ext_vector_type(2)));

constexpr int D = 1024, NB = 8, SEQ = 4096, CTXL = 256, RPB = 4352, NR = NB * RPB;
constexpr int NSLOT_LAT = 65536, NSLOT = 69632;
constexpr int NTHR = 512, NWAVES = 8;
constexpr size_t MiB = 1u << 20;
constexpr size_t WS_CTL = 0, CTL_ZERO_BYTES = 1 * MiB;
constexpr size_t WS_MODS = 2 * MiB;
constexpr size_t WS_ROPE = 3 * MiB;
constexpr size_t WS_AFF = 12 * MiB;
constexpr size_t WS_POS = 15 * MiB;
constexpr size_t WS_IDX = 18 * MiB;
constexpr size_t WS_GATE = 19 * MiB;
constexpr size_t WS_Z = 20 * MiB;
constexpr size_t WS_U = 32 * MiB;
constexpr size_t WS_B1 = 100 * MiB;
constexpr size_t WS_B2 = 304 * MiB;
constexpr size_t WS_HB = WS_B2 + 136 * MiB;
constexpr size_t WS_W = 508 * MiB;
constexpr size_t W_ATTN_IN = WS_W, W_ATTN_OUT = WS_W + 9 * MiB, W_GLA_IN = WS_W + 13 * MiB, W_GLA_OUT = WS_W + 26 * MiB, W_MOE_UP = WS_W + 30 * MiB, W_MOE_DN = WS_W + 286 * MiB;
constexpr size_t WS_GQD = WS_U;
constexpr size_t WS_GKS = WS_W + 414 * MiB;
constexpr size_t WS_GA = WS_GKS + 68 * MiB;
constexpr size_t WS_GCL = WS_GA + 34 * MiB;
constexpr size_t WS_END = WS_GCL + 3 * MiB;
constexpr float EPS = 1e-6f;
constexpr int LDS_BYTES = 147456;
constexpr int RING_BYTES = 131072, MISC_OFF = RING_BYTES + 320;

struct P {
    const float *x, *c, *ctx, *c_ctx, *ada_w, *ada_b, *norm1_g, *norm2_g, *attn_w_in, *attn_w_out,
        *a_q_norm, *a_k_norm, *b_q_norm, *b_k_norm, *na_rpb, *gla_w_in, *gk_w_f, *gk_b_f, *gk_w_b, *gk_b_b,
        *gla_o_norm, *gla_w_out, *moe_router, *moe_w_gate, *moe_w_up, *moe_w_down;
    float* out; unsigned char* ws;
    int ph_lo, ph_hi, seg, pad;
};

__device__ __forceinline__ float bf2f(bf16_t v) { return __uint_as_float(((unsigned)v) << 16); }
__device__ __forceinline__ unsigned f2bf(float f) { unsigned u = __float_as_uint(f); return (u + 0x7fffu + ((u >> 16) & 1u)) >> 16; }
__device__ __forceinline__ unsigned pk2(float lo, float hi) { return f2bf(lo) | (f2bf(hi) << 16); }
__device__ __forceinline__ int hw_tid() {
    int t; asm volatile("v_mbcnt_lo_u32_b32 %0, -1, 0\n\tv_mbcnt_hi_u32_b32 %0, -1, %0" : "=v"(t)); return t;
}
template <int X> __device__ __forceinline__ float swz_xor(float v) { return __uint_as_float((unsigned)__builtin_amdgcn_ds_swizzle((int)__float_as_uint(v), (X << 10) | 0x1f)); }
__device__ __forceinline__ float wave_sum(float v) {
    v += swz_xor<1>(v); v += swz_xor<2>(v); v += swz_xor<4>(v); v += swz_xor<8>(v); v += swz_xor<16>(v);
    auto rr = __builtin_amdgcn_permlane32_swap(__float_as_uint(v), __float_as_uint(v), false, false);
    return __uint_as_float(rr[0]) + __uint_as_float(rr[1]);
}
__device__ __forceinline__ float silu_f(float x) { return x / (1.f + __expf(-x)); }
__device__ __forceinline__ int mod_row(int row) { const int b = row / RPB, t = row - b * RPB; return t < SEQ ? b : 8; }

namespace pg8 {
constexpr int BM = 256, BK = 64, HALF = 128, HTB = HALF * BK * 2, STAGE_BYTES = 8 * HTB, NXCD = 8, WGM = 8;
__device__ __forceinline__ int lds_byte(int r, int c) { const int st = (r >> 4) * 2 + (c >> 5), rr = r & 15, cc = c & 31, ob = rr * 64 + cc * 2; return st * 1024 + (ob ^ (((ob >> 9) & 1) << 5)); }
__device__ __forceinline__ void stage_rc(int b, int& R, int& C) { const int st = b / 1024, sb = b % 1024, swz = sb ^ (((sb >> 9) & 1) << 5); R = (st >> 1) * 16 + swz / 64; C = (st & 1) * 32 + (swz % 64) / 2; }
__device__ __forceinline__ int perm32(int rho) { const int n = rho >> 4, i = rho & 15; return 8 * (i >> 2) + 4 * n + (i & 3); }
struct Unit { int pm, pn; };
struct Gemm { const bf16_t* A; const bf16_t* Bt; int M, N; const int* gather; size_t bgroup; };
struct StaticOrder {
    int nM, nN, nwg, G, c, skip17;
    __device__ void init(int M, int N, int G_, int c_, int skip17_ = 0) { nM = M / BM; nN = N / BM; nwg = nM * nN; G = G_; c = c_; skip17 = skip17_; }
    __device__ bool next(int i, Unit& u) const {
        const long L = (long)i * G + c; if (L >= nwg) return false;
        int wgid = (int)L; { const int q = nwg / NXCD, r = nwg % NXCD, xcd = wgid % NXCD, off = wgid / NXCD; wgid = (xcd < r ? xcd * (q + 1) : r * (q + 1) + (xcd - r) * q) + off; }
        const int nig = WGM * nN, gid = wgid / nig, fm = gid * WGM, gsz = (nM - fm) < WGM ? (nM - fm) : WGM;
        u.pm = fm + ((wgid % nig) % gsz); u.pn = (wgid % nig) / gsz; if (skip17) u.pm += u.pm >> 4; return true;
    }
};
typedef float f32x2_t_ __attribute__((ext_vector_type(2))); typedef __bf16 bf16x2_t_ __attribute__((ext_vector_type(2)));
__device__ __forceinline__ unsigned cvt_pk_bf16(float lo, float hi) { f32x2_t_ v = {lo, hi}; bf16x2_t_ b = __builtin_convertvector(v, bf16x2_t_); return __builtin_bit_cast(unsigned, b); }
__device__ __forceinline__ int expert_of_tile(int pm) { return pm < 256 ? (pm >> 4) : (pm - 256); }

struct EpiBf16 {
    static constexpr bool PERM = true;
    bf16_t* O; int ldc; const float* rowscale;
    __device__ __forceinline__ void operator()(const f32x4 (&acc)[2][2][4][2], const Unit& u, int wr, int wc, int fr, int fq) const {
        const int row0 = u.pm * BM + wr * 64 + fr, col0 = u.pn * BM + wc * 32 + 8 * fq;
#pragma unroll
        for (int ai = 0; ai < 2; ++ai)
#pragma unroll
            for (int m = 0; m < 4; ++m) { bf16_t* rowp = O + (size_t)(row0 + ai * HALF + m * 16) * ldc + col0;
                const float rsc = rowscale ? rowscale[row0 + ai * HALF + m * 16] : 1.f;
#pragma unroll
                for (int bj = 0; bj < 2; ++bj) { const f32x4 v0 = acc[ai][bj][m][0] * rsc, v1 = acc[ai][bj][m][1] * rsc;
                    u32x4 w; w.x = cvt_pk_bf16(v0[0], v0[1]); w.y = cvt_pk_bf16(v0[2], v0[3]); w.z = cvt_pk_bf16(v1[0], v1[1]); w.w = cvt_pk_bf16(v1[2], v1[3]);
                    *(u32x4*)(rowp + bj * HALF) = w; } }
    }
};
struct EpiQKV {
    static constexpr bool PERM = true;
    bf16_t* O; const float* qkg; const float* rope;
    __device__ __forceinline__ void operator()(const f32x4 (&acc)[2][2][4][2], const Unit& u, int wr, int wc, int fr, int fq) const {
        const int sg = 4 * u.pn + wc;
        const int b = u.pm / 17, tt = u.pm - b * 17;
        const int row0 = u.pm * BM + wr * 64 + fr, col0 = sg * 64 + 8 * fq;
        const bool is_q = sg < 8 || (sg >= 12 && sg < 20), is_v = sg == 10 || sg == 11 || sg >= 28;
        const bool do_rope = sg < 10 && tt < 16;
        const float* gp = qkg + 64 * (sg < 8 ? 0 : (sg < 10 ? 1 : (sg < 20 ? 2 : 3)));
        const float qsc = is_q ? 0.18033688011112042f : 1.f;
        const int lane_hi = fq >> 1;
#pragma unroll
        for (int ai = 0; ai < 2; ++ai)
#pragma unroll
            for (int m = 0; m < 4; ++m) {
                f32x4 v[2][2];
                float ss = 0.f;
#pragma unroll
                for (int bj = 0; bj < 2; ++bj)
#pragma unroll
                    for (int n = 0; n < 2; ++n) { v[bj][n] = acc[ai][bj][m][n]; ss += (v[bj][n][0] * v[bj][n][0] + v[bj][n][1] * v[bj][n][1]) + (v[bj][n][2] * v[bj][n][2] + v[bj][n][3] * v[bj][n][3]); }
                if (!is_v) {
                    ss += swz_xor<16>(ss);
                    { auto rr = __builtin_amdgcn_permlane32_swap(__float_as_uint(ss), __float_as_uint(ss), false, false); ss = __uint_as_float(rr[0]) + __uint_as_float(rr[1]); }
                    const float rs = rsqrtf(ss * (1.f / 64.f) + EPS) * qsc;
                    const float* gpl = gp + 8 * fq; asm volatile("" : "+v"(gpl));
#pragma unroll
                    for (int bj = 0; bj < 2; ++bj)
#pragma unroll
                        for (int n = 0; n < 2; ++n) v[bj][n] = v[bj][n] * rs * *(const f32x4*)(gpl + 32 * bj + 4 * n);
                    if (do_rope) {
                        const int posr = tt * 4 + 2 * ai + wr, posc = 16 * m + fr;
#pragma unroll
                        for (int bj = 0; bj < 2; ++bj) {
                            const float* tb = rope + (bj ? posc : posr) * 16 + 8 * (fq & 1);
#pragma unroll
                            for (int n = 0; n < 2; ++n) {
                                const f32x4 cs = *(const f32x4*)(tb + 4 * n), sn = *(const f32x4*)(tb + 1024 + 4 * n);
                                f32x4 ot;
#pragma unroll
                                for (int e = 0; e < 4; ++e) { auto rr = __builtin_amdgcn_permlane32_swap(__float_as_uint(v[bj][n][e]), __float_as_uint(v[bj][n][e]), false, false);
                                    const float other = __uint_as_float(lane_hi ? rr[0] : rr[1]); ot[e] = lane_hi ? other : -other; }
                                v[bj][n] = v[bj][n] * cs + ot * sn;
                            }
                        }
                    }
                }
                bf16_t* rowp = O + (size_t)(row0 + ai * HALF + m * 16) * 2304 + col0;
#pragma unroll
                for (int bj = 0; bj < 2; ++bj) { u32x4 w; w.x = cvt_pk_bf16(v[bj][0][0], v[bj][0][1]); w.y = cvt_pk_bf16(v[bj][0][2], v[bj][0][3]); w.z = cvt_pk_bf16(v[bj][1][0], v[bj][1][1]); w.w = cvt_pk_bf16(v[bj][1][2], v[bj][1][3]);
                    *(u32x4*)(rowp + 32 * bj) = w; }
            }
    }
};
struct EpiGlaIn {
    static constexpr bool PERM = true;
    bf16_t* O; float* Z;
    __device__ __forceinline__ void operator()(const f32x4 (&acc)[2][2][4][2], const Unit& u, int wr, int wc, int fr, int fq) const {
        const int row0 = u.pm * BM + wr * 64 + fr;
        if (u.pn < 12) {
            const int col0 = u.pn * BM + wc * 32 + 8 * fq;
#pragma unroll
            for (int ai = 0; ai < 2; ++ai)
#pragma unroll
                for (int m = 0; m < 4; ++m) { bf16_t* rowp = O + (size_t)(row0 + ai * HALF + m * 16) * 3072 + col0;
#pragma unroll
                    for (int bj = 0; bj < 2; ++bj) { const f32x4 v0 = acc[ai][bj][m][0], v1 = acc[ai][bj][m][1];
                        u32x4 w; w.x = cvt_pk_bf16(v0[0], v0[1]); w.y = cvt_pk_bf16(v0[2], v0[3]); w.z = cvt_pk_bf16(v1[0], v1[1]); w.w = cvt_pk_bf16(v1[2], v1[3]);
                        *(u32x4*)(rowp + bj * HALF) = w; } }
        } else if (wc == 0) {
#pragma unroll
            for (int ai = 0; ai < 2; ++ai)
#pragma unroll
                for (int m = 0; m < 4; ++m) { float* zp = Z + (size_t)(row0 + ai * HALF + m * 16) * 32 + 8 * fq;
                    *(f32x4*)(zp) = acc[ai][0][m][0]; *(f32x4*)(zp + 4) = acc[ai][0][m][1]; }
        }
    }
};
struct EpiResid {
    static constexpr bool PERM = true;
    bf16_t* hb; const float* mods_l; const float* slat; const float* sctx;
    __device__ __forceinline__ void operator()(const f32x4 (&acc)[2][2][4][2], const Unit& u, int wr, int wc, int fr, int fq) const {
        const int b = u.pm / 17, tt = u.pm - b * 17;
        const int mr = tt < 16 ? b : 8;
        const int col0 = u.pn * BM + wc * 32 + 8 * fq;
        bf16_t* base = hb + (size_t)(u.pm * BM + wr * 64 + fr) * D + col0;
        const float* g2 = mods_l + (size_t)mr * 6144 + 2 * 1024 + col0;
        f32x4 gv[2][2];
#pragma unroll
        for (int bj = 0; bj < 2; ++bj)
#pragma unroll
            for (int n = 0; n < 2; ++n) gv[bj][n] = *(const f32x4*)(g2 + bj * HALF + n * 4);
        if (slat != nullptr) {
            const float* sbase = (tt < 16 ? slat + (size_t)(b * SEQ + tt * 256) * D : sctx + (size_t)(b * CTXL) * D) + (size_t)(wr * 64 + fr) * D + col0;
#pragma unroll
            for (int ai = 0; ai < 2; ++ai) {
                f32x4 hv[4][2][2];
#pragma unroll
                for (int m = 0; m < 4; ++m) { const float* rowp = sbase + (size_t)(ai * HALF + m * 16) * D;
#pragma unroll
                    for (int bj = 0; bj < 2; ++bj)
#pragma unroll
                        for (int n = 0; n < 2; ++n) hv[m][bj][n] = *(const f32x4*)(rowp + bj * HALF + n * 4); }
#pragma unroll
                for (int m = 0; m < 4; ++m) { bf16_t* rowp = base + (size_t)(ai * HALF + m * 16) * D;
#pragma unroll
                    for (int bj = 0; bj < 2; ++bj) { const f32x4 r0 = hv[m][bj][0] + gv[bj][0] * acc[ai][bj][m][0], r1 = hv[m][bj][1] + gv[bj][1] * acc[ai][bj][m][1];
                        *(u32x4*)(rowp + bj * HALF) = (u32x4){cvt_pk_bf16(r0[0], r0[1]), cvt_pk_bf16(r0[2], r0[3]), cvt_pk_bf16(r1[0], r1[1]), cvt_pk_bf16(r1[2], r1[3])}; } }
            }
        } else {
#pragma unroll
            for (int ai = 0; ai < 2; ++ai) {
                u32x4 hv[4][2];
#pragma unroll
                for (int m = 0; m < 4; ++m) { const bf16_t* rowp = base + (size_t)(ai * HALF + m * 16) * D;
#pragma unroll
                    for (int bj = 0; bj < 2; ++bj) hv[m][bj] = *(const u32x4*)(rowp + bj * HALF); }
#pragma unroll
                for (int m = 0; m < 4; ++m) { bf16_t* rowp = base + (size_t)(ai * HALF + m * 16) * D;
#pragma unroll
                    for (int bj = 0; bj < 2; ++bj) { const u32x4 t = hv[m][bj];
                        const f32x4 h0 = (f32x4){__uint_as_float(t.x << 16), __uint_as_float(t.x & 0xffff0000u), __uint_as_float(t.y << 16), __uint_as_float(t.y & 0xffff0000u)};
                        const f32x4 h1 = (f32x4){__uint_as_float(t.z << 16), __uint_as_float(t.z & 0xffff0000u), __uint_as_float(t.w << 16), __uint_as_float(t.w & 0xffff0000u)};
                        const f32x4 r0 = h0 + gv[bj][0] * acc[ai][bj][m][0], r1 = h1 + gv[bj][1] * acc[ai][bj][m][1];
                        *(u32x4*)(rowp + bj * HALF) = (u32x4){cvt_pk_bf16(r0[0], r0[1]), cvt_pk_bf16(r0[2], r0[3]), cvt_pk_bf16(r1[0], r1[1]), cvt_pk_bf16(r1[2], r1[3])}; } }
            }
        }
    }
};
struct EpiSwiGLU {
    static constexpr bool PERM = true;
    bf16_t* O;
    __device__ __forceinline__ void operator()(const f32x4 (&acc)[2][2][4][2], const Unit& u, int wr, int wc, int fr, int fq) const {
        const int row0 = u.pm * BM + wr * 64 + fr, col0 = u.pn * HALF + wc * 32 + 8 * fq;
#pragma unroll
        for (int ai = 0; ai < 2; ++ai)
#pragma unroll
            for (int m = 0; m < 4; ++m) { bf16_t* rowp = O + (size_t)(row0 + ai * HALF + m * 16) * 1024 + col0;
                float r[8];
#pragma unroll
                for (int n = 0; n < 2; ++n)
#pragma unroll
                    for (int e = 0; e < 4; ++e) { const float g = acc[ai][0][m][n][e], up = acc[ai][1][m][n][e]; r[n * 4 + e] = g * __builtin_amdgcn_rcpf(1.f + __expf(-g)) * up; }
                u32x4 w; w.x = cvt_pk_bf16(r[0], r[1]); w.y = cvt_pk_bf16(r[2], r[3]); w.z = cvt_pk_bf16(r[4], r[5]); w.w = cvt_pk_bf16(r[6], r[7]);
                *(u32x4*)rowp = w; }
    }
};

__device__ __forceinline__ void glds16_s(const char* sbase, unsigned voff, unsigned lds_dst) { unsigned keep;
    asm volatile("s_nop 4\n\ts_mov_b32 %0, m0\n\ts_mov_b32 m0, %3\n\ts_nop 0\n\tglobal_load_lds_dwordx4 %1, %2\n\ts_mov_b32 m0, %0" : "=&s"(keep) : "v"(voff), "s"(sbase), "s"(lds_dst) : "memory"); }
template <class Epi, bool GATHER, bool GROUPED>
__device__ __forceinline__ void gemm_phase(LAS unsigned char* lds, const Gemm g, const StaticOrder& S, const Epi& E, const int wv_) {
    const int tid = (wv_ << 6) | hw_tid();
    const int wid = wv_, lane = tid & 63, wr = wid >> 2, wc = wid & 3, fr = lane & 15, fq = lane >> 4;
    constexpr int K = 1024, nt = K / BK;
    unsigned voffA[2], voffB[2];
#pragma unroll
    for (int i = 0; i < 2; ++i) { int R, C; stage_rc(tid * 16 + i * 8192, R, C); const int Rb = Epi::PERM ? ((R & ~31) + perm32(R & 31)) : R;
        voffA[i] = (unsigned)(R * K + C) * 2u; voffB[i] = (unsigned)(Rb * K + C) * 2u; }
#define PG8_RA(i) ((int)(voffA[i] >> 11))
#define PG8_CA(i) (voffA[i] & 2047u)
    constexpr size_t kstep = (size_t)(BK * 2);
    constexpr size_t hstep = (size_t)HALF * K * 2;
    constexpr size_t tstep = 2 * hstep;
    const unsigned ldsw = (unsigned)wid * 1024u, lds0 = (unsigned)(size_t)lds;
    const int aoff = lds_byte(wr * 64 + fr, fq * 8), boff = lds_byte(wc * 32 + fr, fq * 8);
#define PG8_SA(b, h) (((b) * 2 + (h)) * HTB)
#define PG8_SB(b, h) ((4 + (b) * 2 + (h)) * HTB)
#define PG8_STAGE_B(bufoff, gbase) do { _Pragma("unroll") for (int _i = 0; _i < 2; ++_i) \
        glds16_s((const char*)(gbase), voffB[_i], lds0 + (unsigned)(bufoff) + ldsw + (unsigned)(_i * 8192)); } while (0)
#define PG8_STAGE_A(bufoff, kp, h, O) do { _Pragma("unroll") for (int _i = 0; _i < 2; ++_i) { \
        if (GATHER) glds16_s((const char*)(kp), (O)[h][_i], lds0 + (unsigned)(bufoff) + ldsw + (unsigned)(_i * 8192)); \
        else glds16_s((const char*)(kp) + (size_t)(h) * hstep, voffA[_i], lds0 + (unsigned)(bufoff) + ldsw + (unsigned)(_i * 8192)); } } while (0)
#define PG8_LDA(dst, b, h) do { _Pragma("unroll") for (int m = 0; m < 4; ++m) _Pragma("unroll") for (int k = 0; k < 2; ++k) dst[m][k] = *(const LAS bf16x8*)(lds + PG8_SA(b, h) + aoff + m * 2048 + k * 1024); } while (0)
#define PG8_LDB(dst, b, h) do { _Pragma("unroll") for (int n = 0; n < 2; ++n) _Pragma("unroll") for (int k = 0; k < 2; ++k) dst[n][k] = *(const LAS bf16x8*)(lds + PG8_SB(b, h) + boff + n * 2048 + k * 1024); } while (0)
#define PG8_MMA(ai, bj, At, Bt) do { __builtin_amdgcn_s_setprio(1); _Pragma("unroll") for (int m = 0; m < 4; ++m) _Pragma("unroll") for (int n = 0; n < 2; ++n) _Pragma("unroll") for (int k = 0; k < 2; ++k) \
        acc[ai][bj][m][n] = __builtin_amdgcn_mfma_f32_16x16x32_bf16(Bt[n][k], At[m][k], acc[ai][bj][m][n], 0, 0, 0); __builtin_amdgcn_s_setprio(0); } while (0)
#define PG8_WAIT_V(n) asm volatile("s_waitcnt vmcnt(" #n ")" ::: "memory")
#define PG8_WAIT_L(n) asm volatile("s_waitcnt lgkmcnt(" #n ")" ::: "memory")
#define PG8_BAR __builtin_amdgcn_s_barrier()
#define PG8_SCHED __builtin_amdgcn_sched_barrier(0)
#define PG8_BOF(u) ((const char*)g.Bt + (GROUPED ? (size_t)expert_of_tile((u).pm) * g.bgroup : (size_t)0) + (size_t)(u).pn * tstep)
#define PG8_AOF(u) (GATHER ? (const char*)g.A : (const char*)g.A + (size_t)(u).pm * tstep)
    Unit cur, nxt; int ui = 0;
    if (!S.next(0, cur)) return;
    unsigned oc[2][2], on[2][2]; unsigned rn[2];
#pragma unroll
    for (int h = 0; h < 2; ++h)
#pragma unroll
        for (int i = 0; i < 2; ++i) { oc[h][i] = 0u; on[h][i] = 0u; rn[h] = 0u; }
    if (GATHER) {
#pragma unroll
        for (int h = 0; h < 2; ++h)
#pragma unroll
            for (int i = 0; i < 2; ++i) { int row = g.gather[cur.pm * BM + h * HALF + PG8_RA(i)]; row = row < 0 ? 0 : (row >= NR ? NR - 1 : row); oc[h][i] = (unsigned)row * (unsigned)(K * 2) + PG8_CA(i); }
    }
    f32x4 acc[2][2][4][2];
#pragma unroll
    for (int a = 0; a < 2; ++a)
#pragma unroll
        for (int b = 0; b < 2; ++b)
#pragma unroll
            for (int m = 0; m < 4; ++m)
#pragma unroll
                for (int n = 0; n < 2; ++n) acc[a][b][m][n] = (f32x4){0.f, 0.f, 0.f, 0.f};
    bf16x8 At[4][2], B0[2][2], B1[2][2];
    const char* cA = PG8_AOF(cur); const char* cB = PG8_BOF(cur);
    PG8_STAGE_B(PG8_SB(0, 0), cB); PG8_STAGE_B(PG8_SB(0, 1), cB + hstep); PG8_STAGE_A(PG8_SA(0, 0), cA, 0, oc); PG8_STAGE_A(PG8_SA(0, 1), cA, 1, oc);
    if (wr == 1) PG8_BAR;
    PG8_WAIT_V(2); PG8_BAR;
    PG8_STAGE_B(PG8_SB(1, 0), cB + kstep); PG8_STAGE_A(PG8_SA(1, 0), cA + kstep, 0, oc); PG8_STAGE_B(PG8_SB(1, 1), cB + hstep + kstep);
    PG8_WAIT_V(6); PG8_BAR;
#define PG8_KBODY(LAST, O2) do { \
            const char* a1 = cA + (size_t)(t + 1) * kstep; \
            const char* a2 = (LAST) ? nA : cA + (size_t)(t + 2) * kstep; const char* b2 = (LAST) ? nB : cB + (size_t)(t + 2) * kstep; \
            const char* a3 = a2 + kstep; const char* b3 = b2 + kstep; \
            PG8_LDB(B0, 0, 0); PG8_LDB(B1, 0, 1); PG8_SCHED; PG8_LDA(At, 0, 0); PG8_STAGE_A(PG8_SA(1, 1), a1, 1, oc); \
            PG8_WAIT_V(8); PG8_WAIT_L(0); PG8_BAR; PG8_MMA(0, 0, At, B0); PG8_MMA(0, 1, At, B1); PG8_BAR; PG8_SCHED; \
            PG8_LDA(At, 0, 1); PG8_STAGE_B(PG8_SB(0, 0), b2); PG8_STAGE_B(PG8_SB(0, 1), b2 + hstep); PG8_STAGE_A(PG8_SA(0, 0), a2, 0, O2); \
            PG8_WAIT_V(8); PG8_WAIT_L(0); PG8_BAR; PG8_MMA(1, 0, At, B0); PG8_MMA(1, 1, At, B1); PG8_BAR; PG8_SCHED; \
            PG8_LDB(B0, 1, 0); PG8_LDB(B1, 1, 1); PG8_SCHED; PG8_LDA(At, 1, 0); PG8_STAGE_A(PG8_SA(0, 1), a2, 1, O2); \
            PG8_WAIT_V(8); PG8_WAIT_L(0); PG8_BAR; PG8_MMA(0, 0, At, B0); PG8_MMA(0, 1, At, B1); PG8_BAR; PG8_SCHED; \
            PG8_LDA(At, 1, 1); PG8_STAGE_B(PG8_SB(1, 0), b3); PG8_STAGE_B(PG8_SB(1, 1), b3 + hstep); PG8_STAGE_A(PG8_SA(1, 0), a3, 0, O2); \
            PG8_WAIT_V(8); PG8_WAIT_L(0); PG8_BAR; PG8_MMA(1, 0, At, B0); PG8_MMA(1, 1, At, B1); PG8_BAR; PG8_SCHED; \
        } while (0)
    for (;;) {
        const bool has_next = S.next(ui + 1, nxt);
        const char* nA = has_next ? PG8_AOF(nxt) : cA; const char* nB = has_next ? PG8_BOF(nxt) : cB;
        if (GATHER && has_next) {
            const int t2 = (wv_ << 6) | hw_tid();
            int R0, C0, R1, C1; stage_rc(t2 * 16, R0, C0); stage_rc(t2 * 16 + 8192, R1, C1);
            const int* gp = g.gather + nxt.pm * BM;
            rn[0] = ((unsigned)gp[R0] & 0xffffu) | ((unsigned)gp[R1] << 16); rn[1] = ((unsigned)gp[HALF + R0] & 0xffffu) | ((unsigned)gp[HALF + R1] << 16);
        }
        int t = 0;
#pragma unroll 1
        for (; t < nt - 2; t += 2) PG8_KBODY(false, oc);
        if (GATHER) {
#pragma unroll
            for (int h = 0; h < 2; ++h)
#pragma unroll
                for (int i = 0; i < 2; ++i) { int row = (int)(i ? (rn[h] >> 16) : (rn[h] & 0xffffu)); row = row >= NR ? NR - 1 : row; on[h][i] = has_next ? (unsigned)row * (unsigned)(K * 2) + (oc[h][i] & 2047u) : oc[h][i]; }
        }
        PG8_KBODY(true, on);
        if (wr == 0) PG8_BAR;
        { const int l2 = hw_tid(); E(acc, cur, wr, wc, l2 & 15, l2 >> 4); }
        if (!has_next) break;
#pragma unroll
        for (int a = 0; a < 2; ++a)
#pragma unroll
            for (int b = 0; b < 2; ++b)
#pragma unroll
                for (int m = 0; m < 4; ++m)
#pragma unroll
                    for (int n = 0; n < 2; ++n) acc[a][b][m][n] = (f32x4){0.f, 0.f, 0.f, 0.f};
        cur = nxt; cA = nA; cB = nB; ++ui;
        if (GATHER) {
#pragma unroll
            for (int h = 0; h < 2; ++h)
#pragma unroll
                for (int i = 0; i < 2; ++i) oc[h][i] = on[h][i];
        }
        if (wr == 1) PG8_BAR;
    }
    PG8_WAIT_V(0);
    PG8_BAR;
#undef PG8_KBODY
#undef PG8_RA
#undef PG8_CA
#undef PG8_SA
#undef PG8_SB
#undef PG8_STAGE_A
#undef PG8_STAGE_B
#undef PG8_LDA
#undef PG8_LDB
#undef PG8_MMA
#undef PG8_WAIT_V
#undef PG8_WAIT_L
#undef PG8_BAR
#undef PG8_SCHED
#undef PG8_BOF
#undef PG8_AOF
}
}

#define XB_TMO      128
#define XB_XCNT(j)  (256  + 64 * (j))
#define XB_XSUB(j)  (1280 + 64 * (j))
#define XB_XGEN(j)  (2304 + 64 * (j))
#define XB_TOP      3328
#define XB_TOPGEN   3392
#define XCD_BAR_WORDS 3456
#define XB_SPIN_CAP (1u << 22)
__device__ __forceinline__ unsigned xb_ld(unsigned* p)              { return __hip_atomic_load(p, __ATOMIC_RELAXED, __HIP_MEMORY_SCOPE_AGENT); }
__device__ __forceinline__ unsigned xb_add(unsigned* p, unsigned v) { return __hip_atomic_fetch_add(p, v, __ATOMIC_RELAXED, __HIP_MEMORY_SCOPE_AGENT); }
__device__ __forceinline__ unsigned xb_xcc_id() { return (unsigned)__builtin_amdgcn_s_getreg((3 << 11) | 20) & 0xFu; }
#define XB_SPIN(cond, bar) do { unsigned _sp = 0; while (cond) { __builtin_amdgcn_s_sleep(1); \
    if ((++_sp & 255u) == 0u) { if (xb_ld(&(bar)[XB_TMO])) break; if (_sp > XB_SPIN_CAP) { atomicAdd(&(bar)[XB_TMO], 1u); break; } } } } while (0)
struct XcdBarrier { unsigned* bar; unsigned x; volatile LAS unsigned* st; };
__device__ __forceinline__ XcdBarrier xcd_barrier_post(unsigned* bar, volatile LAS unsigned* st) {
    XcdBarrier b; b.bar = bar; b.x = xb_xcc_id(); b.st = st;
    if (threadIdx.x == 0) (void)xb_add(&bar[XB_XCNT(b.x)], 1u);
    return b;
}
__device__ __forceinline__ void xcd_barrier_complete(unsigned* bar, unsigned x, unsigned& nloc, unsigned& nx) {
    const unsigned G = gridDim.x * gridDim.y * gridDim.z;
    unsigned sum, cnt, mine, sp = 0u;
    for (;;) {
        sum = 0u; cnt = 0u; mine = 0u;
#pragma unroll
        for (unsigned j = 0; j < 16; ++j) { const unsigned c = xb_ld(&bar[XB_XCNT(j)]); sum += c; cnt += (c > 0u) ? 1u : 0u; mine = (j == x) ? c : mine; }
        if (sum == G) break;
        __builtin_amdgcn_s_sleep(1);
        if ((++sp & 255u) == 0u) { if (xb_ld(&bar[XB_TMO])) break; if (sp > XB_SPIN_CAP) { atomicAdd(&bar[XB_TMO], 1u); break; } }
    }
    nloc = mine > 0u ? mine : 1u; nx = cnt > 0u ? cnt : 1u;
}
__device__ __forceinline__ void xcd_barrier(const XcdBarrier& b, const int wv_) {
    asm volatile("s_waitcnt vmcnt(0)" ::: "memory");
    __syncthreads();
    if (wv_ == 0 && hw_tid() == 0) {
        unsigned* bar = b.bar; asm volatile("" : "+s"(bar));
        __builtin_amdgcn_s_waitcnt(0);
        unsigned nloc = b.st[0], nx = b.st[1];
        if (nloc == 0u) { xcd_barrier_complete(bar, b.x, nloc, nx); b.st[0] = nloc; b.st[1] = nx; }
        const unsigned old = xb_add(&bar[XB_XSUB(b.x)], 1u);
        const unsigned gen = old / nloc;
        if (old + 1u == (gen + 1u) * nloc) {
            __builtin_amdgcn_fence(__ATOMIC_RELEASE, "agent");
            asm volatile("s_waitcnt vmcnt(0)" ::: "memory");
            const unsigned og = xb_add(&bar[XB_TOP], 1u);
            const unsigned tg = og / nx;
            if (og + 1u == (tg + 1u) * nx) xb_add(&bar[XB_TOPGEN], 1u);
            else XB_SPIN(xb_ld(&bar[XB_TOPGEN]) == tg, bar);
            __builtin_amdgcn_fence(__ATOMIC_ACQUIRE, "agent");
            xb_add(&bar[XB_XGEN(b.x)], 1u);
            asm volatile("s_waitcnt vmcnt(0)" ::: "memory");
        } else {
            XB_SPIN(xb_ld(&bar[XB_XGEN(b.x)]) == gen, bar);
            __builtin_amdgcn_fence(__ATOMIC_ACQUIRE, "agent");
            asm volatile("s_waitcnt vmcnt(0)" ::: "memory");
        }
    }
    __syncthreads();
}

__device__ __forceinline__ void p0_transpose_item(const float* W, int N, int kb, int n0, bf16_t* WTrow0  , LAS float* scr, int lane) {
    const int k0 = 64 * kb;
#pragma unroll 8
    for (int i = 0; i < 32; ++i) { const int kk = 2 * i + (lane >> 5); scr[kk * 33 + (lane & 31)] = W[(size_t)(k0 + kk) * N + n0 + (lane & 31)]; }
    asm volatile("s_waitcnt lgkmcnt(0)" ::: "memory");
    const int c = lane & 7;
#pragma unroll
    for (int j = 0; j < 4; ++j) { const int n = (lane >> 3) + 8 * j; const LAS float* s = scr + (8 * c) * 33 + n;
        u32x4 o; o.x = pk2(s[0 * 33], s[1 * 33]); o.y = pk2(s[2 * 33], s[3 * 33]); o.z = pk2(s[4 * 33], s[5 * 33]); o.w = pk2(s[6 * 33], s[7 * 33]);
        *(u32x4*)(WTrow0 + (size_t)n * 1024 + k0 + 8 * c) = o; }
    asm volatile("s_waitcnt lgkmcnt(0)" ::: "memory");
}
constexpr int MOE_ITEMS = 48 * 512, MOE_ALL = 4 * MOE_ITEMS;
constexpr int MOE_PRO = 13312, WIN_B = 224 * 8 * 4, WIN_C = 128 * 8 * 4, WIN_D = 128 * 8 * 6, WIN_E = 192 * 8 * 4;
__device__ __forceinline__ int win_capA(int layer) { return (layer & 1) ? 24 * 8 * 8 : 56 * 8 * 8; }
__device__ __forceinline__ int win_layer_start(int layer) {
    const int full_even = 56 * 8 * 8 + WIN_B + WIN_C + WIN_D + WIN_E, full_odd = 24 * 8 * 8 + WIN_B + WIN_C + WIN_D + WIN_E;
    return MOE_PRO + (layer > 0 ? full_even : 0) + (layer > 1 ? full_odd : 0) + (layer > 2 ? full_even : 0);
}
__device__ __forceinline__ void moe_item_decode(const P& p, unsigned char* ws, int layer, int q, const float*& src, bf16_t*& dst) {
    const int mat = q >> 9, rr = q & 511, kb = rr >> 5, n0 = (rr & 31) * 32, kind = mat >> 4, le = layer * 16 + (mat & 15);
    if (kind < 2) {
        src = (kind == 0 ? p.moe_w_gate : p.moe_w_up) + (size_t)le * 1024 * 1024 + (size_t)(64 * kb) * 1024 + n0;
        dst = (bf16_t*)(ws + W_MOE_UP) + (size_t)le * 2048 * 1024 + (size_t)((n0 >> 7) * 256 + (n0 & 127) + kind * 128) * 1024 + 64 * kb;
    } else {
        src = p.moe_w_down + (size_t)le * 1024 * 1024 + (size_t)(64 * kb) * 1024 + n0;
        dst = (bf16_t*)(ws + W_MOE_DN) + (size_t)le * 1024 * 1024 + (size_t)n0 * 1024 + 64 * kb;
    }
}
__device__ __forceinline__ void moe_convert_win(const P& p, LAS unsigned char* lds, int g0, int npw, int gend, const int wv_) {
    unsigned char* ws = p.ws; asm volatile("" : "+s"(ws));
    const int lane = hw_tid();
    LAS float* scr = (LAS float*)(lds + wv_ * 16384);
    float va[32], vb[32]; bf16_t* da; bf16_t* db;
    int g = g0 + wv_;
    if (gend > MOE_ALL) gend = MOE_ALL;
    if (g < gend) { const float* sa; moe_item_decode(p, ws, g / MOE_ITEMS, g % MOE_ITEMS, sa, da); sa += (size_t)(lane >> 5) * 1024 + (lane & 31);
#pragma unroll
        for (int i = 0; i < 32; ++i) va[i] = sa[(size_t)(2 * i) * 1024]; }
#pragma unroll 1
    for (int k = 0; k < npw; ++k, g += 8) {
        if (g >= gend) break;
        const bool more = k + 1 < npw && g + 8 < gend;
        if (more) { const float* sb; moe_item_decode(p, ws, (g + 8) / MOE_ITEMS, (g + 8) % MOE_ITEMS, sb, db); sb += (size_t)(lane >> 5) * 1024 + (lane & 31);
#pragma unroll
            for (int i = 0; i < 32; ++i) vb[i] = sb[(size_t)(2 * i) * 1024]; }
#pragma unroll
        for (int i = 0; i < 32; ++i) scr[(2 * i + (lane >> 5)) * 33 + (lane & 31)] = va[i];
        asm volatile("s_waitcnt lgkmcnt(0)" ::: "memory");
        const int c = lane & 7;
#pragma unroll
        for (int j = 0; j < 4; ++j) { const int n = (lane >> 3) + 8 * j; const LAS float* s2 = scr + (8 * c) * 33 + n;
            u32x4 o; o.x = pk2(s2[0 * 33], s2[1 * 33]); o.y = pk2(s2[2 * 33], s2[3 * 33]); o.z = pk2(s2[4 * 33], s2[5 * 33]); o.w = pk2(s2[6 * 33], s2[7 * 33]);
            *(u32x4*)(da + (size_t)n * 1024 + 8 * c) = o; }
        asm volatile("s_waitcnt lgkmcnt(0)" ::: "memory");
        if (more) {
#pragma unroll
            for (int i = 0; i < 32; ++i) va[i] = vb[i];
            da = db; }
    }
}
__device__ __forceinline__ void moe_window(const P& p, LAS unsigned char* lds, int layer, int kind, int blk, const int wv_) {
    const int capA = win_capA(layer), s0 = win_layer_start(layer);
    int start, cap, npw;
    if (kind == 0) { start = s0; cap = capA; npw = 8; }
    else if (kind == 1) { start = s0 + capA; cap = WIN_B; npw = 4; }
    else if (kind == 2) { start = s0 + capA + (layer < 3 ? WIN_B : 0); cap = WIN_C; npw = 4; }
    else if (kind == 3) { start = s0 + capA + WIN_B + WIN_C; cap = WIN_D; npw = 6; }
    else { start = s0 + capA + WIN_B + WIN_C + WIN_D; cap = WIN_E; npw = 4; }
    moe_convert_win(p, lds, start + blk * 8 * npw, npw, start + cap, wv_);
}
__device__ __forceinline__ void phase_prologue(const P& p, LAS unsigned char* lds, int vcu, int G, const int wv_) {
    unsigned char* ws = p.ws; asm volatile("" : "+s"(ws));
    const int tid = (wv_ << 6) | hw_tid();
    const int lane = tid & 63, wave = wv_;
    LAS float* scr = (LAS float*)(lds + wave * 16384);
    const int gw = vcu * NWAVES + wave, NGW = G * NWAVES;
    constexpr int I_AI = 16 * 72, I_AO = 16 * 32, I_GI = 16 * 97, I_GO = 16 * 32, I_SMALL = 2 * (I_AI + I_AO + I_GI + I_GO), I_MOE = 16 * 32;
    const int NITEMS = I_SMALL + (G == 256 ? MOE_PRO : MOE_ALL);
    for (int it = gw; it < NITEMS; it += NGW) {
        int r = it;
        if (r < I_SMALL) {
            const int i = r >= I_SMALL / 2 ? 1 : 0; r -= i * (I_SMALL / 2);
            if (r < I_AI) { const int kb = r / 72, nb = r % 72, n0 = nb * 32, drow = (n0 & ~255) + 128 * ((n0 >> 5) & 1) + 32 * ((n0 >> 6) & 3);
                p0_transpose_item(p.attn_w_in + (size_t)i * 1024 * 2304, 2304, kb, n0, (bf16_t*)(ws + W_ATTN_IN) + (size_t)i * 2304 * 1024 + (size_t)drow * 1024, scr, lane); continue; } r -= I_AI;
            if (r < I_AO) { const int kb = r / 32, nb = r % 32; p0_transpose_item(p.attn_w_out + (size_t)i * 1024 * 1024, 1024, kb, nb * 32, (bf16_t*)(ws + W_ATTN_OUT) + (size_t)i * 1024 * 1024 + (size_t)nb * 32 * 1024, scr, lane); continue; } r -= I_AO;
            if (r < I_GI) { const int kb = r / 97, nb = r % 97; p0_transpose_item(p.gla_w_in + (size_t)i * 1024 * 3104, 3104, kb, nb * 32, (bf16_t*)(ws + W_GLA_IN) + (size_t)i * 3328 * 1024 + (size_t)nb * 32 * 1024, scr, lane); continue; } r -= I_GI;
            { const int kb = r / 32, nb = r % 32; p0_transpose_item(p.gla_w_out + (size_t)i * 1024 * 1024, 1024, kb, nb * 32, (bf16_t*)(ws + W_GLA_OUT) + (size_t)i * 1024 * 1024 + (size_t)nb * 32 * 1024, scr, lane); continue; }
        }
        r -= I_SMALL;
        { int layer_, q_;
          layer_ = r / MOE_ITEMS; q_ = r % MOE_ITEMS;
          const float* src_; bf16_t* dst_; moe_item_decode(p, ws, layer_, q_, src_, dst_); p0_transpose_item(src_, 1024, 0, 0, dst_, scr, lane); }
    }
    for (int it = gw; it < 2 * 224; it += NGW) { const int i = it / 224, rr = 3104 + it % 224; u32x4* dst = (u32x4*)((bf16_t*)(ws + W_GLA_IN) + (size_t)i * 3328 * 1024 + (size_t)rr * 1024);
        dst[lane] = (u32x4){0u, 0u, 0u, 0u}; dst[lane + 64] = (u32x4){0u, 0u, 0u, 0u}; }
    __syncthreads();
    {
        LAS float* s = (LAS float*)lds;
        LAS float* red = (LAS float*)(lds + 9 * 1024 * 4);
        for (int i = tid; i < 9 * 1024; i += NTHR) { const int r = i >> 10, k = i & 1023; const float v = r < 8 ? p.c[r * 1024 + k] : p.c_ctx[k]; s[i] = v / (1.f + expf(-v)); }
        __syncthreads();
        float* mods = (float*)(ws + WS_MODS);
        for (int u = vcu; u < 384; u += G) {
            const int l = u / 96, cb = u % 96, cl = tid & 63, ks = tid >> 6, col = cb * 64 + cl;
            float acc[9];
#pragma unroll
            for (int r = 0; r < 9; ++r) acc[r] = 0.f;
            const float* w = p.ada_w + (size_t)l * 1024 * 6144 + col;
            for (int k = ks * 128; k < ks * 128 + 128; ++k) { const float wv = w[(size_t)k * 6144];
#pragma unroll
                for (int r = 0; r < 9; ++r) acc[r] += s[r * 1024 + k] * wv; }
#pragma unroll
            for (int r = 0; r < 9; ++r) red[(ks * 9 + r) * 64 + cl] = acc[r];
            __syncthreads();
            for (int i = tid; i < 9 * 64; i += NTHR) { const int r = i >> 6, c2 = i & 63; float v = 0.f;
#pragma unroll
                for (int q = 0; q < 8; ++q) v += red[(q * 9 + r) * 64 + c2];
                const int cc = cb * 64 + c2, chunk = cc >> 10; v += p.ada_b[l * 6144 + cc];
                if (chunk == 1) v = p.norm1_g[l * 1024 + (cc & 1023)] * (1.f + v); else if (chunk == 4) v = p.norm2_g[l * 1024 + (cc & 1023)] * (1.f + v);
                mods[(size_t)(l * 9 + r) * 6144 + cc] = v; }
            __syncthreads();
        }
    }
    if (vcu == 1 % G) { float* qkg = (float*)(ws + WS_ROPE + 16384);
        for (int i = tid; i < 512; i += NTHR) { const int l = i >> 8, ty = (i >> 6) & 3, d = i & 63; const float* src = ty == 0 ? p.a_q_norm : (ty == 1 ? p.a_k_norm : (ty == 2 ? p.b_q_norm : p.b_k_norm)); qkg[i] = src[l * 64 + d]; } }
    if (vcu == 0) { float* tab = (float*)(ws + WS_ROPE);
        for (int i = tid; i < 1024; i += NTHR) { const int pos = i >> 4, j = i & 15; const float inv = powf(10000.f, -(float)j / 16.f); const float a = (float)pos * inv; tab[i] = cosf(a); tab[1024 + i] = sinf(a); } }
}

template <int WHICH> __device__ __forceinline__ void phase_norm(const P& p, int layer, LAS unsigned char* lds, int vcu, int G, const int wv_, const bool lat_only = false) {
    unsigned char* ws = p.ws; asm volatile("" : "+s"(ws));
    const int lane = hw_tid(), tid = (wv_ << 6) | lane, wave = wv_;
    constexpr int NRW = 2;
    const float* mods = (const float*)(ws + WS_MODS);
    constexpr int UT_PITCH = 2064;
    LAS unsigned char* ut_hi = lds; LAS unsigned char* ut_lo = lds + 16 * UT_PITCH; LAS float* rpart0 = (LAS float*)(lds + 32 * UT_PITCH);
    int rstepi = 0;
    bf16x8 wfh[4], wfl[4];
    if (WHICH == 2) {
        const float* rwt = p.moe_router + (size_t)layer * 1024 * 16;
        const int fr = lane & 15, fq = lane >> 4;
#pragma unroll
        for (int ks = 0; ks < 4; ++ks) {
            float wv[8];
#pragma unroll
            for (int i = 0; i < 8; ++i) wv[i] = rwt[(size_t)(128 * wave + 32 * ks + 8 * fq + i) * 16 + fr];
            unsigned hh[4], ll[4];
#pragma unroll
            for (int i = 0; i < 4; ++i) { const unsigned h0 = f2bf(wv[2 * i]), h1 = f2bf(wv[2 * i + 1]); hh[i] = h0 | (h1 << 16);
                ll[i] = pk2(wv[2 * i] - __uint_as_float(h0 << 16), wv[2 * i + 1] - __uint_as_float(h1 << 16)); }
            wfh[ks] = __builtin_bit_cast(bf16x8, (u32x4){hh[0], hh[1], hh[2], hh[3]}); wfl[ks] = __builtin_bit_cast(bf16x8, (u32x4){ll[0], ll[1], ll[2], ll[3]});
        }
    }
    const int nrows = (WHICH == 3 || lat_only) ? NB * SEQ : NR;
    constexpr bool COMB = WHICH == 3 || WHICH == 1;
    f32x4 vn[NRW][4]; u32x2 vnb[NRW][4]; int slotn[NRW];
#define NORM_ROWMAP(rr_) do { if (WHICH == 3 || lat_only) { const int b_ = (rr_) / SEQ, t_ = (rr_) - b_ * SEQ; (rr_) = b_ * RPB + t_; } } while (0)
#define NORM_LOAD(r0_, V_, S_) do { _Pragma("unroll") for (int q = 0; q < NRW; ++q) { int rr = (r0_) + q; NORM_ROWMAP(rr); const int b = rr / RPB, t = rr - b * RPB; \
            if constexpr (WHICH == 0) { const float* src = t < SEQ ? p.x + (size_t)(b * SEQ + t) * D : p.ctx + (size_t)(b * CTXL + (t - SEQ)) * D; \
                _Pragma("unroll") for (int j = 0; j < 4; ++j) V_[q][j] = ((const GAS f32x4*)src)[lane + 64 * j]; } \
            else { const bf16_t* src = (const bf16_t*)(ws + WS_HB) + (size_t)rr * D; (void)b; (void)t; \
                _Pragma("unroll") for (int j = 0; j < 4; ++j) V_##b[q][j] = ((const GAS u32x2*)src)[lane + 64 * j]; } \
            if (COMB) S_[q] = lane < 16 ? ((const GAS int*)(ws + WS_POS))[(size_t)rr * 16 + lane] : -1; } } while (0)
    constexpr int rstep = NWAVES * NRW;
    const int ngrp = nrows / rstep;
    int r0 = (int)(((long)vcu * ngrp) / G) * rstep + wave * NRW;
    const int rend = (int)(((long)(vcu + 1) * ngrp) / G) * rstep;
    int mr_cur = -1; f32x4 shv[4], scv[4], m5v[4];
#pragma unroll
    for (int j = 0; j < 4; ++j) { shv[j] = (f32x4){0.f, 0.f, 0.f, 0.f}; scv[j] = shv[j]; m5v[j] = shv[j]; }
    if (r0 < rend) NORM_LOAD(r0, vn, slotn);
    for (; r0 < rend; r0 += rstep) {
        int row[NRW], mr[NRW]; f32x4 v[NRW][4]; int slot[NRW];
#pragma unroll
        for (int q = 0; q < NRW; ++q) {
            int rr = r0 + q; NORM_ROWMAP(rr);
            row[q] = rr;
            const int b = rr / RPB, t = rr - b * RPB;
            mr[q] = t < SEQ ? b : 8;
            slot[q] = slotn[q];
#pragma unroll
            for (int j = 0; j < 4; ++j) {
                if constexpr (WHICH == 0) v[q][j] = vn[q][j];
                else { const u32x2 t2 = vnb[q][j]; v[q][j] = (f32x4){__uint_as_float(t2.x << 16), __uint_as_float(t2.x & 0xffff0000u), __uint_as_float(t2.y << 16), __uint_as_float(t2.y & 0xffff0000u)}; }
            }
        }
        if (mr[0] != mr_cur) {
            mr_cur = mr[0];
            if (WHICH != 3) { const float* shift = mods + (size_t)(layer * 9 + mr_cur) * 6144 + (WHICH <= 1 ? 0 : 3) * 1024;
#pragma unroll
                for (int j = 0; j < 4; ++j) { shv[j] = ((const GAS f32x4*)shift)[lane + 64 * j]; scv[j] = ((const GAS f32x4*)(shift + 1024))[lane + 64 * j]; } }
            if (WHICH == 1 || WHICH == 3) { const float* m5 = mods + (size_t)((WHICH == 3 ? 3 : layer - 1) * 9 + mr_cur) * 6144 + 5 * 1024;
#pragma unroll
                for (int j = 0; j < 4; ++j) m5v[j] = ((const GAS f32x4*)m5)[lane + 64 * j]; }
#pragma unroll
            for (int j = 0; j < 4; ++j) asm volatile("" : "+v"(shv[j]), "+v"(scv[j]), "+v"(m5v[j]));
        }
        if (r0 + rstep < rend) NORM_LOAD(r0 + rstep, vn, slotn);
        if (WHICH == 1 || WHICH == 3) {
            const int pl = WHICH == 3 ? 3 : layer - 1;
            const float* gatev = (const float*)(ws + WS_GATE);
            const bf16_t* Y = (const bf16_t*)(ws + WS_B2);
#pragma unroll
            for (int q = 0; q < NRW; ++q) { if (slot[q] >= NSLOT) slot[q] = -1; }
            unsigned long long mskq[NRW]; int sl4[NRW][4]; u32x2 yv4[NRW][4][4];
#pragma unroll
            for (int q = 0; q < NRW; ++q) { mskq[q] = __ballot(slot[q] >= 0);
#pragma unroll
                for (int i = 0; i < 4; ++i) { sl4[q][i] = -1;
                    if (mskq[q]) { const int e = __builtin_ctzll(mskq[q]); mskq[q] &= mskq[q] - 1; sl4[q][i] = __builtin_amdgcn_readlane(slot[q], e); } } }
#pragma unroll
            for (int q = 0; q < NRW; ++q)
#pragma unroll
                for (int i = 0; i < 4; ++i) if (sl4[q][i] >= 0) { const bf16_t* yr = Y + (size_t)sl4[q][i] * 1024;
#pragma unroll
                    for (int j = 0; j < 4; ++j) yv4[q][i][j] = ((const GAS u32x2*)yr)[lane + 64 * j]; }
#pragma unroll
            for (int q = 0; q < NRW; ++q) {
                f32x4 acc[4];
#pragma unroll
                for (int j = 0; j < 4; ++j) acc[j] = (f32x4){0.f, 0.f, 0.f, 0.f};
#pragma unroll
                for (int i = 0; i < 4; ++i) if (sl4[q][i] >= 0) {
#pragma unroll
                    for (int j = 0; j < 4; ++j) { const u32x2 yv = yv4[q][i][j];
                        acc[j][0] += __uint_as_float(yv.x << 16); acc[j][1] += __uint_as_float(yv.x & 0xffff0000u); acc[j][2] += __uint_as_float(yv.y << 16); acc[j][3] += __uint_as_float(yv.y & 0xffff0000u); } }
                unsigned long long msk = mskq[q];
                while (msk) {
                    const int e = __builtin_ctzll(msk); msk &= msk - 1;
                    const int sl = __builtin_amdgcn_readlane(slot[q], e);
                    const bf16_t* yr = Y + (size_t)sl * 1024;
#pragma unroll
                    for (int j = 0; j < 4; ++j) { const u32x2 yv = ((const GAS u32x2*)yr)[lane + 64 * j];
                        acc[j][0] += __uint_as_float(yv.x << 16); acc[j][1] += __uint_as_float(yv.x & 0xffff0000u); acc[j][2] += __uint_as_float(yv.y << 16); acc[j][3] += __uint_as_float(yv.y & 0xffff0000u); }
                }
#pragma unroll
                for (int j = 0; j < 4; ++j) v[q][j] = v[q][j] + m5v[j] * acc[j];
            }
        }
        if (WHICH == 1) {
#pragma unroll
            for (int q = 0; q < NRW; ++q) { bf16_t* hb = (bf16_t*)(ws + WS_HB) + (size_t)row[q] * D;
#pragma unroll
                for (int j = 0; j < 4; ++j) ((GAS u32x2*)hb)[lane + 64 * j] = (u32x2){pg8::cvt_pk_bf16(v[q][j][0], v[q][j][1]), pg8::cvt_pk_bf16(v[q][j][2], v[q][j][3])}; }
        }
        if (WHICH == 3) {
#pragma unroll
            for (int q = 0; q < NRW; ++q) { const int b = row[q] / RPB, t = row[q] - b * RPB; float* orow = p.out + (size_t)(b * SEQ + t) * D;
#pragma unroll
                for (int j = 0; j < 4; ++j) ((GAS f32x4*)orow)[lane + 64 * j] = v[q][j]; }
        }
        if (WHICH == 3) continue;
        {
            float rs[NRW];
#pragma unroll
            for (int q = 0; q < NRW; ++q) {
                float ss = 0.f;
#pragma unroll
                for (int j = 0; j < 4; ++j) ss += v[q][j][0] * v[q][j][0] + v[q][j][1] * v[q][j][1] + v[q][j][2] * v[q][j][2] + v[q][j][3] * v[q][j][3];
                ss = wave_sum(ss);
                rs[q] = rsqrtf(ss * (1.f / 1024.f) + EPS);
            }
#pragma unroll
            for (int j = 0; j < 4; ++j) {
                const f32x4 sh = shv[j], sc = scv[j];
#pragma unroll
                for (int q = 0; q < NRW; ++q) {
                    v[q][j] = v[q][j] * rs[q] * sc + sh;
                    u32x2 o; o.x = pg8::cvt_pk_bf16(v[q][j][0], v[q][j][1]); o.y = pg8::cvt_pk_bf16(v[q][j][2], v[q][j][3]);
                    ((GAS u32x2*)((bf16_t*)(ws + WS_U) + (size_t)row[q] * 1024))[lane + 64 * j] = o;
                }
            }
        }
        if (WHICH == 2) {
#pragma unroll
            for (int q = 0; q < NRW; ++q) {
                LAS unsigned char* th = ut_hi + (wave * 2 + q) * UT_PITCH; LAS unsigned char* tl = ut_lo + (wave * 2 + q) * UT_PITCH;
#pragma unroll
                for (int j = 0; j < 4; ++j) {
                    const unsigned h01 = pg8::cvt_pk_bf16(v[q][j][0], v[q][j][1]), h23 = pg8::cvt_pk_bf16(v[q][j][2], v[q][j][3]);
                    const float l0 = v[q][j][0] - __uint_as_float(h01 << 16), l1 = v[q][j][1] - __uint_as_float(h01 & 0xffff0000u), l2 = v[q][j][2] - __uint_as_float(h23 << 16), l3 = v[q][j][3] - __uint_as_float(h23 & 0xffff0000u);
                    *(LAS u32x2*)(th + (lane + 64 * j) * 8) = (u32x2){h01, h23};
                    *(LAS u32x2*)(tl + (lane + 64 * j) * 8) = (u32x2){pg8::cvt_pk_bf16(l0, l1), pg8::cvt_pk_bf16(l2, l3)};
                }
            }
            __syncthreads();
            {
                const int fr = lane & 15, fq = lane >> 4;
                bf16x8 xh[4], xl[4];
#pragma unroll
                for (int ks = 0; ks < 4; ++ks) { xh[ks] = *(const LAS bf16x8*)(ut_hi + fr * UT_PITCH + (128 * wave + 32 * ks + 8 * fq) * 2); xl[ks] = *(const LAS bf16x8*)(ut_lo + fr * UT_PITCH + (128 * wave + 32 * ks + 8 * fq) * 2); }
                f32x4 pc = (f32x4){0.f, 0.f, 0.f, 0.f};
#pragma unroll
                for (int ks = 0; ks < 4; ++ks) { pc = __builtin_amdgcn_mfma_f32_16x16x32_bf16(wfh[ks], xh[ks], pc, 0, 0, 0); pc = __builtin_amdgcn_mfma_f32_16x16x32_bf16(wfl[ks], xh[ks], pc, 0, 0, 0); pc = __builtin_amdgcn_mfma_f32_16x16x32_bf16(wfh[ks], xl[ks], pc, 0, 0, 0); }
                *(LAS f32x4*)(rpart0 + (rstepi & 1) * 2048 + (wave * 16 + fr) * 16 + 4 * fq) = pc;
            }
            __syncthreads();
            if (tid < 256) {
                const int rr_ = tid >> 4, ee = tid & 15;
                float x = 0.f;
#pragma unroll
                for (int w8 = 0; w8 < 8; ++w8) x += rpart0[(rstepi & 1) * 2048 + (w8 * 16 + rr_) * 16 + ee];
                float mx = x; mx = fmaxf(mx, swz_xor<1>(mx)); mx = fmaxf(mx, swz_xor<2>(mx)); mx = fmaxf(mx, swz_xor<4>(mx)); mx = fmaxf(mx, swz_xor<8>(mx));
                const float ex = expf(x - mx);
                float sm = ex; sm += swz_xor<1>(sm); sm += swz_xor<2>(sm); sm += swz_xor<4>(sm); sm += swz_xor<8>(sm);
                int grow = (r0 - wave * NRW) + rr_;
                NORM_ROWMAP(grow);
                ((GAS float*)(ws + WS_AFF))[(size_t)grow * 16 + ee] = ex / sm;
            }
            ++rstepi;
        }
    }
    if (WHICH == 2) __syncthreads();
#undef NORM_ROWMAP
#undef NORM_LOAD
}

__device__ __forceinline__ void phase_qkprep(const P& p, int layer, int vcu, int G, const int wv_) {
    unsigned char* ws = p.ws; asm volatile("" : "+s"(ws));
    const int tid = (wv_ << 6) | hw_tid();
    const int lane = tid & 63, wave = wv_;
    const int li = layer >> 1;
    const float* tab = (const float*)(ws + WS_ROPE);
    for (int wid = vcu * NWAVES + wave; wid < NR * 26; wid += G * NWAVES) {
        const int row = wid / 26, hs = wid - row * 26;
        int col; const float* g; bool rope;
        if (hs < 8) { col = hs * 64; g = p.a_q_norm + li * 64; rope = true; }
        else if (hs < 10) { col = 512 + (hs - 8) * 64; g = p.a_k_norm + li * 64; rope = true; }
        else if (hs < 18) { col = 768 + (hs - 10) * 64; g = p.b_q_norm + li * 64; rope = false; }
        else { col = 1280 + (hs - 18) * 64; g = p.b_k_norm + li * 64; rope = false; }
        bf16_t* q = (bf16_t*)(ws + WS_B1) + (size_t)row * 2304 + col;
        const float x = bf2f(q[lane]);
        const float ss = wave_sum(x * x);
        float y = x * rsqrtf(ss * (1.f / 64.f) + EPS) * g[lane];
        const int b = row / RPB, t = row - b * RPB;
        if (rope && t < SEQ) {
            const int half = lane >> 5, j = lane & 31;
            const int pos = half == 0 ? (t >> 6) : (t & 63);
            const float cs = tab[pos * 16 + (j & 15)], sn = tab[1024 + pos * 16 + (j & 15)];
            const float other = swz_xor<16>(y);
            y = y * cs + (j < 16 ? -other : other) * sn;
        }
        if (hs < 8 || (hs >= 10 && hs < 18)) y *= 0.18033688011112042f;
        q[lane] = (bf16_t)f2bf(y);
    }
}

namespace attn_body {
using bf16=unsigned short;
using bf16x8=__attribute__((ext_vector_type(8)))short;
using s16x4=__attribute__((ext_vector_type(4)))short;
using f32x16=__attribute__((ext_vector_type(16)))float;
using u32x4=__attribute__((ext_vector_type(4)))unsigned;
constexpr int D=64;
constexpr int NW=8,QBLK=32,QB=QBLK*NW,KVBLK=64;
__device__ __forceinline__ int crow(int r,int hi){return (r&3)+8*(r>>2)+4*hi;}
#define SBAR() __builtin_amdgcn_sched_barrier(0)
#define CINIT (MODE==1?f32x16{}:negm)
struct NaArgs { int ctx_row0, win_row0, r0, wr0; };
constexpr int LDS_NAT_OFF = 86016;
__device__ __forceinline__ void na_mask(f32x16&p0,f32x16&p1,int j,const NaArgs&na,const char*shm,int wid,int r32,int hi,float mhat){
  const float NEG=-INFINITY;
  const int r=na.r0+(wid>>1), c=32*(wid&1)+r32;
  int rs=r-4; rs=rs<0?0:(rs>56?56:rs);
  int cs=c-8; cs=cs<0?0:(cs>48?48:cs);
  const int kr=na.wr0+j, di=kr-rs;
  if(di<0||di>=8){
    #pragma unroll
    for(int q=0;q<16;++q){p0[q]=NEG;p1[q]=NEG;}
  } else {
    const int dr=kr-r+7;
    const float*T=reinterpret_cast<const float*>(shm+LDS_NAT_OFF)+dr*128+63-c+4*hi;
    const int a=4*hi-cs;
    #pragma unroll
    for(int q=0;q<16;++q){ const int kc0=(q&3)+8*(q>>2);
      const float b0=T[kc0], b1=T[kc0+32];
      p0[q]=((unsigned)(a+kc0)<16u)?p0[q]+(b0-mhat):NEG; p1[q]=((unsigned)(a+kc0+32)<16u)?p1[q]+(b1-mhat):NEG;
      if((q&1)==1) SBAR(); }
  }
}
constexpr int NSLOT=3, SLOTB=8192;
constexpr int LDS_K=0, LDS_V=NSLOT*SLOTB, LDS_WS=2*NSLOT*SLOTB, LDS_OST=LDS_WS+NW*64*4, LDS_BYTES=LDS_OST+NW*4096;
constexpr float C2=0.125f*1.4426950408889634f;
__device__ __forceinline__ void glds16(const void*gsrc,unsigned lds_dst){unsigned keep;
  asm volatile("s_mov_b32 %0, m0\n\ts_mov_b32 m0, %2\n\ts_nop 0\n\tglobal_load_lds_dwordx4 %1, off\n\ts_mov_b32 m0, %0":"=&s"(keep):"v"(gsrc),"s"(lds_dst):"memory");}
__device__ __forceinline__ float max3f(float a,float b,float c){float r;asm("v_max3_f32 %0, %1, %2, %3":"=v"(r):"v"(a),"v"(b),"v"(c));return r;}
__device__ __forceinline__ float max2f(float a,float b){float r;asm("v_max_f32_e32 %0, %1, %2":"=v"(r):"v"(a),"v"(b));return r;}
__device__ __forceinline__ float fadd_s(float a,float b){float r;asm("v_add_f32_e32 %0, %1, %2":"=v"(r):"v"(a),"v"(b));return r;}
__device__ __forceinline__ float fsub_s(float a,float b){float r;asm("v_sub_f32_e32 %0, %1, %2":"=v"(r):"v"(a),"v"(b));return r;}
typedef float f32x2_t __attribute__((ext_vector_type(2))); typedef __bf16 bf16x2_t __attribute__((ext_vector_type(2)));
__device__ __forceinline__ unsigned cvtpk_s(float lo,float hi){f32x2_t v={lo,hi};bf16x2_t b=__builtin_convertvector(v,bf16x2_t);return __builtin_bit_cast(unsigned,b);}
#define WAIT_BAR(N) asm volatile("s_waitcnt vmcnt(" #N ") lgkmcnt(0)\n\ts_barrier":::"memory")

__device__ __forceinline__ void qkt(f32x16&p0,f32x16&p1,const char*Kslot,const bf16x8*qr,const f32x16&negm,int r32,int hi){
  const char*kb=Kslot+hi*1024+r32*16;
  #pragma unroll
  for(int d0=0;d0<4;++d0){
    const bf16x8 b0=*reinterpret_cast<const bf16x8*>(kb+d0*2048);
    const bf16x8 b1=*reinterpret_cast<const bf16x8*>(kb+d0*2048+512);
    if(d0==0){p0=__builtin_amdgcn_mfma_f32_32x32x16_bf16(b0,qr[0],negm,0,0,0);p1=__builtin_amdgcn_mfma_f32_32x32x16_bf16(b1,qr[0],negm,0,0,0);}
    else{p0=__builtin_amdgcn_mfma_f32_32x32x16_bf16(b0,qr[d0],p0,0,0,0);p1=__builtin_amdgcn_mfma_f32_32x32x16_bf16(b1,qr[d0],p1,0,0,0);}}
}
typedef __attribute__((address_space(3))) const char* lds_cptr;
typedef short v4i16_t __attribute__((ext_vector_type(4)));
__device__ __forceinline__ void kload8(bf16x8*kf,lds_cptr kp){
  kf[0]=*(const __attribute__((address_space(3))) bf16x8*)(kp);      kf[1]=*(const __attribute__((address_space(3))) bf16x8*)(kp+512);
  kf[2]=*(const __attribute__((address_space(3))) bf16x8*)(kp+2048); kf[3]=*(const __attribute__((address_space(3))) bf16x8*)(kp+2560);
  kf[4]=*(const __attribute__((address_space(3))) bf16x8*)(kp+4096); kf[5]=*(const __attribute__((address_space(3))) bf16x8*)(kp+4608);
  kf[6]=*(const __attribute__((address_space(3))) bf16x8*)(kp+6144); kf[7]=*(const __attribute__((address_space(3))) bf16x8*)(kp+6656);
}
__device__ __forceinline__ void kload2(bf16x8*kf,lds_cptr kp,int j){ kf[2*j]=*(const __attribute__((address_space(3))) bf16x8*)(kp+j*2048); kf[2*j+1]=*(const __attribute__((address_space(3))) bf16x8*)(kp+j*2048+512); }
__device__ __forceinline__ s16x4 vtr(lds_cptr p){ return __builtin_bit_cast(s16x4,__builtin_amdgcn_ds_read_tr16_b64_v4i16((__attribute__((address_space(3))) v4i16_t*)p)); }
__device__ __forceinline__ float rowmax(const f32x16&p0,const f32x16&p1){
  float a=max3f(p0[0],p0[1],p1[0]),b=max3f(p0[2],p0[3],p1[1]);a=max3f(a,p1[2],p1[3]);
  #pragma unroll
  for(int r=4;r<16;r+=4){a=max3f(a,p0[r],p0[r+1]);b=max3f(b,p0[r+2],p0[r+3]);a=max3f(a,p1[r],p1[r+1]);b=max3f(b,p1[r+2],p1[r+3]);}
  const float m=max2f(a,b);
  auto rr=__builtin_amdgcn_permlane32_swap(__float_as_uint(m),__float_as_uint(m),false,false);
  return max2f(__uint_as_float(rr[0]),__uint_as_float(rr[1]));
}
__device__ __forceinline__ void pv(f32x16*o,int vb,bf16x8 pa0,bf16x8 pa1,bf16x8 pa2,bf16x8 pa3){
  #pragma unroll
  for(int d0=0;d0<2;++d0){s16x4 lo[4],hi[4];
    #pragma unroll
    for(int ks=0;ks<4;++ks){
      asm volatile("ds_read_b64_tr_b16 %0,%1 offset:%c2":"=&v"(lo[ks]):"v"(vb),"i"(d0*4096+ks*1024):"memory");
      asm volatile("ds_read_b64_tr_b16 %0,%1 offset:%c2":"=&v"(hi[ks]):"v"(vb),"i"(d0*4096+ks*1024+512):"memory");}
    asm volatile("s_waitcnt lgkmcnt(0)":::"memory");SBAR();
    #define PK(k) (bf16x8){lo[k][0],lo[k][1],lo[k][2],lo[k][3],hi[k][0],hi[k][1],hi[k][2],hi[k][3]}
    o[d0]=__builtin_amdgcn_mfma_f32_32x32x16_bf16(pa0,PK(0),o[d0],0,0,0);
    o[d0]=__builtin_amdgcn_mfma_f32_32x32x16_bf16(pa1,PK(1),o[d0],0,0,0);
    o[d0]=__builtin_amdgcn_mfma_f32_32x32x16_bf16(pa2,PK(2),o[d0],0,0,0);
    o[d0]=__builtin_amdgcn_mfma_f32_32x32x16_bf16(pa3,PK(3),o[d0],0,0,0);
    #undef PK
  }
}

#ifndef ATTN_STORE16
#define ATTN_STORE16(p,v) (*(u32x4*)(p)=(v))
#endif
template<int THRL,int QP,int OP,int MODE> __device__ __forceinline__ void attn_unit(const bf16*Qu,const bf16*__restrict__ Kh,const bf16*__restrict__ Vh,bf16*Ou,const int NT,char*shm,const int wid,const int lane,const NaArgs na){
  const int r32=lane&31,hi=lane>>5;
  const bf16*Qw=Qu+(long)(wid*QBLK)*QP;
  const unsigned lds0=(unsigned)(uintptr_t)shm;
  float*wsf=(float*)(shm+LDS_WS)+wid*64;
  const bf16*ksrc=Kh+(long)lane*QP+wid*8;
  const bf16*vsrc=Vh+(long)(16*(wid&3)+(lane>>2))*QP+(wid>>2)*32+(lane&3)*8;
  const unsigned kdst=lds0+LDS_K+wid*1024, vdst=lds0+LDS_V+wid*1024;
  #define TROW(t) (MODE==0?(long)(t)*KVBLK:((t)<4?(long)na.ctx_row0+(long)(t)*KVBLK:(long)na.win_row0+(long)((t)-4)*KVBLK))
  #define DMA_K(t,slot) glds16(ksrc+TROW(t)*QP,(unsigned)__builtin_amdgcn_readfirstlane(kdst+(slot)))
  #define DMA_V(t,slot) glds16(vsrc+TROW(t)*QP,(unsigned)__builtin_amdgcn_readfirstlane(vdst+(slot)))
  const int vb0=(int)(lds0+LDS_V)+((lane>>4)&1)*32+(lane&3)*8+(4*hi+((lane&15)>>2))*64;
  const char*Kbase=shm+LDS_K; bf16x8 kf[8];
  const lds_cptr shm3=(lds_cptr)shm; const lds_cptr kp0=shm3+LDS_K+hi*1024+r32*16; const lds_cptr vp0=shm3+LDS_V+((lane>>4)&1)*32+(lane&3)*8+(4*hi+((lane&15)>>2))*64;
  DMA_K(0,0);DMA_V(0,0);DMA_K(1,SLOTB);
  bf16x8 qr[4];
  #pragma unroll
  for(int d0=0;d0<4;++d0)qr[d0]=*reinterpret_cast<const bf16x8*>(&Qw[(long)r32*QP+d0*16+hi*8]);
  float mhat=0.f,l_reg=0.f;f32x16 o[2],negm; { float z_=0.f; asm volatile("":"+v"(z_));
    _Pragma("unroll") for(int r=0;r<16;++r){o[0][r]=z_;o[1][r]=z_;negm[r]=z_;} } if(MODE==0)asm volatile("":"+v"(negm));
  #define CMASK(P0,P1,t) do{ if(MODE==1){ if((t)>=4) na_mask(P0,P1,(t)-4,na,shm,wid,r32,hi,mhat); else { _Pragma("unroll") for(int r_=0;r_<16;++r_){P0[r_]-=mhat;P1[r_]-=mhat;} } } }while(0)
  bool resc=false;
  #define START(P0,P1) do{ const float rm=rowmax(P0,P1); resc=false; \
    { const float dl=rm; mhat=fadd_s(mhat,dl); \
      _Pragma("unroll") for(int r=0;r<16;++r){P0[r]=fsub_s(P0[r],dl);P1[r]=fsub_s(P1[r],dl);} \
      if(MODE==0){ _Pragma("unroll") for(int r=0;r<16;++r)negm[r]=-mhat; asm volatile("":"+v"(negm)); } } \
    _Pragma("unroll") for(int r=0;r<16;++r)P0[r]=__builtin_amdgcn_exp2f(P0[r]); }while(0)
  #define RESC() do{ if(resc){ asm volatile("s_waitcnt lgkmcnt(0)":::"memory"); \
      _Pragma("unroll") for(int d_=0;d_<2;++d_) _Pragma("unroll") for(int r=0;r<16;++r)o[d_][r]*=wsf[crow(r,hi)]; } }while(0)
  f32x16 pA0,pA1,pB0,pB1;
  int sl_prev=0,sl_cur=0,sl_next=SLOTB;
  #define ROT() do{sl_prev=sl_cur;sl_cur=sl_next;sl_next=(sl_next==(NSLOT-1)*SLOTB)?0:sl_next+SLOTB;}while(0)
  DMA_K(2,2*SLOTB);
  WAIT_BAR(3);
  qkt(pA0,pA1,Kbase,qr,CINIT,r32,hi);asm volatile("s_nop 15\n\ts_nop 7":"+v"(pA0),"+v"(pA1));CMASK(pA0,pA1,0);
  START(pA0,pA1);
  _Pragma("unroll") for(int r=0;r<16;++r)pA1[r]=__builtin_amdgcn_exp2f(pA1[r]);
  WAIT_BAR(0);
  DMA_K(3,0);DMA_V(1,SLOTB);
  ROT();
  kload8(kf,kp0+sl_cur);
  WAIT_BAR(2);
  s16x4 vlo[8],vhi[8]; u32x4 pw0,pw1,pw2,pw3;
  #define PKW(P,B) cvtpk_s(P[B],P[B+1])
  #define PAF(k) __builtin_bit_cast(bf16x8,pw##k)
  #define VFR(i) (bf16x8){vlo[i][0],vlo[i][1],vlo[i][2],vlo[i][3],vhi[i][0],vhi[i][1],vhi[i][2],vhi[i][3]}
  #define PIN(x) asm volatile("":"+v"(x))
  #define MX3(a,b,c) __builtin_fmaxf(__builtin_fmaxf((a),(b)),(c))
  #define GAPA(MF,A0,A1,A2,A3,W0,W1,PW) do{ MF; sacc+=A0; sacc+=A1; sacc+=A2; sacc+=A3; PIN(sacc); W0; W1; PIN(PW); SBAR(); }while(0)
  #define EX(v) __builtin_amdgcn_exp2f(v)
  #define GAPB(MF,X,B) do{ MF; X[B]=EX(X[B]); X[B+1]=EX(X[B+1]); X[B+2]=EX(X[B+2]); X[B+3]=EX(X[B+3]); PIN(X); SBAR(); }while(0)
  #define VRD(i) do{ vlo[i]=vtr(vp_+(((i)>>2)*4096+((i)&3)*1024)); vhi[i]=vtr(vp_+(((i)>>2)*4096+((i)&3)*1024+512)); }while(0)
  #define KRD(G,j) do{ if(G){ kload2(kf,kp0+sl_next,j); SBAR(); } }while(0)
  #define STEP(C0,C1,P0,P1,t,GK,GV,GL) do{ SBAR(); \
    const lds_cptr vp_=vp0+sl_prev; \
    VRD(0); SBAR(); float sacc=(P0[0]+P0[1]); \
    GAPA(C0=__builtin_amdgcn_mfma_f32_32x32x16_bf16(kf[0],qr[0],CINIT,0,0,0), P0[2],P0[3],P0[4],P0[5],     pw0[0]=PKW(P0,0), pw0[1]=PKW(P0,2), pw0); \
    VRD(4); SBAR(); GAPA(C1=__builtin_amdgcn_mfma_f32_32x32x16_bf16(kf[1],qr[0],CINIT,0,0,0), P0[6],P0[7],P0[8],P0[9],     pw0[2]=PKW(P0,4), pw0[3]=PKW(P0,6), pw0); \
    VRD(1); SBAR(); GAPA(C0=__builtin_amdgcn_mfma_f32_32x32x16_bf16(kf[2],qr[1],C0,0,0,0),   P0[10],P0[11],P0[12],P0[13], pw1[0]=PKW(P0,8), pw1[1]=PKW(P0,10), pw1); \
    VRD(5); SBAR(); GAPA(C1=__builtin_amdgcn_mfma_f32_32x32x16_bf16(kf[3],qr[1],C1,0,0,0),   P0[14],P0[15],P1[0],P1[1],   pw1[2]=PKW(P0,12),pw1[3]=PKW(P0,14), pw1); \
    VRD(2); SBAR(); GAPA(C0=__builtin_amdgcn_mfma_f32_32x32x16_bf16(kf[4],qr[2],C0,0,0,0),   P1[2],P1[3],P1[4],P1[5],     pw2[0]=PKW(P1,0), pw2[1]=PKW(P1,2), pw2); \
    VRD(6); SBAR(); GAPA(C1=__builtin_amdgcn_mfma_f32_32x32x16_bf16(kf[5],qr[2],C1,0,0,0),   P1[6],P1[7],P1[8],P1[9],     pw2[2]=PKW(P1,4), pw2[3]=PKW(P1,6), pw2); \
    VRD(3); SBAR(); GAPA(C0=__builtin_amdgcn_mfma_f32_32x32x16_bf16(kf[6],qr[3],C0,0,0,0),   P1[10],P1[11],P1[12],P1[13], pw3[0]=PKW(P1,8), pw3[1]=PKW(P1,10), pw3); \
    VRD(7); SBAR(); GAPA(C1=__builtin_amdgcn_mfma_f32_32x32x16_bf16(kf[7],qr[3],C1,0,0,0),   P1[14],P1[15],0.f,0.f,       pw3[2]=PKW(P1,12),pw3[3]=PKW(P1,14), pw3); \
    l_reg+=sacc; \
    if(GK){DMA_K((t)+3,sl_cur);} if(GV){DMA_V((t)+1,sl_next);} \
    CMASK(C0,C1,t); \
    { float a=MX3(C0[0],C0[1],C1[0]),b=MX3(C0[2],C0[3],C1[1]); a=MX3(a,C1[2],C1[3]); \
      _Pragma("unroll") for(int r=4;r<16;r+=4){a=MX3(a,C0[r],C0[r+1]);b=MX3(b,C0[r+2],C0[r+3]);a=MX3(a,C1[r],C1[r+1]);b=MX3(b,C1[r+2],C1[r+3]);} \
      float rm=__builtin_fmaxf(a,b); { auto rr=__builtin_amdgcn_permlane32_swap(__float_as_uint(rm),__float_as_uint(rm),false,false); rm=__builtin_fmaxf(__uint_as_float(rr[0]),__uint_as_float(rr[1])); } \
      resc=false; \
      if(__builtin_expect(__any(rm>(float)THRL),0)){ const float dl=__builtin_fmaxf(rm,0.f); mhat+=dl; \
        _Pragma("unroll") for(int r=0;r<16;++r){C0[r]-=dl;C1[r]-=dl;} \
        if(MODE==0){ _Pragma("unroll") for(int r=0;r<16;++r)negm[r]=-mhat; asm volatile("":"+v"(negm)); } \
        const float f=__builtin_amdgcn_exp2f(-dl); l_reg*=f; if(hi==0)wsf[r32]=f; resc=true; } } \
    SBAR(); \
    GAPB(o[0]=__builtin_amdgcn_mfma_f32_32x32x16_bf16(PAF(0),VFR(0),o[0],0,0,0), C0,0); \
    GAPB(o[1]=__builtin_amdgcn_mfma_f32_32x32x16_bf16(PAF(0),VFR(4),o[1],0,0,0), C0,4); \
    KRD(GL,0); GAPB(o[0]=__builtin_amdgcn_mfma_f32_32x32x16_bf16(PAF(1),VFR(1),o[0],0,0,0), C0,8); \
    KRD(GL,1); GAPB(o[1]=__builtin_amdgcn_mfma_f32_32x32x16_bf16(PAF(1),VFR(5),o[1],0,0,0), C0,12); \
    KRD(GL,2); GAPB(o[0]=__builtin_amdgcn_mfma_f32_32x32x16_bf16(PAF(2),VFR(2),o[0],0,0,0), C1,0); \
    KRD(GL,3); GAPB(o[1]=__builtin_amdgcn_mfma_f32_32x32x16_bf16(PAF(2),VFR(6),o[1],0,0,0), C1,4); \
    GAPB(o[0]=__builtin_amdgcn_mfma_f32_32x32x16_bf16(PAF(3),VFR(3),o[0],0,0,0), C1,8); \
    GAPB(o[1]=__builtin_amdgcn_mfma_f32_32x32x16_bf16(PAF(3),VFR(7),o[1],0,0,0), C1,12); \
    }while(0)
  int t=1;
  for(;t+5<NT;t+=2){
    STEP(pB0,pB1,pA0,pA1,t,true,true,true);     WAIT_BAR(2); RESC(); ROT();
    STEP(pA0,pA1,pB0,pB1,t+1,true,true,true);   WAIT_BAR(2); RESC(); ROT();
  }
  #define ENDW(tt) do{ if((tt)+3<NT){WAIT_BAR(2);} else if((tt)+2<NT){WAIT_BAR(1);} else {WAIT_BAR(0);} }while(0)
  for(;t+1<NT;t+=2){
    STEP(pB0,pB1,pA0,pA1,t,(t+3<NT),(t+1<NT),(t+1<NT));       ENDW(t);   RESC(); ROT();
    STEP(pA0,pA1,pB0,pB1,t+1,(t+4<NT),(t+2<NT),(t+2<NT));     ENDW(t+1); RESC(); ROT();
  }
  STEP(pB0,pB1,pA0,pA1,NT-1,false,false,false); RESC();
  { float sacc=pB0[0]+pB0[1]; _Pragma("unroll") for(int r=2;r<16;++r)sacc+=pB0[r]; _Pragma("unroll") for(int r=0;r<16;++r)sacc+=pB1[r]; l_reg+=sacc;
    pw0=(u32x4){PKW(pB0,0),PKW(pB0,2),PKW(pB0,4),PKW(pB0,6)};pw1=(u32x4){PKW(pB0,8),PKW(pB0,10),PKW(pB0,12),PKW(pB0,14)};pw2=(u32x4){PKW(pB1,0),PKW(pB1,2),PKW(pB1,4),PKW(pB1,6)};pw3=(u32x4){PKW(pB1,8),PKW(pB1,10),PKW(pB1,12),PKW(pB1,14)};
    SBAR(); pv(o,vb0+sl_cur,PAF(0),PAF(1),PAF(2),PAF(3)); }
  #undef PKW
  #undef PAF
  #undef VFR
  #undef PIN
  #undef MX3
  #undef GAPA
  #undef GAPB
  #undef EX
  #undef VRD
  #undef KRD
  #undef STEP
  #undef ENDW
  {auto rr=__builtin_amdgcn_permlane32_swap(__float_as_uint(l_reg),__float_as_uint(l_reg),false,false);l_reg=__uint_as_float(rr[0])+__uint_as_float(rr[1]);}
  if(hi==0)wsf[32+r32]=l_reg;asm volatile("s_waitcnt lgkmcnt(0)":::"memory");
  float rli[16];
  #pragma unroll
  for(int r=0;r<16;++r)rli[r]=__builtin_amdgcn_rcpf(wsf[32+crow(r,hi)]);
  bf16*Ow=Ou+(long)(wid*QBLK)*OP;
  { bf16*stg=(bf16*)(shm+LDS_OST)+wid*2048;
    #pragma unroll
    for(int r=0;r<16;++r){const int orow=crow(r,hi);
      #pragma unroll
      for(int d0=0;d0<2;++d0)stg[orow*64+d0*32+r32]=(bf16)f2bf(o[d0][r]*rli[r]);}
    asm volatile("s_waitcnt lgkmcnt(0)":::"memory");
    #pragma unroll
    for(int i=0;i<4;++i){const int row=i*8+(lane>>3),ch=lane&7; const u32x4 v=*(const u32x4*)(stg+row*64+ch*8); ATTN_STORE16(Ow+(long)row*OP+ch*8,v);} }
  asm volatile("s_waitcnt lgkmcnt(0)\n\ts_barrier":::"memory");
  #undef DMA_K
  #undef DMA_V
  #undef TROW
  #undef CMASK
  #undef START
  #undef RESC
  #undef ROT
}
#undef SBAR
#undef WAIT_BAR
}

__device__ __forceinline__ void phase_attn_dense(const P& p, char* shm, int vcu, int G, const int wv_) {
    unsigned char* ws = p.ws; asm volatile("" : "+s"(ws));
    const int lane = hw_tid();
    const attn_body::bf16* QKV = (const attn_body::bf16*)(ws + WS_B1);
    attn_body::bf16* O = (attn_body::bf16*)(ws + WS_B2);
    const attn_body::NaArgs na{0, 0, 0, 0};
    for (int L = vcu; L < 1024 + 128; L += G) {
        size_t qo, ko, vo, oo; int ntile;
        if (L < 1024) {
            const int i = L >> 8, v = L & 255, xcd = v >> 5, j = v & 31;
            const int grp = 2 * xcd + (i >> 1), b = grp >> 1, kvh = grp & 1, u = (i & 1) * 32 + j, h = kvh * 4 + (u >> 4), qb = u & 15;
            const size_t rb = (size_t)b * RPB;
            qo = (rb + qb * 256) * 2304 + 64 * h; ko = rb * 2304 + 512 + 64 * kvh; vo = rb * 2304 + 640 + 64 * kvh; oo = (rb + qb * 256) * 1024 + 64 * h; ntile = 68;
        } else {
            const int u = L - 1024, typ = u >> 6, b = (u >> 3) & 7, h = u & 7;
            const size_t rc = (size_t)b * RPB + SEQ;
            const int qcol = typ ? 768 + 64 * h : 64 * h, kcol = typ ? 1280 + 64 * h : 512 + 64 * (h >> 2), vcol = typ ? 1792 + 64 * h : 640 + 64 * (h >> 2), ocol = typ ? 512 + 64 * h : 64 * h;
            qo = rc * 2304 + qcol; ko = rc * 2304 + kcol; vo = rc * 2304 + vcol; oo = rc * 1024 + ocol; ntile = 4;
        }
        attn_body::attn_unit<8, 2304, 1024, 0>(QKV + qo, QKV + ko, QKV + vo, O + oo, ntile, shm, wv_, lane, na);
    }
}

__device__ __forceinline__ void phase_attn_na(const P& p, int layer, char* shm, int vcu, int G, const int wv_) {
    unsigned char* ws = p.ws; asm volatile("" : "+s"(ws));
    const int lane = hw_tid(), tid = (wv_ << 6) | lane;
    const attn_body::bf16* QKV = (const attn_body::bf16*)(ws + WS_B1);
    attn_body::bf16* O = (attn_body::bf16*)(ws + WS_B2);
    float* T = (float*)(shm + attn_body::LDS_NAT_OFF);
    for (int L = vcu; L < 1024; L += G) {
        const int i = L >> 8, v = L & 255, xcd = v >> 5, j = v & 31;
        const int grp = (i * 8 + xcd) * 2 + (j >> 4), rblk = j & 15, b = grp >> 3, h = grp & 7;
        const float* rpb = p.na_rpb + (size_t)((layer >> 1) * 8 + h) * 15 * 31;
        for (int e = tid; e < 15 * 128; e += NTHR) { const int dr = e >> 7, d = (e & 127) - 63; T[e] = (d >= -15 && d <= 15) ? rpb[dr * 31 + d + 15] * 1.4426950408889634f : -INFINITY; }
        const int r0 = rblk * 4; int wr0 = r0 - 4; wr0 = wr0 < 0 ? 0 : (wr0 > 52 ? 52 : wr0);
        const size_t rb = (size_t)b * RPB;
        const attn_body::NaArgs na{SEQ, wr0 * 64, r0, wr0};
        attn_body::attn_unit<8, 2304, 1024, 1>(QKV + (rb + r0 * 64) * 2304 + 768 + 64 * h, QKV + rb * 2304 + 1280 + 64 * h, QKV + rb * 2304 + 1792 + 64 * h, O + (rb + r0 * 64) * 1024 + 512 + 64 * h, 16, shm, wv_, lane, na);
    }
}

__device__ __forceinline__ int gla_o256(int row, int ch) { return row * 256 + ((ch ^ (row & 15)) << 4); }
__device__ __forceinline__ int gla_o128(int row, int ch) { return (row >> 1) * 256 + (((((row & 1) << 3) | ch) ^ ((row >> 1) & 7)) << 4); }
__device__ __forceinline__ int gla_task(int b, int h, int dir, int s) { return ((b * 4 + h) * 2 + dir) * 68 + s; }
__device__ __forceinline__ int gla_rowc(int b, int dir, int s) { return b * RPB + (s < 4 ? SEQ + 64 * (dir ? 3 - s : s) : 64 * (dir ? 67 - s : s - 4)); }

__device__ __forceinline__ void phase_gla_pre(const P& p, int layer, LAS unsigned char* lds, int vcu, int G, const int wv_) {
    unsigned char* ws = p.ws; asm volatile("" : "+s"(ws));
    const int lane = hw_tid(), tid = (wv_ << 6) | lane, fr = lane & 15, fq = lane >> 4;
    constexpr int L_QD = 0, L_KI = 16384, L_KST = 32768, L_A = 49152, L_SB = 57344, SB_BYTES = 36864, SB_K = 16384, SB_Z = 32768, L_CL = RING_BYTES + 8192;
    static_assert(L_SB + 2 * SB_BYTES <= RING_BYTES && L_CL + 512 <= LDS_BYTES, "gla pre LDS map");
    LAS unsigned char* qd = lds + L_QD; LAS unsigned char* ki = lds + L_KI; LAS unsigned char* ksT = lds + L_KST; LAS unsigned char* Al = lds + L_A;
    LAS float* cls = (LAS float*)(lds + L_CL);
    const unsigned lds0 = (unsigned)(size_t)lds;
    const int li = layer >> 1;
    const bf16_t* X = (const bf16_t*)(ws + WS_B1);
    const float* Z = (const float*)(ws + WS_Z);
    const int pd = 16 * wv_ + fr;
#define GLAP_TASK(i_, bhd_, s_) const int bhd_ = ((i_) & 255) >> 2, s_ = 17 * ((i_) & 3) + ((i_) >> 8)
#define GLAP_DMA(i_, buf_) do { GLAP_TASK((i_), bhd__, s__); const int dir__ = bhd__ & 1, h__ = (bhd__ >> 1) & 3, b__ = bhd__ >> 3; const int rc_ = gla_rowc(b__, dir__, s__); \
        const unsigned sb_ = lds0 + L_SB + (unsigned)(buf_) * SB_BYTES; \
        _Pragma("unroll") for (int jj = 0; jj < 4; ++jj) { const int j = 4 * wv_ + jj;        \
            pg8::glds16_s((const char*)(X + (size_t)(rc_ + 4 * (j & 15)) * 3072 + h__ * 128 + (j >> 4) * 512), (unsigned)((lane >> 4) * 6144 + (((lane & 15) ^ (2 * (j & 3))) << 4)), sb_ + (unsigned)j * 1024u); } \
        if (wv_ < 4) pg8::glds16_s((const char*)(Z + (size_t)(rc_ + 16 * wv_) * 32 + dir__ * 16), (unsigned)((lane >> 2) * 128 + (lane & 3) * 16), sb_ + SB_Z + (unsigned)wv_ * 1024u); } while (0)
    int ti = vcu, kk_ = 0;
    if (ti < 4352) GLAP_DMA(ti, 0);
    int bhd_cur = -1; bf16x8 wx1 = (bf16x8){0, 0, 0, 0, 0, 0, 0, 0}, wx2 = wx1; float gbias = 0.f;
    for (; ti < 4352; ti += G, ++kk_) {
        GLAP_TASK(ti, bhd, s_chunk);
        const int dir = bhd & 1, h = (bhd >> 1) & 3, t = bhd * 68 + s_chunk;
        if (bhd != bhd_cur) {
            bhd_cur = bhd;
            const float* gw = (dir ? p.gk_w_b : p.gk_w_f) + (size_t)li * 16 * 512 + h * 128 + pd + (size_t)(8 * (fq & 1)) * 512;
            float wv8[8];
#pragma unroll
            for (int e = 0; e < 8; ++e) wv8[e] = gw[e * 512];
            gbias = ((dir ? p.gk_b_b : p.gk_b_f) + li * 512)[h * 128 + pd];
            unsigned hh[4], ll[4];
#pragma unroll
            for (int e = 0; e < 4; ++e) { hh[e] = pg8::cvt_pk_bf16(wv8[2 * e], wv8[2 * e + 1]);
                ll[e] = pg8::cvt_pk_bf16(wv8[2 * e] - __uint_as_float(hh[e] << 16), wv8[2 * e + 1] - __uint_as_float(hh[e] & 0xffff0000u)); if (fq >= 2) ll[e] = 0u; }
            wx1 = __builtin_bit_cast(bf16x8, (u32x4){hh[0], hh[1], hh[2], hh[3]}); wx2 = __builtin_bit_cast(bf16x8, (u32x4){ll[0], ll[1], ll[2], ll[3]});
        }
        if (kk_ == 0) asm volatile("s_waitcnt vmcnt(0)" ::: "memory"); else asm volatile("s_waitcnt vmcnt(5)" ::: "memory");
        __syncthreads();
        if (ti + G < 4352) GLAP_DMA(ti + G, (kk_ + 1) & 1);
        LAS unsigned char* sb = lds + L_SB + (kk_ & 1) * SB_BYTES;
        {
            float c[16];
#pragma unroll
            for (int T = 0; T < 4; ++T) {
                const LAS f32x4* zp = (const LAS f32x4*)(sb + SB_Z + (16 * T + fr) * 64 + (fq & 1) * 32);
                const f32x4 za = zp[0], zb = zp[1];
                unsigned zy[4];
#pragma unroll
                for (int e = 0; e < 4; ++e) { const float z0 = e < 2 ? za[2 * e] : zb[2 * e - 4], z1 = e < 2 ? za[2 * e + 1] : zb[2 * e - 3];
                    const unsigned hz = pg8::cvt_pk_bf16(z0, z1), lz = pg8::cvt_pk_bf16(z0 - __uint_as_float(hz << 16), z1 - __uint_as_float(hz & 0xffff0000u)); zy[e] = fq < 2 ? hz : lz; }
                const bf16x8 zf = __builtin_bit_cast(bf16x8, (u32x4){zy[0], zy[1], zy[2], zy[3]});
                f32x4 xa = (f32x4){gbias, gbias, gbias, gbias};
                xa = __builtin_amdgcn_mfma_f32_16x16x32_bf16(zf, wx1, xa, 0, 0, 0);
                xa = __builtin_amdgcn_mfma_f32_16x16x32_bf16(zf, wx2, xa, 0, 0, 0);
#pragma unroll
                for (int i = 0; i < 4; ++i) { const float x = xa[i];
                    const float l = __builtin_amdgcn_logf(1.f + __builtin_amdgcn_exp2f(-fabsf(x) * 1.4426950408889634f));
                    c[4 * T + i] = (fminf(x, 0.f) * 1.4426950408889634f - l) * (1.f / 16.f); }
            }
            float cl = 0.f;
            if (dir == 0) {
#pragma unroll
                for (int T = 0; T < 4; ++T) {
                    c[4 * T + 1] += c[4 * T]; c[4 * T + 2] += c[4 * T + 1]; c[4 * T + 3] += c[4 * T + 2];
                    const float R = c[4 * T + 3];
                    const float p1 = swz_xor<16>(R), pair = R + p1;
                    auto rr = __builtin_amdgcn_permlane32_swap(__float_as_uint(pair), __float_as_uint(pair), false, false);
                    const float q = __uint_as_float(fq >= 2 ? rr[0] : rr[1]);
                    const float ex = ((fq & 1) ? p1 : 0.f) + ((fq & 2) ? q : 0.f) + cl;
#pragma unroll
                    for (int i = 0; i < 4; ++i) c[4 * T + i] += ex;
                    cl += pair + q;
                }
            } else {
#pragma unroll
                for (int T = 3; T >= 0; --T) {
                    c[4 * T + 2] += c[4 * T + 3]; c[4 * T + 1] += c[4 * T + 2]; c[4 * T] += c[4 * T + 1];
                    const float R = c[4 * T];
                    const float p1 = swz_xor<16>(R), pair = R + p1;
                    auto rr = __builtin_amdgcn_permlane32_swap(__float_as_uint(pair), __float_as_uint(pair), false, false);
                    const float q = __uint_as_float(fq >= 2 ? rr[0] : rr[1]);
                    const float ex = ((fq & 1) ? 0.f : p1) + ((fq & 2) ? 0.f : q) + cl;
#pragma unroll
                    for (int i = 0; i < 4; ++i) c[4 * T + i] += ex;
                    cl += pair + q;
                }
            }
            if (fq == 0) cls[pd] = cl;
            const float qs = 0.08838834764831845f, ecl = __builtin_amdgcn_exp2f(cl);
            const int dch = pd >> 3, dlo = (pd & 7) * 2;
            const LAS unsigned char* qsrc = sb + fq * 1024 + ((dch ^ (2 * fq)) << 4) + dlo;
#pragma unroll
            for (int T = 0; T < 4; ++T) {
                unsigned kw[2];
#pragma unroll
                for (int i = 0; i < 4; i += 2) {
                    const int n = 4 * T + i;
                    const float c0 = c[n], c1 = c[n + 1];
                    const float e0 = __builtin_amdgcn_exp2f(c0), e1 = __builtin_amdgcn_exp2f(c1);
                    const float r0 = __builtin_amdgcn_rcpf(e0), r1 = __builtin_amdgcn_rcpf(e1);
                    const float q0 = bf2f(*(const LAS bf16_t*)(qsrc + 4096 * T + 256 * i)), q1 = bf2f(*(const LAS bf16_t*)(qsrc + 4096 * T + 256 * (i + 1)));
                    const float k0 = bf2f(*(const LAS bf16_t*)(qsrc + SB_K + 4096 * T + 256 * i)), k1 = bf2f(*(const LAS bf16_t*)(qsrc + SB_K + 4096 * T + 256 * (i + 1)));
                    const int tk0 = 16 * T + 4 * fq + i;
                    const unsigned qq = pg8::cvt_pk_bf16(q0 * qs * e0, q1 * qs * e1), kk2 = pg8::cvt_pk_bf16(k0 * r0, k1 * r1);
                    *(LAS bf16_t*)(qd + gla_o256(tk0, dch) + dlo) = (bf16_t)(qq & 0xffffu); *(LAS bf16_t*)(qd + gla_o256(tk0 + 1, dch) + dlo) = (bf16_t)(qq >> 16);
                    *(LAS bf16_t*)(ki + gla_o256(tk0, dch) + dlo) = (bf16_t)(kk2 & 0xffffu); *(LAS bf16_t*)(ki + gla_o256(tk0 + 1, dch) + dlo) = (bf16_t)(kk2 >> 16);
                    kw[i >> 1] = pg8::cvt_pk_bf16(k0 * (ecl * r0), k1 * (ecl * r1));
                }
                *(LAS u32x2*)(ksT + gla_o128(pd, 2 * T + (fq >> 1)) + (fq & 1) * 8) = (u32x2){kw[0], kw[1]};
            }
        }
        __syncthreads();
        {
            const int it = wv_ >> 1;
            f32x4 a2[2] = {(f32x4){0.f, 0.f, 0.f, 0.f}, (f32x4){0.f, 0.f, 0.f, 0.f}};
#pragma unroll
            for (int kk = 0; kk < 4; ++kk) {
                const bf16x8 xa = *(const LAS bf16x8*)(qd + gla_o256(16 * it + fr, 4 * kk + fq));
#pragma unroll
                for (int jj = 0; jj < 2; ++jj) { const int jt = 2 * (wv_ & 1) + jj;
                    const bf16x8 yb = *(const LAS bf16x8*)(ki + gla_o256(16 * jt + fr, 4 * kk + fq));
                    a2[jj] = __builtin_amdgcn_mfma_f32_16x16x32_bf16(yb, xa, a2[jj], 0, 0, 0); }
            }
#pragma unroll
            for (int jj = 0; jj < 2; ++jj) { const int jt = 2 * (wv_ & 1) + jj; const int i = 16 * it + fr, j0 = 16 * jt + 4 * fq;
                float m4[4];
#pragma unroll
                for (int cc = 0; cc < 4; ++cc) { const int j = j0 + cc; const bool keep = dir ? (j >= i) : (j <= i); m4[cc] = keep ? a2[jj][cc] : 0.f; }
                *(LAS u32x2*)(Al + gla_o128(i, j0 >> 3) + (j0 & 7) * 2) = (u32x2){pg8::cvt_pk_bf16(m4[0], m4[1]), pg8::cvt_pk_bf16(m4[2], m4[3])}; }
        }
        __syncthreads();
        {
            GAS u32x4* gq = (GAS u32x4*)(ws + WS_GQD + (size_t)t * 16384); GAS u32x4* gk = (GAS u32x4*)(ws + WS_GKS + (size_t)t * 16384); GAS u32x4* ga = (GAS u32x4*)(ws + WS_GA + (size_t)t * 8192); GAS u32x4* gc = (GAS u32x4*)(ws + WS_GCL + (size_t)t * 512);
            gq[tid] = *(const LAS u32x4*)(qd + tid * 16); gq[tid + 512] = *(const LAS u32x4*)(qd + (tid + 512) * 16);
            gk[tid] = *(const LAS u32x4*)(ksT + tid * 16); gk[tid + 512] = *(const LAS u32x4*)(ksT + (tid + 512) * 16);
            ga[tid] = *(const LAS u32x4*)(Al + tid * 16);
            if (tid < 32) gc[tid] = *(const LAS u32x4*)((LAS unsigned char*)cls + tid * 16);
        }
        __syncthreads();
    }
    asm volatile("s_waitcnt vmcnt(0)" ::: "memory");
#undef GLAP_DMA
#undef GLAP_TASK
}

__device__ __forceinline__ void phase_gla_scan(const P& p, int layer, LAS unsigned char* lds, int vcu, int G, const int wv_) {
    unsigned char* ws = p.ws; asm volatile("" : "+s"(ws));
    const int lane = hw_tid(), tid = (wv_ << 6) | lane, fr = lane & 15, fq = lane >> 4;
    constexpr int B_QD = 0, B_KST = 16384, B_A = 32768, B_V = 40960, B_CL = 49152, BUF = 50176, L_ST = 2 * BUF;
    static_assert(L_ST + 16384 <= RING_BYTES, "gla scan LDS map");
    LAS unsigned char* ST = lds + L_ST;
    const unsigned lds0 = (unsigned)(size_t)lds;
    const bf16_t* X = (const bf16_t*)(ws + WS_B1);
    for (int u = vcu; u < 256; u += G) {
        const int b = u >> 5, h = (u >> 3) & 3, dir = (u >> 2) & 1, sl = u & 3;
        bf16_t* O = (bf16_t*)(ws + WS_B2) + (dir ? (size_t)68 * MiB / 2 : 0);
        const int tk0 = gla_task(b, h, dir, 0);
        f32x4 sacc[4];
#pragma unroll
        for (int et = 0; et < 4; ++et) sacc[et] = (f32x4){0.f, 0.f, 0.f, 0.f};
        for (int e = tid; e < 4096; e += NTHR) ((LAS unsigned*)ST)[e] = 0u;
#define GLAS_DMA(s_) do { const int s__ = (s_); const unsigned bo_ = lds0 + (unsigned)((s__ & 1) * BUF); const size_t tk_ = (size_t)(tk0 + s__); const unsigned lo_ = (unsigned)lane * 16u; \
            pg8::glds16_s((const char*)(ws + WS_GQD) + tk_ * 16384 + (2 * wv_) * 1024, lo_, bo_ + B_QD + (2 * wv_) * 1024); pg8::glds16_s((const char*)(ws + WS_GQD) + tk_ * 16384 + (2 * wv_ + 1) * 1024, lo_, bo_ + B_QD + (2 * wv_ + 1) * 1024); \
            pg8::glds16_s((const char*)(ws + WS_GKS) + tk_ * 16384 + (2 * wv_) * 1024, lo_, bo_ + B_KST + (2 * wv_) * 1024); pg8::glds16_s((const char*)(ws + WS_GKS) + tk_ * 16384 + (2 * wv_ + 1) * 1024, lo_, bo_ + B_KST + (2 * wv_ + 1) * 1024); \
            pg8::glds16_s((const char*)(ws + WS_GA) + tk_ * 8192 + wv_ * 1024, lo_, bo_ + B_A + wv_ * 1024); \
            pg8::glds16_s((const char*)(X + (size_t)(gla_rowc(b, dir, s__) + 8 * wv_) * 3072 + 1024 + h * 256 + sl * 64), (unsigned)((lane >> 3) * 6144 + (((lane & 7) ^ (2 * (((lane >> 4) & 1) | ((wv_ & 1) << 1)))) << 4)), bo_ + B_V + wv_ * 1024); \
            if (wv_ == 0 && lane < 32) pg8::glds16_s((const char*)(ws + WS_GCL) + tk_ * 512, lo_, bo_ + B_CL); } while (0)
        GLAS_DMA(0); GLAS_DMA(1);
        __syncthreads();
#pragma unroll 1
        for (int s = 0; s < 68; ++s) {
            LAS unsigned char* bq = lds + (s & 1) * BUF;
            const int rowc = gla_rowc(b, dir, s);
            if (s == 0) asm volatile("s_waitcnt vmcnt(6)" ::: "memory");
            else if (s == 1) { if (wv_ == 0) asm volatile("s_waitcnt vmcnt(9)" ::: "memory"); else asm volatile("s_waitcnt vmcnt(8)" ::: "memory"); }
            else if (s + 1 < 68) { if (wv_ == 0) asm volatile("s_waitcnt vmcnt(11)" ::: "memory"); else asm volatile("s_waitcnt vmcnt(10)" ::: "memory"); }
            else asm volatile("s_waitcnt vmcnt(4)" ::: "memory");
            __syncthreads();
            {
                const int it = wv_ >> 1, e0 = 2 * (wv_ & 1);
                bf16x8 fa[2], fq4[4], fv[2][4], fs[4][2], fk[2];
                typedef short s4v __attribute__((ext_vector_type(4)));
                const int tq = fr >> 2, tp = fr & 3, fx = ((tq >> 1) & 1) | ((fq & 1) << 1);
                LAS unsigned char* vb = bq + B_V + (8 * fq + tq) * 128 + tp * 8;
#pragma unroll
                for (int kk = 0; kk < 2; ++kk) { fa[kk] = *(const LAS bf16x8*)(bq + B_A + gla_o128(16 * it + fr, 4 * kk + fq)); fk[kk] = *(const LAS bf16x8*)(bq + B_KST + gla_o128(16 * wv_ + fr, 4 * kk + fq));
#pragma unroll
                    for (int et = 0; et < 4; ++et) { LAS unsigned char* va = vb + kk * 4096 + ((et ^ fx) << 5);
                        const s4v lo4 = __builtin_amdgcn_ds_read_tr16_b64_v4i16((LAS s4v*)va), hi4 = __builtin_amdgcn_ds_read_tr16_b64_v4i16((LAS s4v*)(va + 512));
                        fv[kk][et] = __builtin_shufflevector(lo4, hi4, 0, 1, 2, 3, 4, 5, 6, 7); }
 }
#pragma unroll
                for (int kk = 0; kk < 4; ++kk) { fq4[kk] = *(const LAS bf16x8*)(bq + B_QD + gla_o256(16 * it + fr, 4 * kk + fq));
#pragma unroll
                    for (int jj = 0; jj < 2; ++jj) fs[kk][jj] = *(const LAS bf16x8*)(ST + gla_o256(16 * (e0 + jj) + fr, 4 * kk + fq)); }
                const f32x4 clv = *(const LAS f32x4*)(bq + B_CL + (16 * wv_ + 4 * fq) * 4);
                asm volatile("s_waitcnt lgkmcnt(0)" ::: "memory");
                __syncthreads();
                if (s + 2 < 68) GLAS_DMA(s + 2);
                f32x4 o2[2] = {(f32x4){0.f, 0.f, 0.f, 0.f}, (f32x4){0.f, 0.f, 0.f, 0.f}};
                if (wv_ & 1) {
#pragma unroll
                    for (int kk = 0; kk < 2; ++kk)
#pragma unroll
                        for (int jj = 0; jj < 2; ++jj) o2[jj] = __builtin_amdgcn_mfma_f32_16x16x32_bf16(fv[kk][2 + jj], fa[kk], o2[jj], 0, 0, 0);
                } else {
#pragma unroll
                    for (int kk = 0; kk < 2; ++kk)
#pragma unroll
                        for (int jj = 0; jj < 2; ++jj) o2[jj] = __builtin_amdgcn_mfma_f32_16x16x32_bf16(fv[kk][jj], fa[kk], o2[jj], 0, 0, 0);
                }
#pragma unroll
                for (int kk = 0; kk < 4; ++kk)
#pragma unroll
                    for (int jj = 0; jj < 2; ++jj) o2[jj] = __builtin_amdgcn_mfma_f32_16x16x32_bf16(fs[kk][jj], fq4[kk], o2[jj], 0, 0, 0);
                const f32x4 dec = (f32x4){__builtin_amdgcn_exp2f(clv[0]), __builtin_amdgcn_exp2f(clv[1]), __builtin_amdgcn_exp2f(clv[2]), __builtin_amdgcn_exp2f(clv[3])};
#pragma unroll
                for (int et = 0; et < 4; ++et) sacc[et] = sacc[et] * dec;
#pragma unroll
                for (int kk = 0; kk < 2; ++kk)
#pragma unroll
                    for (int et = 0; et < 4; ++et) sacc[et] = __builtin_amdgcn_mfma_f32_16x16x32_bf16(fk[kk], fv[kk][et], sacc[et], 0, 0, 0);
#pragma unroll
                for (int jj = 0; jj < 2; ++jj) { const int et = e0 + jj;
                    *(GAS u32x2*)(O + (size_t)(rowc + 16 * it + fr) * 1024 + h * 256 + sl * 64 + 16 * et + 4 * fq) = (u32x2){pg8::cvt_pk_bf16(o2[jj][0], o2[jj][1]), pg8::cvt_pk_bf16(o2[jj][2], o2[jj][3])}; }
            }
#pragma unroll
            for (int et = 0; et < 4; ++et) { const int d0 = 16 * wv_ + 4 * fq; *(LAS u32x2*)(ST + gla_o256(16 * et + fr, d0 >> 3) + (d0 & 7) * 2) = (u32x2){pg8::cvt_pk_bf16(sacc[et][0], sacc[et][1]), pg8::cvt_pk_bf16(sacc[et][2], sacc[et][3])}; }
        }
        __syncthreads();
#undef GLAS_DMA
    }
}

__device__ __forceinline__ void phase_gla_merge(const P& p, int layer, int vcu, int G, const int wv_) {
    unsigned char* ws = p.ws; asm volatile("" : "+s"(ws));
    const int lane = hw_tid(), wave = wv_;
    constexpr int NRW = 4;
    const bf16_t* OF = (const bf16_t*)(ws + WS_B2); const bf16_t* OB = OF + (size_t)68 * MiB / 2; bf16_t* O = (bf16_t*)(ws + WS_B2);
    const bf16_t* X = (const bf16_t*)(ws + WS_B1);
    const f32x4 gn = *(const f32x4*)(p.gla_o_norm + (layer >> 1) * 256 + lane * 4);
    for (int r0 = (vcu * NWAVES + wave) * NRW; r0 < NR; r0 += G * NWAVES * NRW) {
        u32x2 a[NRW][4], bb[NRW][4], og[NRW][4];
#pragma unroll
        for (int q = 0; q < NRW; ++q)
#pragma unroll
            for (int h = 0; h < 4; ++h) { const size_t i0 = (size_t)(r0 + q) * 1024 + h * 256 + lane * 4;
                a[q][h] = *(const u32x2*)(OF + i0); bb[q][h] = *(const u32x2*)(OB + i0); og[q][h] = *(const u32x2*)(X + (size_t)(r0 + q) * 3072 + 2048 + h * 256 + lane * 4); }
#pragma unroll
        for (int q = 0; q < NRW; ++q)
#pragma unroll
            for (int h = 0; h < 4; ++h) {
                float x[4];
                x[0] = __uint_as_float(a[q][h].x << 16) + __uint_as_float(bb[q][h].x << 16); x[1] = __uint_as_float(a[q][h].x & 0xffff0000u) + __uint_as_float(bb[q][h].x & 0xffff0000u);
                x[2] = __uint_as_float(a[q][h].y << 16) + __uint_as_float(bb[q][h].y << 16); x[3] = __uint_as_float(a[q][h].y & 0xffff0000u) + __uint_as_float(bb[q][h].y & 0xffff0000u);
                const float ss = wave_sum((x[0] * x[0] + x[1] * x[1]) + (x[2] * x[2] + x[3] * x[3]));
                const float rs = rsqrtf(ss * (1.f / 256.f) + EPS);
                const float ogf[4] = {__uint_as_float(og[q][h].x << 16), __uint_as_float(og[q][h].x & 0xffff0000u), __uint_as_float(og[q][h].y << 16), __uint_as_float(og[q][h].y & 0xffff0000u)};
                float r[4];
#pragma unroll
                for (int j = 0; j < 4; ++j) r[j] = x[j] * rs * gn[j] * silu_f(ogf[j]);
                *(u32x2*)(O + (size_t)(r0 + q) * 1024 + h * 256 + lane * 4) = (u32x2){pk2(r[0], r[1]), pk2(r[2], r[3])};
            }
    }
}

__device__ __forceinline__ int wave_sum_i(int v) {
    v += __builtin_amdgcn_ds_swizzle(v, (1 << 10) | 0x1f); v += __builtin_amdgcn_ds_swizzle(v, (2 << 10) | 0x1f); v += __builtin_amdgcn_ds_swizzle(v, (4 << 10) | 0x1f);
    v += __builtin_amdgcn_ds_swizzle(v, (8 << 10) | 0x1f); v += __builtin_amdgcn_ds_swizzle(v, (16 << 10) | 0x1f);
    auto rr = __builtin_amdgcn_permlane32_swap((unsigned)v, (unsigned)v, false, false);
    return (int)(rr[0] + rr[1]);
}
__device__ __forceinline__ void phase_topk(const P& p, LAS unsigned char* lds, int vcu, int G, const int wv_, const int nunits) {
    unsigned char* ws = p.ws; asm volatile("" : "+s"(ws));
    const int lane = hw_tid(), tid = (wv_ << 6) | lane;
    LAS int* red = (LAS int*)lds;
    const float* aff = (const float*)(ws + WS_AFF);
    int* idx = (int*)(ws + WS_IDX); float* gatev = (float*)(ws + WS_GATE); int* pos = (int*)(ws + WS_POS);
    for (int u = vcu; u < nunits; u += G) {
        const int s = u >> 4, e = u & 15, b = s & 7;
        const int n = s < 8 ? SEQ : CTXL, cap = n / 8;
        const int row0 = b * RPB + (s < 8 ? 0 : SEQ);
        unsigned key[8];
#pragma unroll
        for (int k = 0; k < 8; ++k) { const int i = tid * 8 + k; key[k] = i < n ? (__float_as_uint(aff[(size_t)(row0 + i) * 16 + e]) | 0x80000000u) : 0u; }
        unsigned T = 0u;
#pragma unroll 1
        for (int lo = 30; lo >= 0; lo -= 2) {
            const unsigned c1 = T | (1u << lo), c2 = T | (2u << lo), c3 = T | (3u << lo);
            int c = 0;
#pragma unroll
            for (int k = 0; k < 8; ++k) c += (key[k] >= c1 ? 1 : 0) + (key[k] >= c2 ? (1 << 10) : 0) + (key[k] >= c3 ? (1 << 20) : 0);
            c = wave_sum_i(c);
            LAS int* rb = red + ((lo >> 1) & 1) * 8;
            if (lane == 0) rb[wv_] = c;
            __syncthreads();
            int t1 = 0, t2 = 0, t3 = 0;
#pragma unroll
            for (int q = 0; q < 8; ++q) { const int v = rb[q]; t1 += v & 1023; t2 += (v >> 10) & 1023; t3 += (v >> 20) & 1023; }
            T = t3 >= cap ? c3 : (t2 >= cap ? c2 : (t1 >= cap ? c1 : T));
        }
        int mine = 0;
#pragma unroll
        for (int k = 0; k < 8; ++k) mine += (key[k] > T ? 1 : 0) + (key[k] == T ? 0x10000 : 0);
        int inc = mine;
#pragma unroll
        for (int o = 1; o < 64; o <<= 1) { const int t2 = __builtin_amdgcn_ds_bpermute(((lane - o) & 63) << 2, inc); if (lane >= o) inc += t2; }
        __syncthreads();
        if (lane == 63) red[16 + wv_] = inc;
        __syncthreads();
        int base = 0, total = 0;
#pragma unroll
        for (int q = 0; q < 8; ++q) { const int t2 = red[16 + q]; total += t2; if (q < wv_) base += t2; }
        int ex = base + inc - mine;
        const int m = total & 0xffff;
        const int slot0 = (s < 8 ? 0 : NSLOT_LAT) + (e * 8 + b) * cap;
#pragma unroll
        for (int k = 0; k < 8; ++k) {
            const int i = tid * 8 + k;
            if (i < n) {
                const int g = ex & 0xffff, q = ex >> 16;
                int sl = -1;
                if (key[k] > T) sl = g; else if (key[k] == T && m + q < cap) sl = m + q;
                const int row = row0 + i;
                if (sl >= 0) { idx[slot0 + sl] = row; gatev[slot0 + sl] = __uint_as_float(key[k] & 0x7fffffffu); }
                pos[(size_t)row * 16 + e] = sl >= 0 ? slot0 + sl : -1;
                ex += (key[k] > T ? 1 : 0) + (key[k] == T ? 0x10000 : 0);
            }
        }
        __syncthreads();
    }
}

constexpr int N_PHASES = 38;
__global__ void __launch_bounds__(NTHR, 2) mega_fwd(P p) {
    extern __shared__ __attribute__((aligned(16))) unsigned char lds_raw[];
    LAS unsigned char* lds = (LAS unsigned char*)lds_raw;
    volatile LAS unsigned* MISC = (volatile LAS unsigned*)(lds + MISC_OFF);
    const int tid = threadIdx.x;
    const int wv0 = __builtin_amdgcn_readfirstlane(tid >> 6);
    const int G = gridDim.x; const int bx0 = blockIdx.x;
    const int vcu0 = (G % 8 == 0) ? (bx0 % 8) * (G / 8) + bx0 / 8 : bx0;
    for (int u = tid; u < (LDS_BYTES - RING_BYTES) / 4; u += NTHR) ((LAS unsigned*)(lds + RING_BYTES))[u] = 0u;
    __syncthreads();
    const int lo = p.ph_lo, hi = p.ph_hi;
    unsigned* barw = (unsigned*)(p.ws + WS_CTL) + 4096 + p.seg * XCD_BAR_WORDS;
    XcdBarrier bar; bar.bar = barw; bar.x = 0; bar.st = MISC + 8;
    if (hi - lo > 1) bar = xcd_barrier_post(barw, MISC + 8);
#define IN(k) (lo <= (k) && (k) < hi)
#define SEAM(k) do { if ((k) + 1 < hi) xcd_barrier(bar, wv0); } while (0)
    if (IN(0)) { for (int rep_ = 0; rep_ < ((DUP_MASK >> 0) & 1) + 1; ++rep_) { phase_prologue(p, lds, vcu0, G, wv0); } SEAM(0); }
#pragma unroll 1
    for (int layer = 0; layer < 4; ++layer) {
        const int base = 1 + 9 * layer, li = layer >> 1;
        int bx = bx0, vcu = vcu0, wv = wv0; unsigned char* ws = p.ws; asm volatile("" : "+s"(bx), "+s"(vcu), "+s"(ws), "+s"(wv));
        if (IN(base + 0)) { if (layer == 0) phase_norm<0>(p, layer, lds, vcu, G, wv); else phase_norm<1>(p, layer, lds, vcu, G, wv); SEAM(base + 0); }
        if ((layer & 1) == 0) {
            if (IN(base + 1)) {
                pg8::Gemm g{(const bf16_t*)(ws + WS_U), (const bf16_t*)(ws + W_ATTN_IN) + (size_t)li * 2304 * 1024, NR, 2304, nullptr, 0};
                pg8::StaticOrder S; S.init(NR, 2304, G, bx);
                pg8::EpiQKV E{(bf16_t*)(ws + WS_B1), (const float*)(ws + WS_ROPE + 16384) + li * 256, (const float*)(ws + WS_ROPE)};
                for (int rep_ = 0; rep_ < ((DUP_MASK >> 1) & 1) + 1; ++rep_) { pg8::gemm_phase<pg8::EpiQKV, false, false>(lds, g, S, E, wv); }
                if (G == 256 && bx >= 200) moe_window(p, lds, layer, 0, bx - 200, wv);
                SEAM(base + 1);
            }
            if (IN(base + 3)) { for (int rep_ = 0; rep_ < ((DUP_MASK >> 2) & 1) + 1; ++rep_) { phase_attn_dense(p, (char*)lds_raw, vcu, G, wv); phase_attn_na(p, layer, (char*)lds_raw, vcu, G, wv); } SEAM(base + 3); }
        } else {
            if (IN(base + 1)) {
                pg8::Gemm g{(const bf16_t*)(ws + WS_U), (const bf16_t*)(ws + W_GLA_IN) + (size_t)li * 3328 * 1024, NR, 3328, nullptr, 0};
                pg8::StaticOrder S; S.init(NR, 3328, G, bx);
                pg8::EpiGlaIn E{(bf16_t*)(ws + WS_B1), (float*)(ws + WS_Z)};
                for (int rep_ = 0; rep_ < ((DUP_MASK >> 1) & 1) + 1; ++rep_) { pg8::gemm_phase<pg8::EpiGlaIn, false, false>(lds, g, S, E, wv); }
                if (G == 256 && bx >= 232) moe_window(p, lds, layer, 0, bx - 232, wv);
                SEAM(base + 1);
            }
            if (IN(base + 2)) { for (int rep_ = 0; rep_ < ((DUP_MASK >> 3) & 1) + 1; ++rep_) { phase_gla_pre(p, layer, lds, vcu, G, wv); } xcd_barrier(bar, wv0); phase_gla_scan(p, layer, lds, vcu, G, wv); SEAM(base + 2); }
            if (IN(base + 3)) { for (int rep_ = 0; rep_ < ((DUP_MASK >> 4) & 1) + 1; ++rep_) { phase_gla_merge(p, layer, vcu, G, wv); } SEAM(base + 3); }
        }
        if (IN(base + 4)) {
            const bf16_t* A = (const bf16_t*)(ws + WS_B2);
            const bf16_t* Bt = (layer & 1) ? (const bf16_t*)(ws + W_GLA_OUT) + (size_t)li * 1024 * 1024 : (const bf16_t*)(ws + W_ATTN_OUT) + (size_t)li * 1024 * 1024;
            pg8::Gemm g{A, Bt, NR, 1024, nullptr, 0};
            pg8::StaticOrder S; if (layer == 3) S.init(NB * SEQ, 1024, G, bx, 1); else S.init(NR, 1024, G, bx);
            pg8::EpiResid E{(bf16_t*)(ws + WS_HB), (const float*)(ws + WS_MODS) + (size_t)layer * 9 * 6144, layer == 0 ? p.x : nullptr, layer == 0 ? p.ctx : nullptr};
            pg8::gemm_phase<pg8::EpiResid, false, false>(lds, g, S, E, wv);
            if (layer < 3 && G == 256 && bx >= 32) moe_window(p, lds, layer, 1, bx - 32, wv);
            SEAM(base + 4);
        }
        if (IN(base + 5)) { for (int rep_ = 0; rep_ < ((DUP_MASK >> 5) & 1) + 1; ++rep_) { phase_norm<2>(p, layer, lds, vcu, G, wv, layer == 3); } SEAM(base + 5); }
        if (IN(base + 6)) { for (int rep_ = 0; rep_ < ((DUP_MASK >> 6) & 1) + 1; ++rep_) { phase_topk(p, lds, vcu, G, wv, layer == 3 ? 128 : 256); }
            if (G == 256 && vcu >= 128) moe_window(p, lds, layer, 2, vcu - 128, wv);        SEAM(base + 6); }
        if (IN(base + 7)) {
            pg8::Gemm g{(const bf16_t*)(ws + WS_U), (const bf16_t*)(ws + W_MOE_UP) + (size_t)layer * 16 * 2048 * 1024, NSLOT, 2048, (const int*)(ws + WS_IDX), (size_t)2048 * 1024 * 2};
            pg8::StaticOrder S; S.init(layer == 3 ? NSLOT_LAT : NSLOT, 2048, G, bx);
            pg8::EpiSwiGLU E{(bf16_t*)(ws + WS_B1)};
            for (int rep_ = 0; rep_ < ((DUP_MASK >> 7) & 1) + 1; ++rep_) { pg8::gemm_phase<pg8::EpiSwiGLU, true, true>(lds, g, S, E, wv); }
            if (layer < 3 && G == 256 && bx >= 128) moe_window(p, lds, layer, 3, bx - 128, wv);
            SEAM(base + 7);
        }
        if (IN(base + 8)) {
            pg8::Gemm g{(const bf16_t*)(ws + WS_B1), (const bf16_t*)(ws + W_MOE_DN) + (size_t)layer * 16 * 1024 * 1024, NSLOT, 1024, nullptr, (size_t)1024 * 1024 * 2};
            pg8::StaticOrder S; S.init(layer == 3 ? NSLOT_LAT : NSLOT, 1024, G, bx);
            pg8::EpiBf16 E{(bf16_t*)(ws + WS_B2), 1024, (const float*)(ws + WS_GATE)};
            for (int rep_ = 0; rep_ < ((DUP_MASK >> 8) & 1) + 1; ++rep_) { pg8::gemm_phase<pg8::EpiBf16, false, true>(lds, g, S, E, wv); }
            if (layer < 3 && G == 256 && bx >= 64) moe_window(p, lds, layer, 4, bx - 64, wv);
            SEAM(base + 8);
        }
    }
    if (IN(37)) phase_norm<3>(p, 3, lds, vcu0, G, wv0);
#undef IN
#undef SEAM
}
}

extern "C" void kernel_launch(void* const* d_in, const int* in_sizes, int n_in, void* d_out, int out_size, void* d_ws, size_t ws_size, hipStream_t stream) {
    static int grid = 0;
    if (grid == 0) {
        if (ws_size < WS_END) { fprintf(stderr, "kernel_launch: workspace too small: %zu < %zu\n", ws_size, (size_t)WS_END); grid = -1; return; }
        int dev = 0, cus = 0;
        if (hipGetDevice(&dev) != hipSuccess || hipDeviceGetAttribute(&cus, hipDeviceAttributeMultiprocessorCount, dev) != hipSuccess) { grid = -1; return; }
        if (hipFuncSetAttribute((const void*)mega_fwd, hipFuncAttributeMaxDynamicSharedMemorySize, LDS_BYTES) != hipSuccess) { fprintf(stderr, "kernel_launch: hipFuncSetAttribute failed\n"); grid = -1; return; }
        int per_cu = 0;
        if (hipOccupancyMaxActiveBlocksPerMultiprocessor(&per_cu, (const void*)mega_fwd, NTHR, LDS_BYTES) != hipSuccess || per_cu < 1) fprintf(stderr, "kernel_launch: occupancy query reports %d\n", per_cu);
        (void)hipGetLastError();
        grid = cus;
    }
    if (grid < 0) return;
    (void)hipMemsetAsync((char*)d_ws + WS_CTL, 0, CTL_ZERO_BYTES, stream);
    P p{};
    const float** pp = (const float**)&p;
    for (int i = 0; i < 26; ++i) pp[i] = (const float*)d_in[i];
    p.out = (float*)d_out; p.ws = (unsigned char*)d_ws;
    p.ph_lo = 0; p.ph_hi = N_PHASES; p.seg = 0;
    hipLaunchKernelGGL(mega_fwd, dim3(grid), dim3(NTHR), LDS_BYTES, stream, p);
}
```

```cpp
#include <hip/hip_runtime.h>
#include <stdint.h>
#include <math.h>
#include <cstdio>

#ifndef DUP_MASK
#define DUP_MASK 0
#endif

namespace {
#define LAS __attribute__((address_space(3)))
#define GAS __attribute__((address_space(1)))
typedef unsigned short bf16_t;
typedef short bf16x8 __attribute__((ext_vector_type(8)));
typedef float f32x4 __attribute__((ext_vector_type(4)));
typedef unsigned u32x4 __attribute__((ext_vector_type(4)));
typedef unsigned u32x2 __attribute__((ext_vector_type(2)));

constexpr int D = 1024, NB = 8, SEQ = 4096, CTXL = 256, RPB = 4352, NR = NB * RPB;
constexpr int NSLOT_LAT = 65536, NSLOT = 69632;
constexpr int NTHR = 512, NWAVES = 8;
constexpr size_t MiB = 1u << 20;
constexpr size_t WS_CTL = 0, CTL_ZERO_BYTES = 1 * MiB;
constexpr size_t WS_MODS = 2 * MiB;
constexpr size_t WS_ROPE = 3 * MiB;
constexpr size_t WS_AFF = 12 * MiB;
constexpr size_t WS_POS = 15 * MiB;
constexpr size_t WS_IDX = 18 * MiB;
constexpr size_t WS_GATE = 19 * MiB;
constexpr size_t WS_Z = 20 * MiB;
constexpr size_t WS_U = 32 * MiB;
constexpr size_t WS_B1 = 100 * MiB;
constexpr size_t WS_B2 = 304 * MiB;
constexpr size_t WS_HB = WS_B2 + 136 * MiB;
constexpr size_t WS_W = 508 * MiB;
constexpr size_t W_ATTN_IN = WS_W, W_ATTN_OUT = WS_W + 9 * MiB, W_GLA_IN = WS_W + 13 * MiB, W_GLA_OUT = WS_W + 26 * MiB, W_MOE_UP = WS_W + 30 * MiB, W_MOE_DN = WS_W + 286 * MiB;
constexpr size_t WS_GQD = WS_U;
constexpr size_t WS_GKS = WS_W + 414 * MiB;
constexpr size_t WS_GA = WS_GKS + 68 * MiB;
constexpr size_t WS_GCL = WS_GA + 34 * MiB;
constexpr size_t WS_END = WS_GCL + 3 * MiB;
constexpr float EPS = 1e-6f;
constexpr int LDS_BYTES = 147456;
constexpr int RING_BYTES = 131072, MISC_OFF = RING_BYTES + 320;

struct P {
    const float *x, *c, *ctx, *c_ctx, *ada_w, *ada_b, *norm1_g, *norm2_g, *attn_w_in, *attn_w_out,
        *a_q_norm, *a_k_norm, *b_q_norm, *b_k_norm, *na_rpb, *gla_w_in, *gk_w_f, *gk_b_f, *gk_w_b, *gk_b_b,
        *gla_o_norm, *gla_w_out, *moe_router, *moe_w_gate, *moe_w_up, *moe_w_down;
    float* out; unsigned char* ws;
    int ph_lo, ph_hi, seg, pad;
};

__device__ __forceinline__ float bf2f(bf16_t v) { return __uint_as_float(((unsigned)v) << 16); }
__device__ __forceinline__ unsigned f2bf(float f) { unsigned u = __float_as_uint(f); return (u + 0x7fffu + ((u >> 16) & 1u)) >> 16; }
__device__ __forceinline__ unsigned pk2(float lo, float hi) { return f2bf(lo) | (f2bf(hi) << 16); }
__device__ __forceinline__ int hw_tid() {
    int t; asm volatile("v_mbcnt_lo_u32_b32 %0, -1, 0\n\tv_mbcnt_hi_u32_b32 %0, -1, %0" : "=v"(t)); return t;
}
template <int X> __device__ __forceinline__ float swz_xor(float v) { return __uint_as_float((unsigned)__builtin_amdgcn_ds_swizzle((int)__float_as_uint(v), (X << 10) | 0x1f)); }
__device__ __forceinline__ float wave_sum(float v) {
    v += swz_xor<1>(v); v += swz_xor<2>(v); v += swz_xor<4>(v); v += swz_xor<8>(v); v += swz_xor<16>(v);
    auto rr = __builtin_amdgcn_permlane32_swap(__float_as_uint(v), __float_as_uint(v), false, false);
    return __uint_as_float(rr[0]) + __uint_as_float(rr[1]);
}
__device__ __forceinline__ float silu_f(float x) { return x / (1.f + __expf(-x)); }
__device__ __forceinline__ int mod_row(int row) { const int b = row / RPB, t = row - b * RPB; return t < SEQ ? b : 8; }

namespace pg8 {
constexpr int BM = 256, BK = 64, HALF = 128, HTB = HALF * BK * 2, STAGE_BYTES = 8 * HTB, NXCD = 8, WGM = 8;
__device__ __forceinline__ int lds_byte(int r, int c) { const int st = (r >> 4) * 2 + (c >> 5), rr = r & 15, cc = c & 31, ob = rr * 64 + cc * 2; return st * 1024 + (ob ^ (((ob >> 9) & 1) << 5)); }
__device__ __forceinline__ void stage_rc(int b, int& R, int& C) { const int st = b / 1024, sb = b % 1024, swz = sb ^ (((sb >> 9) & 1) << 5); R = (st >> 1) * 16 + swz / 64; C = (st & 1) * 32 + (swz % 64) / 2; }
__device__ __forceinline__ int perm32(int rho) { const int n = rho >> 4, i = rho & 15; return 8 * (i >> 2) + 4 * n + (i & 3); }
struct Unit { int pm, pn; };
struct Gemm { const bf16_t* A; const bf16_t* Bt; int M, N; const int* gather; size_t bgroup; };
struct StaticOrder {
    int nM, nN, nwg, G, c, skip17;
    __device__ void init(int M, int N, int G_, int c_, int skip17_ = 0) { nM = M / BM; nN = N / BM; nwg = nM * nN; G = G_; c = c_; skip17 = skip17_; }
    __device__ bool next(int i, Unit& u) const {
        const long L = (long)i * G + c; if (L >= nwg) return false;
        int wgid = (int)L; { const int q = nwg / NXCD, r = nwg % NXCD, xcd = wgid % NXCD, off = wgid / NXCD; wgid = (xcd < r ? xcd * (q + 1) : r * (q + 1) + (xcd - r) * q) + off; }
        const int nig = WGM * nN, gid = wgid / nig, fm = gid * WGM, gsz = (nM - fm) < WGM ? (nM - fm) : WGM;
        u.pm = fm + ((wgid % nig) % gsz); u.pn = (wgid % nig) / gsz; if (skip17) u.pm += u.pm >> 4; return true;
    }
};
typedef float f32x2_t_ __attribute__((ext_vector_type(2))); typedef __bf16 bf16x2_t_ __attribute__((ext_vector_type(2)));
__device__ __forceinline__ unsigned cvt_pk_bf16(float lo, float hi) { f32x2_t_ v = {lo, hi}; bf16x2_t_ b = __builtin_convertvector(v, bf16x2_t_); return __builtin_bit_cast(unsigned, b); }
__device__ __forceinline__ int expert_of_tile(int pm) { return pm < 256 ? (pm >> 4) : (pm - 256); }

struct EpiBf16 {
    static constexpr bool PERM = true;
    bf16_t* O; int ldc; const float* rowscale;
    __device__ __forceinline__ void operator()(const f32x4 (&acc)[2][2][4][2], const Unit& u, int wr, int wc, int fr, int fq) const {
        const int row0 = u.pm * BM + wr * 64 + fr, col0 = u.pn * BM + wc * 32 + 8 * fq;
#pragma unroll
        for (int ai = 0; ai < 2; ++ai)
#pragma unroll
            for (int m = 0; m < 4; ++m) { bf16_t* rowp = O + (size_t)(row0 + ai * HALF + m * 16) * ldc + col0;
                const float rsc = rowscale ? rowscale[row0 + ai * HALF + m * 16] : 1.f;
#pragma unroll
                for (int bj = 0; bj < 2; ++bj) { const f32x4 v0 = acc[ai][bj][m][0] * rsc, v1 = acc[ai][bj][m][1] * rsc;
                    u32x4 w; w.x = cvt_pk_bf16(v0[0], v0[1]); w.y = cvt_pk_bf16(v0[2], v0[3]); w.z = cvt_pk_bf16(v1[0], v1[1]); w.w = cvt_pk_bf16(v1[2], v1[3]);
                    *(u32x4*)(rowp + bj * HALF) = w; } }
    }
};
struct EpiQKV {
    static constexpr bool PERM = true;
    bf16_t* O; const float* qkg; const float* rope;
    __device__ __forceinline__ void operator()(const f32x4 (&acc)[2][2][4][2], const Unit& u, int wr, int wc, int fr, int fq) const {
        const int sg = 4 * u.pn + wc;
        const int b = u.pm / 17, tt = u.pm - b * 17;
        const int row0 = u.pm * BM + wr * 64 + fr, col0 = sg * 64 + 8 * fq;
        const bool is_q = sg < 8 || (sg >= 12 && sg < 20), is_v = sg == 10 || sg == 11 || sg >= 28;
        const bool do_rope = sg < 10 && tt < 16;
        const float* gp = qkg + 64 * (sg < 8 ? 0 : (sg < 10 ? 1 : (sg < 20 ? 2 : 3)));
        const float qsc = is_q ? 0.18033688011112042f : 1.f;
        const int lane_hi = fq >> 1;
#pragma unroll
        for (int ai = 0; ai < 2; ++ai)
#pragma unroll
            for (int m = 0; m < 4; ++m) {
                f32x4 v[2][2];
                float ss = 0.f;
#pragma unroll
                for (int bj = 0; bj < 2; ++bj)
#pragma unroll
                    for (int n = 0; n < 2; ++n) { v[bj][n] = acc[ai][bj][m][n]; ss += (v[bj][n][0] * v[bj][n][0] + v[bj][n][1] * v[bj][n][1]) + (v[bj][n][2] * v[bj][n][2] + v[bj][n][3] * v[bj][n][3]); }
                if (!is_v) {
                    ss += swz_xor<16>(ss);
                    { auto rr = __builtin_amdgcn_permlane32_swap(__float_as_uint(ss), __float_as_uint(ss), false, false); ss = __uint_as_float(rr[0]) + __uint_as_float(rr[1]); }
                    const float rs = rsqrtf(ss * (1.f / 64.f) + EPS) * qsc;
                    const float* gpl = gp + 8 * fq; asm volatile("" : "+v"(gpl));
#pragma unroll
                    for (int bj = 0; bj < 2; ++bj)
#pragma unroll
                        for (int n = 0; n < 2; ++n) v[bj][n] = v[bj][n] * rs * *(const f32x4*)(gpl + 32 * bj + 4 * n);
                    if (do_rope) {
                        const int posr = tt * 4 + 2 * ai + wr, posc = 16 * m + fr;
#pragma unroll
                        for (int bj = 0; bj < 2; ++bj) {
                            const float* tb = rope + (bj ? posc : posr) * 16 + 8 * (fq & 1);
#pragma unroll
                            for (int n = 0; n < 2; ++n) {
                                const f32x4 cs = *(const f32x4*)(tb + 4 * n), sn = *(const f32x4*)(tb + 1024 + 4 * n);
                                f32x4 ot;
#pragma unroll
                                for (int e = 0; e < 4; ++e) { auto rr = __builtin_amdgcn_permlane32_swap(__float_as_uint(v[bj][n][e]), __float_as_uint(v[bj][n][e]), false, false);
                                    const float other = __uint_as_float(lane_hi ? rr[0] : rr[1]); ot[e] = lane_hi ? other : -other; }
                                v[bj][n] = v[bj][n] * cs + ot * sn;
                            }
                        }
                    }
                }
                bf16_t* rowp = O + (size_t)(row0 + ai * HALF + m * 16) * 2304 + col0;
#pragma unroll
                for (int bj = 0; bj < 2; ++bj) { u32x4 w; w.x = cvt_pk_bf16(v[bj][0][0], v[bj][0][1]); w.y = cvt_pk_bf16(v[bj][0][2], v[bj][0][3]); w.z = cvt_pk_bf16(v[bj][1][0], v[bj][1][1]); w.w = cvt_pk_bf16(v[bj][1][2], v[bj][1][3]);
                    *(u32x4*)(rowp + 32 * bj) = w; }
            }
    }
};
struct EpiGlaIn {
    static constexpr bool PERM = true;
    bf16_t* O; float* Z;
    __device__ __forceinline__ void operator()(const f32x4 (&acc)[2][2][4][2], const Unit& u, int wr, int wc, int fr, int fq) const {
        const int row0 = u.pm * BM + wr * 64 + fr;
        if (u.pn < 12) {
            const int col0 = u.pn * BM + wc * 32 + 8 * fq;
#pragma unroll
            for (int ai = 0; ai < 2; ++ai)
#pragma unroll
                for (int m = 0; m < 4; ++m) { bf16_t* rowp = O + (size_t)(row0 + ai * HALF + m * 16) * 3072 + col0;
#pragma unroll
                    for (int bj = 0; bj < 2; ++bj) { const f32x4 v0 = acc[ai][bj][m][0], v1 = acc[ai][bj][m][1];
                        u32x4 w; w.x = cvt_pk_bf16(v0[0], v0[1]); w.y = cvt_pk_bf16(v0[2], v0[3]); w.z = cvt_pk_bf16(v1[0], v1[1]); w.w = cvt_pk_bf16(v1[2], v1[3]);
                        *(u32x4*)(rowp + bj * HALF) = w; } }
        } else if (wc == 0) {
#pragma unroll
            for (int ai = 0; ai < 2; ++ai)
#pragma unroll
                for (int m = 0; m < 4; ++m) { float* zp = Z + (size_t)(row0 + ai * HALF + m * 16) * 32 + 8 * fq;
                    *(f32x4*)(zp) = acc[ai][0][m][0]; *(f32x4*)(zp + 4) = acc[ai][0][m][1]; }
        }
    }
};
struct EpiResid {
    static constexpr bool PERM = true;
    bf16_t* hb; const float* mods_l; const float* slat; const float* sctx;
    __device__ __forceinline__ void operator()(const f32x4 (&acc)[2][2][4][2], const Unit& u, int wr, int wc, int fr, int fq) const {
        const int b = u.pm / 17, tt = u.pm - b * 17;
        const int mr = tt < 16 ? b : 8;
        const int col0 = u.pn * BM + wc * 32 + 8 * fq;
        bf16_t* base = hb + (size_t)(u.pm * BM + wr * 64 + fr) * D + col0;
        const float* g2 = mods_l + (size_t)mr * 6144 + 2 * 1024 + col0;
        f32x4 gv[2][2];
#pragma unroll
        for (int bj = 0; bj < 2; ++bj)
#pragma unroll
            for (int n = 0; n < 2; ++n) gv[bj][n] = *(const f32x4*)(g2 + bj * HALF + n * 4);
        if (slat != nullptr) {
            const float* sbase = (tt < 16 ? slat + (size_t)(b * SEQ + tt * 256) * D : sctx + (size_t)(b * CTXL) * D) + (size_t)(wr * 64 + fr) * D + col0;
#pragma unroll
            for (int ai = 0; ai < 2; ++ai) {
                f32x4 hv[4][2][2];
#pragma unroll
                for (int m = 0; m < 4; ++m) { const float* rowp = sbase + (size_t)(ai * HALF + m * 16) * D;
#pragma unroll
                    for (int bj = 0; bj < 2; ++bj)
#pragma unroll
                        for (int n = 0; n < 2; ++n) hv[m][bj][n] = *(const f32x4*)(rowp + bj * HALF + n * 4); }
#pragma unroll
                for (int m = 0; m < 4; ++m) { bf16_t* rowp = base + (size_t)(ai * HALF + m * 16) * D;
#pragma unroll
                    for (int bj = 0; bj < 2; ++bj) { const f32x4 r0 = hv[m][bj][0] + gv[bj][0] * acc[ai][bj][m][0], r1 = hv[m][bj][1] + gv[bj][1] * acc[ai][bj][m][1];
                        *(u32x4*)(rowp + bj * HALF) = (u32x4){cvt_pk_bf16(r0[0], r0[1]), cvt_pk_bf16(r0[2], r0[3]), cvt_pk_bf16(r1[0], r1[1]), cvt_pk_bf16(r1[2], r1[3])}; } }
            }
        } else {
#pragma unroll
            for (int ai = 0; ai < 2; ++ai) {
                u32x4 hv[4][2];
#pragma unroll
                for (int m = 0; m < 4; ++m) { const bf16_t* rowp = base + (size_t)(ai * HALF + m * 16) * D;
#pragma unroll
                    for (int bj = 0; bj < 2; ++bj) hv[m][bj] = *(const u32x4*)(rowp + bj * HALF); }
#pragma unroll
                for (int m = 0; m < 4; ++m) { bf16_t* rowp = base + (size_t)(ai * HALF + m * 16) * D;
#pragma unroll
                    for (int bj = 0; bj < 2; ++bj) { const u32x4 t = hv[m][bj];
                        const f32x4 h0 = (f32x4){__uint_as_float(t.x << 16), __uint_as_float(t.x & 0xffff0000u), __uint_as_float(t.y << 16), __uint_as_float(t.y & 0xffff0000u)};
                        const f32x4 h1 = (f32x4){__uint_as_float(t.z << 16), __uint_as_float(t.z & 0xffff0000u), __uint_as_float(t.w << 16), __uint_as_float(t.w & 0xffff0000u)};
                        const f32x4 r0 = h0 + gv[bj][0] * acc[ai][bj][m][0], r1 = h1 + gv[bj][1] * acc[ai][bj][m][1];
                        *(u32x4*)(rowp + bj * HALF) = (u32x4){cvt_pk_bf16(r0[0], r0[1]), cvt_pk_bf16(r0[2], r0[3]), cvt_pk_bf16(r1[0], r1[1]), cvt_pk_bf16(r1[2], r1[3])}; } }
            }
        }
    }
};
struct EpiSwiGLU {
    static constexpr bool PERM = true;
    bf16_t* O;
    __device__ __forceinline__ void operator()(const f32x4 (&acc)[2][2][4][2], const Unit& u, int wr, int wc, int fr, int fq) const {
        const int row0 = u.pm * BM + wr * 64 + fr, col0 = u.pn * HALF + wc * 32 + 8 * fq;
#pragma unroll
        for (int ai = 0; ai < 2; ++ai)
#pragma unroll
            for (int m = 0; m < 4; ++m) { bf16_t* rowp = O + (size_t)(row0 + ai * HALF + m * 16) * 1024 + col0;
                float r[8];
#pragma unroll
                for (int n = 0; n < 2; ++n)
#pragma unroll
                    for (int e = 0; e < 4; ++e) { const float g = acc[ai][0][m][n][e], up = acc[ai][1][m][n][e]; r[n * 4 + e] = g * __builtin_amdgcn_rcpf(1.f + __expf(-g)) * up; }
                u32x4 w; w.x = cvt_pk_bf16(r[0], r[1]); w.y = cvt_pk_bf16(r[2], r[3]); w.z = cvt_pk_bf16(r[4], r[5]); w.w = cvt_pk_bf16(r[6], r[7]);
                *(u32x4*)rowp = w; }
    }
};

__device__ __forceinline__ void glds16_s(const char* sbase, unsigned voff, unsigned lds_dst) { unsigned keep;
    asm volatile("s_nop 4\n\ts_mov_b32 %0, m0\n\ts_mov_b32 m0, %3\n\ts_nop 0\n\tglobal_load_lds_dwordx4 %1, %2\n\ts_mov_b32 m0, %0" : "=&s"(keep) : "v"(voff), "s"(sbase), "s"(lds_dst) : "memory"); }
template <class Epi, bool GATHER, bool GROUPED>
__device__ __forceinline__ void gemm_phase(LAS unsigned char* lds, const Gemm g, const StaticOrder& S, const Epi& E, const int wv_) {
    const int tid = (wv_ << 6) | hw_tid();
    const int wid = wv_, lane = tid & 63, wr = wid >> 2, wc = wid & 3, fr = lane & 15, fq = lane >> 4;
    constexpr int K = 1024, nt = K / BK;
    unsigned voffA[2], voffB[2];
#pragma unroll
    for (int i = 0; i < 2; ++i) { int R, C; stage_rc(tid * 16 + i * 8192, R, C); const int Rb = Epi::PERM ? ((R & ~31) + perm32(R & 31)) : R;
        voffA[i] = (unsigned)(R * K + C) * 2u; voffB[i] = (unsigned)(Rb * K + C) * 2u; }
#define PG8_RA(i) ((int)(voffA[i] >> 11))
#define PG8_CA(i) (voffA[i] & 2047u)
    constexpr size_t kstep = (size_t)(BK * 2);
    constexpr size_t hstep = (size_t)HALF * K * 2;
    constexpr size_t tstep = 2 * hstep;
    const unsigned ldsw = (unsigned)wid * 1024u, lds0 = (unsigned)(size_t)lds;
    const int aoff = lds_byte(wr * 64 + fr, fq * 8), boff = lds_byte(wc * 32 + fr, fq * 8);
#define PG8_SA(b, h) (((b) * 2 + (h)) * HTB)
#define PG8_SB(b, h) ((4 + (b) * 2 + (h)) * HTB)
#define PG8_STAGE_B(bufoff, gbase) do { _Pragma("unroll") for (int _i = 0; _i < 2; ++_i) \
        glds16_s((const char*)(gbase), voffB[_i], lds0 + (unsigned)(bufoff) + ldsw + (unsigned)(_i * 8192)); } while (0)
#define PG8_STAGE_A(bufoff, kp, h, O) do { _Pragma("unroll") for (int _i = 0; _i < 2; ++_i) { \
        if (GATHER) glds16_s((const char*)(kp), (O)[h][_i], lds0 + (unsigned)(bufoff) + ldsw + (unsigned)(_i * 8192)); \
        else glds16_s((const char*)(kp) + (size_t)(h) * hstep, voffA[_i], lds0 + (unsigned)(bufoff) + ldsw + (unsigned)(_i * 8192)); } } while (0)
#define PG8_LDA(dst, b, h) do { _Pragma("unroll") for (int m = 0; m < 4; ++m) _Pragma("unroll") for (int k = 0; k < 2; ++k) dst[m][k] = *(const LAS bf16x8*)(lds + PG8_SA(b, h) + aoff + m * 2048 + k * 1024); } while (0)
#define PG8_LDB(dst, b, h) do { _Pragma("unroll") for (int n = 0; n < 2; ++n) _Pragma("unroll") for (int k = 0; k < 2; ++k) dst[n][k] = *(const LAS bf16x8*)(lds + PG8_SB(b, h) + boff + n * 2048 + k * 1024); } while (0)
#define PG8_MMA(ai, bj, At, Bt) do { __builtin_amdgcn_s_setprio(1); _Pragma("unroll") for (int m = 0; m < 4; ++m) _Pragma("unroll") for (int n = 0; n < 2; ++n) _Pragma("unroll") for (int k = 0; k < 2; ++k) \
        acc[ai][bj][m][n] = __builtin_amdgcn_mfma_f32_16x16x32_bf16(Bt[n][k], At[m][k], acc[ai][bj][m][n], 0, 0, 0); __builtin_amdgcn_s_setprio(0); } while (0)
#define PG8_WAIT_V(n) asm volatile("s_waitcnt vmcnt(" #n ")" ::: "memory")
#define PG8_WAIT_L(n) asm volatile("s_waitcnt lgkmcnt(" #n ")" ::: "memory")
#define PG8_BAR __builtin_amdgcn_s_barrier()
#define PG8_SCHED __builtin_amdgcn_sched_barrier(0)
#define PG8_BOF(u) ((const char*)g.Bt + (GROUPED ? (size_t)expert_of_tile((u).pm) * g.bgroup : (size_t)0) + (size_t)(u).pn * tstep)
#define PG8_AOF(u) (GATHER ? (const char*)g.A : (const char*)g.A + (size_t)(u).pm * tstep)
    Unit cur, nxt; int ui = 0;
    if (!S.next(0, cur)) return;
    unsigned oc[2][2], on[2][2]; unsigned rn[2];
#pragma unroll
    for (int h = 0; h < 2; ++h)
#pragma unroll
        for (int i = 0; i < 2; ++i) { oc[h][i] = 0u; on[h][i] = 0u; rn[h] = 0u; }
    if (GATHER) {
#pragma unroll
        for (int h = 0; h < 2; ++h)
#pragma unroll
            for (int i = 0; i < 2; ++i) { int row = g.gather[cur.pm * BM + h * HALF + PG8_RA(i)]; row = row < 0 ? 0 : (row >= NR ? NR - 1 : row); oc[h][i] = (unsigned)row * (unsigned)(K * 2) + PG8_CA(i); }
    }
    f32x4 acc[2][2][4][2];
#pragma unroll
    for (int a = 0; a < 2; ++a)
#pragma unroll
        for (int b = 0; b < 2; ++b)
#pragma unroll
            for (int m = 0; m < 4; ++m)
#pragma unroll
                for (int n = 0; n < 2; ++n) acc[a][b][m][n] = (f32x4){0.f, 0.f, 0.f, 0.f};
    bf16x8 At[4][2], B0[2][2], B1[2][2];
    const char* cA = PG8_AOF(cur); const char* cB = PG8_BOF(cur);
    PG8_STAGE_B(PG8_SB(0, 0), cB); PG8_STAGE_B(PG8_SB(0, 1), cB + hstep); PG8_STAGE_A(PG8_SA(0, 0), cA, 0, oc); PG8_STAGE_A(PG8_SA(0, 1), cA, 1, oc);
    if (wr == 1) PG8_BAR;
    PG8_WAIT_V(2); PG8_BAR;
    PG8_STAGE_B(PG8_SB(1, 0), cB + kstep); PG8_STAGE_A(PG8_SA(1, 0), cA + kstep, 0, oc); PG8_STAGE_B(PG8_SB(1, 1), cB + hstep + kstep);
    PG8_WAIT_V(6); PG8_BAR;
#define PG8_KBODY(LAST, O2) do { \
            const char* a1 = cA + (size_t)(t + 1) * kstep; \
            const char* a2 = (LAST) ? nA : cA + (size_t)(t + 2) * kstep; const char* b2 = (LAST) ? nB : cB + (size_t)(t + 2) * kstep; \
            const char* a3 = a2 + kstep; const char* b3 = b2 + kstep; \
            PG8_LDB(B0, 0, 0); PG8_LDB(B1, 0, 1); PG8_SCHED; PG8_LDA(At, 0, 0); PG8_STAGE_A(PG8_SA(1, 1), a1, 1, oc); \
            PG8_WAIT_V(8); PG8_WAIT_L(0); PG8_BAR; PG8_MMA(0, 0, At, B0); PG8_MMA(0, 1, At, B1); PG8_BAR; PG8_SCHED; \
            PG8_LDA(At, 0, 1); PG8_STAGE_B(PG8_SB(0, 0), b2); PG8_STAGE_B(PG8_SB(0, 1), b2 + hstep); PG8_STAGE_A(PG8_SA(0, 0), a2, 0, O2); \
            PG8_WAIT_V(8); PG8_WAIT_L(0); PG8_BAR; PG8_MMA(1, 0, At, B0); PG8_MMA(1, 1, At, B1); PG8_BAR; PG8_SCHED; \
            PG8_LDB(B0, 1, 0); PG8_LDB(B1, 1, 1); PG8_SCHED; PG8_LDA(At, 1, 0); PG8_STAGE_A(PG8_SA(0, 1), a2, 1, O2); \
            PG8_WAIT_V(8); PG8_WAIT_L(0); PG8_BAR; PG8_MMA(0, 0, At, B0); PG8_MMA(0, 1, At, B1); PG8_BAR; PG8_SCHED; \
            PG8_LDA(At, 1, 1); PG8_STAGE_B(PG8_SB(1, 0), b3); PG8_STAGE_B(PG8_SB(1, 1), b3 + hstep); PG8_STAGE_A(PG8_SA(1, 0), a3, 0, O2); \
            PG8_WAIT_V(8); PG8_WAIT_L(0); PG8_BAR; PG8_MMA(1, 0, At, B0); PG8_MMA(1, 1, At, B1); PG8_BAR; PG8_SCHED; \
        } while (0)
    for (;;) {
        const bool has_next = S.next(ui + 1, nxt);
        const char* nA = has_next ? PG8_AOF(nxt) : cA; const char* nB = has_next ? PG8_BOF(nxt) : cB;
        if (GATHER && has_next) {
            const int t2 = (wv_ << 6) | hw_tid();
            int R0, C0, R1, C1; stage_rc(t2 * 16, R0, C0); stage_rc(t2 * 16 + 8192, R1, C1);
            const int* gp = g.gather + nxt.pm * BM;
            rn[0] = ((unsigned)gp[R0] & 0xffffu) | ((unsigned)gp[R1] << 16); rn[1] = ((unsigned)gp[HALF + R0] & 0xffffu) | ((unsigned)gp[HALF + R1] << 16);
        }
        int t = 0;
#pragma unroll 1
        for (; t < nt - 2; t += 2) PG8_KBODY(false, oc);
        if (GATHER) {
#pragma unroll
            for (int h = 0; h < 2; ++h)
#pragma unroll
                for (int i = 0; i < 2; ++i) { int row = (int)(i ? (rn[h] >> 16) : (rn[h] & 0xffffu)); row = row >= NR ? NR - 1 : row; on[h][i] = has_next ? (unsigned)row * (unsigned)(K * 2) + (oc[h][i] & 2047u) : oc[h][i]; }
        }
        PG8_KBODY(true, on);
        if (wr == 0) PG8_BAR;
        { const int l2 = hw_tid(); E(acc, cur, wr, wc, l2 & 15, l2 >> 4); }
        if (!has_next) break;
#pragma unroll
        for (int a = 0; a < 2; ++a)
#pragma unroll
            for (int b = 0; b < 2; ++b)
#pragma unroll
                for (int m = 0; m < 4; ++m)
#pragma unroll
                    for (int n = 0; n < 2; ++n) acc[a][b][m][n] = (f32x4){0.f, 0.f, 0.f, 0.f};
        cur = nxt; cA = nA; cB = nB; ++ui;
        if (GATHER) {
#pragma unroll
            for (int h = 0; h < 2; ++h)
#pragma unroll
                for (int i = 0; i < 2; ++i) oc[h][i] = on[h][i];
        }
        if (wr == 1) PG8_BAR;
    }
    PG8_WAIT_V(0);
    PG8_BAR;
#undef PG8_KBODY
#undef PG8_RA
#undef PG8_CA
#undef PG8_SA
#undef PG8_SB
#undef PG8_STAGE_A
#undef PG8_STAGE_B
#undef PG8_LDA
#undef PG8_LDB
#undef PG8_MMA
#undef PG8_WAIT_V
#undef PG8_WAIT_L
#undef PG8_BAR
#undef PG8_SCHED
#undef PG8_BOF
#undef PG8_AOF
}
}

#define XB_TMO      128
#define XB_XCNT(j)  (256  + 64 * (j))
#define XB_XSUB(j)  (1280 + 64 * (j))
#define XB_XGEN(j)  (2304 + 64 * (j))
#define XB_TOP      3328
#define XB_TOPGEN   3392
#define XCD_BAR_WORDS 3456
#define XB_SPIN_CAP (1u << 22)
__device__ __forceinline__ unsigned xb_ld(unsigned* p)              { return __hip_atomic_load(p, __ATOMIC_RELAXED, __HIP_MEMORY_SCOPE_AGENT); }
__device__ __forceinline__ unsigned xb_add(unsigned* p, unsigned v) { return __hip_atomic_fetch_add(p, v, __ATOMIC_RELAXED, __HIP_MEMORY_SCOPE_AGENT); }
__device__ __forceinline__ unsigned xb_xcc_id() { return (unsigned)__builtin_amdgcn_s_getreg((3 << 11) | 20) & 0xFu; }
#define XB_SPIN(cond, bar) do { unsigned _sp = 0; while (cond) { __builtin_amdgcn_s_sleep(1); \
    if ((++_sp & 255u) == 0u) { if (xb_ld(&(bar)[XB_TMO])) break; if (_sp > XB_SPIN_CAP) { atomicAdd(&(bar)[XB_TMO], 1u); break; } } } } while (0)
struct XcdBarrier { unsigned* bar; unsigned x; volatile LAS unsigned* st; };
__device__ __forceinline__ XcdBarrier xcd_barrier_post(unsigned* bar, volatile LAS unsigned* st) {
    XcdBarrier b; b.bar = bar; b.x = xb_xcc_id(); b.st = st;
    if (threadIdx.x == 0) (void)xb_add(&bar[XB_XCNT(b.x)], 1u);
    return b;
}
__device__ __forceinline__ void xcd_barrier_complete(unsigned* bar, unsigned x, unsigned& nloc, unsigned& nx) {
    const unsigned G = gridDim.x * gridDim.y * gridDim.z;
    unsigned sum, cnt, mine, sp = 0u;
    for (;;) {
        sum = 0u; cnt = 0u; mine = 0u;
#pragma unroll
        for (unsigned j = 0; j < 16; ++j) { const unsigned c = xb_ld(&bar[XB_XCNT(j)]); sum += c; cnt += (c > 0u) ? 1u : 0u; mine = (j == x) ? c : mine; }
        if (sum == G) break;
        __builtin_amdgcn_s_sleep(1);
        if ((++sp & 255u) == 0u) { if (xb_ld(&bar[XB_TMO])) break; if (sp > XB_SPIN_CAP) { atomicAdd(&bar[XB_TMO], 1u); break; } }
    }
    nloc = mine > 0u ? mine : 1u; nx = cnt > 0u ? cnt : 1u;
}
__device__ __forceinline__ void xcd_barrier(const XcdBarrier& b, const int wv_) {
    asm volatile("s_waitcnt vmcnt(0)" ::: "memory");
    __syncthreads();
    if (wv_ == 0 && hw_tid() == 0) {
        unsigned* bar = b.bar; asm volatile("" : "+s"(bar));
        __builtin_amdgcn_s_waitcnt(0);
        unsigned nloc = b.st[0], nx = b.st[1];
        if (nloc == 0u) { xcd_barrier_complete(bar, b.x, nloc, nx); b.st[0] = nloc; b.st[1] = nx; }
        const unsigned old = xb_add(&bar[XB_XSUB(b.x)], 1u);
        const unsigned gen = old / nloc;
        if (old + 1u == (gen + 1u) * nloc) {
            __builtin_amdgcn_fence(__ATOMIC_RELEASE, "agent");
            asm volatile("s_waitcnt vmcnt(0)" ::: "memory");
            const unsigned og = xb_add(&bar[XB_TOP], 1u);
            const unsigned tg = og / nx;
            if (og + 1u == (tg + 1u) * nx) xb_add(&bar[XB_TOPGEN], 1u);
            else XB_SPIN(xb_ld(&bar[XB_TOPGEN]) == tg, bar);
            __builtin_amdgcn_fence(__ATOMIC_ACQUIRE, "agent");
            xb_add(&bar[XB_XGEN(b.x)], 1u);
            asm volatile("s_waitcnt vmcnt(0)" ::: "memory");
        } else {
            XB_SPIN(xb_ld(&bar[XB_XGEN(b.x)]) == gen, bar);
            __builtin_amdgcn_fence(__ATOMIC_ACQUIRE, "agent");
            asm volatile("s_waitcnt vmcnt(0)" ::: "memory");
        }
    }
    __syncthreads();
}

__device__ __forceinline__ void p0_transpose_item(const float* W, int N, int kb, int n0, bf16_t* WTrow0  , LAS float* scr, int lane) {
    const int k0 = 64 * kb;
#pragma unroll 8
    for (int i = 0; i < 32; ++i) { const int kk = 2 * i + (lane >> 5); scr[kk * 33 + (lane & 31)] = W[(size_t)(k0 + kk) * N + n0 + (lane & 31)]; }
    asm volatile("s_waitcnt lgkmcnt(0)" ::: "memory");
    const int c = lane & 7;
#pragma unroll
    for (int j = 0; j < 4; ++j) { const int n = (lane >> 3) + 8 * j; const LAS float* s = scr + (8 * c) * 33 + n;
        u32x4 o; o.x = pk2(s[0 * 33], s[1 * 33]); o.y = pk2(s[2 * 33], s[3 * 33]); o.z = pk2(s[4 * 33], s[5 * 33]); o.w = pk2(s[6 * 33], s[7 * 33]);
        *(u32x4*)(WTrow0 + (size_t)n * 1024 + k0 + 8 * c) = o; }
    asm volatile("s_waitcnt lgkmcnt(0)" ::: "memory");
}
constexpr int MOE_ITEMS = 48 * 512, MOE_ALL = 4 * MOE_ITEMS;
constexpr int MOE_PRO = 6144, WIN_B = 224 * 8 * 4, WIN_C = 128 * 8 * 5, WIN_D = 128 * 8 * 7, WIN_E = 192 * 8 * 5;
__device__ __forceinline__ int win_capA(int layer) { return (layer & 1) ? 24 * 8 * 8 : 56 * 8 * 8; }
__device__ __forceinline__ int win_layer_start(int layer) {
    const int full_even = 56 * 8 * 8 + WIN_B + WIN_C + WIN_D + WIN_E, full_odd = 24 * 8 * 8 + WIN_B + WIN_C + WIN_D + WIN_E;
    return MOE_PRO + (layer > 0 ? full_even : 0) + (layer > 1 ? full_odd : 0) + (layer > 2 ? full_even : 0);
}
__device__ __forceinline__ void moe_item_decode(const P& p, unsigned char* ws, int layer, int q, const float*& src, bf16_t*& dst) {
    const int mat = q >> 9, rr = q & 511, kb = rr >> 5, n0 = (rr & 31) * 32, kind = mat >> 4, le = layer * 16 + (mat & 15);
    if (kind < 2) {
        src = (kind == 0 ? p.moe_w_gate : p.moe_w_up) + (size_t)le * 1024 * 1024 + (size_t)(64 * kb) * 1024 + n0;
        dst = (bf16_t*)(ws + W_MOE_UP) + (size_t)le * 2048 * 1024 + (size_t)((n0 >> 7) * 256 + (n0 & 127) + kind * 128) * 1024 + 64 * kb;
    } else {
        src = p.moe_w_down + (size_t)le * 1024 * 1024 + (size_t)(64 * kb) * 1024 + n0;
        dst = (bf16_t*)(ws + W_MOE_DN) + (size_t)le * 1024 * 1024 + (size_t)n0 * 1024 + 64 * kb;
    }
}
__device__ __forceinline__ void moe_convert_win(const P& p, LAS unsigned char* lds, int g0, int npw, int gend, const int wv_) {
    unsigned char* ws = p.ws; asm volatile("" : "+s"(ws));
    const int lane = hw_tid();
    LAS float* scr = (LAS float*)(lds + wv_ * 16384);
    float va[32], vb[32]; bf16_t* da; bf16_t* db;
    int g = g0 + wv_;
    if (gend > MOE_ALL) gend = MOE_ALL;
    if (g < gend) { const float* sa; moe_item_decode(p, ws, g / MOE_ITEMS, g % MOE_ITEMS, sa, da); sa += (size_t)(lane >> 5) * 1024 + (lane & 31);
#pragma unroll
        for (int i = 0; i < 32; ++i) va[i] = sa[(size_t)(2 * i) * 1024]; }
#pragma unroll 1
    for (int k = 0; k < npw; ++k, g += 8) {
        if (g >= gend) break;
        const bool more = k + 1 < npw && g + 8 < gend;
        if (more) { const float* sb; moe_item_decode(p, ws, (g + 8) / MOE_ITEMS, (g + 8) % MOE_ITEMS, sb, db); sb += (size_t)(lane >> 5) * 1024 + (lane & 31);
#pragma unroll
            for (int i = 0; i < 32; ++i) vb[i] = sb[(size_t)(2 * i) * 1024]; }
#pragma unroll
        for (int i = 0; i < 32; ++i) scr[(2 * i + (lane >> 5)) * 33 + (lane & 31)] = va[i];
        asm volatile("s_waitcnt lgkmcnt(0)" ::: "memory");
        const int c = lane & 7;
#pragma unroll
        for (int j = 0; j < 4; ++j) { const int n = (lane >> 3) + 8 * j; const LAS float* s2 = scr + (8 * c) * 33 + n;
            u32x4 o; o.x = pk2(s2[0 * 33], s2[1 * 33]); o.y = pk2(s2[2 * 33], s2[3 * 33]); o.z = pk2(s2[4 * 33], s2[5 * 33]); o.w = pk2(s2[6 * 33], s2[7 * 33]);
            *(u32x4*)(da + (size_t)n * 1024 + 8 * c) = o; }
        asm volatile("s_waitcnt lgkmcnt(0)" ::: "memory");
        if (more) {
#pragma unroll
            for (int i = 0; i < 32; ++i) va[i] = vb[i];
            da = db; }
    }
}
__device__ __forceinline__ void moe_window(const P& p, LAS unsigned char* lds, int layer, int kind, int blk, const int wv_) {
    const int capA = win_capA(layer), s0 = win_layer_start(layer);
    int start, cap, npw;
    if (kind == 0) { start = s0; cap = capA; npw = 8; }
    else if (kind == 1) { start = s0 + capA; cap = WIN_B; npw = 4; }
    else if (kind == 2) { start = s0 + capA + (layer < 3 ? WIN_B : 0); cap = WIN_C; npw = 5; }
    else if (kind == 3) { start = s0 + capA + WIN_B + WIN_C; cap = WIN_D; npw = 7; }
    else { start = s0 + capA + WIN_B + WIN_C + WIN_D; cap = WIN_E; npw = 5; }
    moe_convert_win(p, lds, start + blk * 8 * npw, npw, start + cap, wv_);
}
__device__ __forceinline__ void phase_prologue(const P& p, LAS unsigned char* lds, int vcu, int G, const int wv_) {
    unsigned char* ws = p.ws; asm volatile("" : "+s"(ws));
    const int tid = (wv_ << 6) | hw_tid();
    const int lane = tid & 63, wave = wv_;
    LAS float* scr = (LAS float*)(lds + wave * 16384);
    const int gw = vcu * NWAVES + wave, NGW = G * NWAVES;
    constexpr int I_AI = 16 * 72, I_AO = 16 * 32, I_GI = 16 * 97, I_GO = 16 * 32, I_SMALL = 2 * (I_AI + I_AO + I_GI + I_GO), I_MOE = 16 * 32;
    const int NITEMS = I_SMALL + (G == 256 ? MOE_PRO : MOE_ALL);
    for (int it = gw; it < NITEMS; it += NGW) {
        int r = it;
        if (r < I_SMALL) {
            const int i = r >= I_SMALL / 2 ? 1 : 0; r -= i * (I_SMALL / 2);
            if (r < I_AI) { const int kb = r / 72, nb = r % 72, n0 = nb * 32, drow = (n0 & ~255) + 128 * ((n0 >> 5) & 1) + 32 * ((n0 >> 6) & 3);
                p0_transpose_item(p.attn_w_in + (size_t)i * 1024 * 2304, 2304, kb, n0, (bf16_t*)(ws + W_ATTN_IN) + (size_t)i * 2304 * 1024 + (size_t)drow * 1024, scr, lane); continue; } r -= I_AI;
            if (r < I_AO) { const int kb = r / 32, nb = r % 32; p0_transpose_item(p.attn_w_out + (size_t)i * 1024 * 1024, 1024, kb, nb * 32, (bf16_t*)(ws + W_ATTN_OUT) + (size_t)i * 1024 * 1024 + (size_t)nb * 32 * 1024, scr, lane); continue; } r -= I_AO;
            if (r < I_GI) { const int kb = r / 97, nb = r % 97; p0_transpose_item(p.gla_w_in + (size_t)i * 1024 * 3104, 3104, kb, nb * 32, (bf16_t*)(ws + W_GLA_IN) + (size_t)i * 3328 * 1024 + (size_t)nb * 32 * 1024, scr, lane); continue; } r -= I_GI;
            { const int kb = r / 32, nb = r % 32; p0_transpose_item(p.gla_w_out + (size_t)i * 1024 * 1024, 1024, kb, nb * 32, (bf16_t*)(ws + W_GLA_OUT) + (size_t)i * 1024 * 1024 + (size_t)nb * 32 * 1024, scr, lane); continue; }
        }
        r -= I_SMALL;
        { int layer_, q_;
          layer_ = r / MOE_ITEMS; q_ = r % MOE_ITEMS;
          const float* src_; bf16_t* dst_; moe_item_decode(p, ws, layer_, q_, src_, dst_); p0_transpose_item(src_, 1024, 0, 0, dst_, scr, lane); }
    }
    for (int it = gw; it < 2 * 224; it += NGW) { const int i = it / 224, rr = 3104 + it % 224; u32x4* dst = (u32x4*)((bf16_t*)(ws + W_GLA_IN) + (size_t)i * 3328 * 1024 + (size_t)rr * 1024);
        dst[lane] = (u32x4){0u, 0u, 0u, 0u}; dst[lane + 64] = (u32x4){0u, 0u, 0u, 0u}; }
    __syncthreads();
    {
        LAS float* s = (LAS float*)lds;
        LAS float* red = (LAS float*)(lds + 9 * 1024 * 4);
        for (int i = tid; i < 9 * 1024; i += NTHR) { const int r = i >> 10, k = i & 1023; const float v = r < 8 ? p.c[r * 1024 + k] : p.c_ctx[k]; s[i] = v / (1.f + expf(-v)); }
        __syncthreads();
        float* mods = (float*)(ws + WS_MODS);
        for (int u = vcu; u < 384; u += G) {
            const int l = u / 96, cb = u % 96, cl = tid & 63, ks = tid >> 6, col = cb * 64 + cl;
            float acc[9];
#pragma unroll
            for (int r = 0; r < 9; ++r) acc[r] = 0.f;
            const float* w = p.ada_w + (size_t)l * 1024 * 6144 + col;
            for (int k = ks * 128; k < ks * 128 + 128; ++k) { const float wv = w[(size_t)k * 6144];
#pragma unroll
                for (int r = 0; r < 9; ++r) acc[r] += s[r * 1024 + k] * wv; }
#pragma unroll
            for (int r = 0; r < 9; ++r) red[(ks * 9 + r) * 64 + cl] = acc[r];
            __syncthreads();
            for (int i = tid; i < 9 * 64; i += NTHR) { const int r = i >> 6, c2 = i & 63; float v = 0.f;
#pragma unroll
                for (int q = 0; q < 8; ++q) v += red[(q * 9 + r) * 64 + c2];
                const int cc = cb * 64 + c2, chunk = cc >> 10; v += p.ada_b[l * 6144 + cc];
                if (chunk == 1) v = p.norm1_g[l * 1024 + (cc & 1023)] * (1.f + v); else if (chunk == 4) v = p.norm2_g[l * 1024 + (cc & 1023)] * (1.f + v);
                mods[(size_t)(l * 9 + r) * 6144 + cc] = v; }
            __syncthreads();
        }
    }
    if (vcu == 1 % G) { float* qkg = (float*)(ws + WS_ROPE + 16384);
        for (int i = tid; i < 512; i += NTHR) { const int l = i >> 8, ty = (i >> 6) & 3, d = i & 63; const float* src = ty == 0 ? p.a_q_norm : (ty == 1 ? p.a_k_norm : (ty == 2 ? p.b_q_norm : p.b_k_norm)); qkg[i] = src[l * 64 + d]; } }
    if (vcu == 0) { float* tab = (float*)(ws + WS_ROPE);
        for (int i = tid; i < 1024; i += NTHR) { const int pos = i >> 4, j = i & 15; const float inv = powf(10000.f, -(float)j / 16.f); const float a = (float)pos * inv; tab[i] = cosf(a); tab[1024 + i] = sinf(a); } }
}

template <int WHICH> __device__ __forceinline__ void phase_norm(const P& p, int layer, LAS unsigned char* lds, int vcu, int G, const int wv_, const bool lat_only = false) {
    unsigned char* ws = p.ws; asm volatile("" : "+s"(ws));
    const int lane = hw_tid(), tid = (wv_ << 6) | lane, wave = wv_;
    constexpr int NRW = 2;
    const float* mods = (const float*)(ws + WS_MODS);
    constexpr int UT_PITCH = 2064;
    LAS unsigned char* ut_hi = lds; LAS unsigned char* ut_lo = lds + 16 * UT_PITCH; LAS float* rpart0 = (LAS float*)(lds + 32 * UT_PITCH);
    int rstepi = 0;
    bf16x8 wfh[4], wfl[4];
    if (WHICH == 2) {
        const float* rwt = p.moe_router + (size_t)layer * 1024 * 16;
        const int fr = lane & 15, fq = lane >> 4;
#pragma unroll
        for (int ks = 0; ks < 4; ++ks) {
            float wv[8];
#pragma unroll
            for (int i = 0; i < 8; ++i) wv[i] = rwt[(size_t)(128 * wave + 32 * ks + 8 * fq + i) * 16 + fr];
            unsigned hh[4], ll[4];
#pragma unroll
            for (int i = 0; i < 4; ++i) { const unsigned h0 = f2bf(wv[2 * i]), h1 = f2bf(wv[2 * i + 1]); hh[i] = h0 | (h1 << 16);
                ll[i] = pk2(wv[2 * i] - __uint_as_float(h0 << 16), wv[2 * i + 1] - __uint_as_float(h1 << 16)); }
            wfh[ks] = __builtin_bit_cast(bf16x8, (u32x4){hh[0], hh[1], hh[2], hh[3]}); wfl[ks] = __builtin_bit_cast(bf16x8, (u32x4){ll[0], ll[1], ll[2], ll[3]});
        }
    }
    const int nrows = (WHICH == 3 || lat_only) ? NB * SEQ : NR;
    constexpr bool COMB = WHICH == 3 || WHICH == 1;
    f32x4 vn[NRW][4]; u32x2 vnb[NRW][4]; int slotn[NRW];
#define NORM_ROWMAP(rr_) do { if (WHICH == 3 || lat_only) { const int b_ = (rr_) / SEQ, t_ = (rr_) - b_ * SEQ; (rr_) = b_ * RPB + t_; } } while (0)
#define NORM_LOAD(r0_, V_, S_) do { _Pragma("unroll") for (int q = 0; q < NRW; ++q) { int rr = (r0_) + q; NORM_ROWMAP(rr); const int b = rr / RPB, t = rr - b * RPB; \
            if constexpr (WHICH == 0) { const float* src = t < SEQ ? p.x + (size_t)(b * SEQ + t) * D : p.ctx + (size_t)(b * CTXL + (t - SEQ)) * D; \
                _Pragma("unroll") for (int j = 0; j < 4; ++j) V_[q][j] = ((const GAS f32x4*)src)[lane + 64 * j]; } \
            else { const bf16_t* src = (const bf16_t*)(ws + WS_HB) + (size_t)rr * D; (void)b; (void)t; \
                _Pragma("unroll") for (int j = 0; j < 4; ++j) V_##b[q][j] = ((const GAS u32x2*)src)[lane + 64 * j]; } \
            if (COMB) S_[q] = lane < 16 ? ((const GAS int*)(ws + WS_POS))[(size_t)rr * 16 + lane] : -1; } } while (0)
    constexpr int rstep = NWAVES * NRW;
    const int ngrp = nrows / rstep;
    int r0 = (int)(((long)vcu * ngrp) / G) * rstep + wave * NRW;
    const int rend = (int)(((long)(vcu + 1) * ngrp) / G) * rstep;
    int mr_cur = -1; f32x4 shv[4], scv[4], m5v[4];
#pragma unroll
    for (int j = 0; j < 4; ++j) { shv[j] = (f32x4){0.f, 0.f, 0.f, 0.f}; scv[j] = shv[j]; m5v[j] = shv[j]; }
    if (r0 < rend) NORM_LOAD(r0, vn, slotn);
    for (; r0 < rend; r0 += rstep) {
        int row[NRW], mr[NRW]; f32x4 v[NRW][4]; int slot[NRW];
#pragma unroll
        for (int q = 0; q < NRW; ++q) {
            int rr = r0 + q; NORM_ROWMAP(rr);
            row[q] = rr;
            const int b = rr / RPB, t = rr - b * RPB;
            mr[q] = t < SEQ ? b : 8;
            slot[q] = slotn[q];
#pragma unroll
            for (int j = 0; j < 4; ++j) {
                if constexpr (WHICH == 0) v[q][j] = vn[q][j];
                else { const u32x2 t2 = vnb[q][j]; v[q][j] = (f32x4){__uint_as_float(t2.x << 16), __uint_as_float(t2.x & 0xffff0000u), __uint_as_float(t2.y << 16), __uint_as_float(t2.y & 0xffff0000u)}; }
            }
        }
        if (mr[0] != mr_cur) {
            mr_cur = mr[0];
            if (WHICH != 3) { const float* shift = mods + (size_t)(layer * 9 + mr_cur) * 6144 + (WHICH <= 1 ? 0 : 3) * 1024;
#pragma unroll
                for (int j = 0; j < 4; ++j) { shv[j] = ((const GAS f32x4*)shift)[lane + 64 * j]; scv[j] = ((const GAS f32x4*)(shift + 1024))[lane + 64 * j]; } }
            if (WHICH == 1 || WHICH == 3) { const float* m5 = mods + (size_t)((WHICH == 3 ? 3 : layer - 1) * 9 + mr_cur) * 6144 + 5 * 1024;
#pragma unroll
                for (int j = 0; j < 4; ++j) m5v[j] = ((const GAS f32x4*)m5)[lane + 64 * j]; }
#pragma unroll
            for (int j = 0; j < 4; ++j) asm volatile("" : "+v"(shv[j]), "+v"(scv[j]), "+v"(m5v[j]));
        }
        if (r0 + rstep < rend) NORM_LOAD(r0 + rstep, vn, slotn);
        if (WHICH == 1 || WHICH == 3) {
            const int pl = WHICH == 3 ? 3 : layer - 1;
            const float* gatev = (const float*)(ws + WS_GATE);
            const bf16_t* Y = (const bf16_t*)(ws + WS_B2);
#pragma unroll
            for (int q = 0; q < NRW; ++q) { if (slot[q] >= NSLOT) slot[q] = -1; }
            unsigned long long mskq[NRW]; int sl4[NRW][4]; u32x2 yv4[NRW][4][4];
#pragma unroll
            for (int q = 0; q < NRW; ++q) { mskq[q] = __ballot(slot[q] >= 0);
#pragma unroll
                for (int i = 0; i < 4; ++i) { sl4[q][i] = -1;
                    if (mskq[q]) { const int e = __builtin_ctzll(mskq[q]); mskq[q] &= mskq[q] - 1; sl4[q][i] = __builtin_amdgcn_readlane(slot[q], e); } } }
#pragma unroll
            for (int q = 0; q < NRW; ++q)
#pragma unroll
                for (int i = 0; i < 4; ++i) if (sl4[q][i] >= 0) { const bf16_t* yr = Y + (size_t)sl4[q][i] * 1024;
#pragma unroll
                    for (int j = 0; j < 4; ++j) yv4[q][i][j] = ((const GAS u32x2*)yr)[lane + 64 * j]; }
#pragma unroll
            for (int q = 0; q < NRW; ++q) {
                f32x4 acc[4];
#pragma unroll
                for (int j = 0; j < 4; ++j) acc[j] = (f32x4){0.f, 0.f, 0.f, 0.f};
#pragma unroll
                for (int i = 0; i < 4; ++i) if (sl4[q][i] >= 0) {
#pragma unroll
                    for (int j = 0; j < 4; ++j) { const u32x2 yv = yv4[q][i][j];
                        acc[j][0] += __uint_as_float(yv.x << 16); acc[j][1] += __uint_as_float(yv.x & 0xffff0000u); acc[j][2] += __uint_as_float(yv.y << 16); acc[j][3] += __uint_as_float(yv.y & 0xffff0000u); } }
                unsigned long long msk = mskq[q];
                while (msk) {
                    const int e = __builtin_ctzll(msk); msk &= msk - 1;
                    const int sl = __builtin_amdgcn_readlane(slot[q], e);
                    const bf16_t* yr = Y + (size_t)sl * 1024;
#pragma unroll
                    for (int j = 0; j < 4; ++j) { const u32x2 yv = ((const GAS u32x2*)yr)[lane + 64 * j];
                        acc[j][0] += __uint_as_float(yv.x << 16); acc[j][1] += __uint_as_float(yv.x & 0xffff0000u); acc[j][2] += __uint_as_float(yv.y << 16); acc[j][3] += __uint_as_float(yv.y & 0xffff0000u); }
                }
#pragma unroll
                for (int j = 0; j < 4; ++j) v[q][j] = v[q][j] + m5v[j] * acc[j];
            }
        }
        if (WHICH == 1) {
#pragma unroll
            for (int q = 0; q < NRW; ++q) { bf16_t* hb = (bf16_t*)(ws + WS_HB) + (size_t)row[q] * D;
#pragma unroll
                for (int j = 0; j < 4; ++j) ((GAS u32x2*)hb)[lane + 64 * j] = (u32x2){pg8::cvt_pk_bf16(v[q][j][0], v[q][j][1]), pg8::cvt_pk_bf16(v[q][j][2], v[q][j][3])}; }
        }
        if (WHICH == 3) {
#pragma unroll
            for (int q = 0; q < NRW; ++q) { const int b = row[q] / RPB, t = row[q] - b * RPB; float* orow = p.out + (size_t)(b * SEQ + t) * D;
#pragma unroll
                for (int j = 0; j < 4; ++j) ((GAS f32x4*)orow)[lane + 64 * j] = v[q][j]; }
        }
        if (WHICH == 3) continue;
        {
            float rs[NRW];
#pragma unroll
            for (int q = 0; q < NRW; ++q) {
                float ss = 0.f;
#pragma unroll
                for (int j = 0; j < 4; ++j) ss += v[q][j][0] * v[q][j][0] + v[q][j][1] * v[q][j][1] + v[q][j][2] * v[q][j][2] + v[q][j][3] * v[q][j][3];
                ss = wave_sum(ss);
                rs[q] = rsqrtf(ss * (1.f / 1024.f) + EPS);
            }
#pragma unroll
            for (int j = 0; j < 4; ++j) {
                const f32x4 sh = shv[j], sc = scv[j];
#pragma unroll
                for (int q = 0; q < NRW; ++q) {
                    v[q][j] = v[q][j] * rs[q] * sc + sh;
                    u32x2 o; o.x = pg8::cvt_pk_bf16(v[q][j][0], v[q][j][1]); o.y = pg8::cvt_pk_bf16(v[q][j][2], v[q][j][3]);
                    ((GAS u32x2*)((bf16_t*)(ws + WS_U) + (size_t)row[q] * 1024))[lane + 64 * j] = o;
                }
            }
        }
        if (WHICH == 2) {
#pragma unroll
            for (int q = 0; q < NRW; ++q) {
                LAS unsigned char* th = ut_hi + (wave * 2 + q) * UT_PITCH; LAS unsigned char* tl = ut_lo + (wave * 2 + q) * UT_PITCH;
#pragma unroll
                for (int j = 0; j < 4; ++j) {
                    const unsigned h01 = pg8::cvt_pk_bf16(v[q][j][0], v[q][j][1]), h23 = pg8::cvt_pk_bf16(v[q][j][2], v[q][j][3]);
                    const float l0 = v[q][j][0] - __uint_as_float(h01 << 16), l1 = v[q][j][1] - __uint_as_float(h01 & 0xffff0000u), l2 = v[q][j][2] - __uint_as_float(h23 << 16), l3 = v[q][j][3] - __uint_as_float(h23 & 0xffff0000u);
                    *(LAS u32x2*)(th + (lane + 64 * j) * 8) = (u32x2){h01, h23};
                    *(LAS u32x2*)(tl + (lane + 64 * j) * 8) = (u32x2){pg8::cvt_pk_bf16(l0, l1), pg8::cvt_pk_bf16(l2, l3)};
                }
            }
            __syncthreads();
            {
                const int fr = lane & 15, fq = lane >> 4;
                bf16x8 xh[4], xl[4];
#pragma unroll
                for (int ks = 0; ks < 4; ++ks) { xh[ks] = *(const LAS bf16x8*)(ut_hi + fr * UT_PITCH + (128 * wave + 32 * ks + 8 * fq) * 2); xl[ks] = *(const LAS bf16x8*)(ut_lo + fr * UT_PITCH + (128 * wave + 32 * ks + 8 * fq) * 2); }
                f32x4 pc = (f32x4){0.f, 0.f, 0.f, 0.f};
#pragma unroll
                for (int ks = 0; ks < 4; ++ks) { pc = __builtin_amdgcn_mfma_f32_16x16x32_bf16(wfh[ks], xh[ks], pc, 0, 0, 0); pc = __builtin_amdgcn_mfma_f32_16x16x32_bf16(wfl[ks], xh[ks], pc, 0, 0, 0); pc = __builtin_amdgcn_mfma_f32_16x16x32_bf16(wfh[ks], xl[ks], pc, 0, 0, 0); }
                *(LAS f32x4*)(rpart0 + (rstepi & 1) * 2048 + (wave * 16 + fr) * 16 + 4 * fq) = pc;
            }
            __syncthreads();
            if (tid < 256) {
                const int rr_ = tid >> 4, ee = tid & 15;
                float x = 0.f;
#pragma unroll
                for (int w8 = 0; w8 < 8; ++w8) x += rpart0[(rstepi & 1) * 2048 + (w8 * 16 + rr_) * 16 + ee];
                float mx = x; mx = fmaxf(mx, swz_xor<1>(mx)); mx = fmaxf(mx, swz_xor<2>(mx)); mx = fmaxf(mx, swz_xor<4>(mx)); mx = fmaxf(mx, swz_xor<8>(mx));
                const float ex = expf(x - mx);
                float sm = ex; sm += swz_xor<1>(sm); sm += swz_xor<2>(sm); sm += swz_xor<4>(sm); sm += swz_xor<8>(sm);
                int grow = (r0 - wave * NRW) + rr_;
                NORM_ROWMAP(grow);
                ((GAS float*)(ws + WS_AFF))[(size_t)grow * 16 + ee] = ex / sm;
            }
            ++rstepi;
        }
    }
    if (WHICH == 2) __syncthreads();
#undef NORM_ROWMAP
#undef NORM_LOAD
}

__device__ __forceinline__ void phase_qkprep(const P& p, int layer, int vcu, int G, const int wv_) {
    unsigned char* ws = p.ws; asm volatile("" : "+s"(ws));
    const int tid = (wv_ << 6) | hw_tid();
    const int lane = tid & 63, wave = wv_;
    const int li = layer >> 1;
    const float* tab = (const float*)(ws + WS_ROPE);
    for (int wid = vcu * NWAVES + wave; wid < NR * 26; wid += G * NWAVES) {
        const int row = wid / 26, hs = wid - row * 26;
        int col; const float* g; bool rope;
        if (hs < 8) { col = hs * 64; g = p.a_q_norm + li * 64; rope = true; }
        else if (hs < 10) { col = 512 + (hs - 8) * 64; g = p.a_k_norm + li * 64; rope = true; }
        else if (hs < 18) { col = 768 + (hs - 10) * 64; g = p.b_q_norm + li * 64; rope = false; }
        else { col = 1280 + (hs - 18) * 64; g = p.b_k_norm + li * 64; rope = false; }
        bf16_t* q = (bf16_t*)(ws + WS_B1) + (size_t)row * 2304 + col;
        const float x = bf2f(q[lane]);
        const float ss = wave_sum(x * x);
        float y = x * rsqrtf(ss * (1.f / 64.f) + EPS) * g[lane];
        const int b = row / RPB, t = row - b * RPB;
        if (rope && t < SEQ) {
            const int half = lane >> 5, j = lane & 31;
            const int pos = half == 0 ? (t >> 6) : (t & 63);
            const float cs = tab[pos * 16 + (j & 15)], sn = tab[1024 + pos * 16 + (j & 15)];
            const float other = swz_xor<16>(y);
            y = y * cs + (j < 16 ? -other : other) * sn;
        }
        if (hs < 8 || (hs >= 10 && hs < 18)) y *= 0.18033688011112042f;
        q[lane] = (bf16_t)f2bf(y);
    }
}

namespace attn_body {
using bf16=unsigned short;
using bf16x8=__attribute__((ext_vector_type(8)))short;
using s16x4=__attribute__((ext_vector_type(4)))short;
using f32x16=__attribute__((ext_vector_type(16)))float;
using u32x4=__attribute__((ext_vector_type(4)))unsigned;
constexpr int D=64;
constexpr int NW=8,QBLK=32,QB=QBLK*NW,KVBLK=64;
__device__ __forceinline__ int crow(int r,int hi){return (r&3)+8*(r>>2)+4*hi;}
#define SBAR() __builtin_amdgcn_sched_barrier(0)
#define CINIT (MODE==1?f32x16{}:negm)
struct NaArgs { int ctx_row0, win_row0, r0, wr0; };
constexpr int LDS_NAT_OFF = 86016;
__device__ __forceinline__ void na_mask(f32x16&p0,f32x16&p1,int j,const NaArgs&na,const char*shm,int wid,int r32,int hi,float mhat){
  const float NEG=-INFINITY;
  const int r=na.r0+(wid>>1), c=32*(wid&1)+r32;
  int rs=r-4; rs=rs<0?0:(rs>56?56:rs);
  int cs=c-8; cs=cs<0?0:(cs>48?48:cs);
  const int kr=na.wr0+j, di=kr-rs;
  if(di<0||di>=8){
    #pragma unroll
    for(int q=0;q<16;++q){p0[q]=NEG;p1[q]=NEG;}
  } else {
    const int dr=kr-r+7;
    const float*T=reinterpret_cast<const float*>(shm+LDS_NAT_OFF)+dr*128+63-c+4*hi;
    const int a=4*hi-cs;
    #pragma unroll
    for(int q=0;q<16;++q){ const int kc0=(q&3)+8*(q>>2);
      const float b0=T[kc0], b1=T[kc0+32];
      p0[q]=((unsigned)(a+kc0)<16u)?p0[q]+(b0-mhat):NEG; p1[q]=((unsigned)(a+kc0+32)<16u)?p1[q]+(b1-mhat):NEG;
      if((q&1)==1) SBAR(); }
  }
}
constexpr int NSLOT=3, SLOTB=8192;
constexpr int LDS_K=0, LDS_V=NSLOT*SLOTB, LDS_WS=2*NSLOT*SLOTB, LDS_OST=LDS_WS+NW*64*4, LDS_BYTES=LDS_OST+NW*4096;
constexpr float C2=0.125f*1.4426950408889634f;
__device__ __forceinline__ void glds16(const void*gsrc,unsigned lds_dst){unsigned keep;
  asm volatile("s_mov_b32 %0, m0\n\ts_mov_b32 m0, %2\n\ts_nop 0\n\tglobal_load_lds_dwordx4 %1, off\n\ts_mov_b32 m0, %0":"=&s"(keep):"v"(gsrc),"s"(lds_dst):"memory");}
__device__ __forceinline__ float max3f(float a,float b,float c){float r;asm("v_max3_f32 %0, %1, %2, %3":"=v"(r):"v"(a),"v"(b),"v"(c));return r;}
__device__ __forceinline__ float max2f(float a,float b){float r;asm("v_max_f32_e32 %0, %1, %2":"=v"(r):"v"(a),"v"(b));return r;}
__device__ __forceinline__ float fadd_s(float a,float b){float r;asm("v_add_f32_e32 %0, %1, %2":"=v"(r):"v"(a),"v"(b));return r;}
__device__ __forceinline__ float fsub_s(float a,float b){float r;asm("v_sub_f32_e32 %0, %1, %2":"=v"(r):"v"(a),"v"(b));return r;}
typedef float f32x2_t __attribute__((ext_vector_type(2))); typedef __bf16 bf16x2_t __attribute__((ext_vector_type(2)));
__device__ __forceinline__ unsigned cvtpk_s(float lo,float hi){f32x2_t v={lo,hi};bf16x2_t b=__builtin_convertvector(v,bf16x2_t);return __builtin_bit_cast(unsigned,b);}
#define WAIT_BAR(N) asm volatile("s_waitcnt vmcnt(" #N ") lgkmcnt(0)\n\ts_barrier":::"memory")

__device__ __forceinline__ void qkt(f32x16&p0,f32x16&p1,const char*Kslot,const bf16x8*qr,const f32x16&negm,int r32,int hi){
  const char*kb=Kslot+hi*1024+r32*16;
  #pragma unroll
  for(int d0=0;d0<4;++d0){
    const bf16x8 b0=*reinterpret_cast<const bf16x8*>(kb+d0*2048);
    const bf16x8 b1=*reinterpret_cast<const bf16x8*>(kb+d0*2048+512);
    if(d0==0){p0=__builtin_amdgcn_mfma_f32_32x32x16_bf16(b0,qr[0],negm,0,0,0);p1=__builtin_amdgcn_mfma_f32_32x32x16_bf16(b1,qr[0],negm,0,0,0);}
    else{p0=__builtin_amdgcn_mfma_f32_32x32x16_bf16(b0,qr[d0],p0,0,0,0);p1=__builtin_amdgcn_mfma_f32_32x32x16_bf16(b1,qr[d0],p1,0,0,0);}}
}
typedef __attribute__((address_space(3))) const char* lds_cptr;
typedef short v4i16_t __attribute__((ext_vector_type(4)));
__device__ __forceinline__ void kload8(bf16x8*kf,lds_cptr kp){
  kf[0]=*(const __attribute__((address_space(3))) bf16x8*)(kp);      kf[1]=*(const __attribute__((address_space(3))) bf16x8*)(kp+512);
  kf[2]=*(const __attribute__((address_space(3))) bf16x8*)(kp+2048); kf[3]=*(const __attribute__((address_space(3))) bf16x8*)(kp+2560);
  kf[4]=*(const __attribute__((address_space(3))) bf16x8*)(kp+4096); kf[5]=*(const __attribute__((address_space(3))) bf16x8*)(kp+4608);
  kf[6]=*(const __attribute__((address_space(3))) bf16x8*)(kp+6144); kf[7]=*(const __attribute__((address_space(3))) bf16x8*)(kp+6656);
}
__device__ __forceinline__ void kload2(bf16x8*kf,lds_cptr kp,int j){ kf[2*j]=*(const __attribute__((address_space(3))) bf16x8*)(kp+j*2048); kf[2*j+1]=*(const __attribute__((address_space(3))) bf16x8*)(kp+j*2048+512); }
__device__ __forceinline__ s16x4 vtr(lds_cptr p){ return __builtin_bit_cast(s16x4,__builtin_amdgcn_ds_read_tr16_b64_v4i16((__attribute__((address_space(3))) v4i16_t*)p)); }
__device__ __forceinline__ float rowmax(const f32x16&p0,const f32x16&p1){
  float a=max3f(p0[0],p0[1],p1[0]),b=max3f(p0[2],p0[3],p1[1]);a=max3f(a,p1[2],p1[3]);
  #pragma unroll
  for(int r=4;r<16;r+=4){a=max3f(a,p0[r],p0[r+1]);b=max3f(b,p0[r+2],p0[r+3]);a=max3f(a,p1[r],p1[r+1]);b=max3f(b,p1[r+2],p1[r+3]);}
  const float m=max2f(a,b);
  auto rr=__builtin_amdgcn_permlane32_swap(__float_as_uint(m),__float_as_uint(m),false,false);
  return max2f(__uint_as_float(rr[0]),__uint_as_float(rr[1]));
}
__device__ __forceinline__ void pv(f32x16*o,int vb,bf16x8 pa0,bf16x8 pa1,bf16x8 pa2,bf16x8 pa3){
  #pragma unroll
  for(int d0=0;d0<2;++d0){s16x4 lo[4],hi[4];
    #pragma unroll
    for(int ks=0;ks<4;++ks){
      asm volatile("ds_read_b64_tr_b16 %0,%1 offset:%c2":"=&v"(lo[ks]):"v"(vb),"i"(d0*4096+ks*1024):"memory");
      asm volatile("ds_read_b64_tr_b16 %0,%1 offset:%c2":"=&v"(hi[ks]):"v"(vb),"i"(d0*4096+ks*1024+512):"memory");}
    asm volatile("s_waitcnt lgkmcnt(0)":::"memory");SBAR();
    #define PK(k) (bf16x8){lo[k][0],lo[k][1],lo[k][2],lo[k][3],hi[k][0],hi[k][1],hi[k][2],hi[k][3]}
    o[d0]=__builtin_amdgcn_mfma_f32_32x32x16_bf16(pa0,PK(0),o[d0],0,0,0);
    o[d0]=__builtin_amdgcn_mfma_f32_32x32x16_bf16(pa1,PK(1),o[d0],0,0,0);
    o[d0]=__builtin_amdgcn_mfma_f32_32x32x16_bf16(pa2,PK(2),o[d0],0,0,0);
    o[d0]=__builtin_amdgcn_mfma_f32_32x32x16_bf16(pa3,PK(3),o[d0],0,0,0);
    #undef PK
  }
}

#ifndef ATTN_STORE16
#define ATTN_STORE16(p,v) (*(u32x4*)(p)=(v))
#endif
template<int THRL,int QP,int OP,int MODE> __device__ __forceinline__ void attn_unit(const bf16*Qu,const bf16*__restrict__ Kh,const bf16*__restrict__ Vh,bf16*Ou,const int NT,char*shm,const int wid,const int lane,const NaArgs na){
  const int r32=lane&31,hi=lane>>5;
  const bf16*Qw=Qu+(long)(wid*QBLK)*QP;
  const unsigned lds0=(unsigned)(uintptr_t)shm;
  float*wsf=(float*)(shm+LDS_WS)+wid*64;
  const bf16*ksrc=Kh+(long)lane*QP+wid*8;
  const bf16*vsrc=Vh+(long)(16*(wid&3)+(lane>>2))*QP+(wid>>2)*32+(lane&3)*8;
  const unsigned kdst=lds0+LDS_K+wid*1024, vdst=lds0+LDS_V+wid*1024;
  #define TROW(t) (MODE==0?(long)(t)*KVBLK:((t)<4?(long)na.ctx_row0+(long)(t)*KVBLK:(long)na.win_row0+(long)((t)-4)*KVBLK))
  #define DMA_K(t,slot) glds16(ksrc+TROW(t)*QP,(unsigned)__builtin_amdgcn_readfirstlane(kdst+(slot)))
  #define DMA_V(t,slot) glds16(vsrc+TROW(t)*QP,(unsigned)__builtin_amdgcn_readfirstlane(vdst+(slot)))
  const int vb0=(int)(lds0+LDS_V)+((lane>>4)&1)*32+(lane&3)*8+(4*hi+((lane&15)>>2))*64;
  const char*Kbase=shm+LDS_K; bf16x8 kf[8];
  const lds_cptr shm3=(lds_cptr)shm; const lds_cptr kp0=shm3+LDS_K+hi*1024+r32*16; const lds_cptr vp0=shm3+LDS_V+((lane>>4)&1)*32+(lane&3)*8+(4*hi+((lane&15)>>2))*64;
  DMA_K(0,0);DMA_V(0,0);DMA_K(1,SLOTB);
  bf16x8 qr[4];
  #pragma unroll
  for(int d0=0;d0<4;++d0)qr[d0]=*reinterpret_cast<const bf16x8*>(&Qw[(long)r32*QP+d0*16+hi*8]);
  float mhat=0.f,l_reg=0.f;f32x16 o[2],negm; { float z_=0.f; asm volatile("":"+v"(z_));
    _Pragma("unroll") for(int r=0;r<16;++r){o[0][r]=z_;o[1][r]=z_;negm[r]=z_;} } if(MODE==0)asm volatile("":"+v"(negm));
  #define CMASK(P0,P1,t) do{ if(MODE==1){ if((t)>=4) na_mask(P0,P1,(t)-4,na,shm,wid,r32,hi,mhat); else { _Pragma("unroll") for(int r_=0;r_<16;++r_){P0[r_]-=mhat;P1[r_]-=mhat;} } } }while(0)
  bool resc=false;
  #define START(P0,P1) do{ const float rm=rowmax(P0,P1); resc=false; \
    { const float dl=rm; mhat=fadd_s(mhat,dl); \
      _Pragma("unroll") for(int r=0;r<16;++r){P0[r]=fsub_s(P0[r],dl);P1[r]=fsub_s(P1[r],dl);} \
      if(MODE==0){ _Pragma("unroll") for(int r=0;r<16;++r)negm[r]=-mhat; asm volatile("":"+v"(negm)); } } \
    _Pragma("unroll") for(int r=0;r<16;++r)P0[r]=__builtin_amdgcn_exp2f(P0[r]); }while(0)
  #define RESC() do{ if(resc){ asm volatile("s_waitcnt lgkmcnt(0)":::"memory"); \
      _Pragma("unroll") for(int d_=0;d_<2;++d_) _Pragma("unroll") for(int r=0;r<16;++r)o[d_][r]*=wsf[crow(r,hi)]; } }while(0)
  f32x16 pA0,pA1,pB0,pB1;
  int sl_prev=0,sl_cur=0,sl_next=SLOTB;
  #define ROT() do{sl_prev=sl_cur;sl_cur=sl_next;sl_next=(sl_next==(NSLOT-1)*SLOTB)?0:sl_next+SLOTB;}while(0)
  DMA_K(2,2*SLOTB);
  WAIT_BAR(3);
  qkt(pA0,pA1,Kbase,qr,CINIT,r32,hi);asm volatile("s_nop 15\n\ts_nop 7":"+v"(pA0),"+v"(pA1));CMASK(pA0,pA1,0);
  START(pA0,pA1);
  _Pragma("unroll") for(int r=0;r<16;++r)pA1[r]=__builtin_amdgcn_exp2f(pA1[r]);
  WAIT_BAR(0);
  DMA_K(3,0);DMA_V(1,SLOTB);
  ROT();
  kload8(kf,kp0+sl_cur);
  WAIT_BAR(2);
  s16x4 vlo[8],vhi[8]; u32x4 pw0,pw1,pw2,pw3;
  #define PKW(P,B) cvtpk_s(P[B],P[B+1])
  #define PAF(k) __builtin_bit_cast(bf16x8,pw##k)
  #define VFR(i) (bf16x8){vlo[i][0],vlo[i][1],vlo[i][2],vlo[i][3],vhi[i][0],vhi[i][1],vhi[i][2],vhi[i][3]}
  #define PIN(x) asm volatile("":"+v"(x))
  #define MX3(a,b,c) __builtin_fmaxf(__builtin_fmaxf((a),(b)),(c))
  #define GAPA(MF,A0,A1,A2,A3,W0,W1,PW) do{ MF; sacc+=A0; sacc+=A1; sacc+=A2; sacc+=A3; PIN(sacc); W0; W1; PIN(PW); SBAR(); }while(0)
  #define EX(v) __builtin_amdgcn_exp2f(v)
  #define GAPB(MF,X,B) do{ MF; X[B]=EX(X[B]); X[B+1]=EX(X[B+1]); X[B+2]=EX(X[B+2]); X[B+3]=EX(X[B+3]); PIN(X); SBAR(); }while(0)
  #define VRD(i) do{ vlo[i]=vtr(vp_+(((i)>>2)*4096+((i)&3)*1024)); vhi[i]=vtr(vp_+(((i)>>2)*4096+((i)&3)*1024+512)); }while(0)
  #define KRD(G,j) do{ if(G){ kload2(kf,kp0+sl_next,j); SBAR(); } }while(0)
  #define STEP(C0,C1,P0,P1,t,GK,GV,GL) do{ SBAR(); \
    const lds_cptr vp_=vp0+sl_prev; \
    VRD(0); SBAR(); float sacc=(P0[0]+P0[1]); \
    GAPA(C0=__builtin_amdgcn_mfma_f32_32x32x16_bf16(kf[0],qr[0],CINIT,0,0,0), P0[2],P0[3],P0[4],P0[5],     pw0[0]=PKW(P0,0), pw0[1]=PKW(P0,2), pw0); \
    VRD(4); SBAR(); GAPA(C1=__builtin_amdgcn_mfma_f32_32x32x16_bf16(kf[1],qr[0],CINIT,0,0,0), P0[6],P0[7],P0[8],P0[9],     pw0[2]=PKW(P0,4), pw0[3]=PKW(P0,6), pw0); \
    VRD(1); SBAR(); GAPA(C0=__builtin_amdgcn_mfma_f32_32x32x16_bf16(kf[2],qr[1],C0,0,0,0),   P0[10],P0[11],P0[12],P0[13], pw1[0]=PKW(P0,8), pw1[1]=PKW(P0,10), pw1); \
    VRD(5); SBAR(); GAPA(C1=__builtin_amdgcn_mfma_f32_32x32x16_bf16(kf[3],qr[1],C1,0,0,0),   P0[14],P0[15],P1[0],P1[1],   pw1[2]=PKW(P0,12),pw1[3]=PKW(P0,14), pw1); \
    VRD(2); SBAR(); GAPA(C0=__builtin_amdgcn_mfma_f32_32x32x16_bf16(kf[4],qr[2],C0,0,0,0),   P1[2],P1[3],P1[4],P1[5],     pw2[0]=PKW(P1,0), pw2[1]=PKW(P1,2), pw2); \
    VRD(6); SBAR(); GAPA(C1=__builtin_amdgcn_mfma_f32_32x32x16_bf16(kf[5],qr[2],C1,0,0,0),   P1[6],P1[7],P1[8],P1[9],     pw2[2]=PKW(P1,4), pw2[3]=PKW(P1,6), pw2); \
    VRD(3); SBAR(); GAPA(C0=__builtin_amdgcn_mfma_f32_32x32x16_bf16(kf[6],qr[3],C0,0,0,0),   P1[10],P1[11],P1[12],P1[13], pw3[0]=PKW(P1,8), pw3[1]=PKW(P1,10), pw3); \
    VRD(7); SBAR(); GAPA(C1=__builtin_amdgcn_mfma_f32_32x32x16_bf16(kf[7],qr[3],C1,0,0,0),   P1[14],P1[15],0.f,0.f,       pw3[2]=PKW(P1,12),pw3[3]=PKW(P1,14), pw3); \
    l_reg+=sacc; \
    if(GK){DMA_K((t)+3,sl_cur);} if(GV){DMA_V((t)+1,sl_next);} \
    CMASK(C0,C1,t); \
    { float a=MX3(C0[0],C0[1],C1[0]),b=MX3(C0[2],C0[3],C1[1]); a=MX3(a,C1[2],C1[3]); \
      _Pragma("unroll") for(int r=4;r<16;r+=4){a=MX3(a,C0[r],C0[r+1]);b=MX3(b,C0[r+2],C0[r+3]);a=MX3(a,C1[r],C1[r+1]);b=MX3(b,C1[r+2],C1[r+3]);} \
      float rm=__builtin_fmaxf(a,b); { auto rr=__builtin_amdgcn_permlane32_swap(__float_as_uint(rm),__float_as_uint(rm),false,false); rm=__builtin_fmaxf(__uint_as_float(rr[0]),__uint_as_float(rr[1])); } \
      resc=false; \
      if(__builtin_expect(__any(rm>(float)THRL),0)){ const float dl=__builtin_fmaxf(rm,0.f); mhat+=dl; \
        _Pragma("unroll") for(int r=0;r<16;++r){C0[r]-=dl;C1[r]-=dl;} \
        if(MODE==0){ _Pragma("unroll") for(int r=0;r<16;++r)negm[r]=-mhat; asm volatile("":"+v"(negm)); } \
        const float f=__builtin_amdgcn_exp2f(-dl); l_reg*=f; if(hi==0)wsf[r32]=f; resc=true; } } \
    SBAR(); \
    GAPB(o[0]=__builtin_amdgcn_mfma_f32_32x32x16_bf16(PAF(0),VFR(0),o[0],0,0,0), C0,0); \
    GAPB(o[1]=__builtin_amdgcn_mfma_f32_32x32x16_bf16(PAF(0),VFR(4),o[1],0,0,0), C0,4); \
    KRD(GL,0); GAPB(o[0]=__builtin_amdgcn_mfma_f32_32x32x16_bf16(PAF(1),VFR(1),o[0],0,0,0), C0,8); \
    KRD(GL,1); GAPB(o[1]=__builtin_amdgcn_mfma_f32_32x32x16_bf16(PAF(1),VFR(5),o[1],0,0,0), C0,12); \
    KRD(GL,2); GAPB(o[0]=__builtin_amdgcn_mfma_f32_32x32x16_bf16(PAF(2),VFR(2),o[0],0,0,0), C1,0); \
    KRD(GL,3); GAPB(o[1]=__builtin_amdgcn_mfma_f32_32x32x16_bf16(PAF(2),VFR(6),o[1],0,0,0), C1,4); \
    GAPB(o[0]=__builtin_amdgcn_mfma_f32_32x32x16_bf16(PAF(3),VFR(3),o[0],0,0,0), C1,8); \
    GAPB(o[1]=__builtin_amdgcn_mfma_f32_32x32x16_bf16(PAF(3),VFR(7),o[1],0,0,0), C1,12); \
    }while(0)
  int t=1;
  for(;t+5<NT;t+=2){
    STEP(pB0,pB1,pA0,pA1,t,true,true,true);     WAIT_BAR(2); RESC(); ROT();
    STEP(pA0,pA1,pB0,pB1,t+1,true,true,true);   WAIT_BAR(2); RESC(); ROT();
  }
  #define ENDW(tt) do{ if((tt)+3<NT){WAIT_BAR(2);} else if((tt)+2<NT){WAIT_BAR(1);} else {WAIT_BAR(0);} }while(0)
  for(;t+1<NT;t+=2){
    STEP(pB0,pB1,pA0,pA1,t,(t+3<NT),(t+1<NT),(t+1<NT));       ENDW(t);   RESC(); ROT();
    STEP(pA0,pA1,pB0,pB1,t+1,(t+4<NT),(t+2<NT),(t+2<NT));     ENDW(t+1); RESC(); ROT();
  }
  STEP(pB0,pB1,pA0,pA1,NT-1,false,false,false); RESC();
  { float sacc=pB0[0]+pB0[1]; _Pragma("unroll") for(int r=2;r<16;++r)sacc+=pB0[r]; _Pragma("unroll") for(int r=0;r<16;++r)sacc+=pB1[r]; l_reg+=sacc;
    pw0=(u32x4){PKW(pB0,0),PKW(pB0,2),PKW(pB0,4),PKW(pB0,6)};pw1=(u32x4){PKW(pB0,8),PKW(pB0,10),PKW(pB0,12),PKW(pB0,14)};pw2=(u32x4){PKW(pB1,0),PKW(pB1,2),PKW(pB1,4),PKW(pB1,6)};pw3=(u32x4){PKW(pB1,8),PKW(pB1,10),PKW(pB1,12),PKW(pB1,14)};
    SBAR(); pv(o,vb0+sl_cur,PAF(0),PAF(1),PAF(2),PAF(3)); }
  #undef PKW
  #undef PAF
  #undef VFR
  #undef PIN
  #undef MX3
  #undef GAPA
  #undef GAPB
  #undef EX
  #undef VRD
  #undef KRD
  #undef STEP
  #undef ENDW
  {auto rr=__builtin_amdgcn_permlane32_swap(__float_as_uint(l_reg),__float_as_uint(l_reg),false,false);l_reg=__uint_as_float(rr[0])+__uint_as_float(rr[1]);}
  if(hi==0)wsf[32+r32]=l_reg;asm volatile("s_waitcnt lgkmcnt(0)":::"memory");
  float rli[16];
  #pragma unroll
  for(int r=0;r<16;++r)rli[r]=__builtin_amdgcn_rcpf(wsf[32+crow(r,hi)]);
  bf16*Ow=Ou+(long)(wid*QBLK)*OP;
  { bf16*stg=(bf16*)(shm+LDS_OST)+wid*2048;
    #pragma unroll
    for(int r=0;r<16;++r){const int orow=crow(r,hi);
      #pragma unroll
      for(int d0=0;d0<2;++d0)stg[orow*64+d0*32+r32]=(bf16)f2bf(o[d0][r]*rli[r]);}
    asm volatile("s_waitcnt lgkmcnt(0)":::"memory");
    #pragma unroll
    for(int i=0;i<4;++i){const int row=i*8+(lane>>3),ch=lane&7; const u32x4 v=*(const u32x4*)(stg+row*64+ch*8); ATTN_STORE16(Ow+(long)row*OP+ch*8,v);} }
  asm volatile("s_waitcnt lgkmcnt(0)\n\ts_barrier":::"memory");
  #undef DMA_K
  #undef DMA_V
  #undef TROW
  #undef CMASK
  #undef START
  #undef RESC
  #undef ROT
}
#undef SBAR
#undef WAIT_BAR
}

__device__ __forceinline__ void phase_attn_dense(const P& p, char* shm, int vcu, int G, const int wv_) {
    unsigned char* ws = p.ws; asm volatile("" : "+s"(ws));
    const int lane = hw_tid();
    const attn_body::bf16* QKV = (const attn_body::bf16*)(ws + WS_B1);
    attn_body::bf16* O = (attn_body::bf16*)(ws + WS_B2);
    const attn_body::NaArgs na{0, 0, 0, 0};
    for (int L = vcu; L < 1024 + 128; L += G) {
        size_t qo, ko, vo, oo; int ntile;
        if (L < 1024) {
            const int i = L >> 8, v = L & 255, xcd = v >> 5, j = v & 31;
            const int grp = 2 * xcd + (i >> 1), b = grp >> 1, kvh = grp & 1, u = (i & 1) * 32 + j, h = kvh * 4 + (u >> 4), qb = u & 15;
            const size_t rb = (size_t)b * RPB;
            qo = (rb + qb * 256) * 2304 + 64 * h; ko = rb * 2304 + 512 + 64 * kvh; vo = rb * 2304 + 640 + 64 * kvh; oo = (rb + qb * 256) * 1024 + 64 * h; ntile = 68;
        } else {
            const int u = L - 1024, typ = u >> 6, b = (u >> 3) & 7, h = u & 7;
            const size_t rc = (size_t)b * RPB + SEQ;
            const int qcol = typ ? 768 + 64 * h : 64 * h, kcol = typ ? 1280 + 64 * h : 512 + 64 * (h >> 2), vcol = typ ? 1792 + 64 * h : 640 + 64 * (h >> 2), ocol = typ ? 512 + 64 * h : 64 * h;
            qo = rc * 2304 + qcol; ko = rc * 2304 + kcol; vo = rc * 2304 + vcol; oo = rc * 1024 + ocol; ntile = 4;
        }
        attn_body::attn_unit<8, 2304, 1024, 0>(QKV + qo, QKV + ko, QKV + vo, O + oo, ntile, shm, wv_, lane, na);
    }
}

__device__ __forceinline__ void phase_attn_na(const P& p, int layer, char* shm, int vcu, int G, const int wv_) {
    unsigned char* ws = p.ws; asm volatile("" : "+s"(ws));
    const int lane = hw_tid(), tid = (wv_ << 6) | lane;
    const attn_body::bf16* QKV = (const attn_body::bf16*)(ws + WS_B1);
    attn_body::bf16* O = (attn_body::bf16*)(ws + WS_B2);
    float* T = (float*)(shm + attn_body::LDS_NAT_OFF);
    for (int L = vcu; L < 1024; L += G) {
        const int i = L >> 8, v = L & 255, xcd = v >> 5, j = v & 31;
        const int grp = (i * 8 + xcd) * 2 + (j >> 4), rblk = j & 15, b = grp >> 3, h = grp & 7;
        const float* rpb = p.na_rpb + (size_t)((layer >> 1) * 8 + h) * 15 * 31;
        for (int e = tid; e < 15 * 128; e += NTHR) { const int dr = e >> 7, d = (e & 127) - 63; T[e] = (d >= -15 && d <= 15) ? rpb[dr * 31 + d + 15] * 1.4426950408889634f : -INFINITY; }
        const int r0 = rblk * 4; int wr0 = r0 - 4; wr0 = wr0 < 0 ? 0 : (wr0 > 52 ? 52 : wr0);
        const size_t rb = (size_t)b * RPB;
        const attn_body::NaArgs na{SEQ, wr0 * 64, r0, wr0};
        attn_body::attn_unit<8, 2304, 1024, 1>(QKV + (rb + r0 * 64) * 2304 + 768 + 64 * h, QKV + rb * 2304 + 1280 + 64 * h, QKV + rb * 2304 + 1792 + 64 * h, O + (rb + r0 * 64) * 1024 + 512 + 64 * h, 16, shm, wv_, lane, na);
    }
}

__device__ __forceinline__ int gla_o256(int row, int ch) { return row * 256 + ((ch ^ (row & 15)) << 4); }
__device__ __forceinline__ int gla_o128(int row, int ch) { return (row >> 1) * 256 + (((((row & 1) << 3) | ch) ^ ((row >> 1) & 7)) << 4); }
__device__ __forceinline__ int gla_task(int b, int h, int dir, int s) { return ((b * 4 + h) * 2 + dir) * 68 + s; }
__device__ __forceinline__ int gla_rowc(int b, int dir, int s) { return b * RPB + (s < 4 ? SEQ + 64 * (dir ? 3 - s : s) : 64 * (dir ? 67 - s : s - 4)); }

__device__ __forceinline__ void phase_gla_pre(const P& p, int layer, LAS unsigned char* lds, int vcu, int G, const int wv_) {
    unsigned char* ws = p.ws; asm volatile("" : "+s"(ws));
    const int lane = hw_tid(), tid = (wv_ << 6) | lane, fr = lane & 15, fq = lane >> 4;
    constexpr int L_QD = 0, L_KI = 16384, L_KST = 32768, L_A = 49152, L_SB = 57344, SB_BYTES = 36864, SB_K = 16384, SB_Z = 32768, L_CL = RING_BYTES + 8192;
    static_assert(L_SB + 2 * SB_BYTES <= RING_BYTES && L_CL + 512 <= LDS_BYTES, "gla pre LDS map");
    LAS unsigned char* qd = lds + L_QD; LAS unsigned char* ki = lds + L_KI; LAS unsigned char* ksT = lds + L_KST; LAS unsigned char* Al = lds + L_A;
    LAS float* cls = (LAS float*)(lds + L_CL);
    const unsigned lds0 = (unsigned)(size_t)lds;
    const int li = layer >> 1;
    const bf16_t* X = (const bf16_t*)(ws + WS_B1);
    const float* Z = (const float*)(ws + WS_Z);
    const int pd = 16 * wv_ + fr;
#define GLAP_TASK(i_, bhd_, s_) const int bhd_ = ((i_) & 255) >> 2, s_ = 17 * ((i_) & 3) + ((i_) >> 8)
#define GLAP_DMA(i_, buf_) do { GLAP_TASK((i_), bhd__, s__); const int dir__ = bhd__ & 1, h__ = (bhd__ >> 1) & 3, b__ = bhd__ >> 3; const int rc_ = gla_rowc(b__, dir__, s__); \
        const unsigned sb_ = lds0 + L_SB + (unsigned)(buf_) * SB_BYTES; \
        _Pragma("unroll") for (int jj = 0; jj < 4; ++jj) { const int j = 4 * wv_ + jj;        \
            pg8::glds16_s((const char*)(X + (size_t)(rc_ + 4 * (j & 15)) * 3072 + h__ * 128 + (j >> 4) * 512), (unsigned)((lane >> 4) * 6144 + (((lane & 15) ^ (2 * (j & 3))) << 4)), sb_ + (unsigned)j * 1024u); } \
        if (wv_ < 4) pg8::glds16_s((const char*)(Z + (size_t)(rc_ + 16 * wv_) * 32 + dir__ * 16), (unsigned)((lane >> 2) * 128 + (lane & 3) * 16), sb_ + SB_Z + (unsigned)wv_ * 1024u); } while (0)
    int ti = vcu, kk_ = 0;
    if (ti < 4352) GLAP_DMA(ti, 0);
    int bhd_cur = -1; bf16x8 wx1 = (bf16x8){0, 0, 0, 0, 0, 0, 0, 0}, wx2 = wx1; float gbias = 0.f;
    for (; ti < 4352; ti += G, ++kk_) {
        GLAP_TASK(ti, bhd, s_chunk);
        const int dir = bhd & 1, h = (bhd >> 1) & 3, t = bhd * 68 + s_chunk;
        if (bhd != bhd_cur) {
            bhd_cur = bhd;
            const float* gw = (dir ? p.gk_w_b : p.gk_w_f) + (size_t)li * 16 * 512 + h * 128 + pd + (size_t)(8 * (fq & 1)) * 512;
            float wv8[8];
#pragma unroll
            for (int e = 0; e < 8; ++e) wv8[e] = gw[e * 512];
            gbias = ((dir ? p.gk_b_b : p.gk_b_f) + li * 512)[h * 128 + pd];
            unsigned hh[4], ll[4];
#pragma unroll
            for (int e = 0; e < 4; ++e) { hh[e] = pg8::cvt_pk_bf16(wv8[2 * e], wv8[2 * e + 1]);
                ll[e] = pg8::cvt_pk_bf16(wv8[2 * e] - __uint_as_float(hh[e] << 16), wv8[2 * e + 1] - __uint_as_float(hh[e] & 0xffff0000u)); if (fq >= 2) ll[e] = 0u; }
            wx1 = __builtin_bit_cast(bf16x8, (u32x4){hh[0], hh[1], hh[2], hh[3]}); wx2 = __builtin_bit_cast(bf16x8, (u32x4){ll[0], ll[1], ll[2], ll[3]});
        }
        if (kk_ == 0) asm volatile("s_waitcnt vmcnt(0)" ::: "memory"); else asm volatile("s_waitcnt vmcnt(5)" ::: "memory");
        __syncthreads();
        if (ti + G < 4352) GLAP_DMA(ti + G, (kk_ + 1) & 1);
        LAS unsigned char* sb = lds + L_SB + (kk_ & 1) * SB_BYTES;
        {
            float c[16];
#pragma unroll
            for (int T = 0; T < 4; ++T) {
                const LAS f32x4* zp = (const LAS f32x4*)(sb + SB_Z + (16 * T + fr) * 64 + (fq & 1) * 32);
                const f32x4 za = zp[0], zb = zp[1];
                unsigned zy[4];
#pragma unroll
                for (int e = 0; e < 4; ++e) { const float z0 = e < 2 ? za[2 * e] : zb[2 * e - 4], z1 = e < 2 ? za[2 * e + 1] : zb[2 * e - 3];
                    const unsigned hz = pg8::cvt_pk_bf16(z0, z1), lz = pg8::cvt_pk_bf16(z0 - __uint_as_float(hz << 16), z1 - __uint_as_float(hz & 0xffff0000u)); zy[e] = fq < 2 ? hz : lz; }
                const bf16x8 zf = __builtin_bit_cast(bf16x8, (u32x4){zy[0], zy[1], zy[2], zy[3]});
                f32x4 xa = (f32x4){gbias, gbias, gbias, gbias};
                xa = __builtin_amdgcn_mfma_f32_16x16x32_bf16(zf, wx1, xa, 0, 0, 0);
                xa = __builtin_amdgcn_mfma_f32_16x16x32_bf16(zf, wx2, xa, 0, 0, 0);
#pragma unroll
                for (int i = 0; i < 4; ++i) { const float x = xa[i];
                    const float l = __builtin_amdgcn_logf(1.f + __builtin_amdgcn_exp2f(-fabsf(x) * 1.4426950408889634f));
                    c[4 * T + i] = (fminf(x, 0.f) * 1.4426950408889634f - l) * (1.f / 16.f); }
            }
            float cl = 0.f;
            if (dir == 0) {
#pragma unroll
                for (int T = 0; T < 4; ++T) {
                    c[4 * T + 1] += c[4 * T]; c[4 * T + 2] += c[4 * T + 1]; c[4 * T + 3] += c[4 * T + 2];
                    const float R = c[4 * T + 3];
                    const float p1 = swz_xor<16>(R), pair = R + p1;
                    auto rr = __builtin_amdgcn_permlane32_swap(__float_as_uint(pair), __float_as_uint(pair), false, false);
                    const float q = __uint_as_float(fq >= 2 ? rr[0] : rr[1]);
                    const float ex = ((fq & 1) ? p1 : 0.f) + ((fq & 2) ? q : 0.f) + cl;
#pragma unroll
                    for (int i = 0; i < 4; ++i) c[4 * T + i] += ex;
                    cl += pair + q;
                }
            } else {
#pragma unroll
                for (int T = 3; T >= 0; --T) {
                    c[4 * T + 2] += c[4 * T + 3]; c[4 * T + 1] += c[4 * T + 2]; c[4 * T] += c[4 * T + 1];
                    const float R = c[4 * T];
                    const float p1 = swz_xor<16>(R), pair = R + p1;
                    auto rr = __builtin_amdgcn_permlane32_swap(__float_as_uint(pair), __float_as_uint(pair), false, false);
                    const float q = __uint_as_float(fq >= 2 ? rr[0] : rr[1]);
                    const float ex = ((fq & 1) ? 0.f : p1) + ((fq & 2) ? 0.f : q) + cl;
#pragma unroll
                    for (int i = 0; i < 4; ++i) c[4 * T + i] += ex;
                    cl += pair + q;
                }
            }
            if (fq == 0) cls[pd] = cl;
            const float qs = 0.08838834764831845f, ecl = __builtin_amdgcn_exp2f(cl);
            const int dch = pd >> 3, dlo = (pd & 7) * 2;
            const LAS unsigned char* qsrc = sb + fq * 1024 + ((dch ^ (2 * fq)) << 4) + dlo;
#pragma unroll
            for (int T = 0; T < 4; ++T) {
                unsigned kw[2];
#pragma unroll
                for (int i = 0; i < 4; i += 2) {
                    const int n = 4 * T + i;
                    const float c0 = c[n], c1 = c[n + 1];
                    const float e0 = __builtin_amdgcn_exp2f(c0), e1 = __builtin_amdgcn_exp2f(c1);
                    const float r0 = __builtin_amdgcn_rcpf(e0), r1 = __builtin_amdgcn_rcpf(e1);
                    const float q0 = bf2f(*(const LAS bf16_t*)(qsrc + 4096 * T + 256 * i)), q1 = bf2f(*(const LAS bf16_t*)(qsrc + 4096 * T + 256 * (i + 1)));
                    const float k0 = bf2f(*(const LAS bf16_t*)(qsrc + SB_K + 4096 * T + 256 * i)), k1 = bf2f(*(const LAS bf16_t*)(qsrc + SB_K + 4096 * T + 256 * (i + 1)));
                    const int tk0 = 16 * T + 4 * fq + i;
                    const unsigned qq = pg8::cvt_pk_bf16(q0 * qs * e0, q1 * qs * e1), kk2 = pg8::cvt_pk_bf16(k0 * r0, k1 * r1);
                    *(LAS bf16_t*)(qd + gla_o256(tk0, dch) + dlo) = (bf16_t)(qq & 0xffffu); *(LAS bf16_t*)(qd + gla_o256(tk0 + 1, dch) + dlo) = (bf16_t)(qq >> 16);
                    *(LAS bf16_t*)(ki + gla_o256(tk0, dch) + dlo) = (bf16_t)(kk2 & 0xffffu); *(LAS bf16_t*)(ki + gla_o256(tk0 + 1, dch) + dlo) = (bf16_t)(kk2 >> 16);
                    kw[i >> 1] = pg8::cvt_pk_bf16(k0 * (ecl * r0), k1 * (ecl * r1));
                }
                *(LAS u32x2*)(ksT + gla_o128(pd, 2 * T + (fq >> 1)) + (fq & 1) * 8) = (u32x2){kw[0], kw[1]};
            }
        }
        __syncthreads();
        {
            const int it = wv_ >> 1;
            f32x4 a2[2] = {(f32x4){0.f, 0.f, 0.f, 0.f}, (f32x4){0.f, 0.f, 0.f, 0.f}};
#pragma unroll
            for (int kk = 0; kk < 4; ++kk) {
                const bf16x8 xa = *(const LAS bf16x8*)(qd + gla_o256(16 * it + fr, 4 * kk + fq));
#pragma unroll
                for (int jj = 0; jj < 2; ++jj) { const int jt = 2 * (wv_ & 1) + jj;
                    const bf16x8 yb = *(const LAS bf16x8*)(ki + gla_o256(16 * jt + fr, 4 * kk + fq));
                    a2[jj] = __builtin_amdgcn_mfma_f32_16x16x32_bf16(yb, xa, a2[jj], 0, 0, 0); }
            }
#pragma unroll
            for (int jj = 0; jj < 2; ++jj) { const int jt = 2 * (wv_ & 1) + jj; const int i = 16 * it + fr, j0 = 16 * jt + 4 * fq;
                float m4[4];
#pragma unroll
                for (int cc = 0; cc < 4; ++cc) { const int j = j0 + cc; const bool keep = dir ? (j >= i) : (j <= i); m4[cc] = keep ? a2[jj][cc] : 0.f; }
                *(LAS u32x2*)(Al + gla_o128(i, j0 >> 3) + (j0 & 7) * 2) = (u32x2){pg8::cvt_pk_bf16(m4[0], m4[1]), pg8::cvt_pk_bf16(m4[2], m4[3])}; }
        }
        __syncthreads();
        {
            GAS u32x4* gq = (GAS u32x4*)(ws + WS_GQD + (size_t)t * 16384); GAS u32x4* gk = (GAS u32x4*)(ws + WS_GKS + (size_t)t * 16384); GAS u32x4* ga = (GAS u32x4*)(ws + WS_GA + (size_t)t * 8192); GAS u32x4* gc = (GAS u32x4*)(ws + WS_GCL + (size_t)t * 512);
            gq[tid] = *(const LAS u32x4*)(qd + tid * 16); gq[tid + 512] = *(const LAS u32x4*)(qd + (tid + 512) * 16);
            gk[tid] = *(const LAS u32x4*)(ksT + tid * 16); gk[tid + 512] = *(const LAS u32x4*)(ksT + (tid + 512) * 16);
            ga[tid] = *(const LAS u32x4*)(Al + tid * 16);
            if (tid < 32) gc[tid] = *(const LAS u32x4*)((LAS unsigned char*)cls + tid * 16);
        }
        __syncthreads();
    }
    asm volatile("s_waitcnt vmcnt(0)" ::: "memory");
#undef GLAP_DMA
#undef GLAP_TASK
}

__device__ __forceinline__ void phase_gla_scan(const P& p, int layer, LAS unsigned char* lds, int vcu, int G, const int wv_) {
    unsigned char* ws = p.ws; asm volatile("" : "+s"(ws));
    const int lane = hw_tid(), tid = (wv_ << 6) | lane, fr = lane & 15, fq = lane >> 4;
    constexpr int B_QD = 0, B_KST = 16384, B_A = 32768, B_V = 40960, B_CL = 49152, BUF = 50176, L_ST = 2 * BUF;
    static_assert(L_ST + 16384 <= RING_BYTES, "gla scan LDS map");
    LAS unsigned char* ST = lds + L_ST;
    const unsigned lds0 = (unsigned)(size_t)lds;
    const bf16_t* X = (const bf16_t*)(ws + WS_B1);
    for (int u = vcu; u < 256; u += G) {
        const int b = u >> 5, h = (u >> 3) & 3, dir = (u >> 2) & 1, sl = u & 3;
        bf16_t* O = (bf16_t*)(ws + WS_B2) + (dir ? (size_t)68 * MiB / 2 : 0);
        const int tk0 = gla_task(b, h, dir, 0);
        f32x4 sacc[4];
#pragma unroll
        for (int et = 0; et < 4; ++et) sacc[et] = (f32x4){0.f, 0.f, 0.f, 0.f};
        for (int e = tid; e < 4096; e += NTHR) ((LAS unsigned*)ST)[e] = 0u;
#define GLAS_DMA(s_) do { const int s__ = (s_); const unsigned bo_ = lds0 + (unsigned)((s__ & 1) * BUF); const size_t tk_ = (size_t)(tk0 + s__); const unsigned lo_ = (unsigned)lane * 16u; \
            pg8::glds16_s((const char*)(ws + WS_GQD) + tk_ * 16384 + (2 * wv_) * 1024, lo_, bo_ + B_QD + (2 * wv_) * 1024); pg8::glds16_s((const char*)(ws + WS_GQD) + tk_ * 16384 + (2 * wv_ + 1) * 1024, lo_, bo_ + B_QD + (2 * wv_ + 1) * 1024); \
            pg8::glds16_s((const char*)(ws + WS_GKS) + tk_ * 16384 + (2 * wv_) * 1024, lo_, bo_ + B_KST + (2 * wv_) * 1024); pg8::glds16_s((const char*)(ws + WS_GKS) + tk_ * 16384 + (2 * wv_ + 1) * 1024, lo_, bo_ + B_KST + (2 * wv_ + 1) * 1024); \
            pg8::glds16_s((const char*)(ws + WS_GA) + tk_ * 8192 + wv_ * 1024, lo_, bo_ + B_A + wv_ * 1024); \
            pg8::glds16_s((const char*)(X + (size_t)(gla_rowc(b, dir, s__) + 8 * wv_) * 3072 + 1024 + h * 256 + sl * 64), (unsigned)((lane >> 3) * 6144 + (((lane & 7) ^ (2 * (((lane >> 4) & 1) | ((wv_ & 1) << 1)))) << 4)), bo_ + B_V + wv_ * 1024); \
            if (wv_ == 0 && lane < 32) pg8::glds16_s((const char*)(ws + WS_GCL) + tk_ * 512, lo_, bo_ + B_CL); } while (0)
        GLAS_DMA(0); GLAS_DMA(1);
        __syncthreads();
#pragma unroll 1
        for (int s = 0; s < 68; ++s) {
            LAS unsigned char* bq = lds + (s & 1) * BUF;
            const int rowc = gla_rowc(b, dir, s);
            if (s == 0) asm volatile("s_waitcnt vmcnt(6)" ::: "memory");
            else if (s == 1) { if (wv_ == 0) asm volatile("s_waitcnt vmcnt(9)" ::: "memory"); else asm volatile("s_waitcnt vmcnt(8)" ::: "memory"); }
            else if (s + 1 < 68) { if (wv_ == 0) asm volatile("s_waitcnt vmcnt(11)" ::: "memory"); else asm volatile("s_waitcnt vmcnt(10)" ::: "memory"); }
            else asm volatile("s_waitcnt vmcnt(4)" ::: "memory");
            __syncthreads();
            {
                const int it = wv_ >> 1, e0 = 2 * (wv_ & 1);
                bf16x8 fa[2], fq4[4], fv[2][4], fs[4][2], fk[2];
                typedef short s4v __attribute__((ext_vector_type(4)));
                const int tq = fr >> 2, tp = fr & 3, fx = ((tq >> 1) & 1) | ((fq & 1) << 1);
                LAS unsigned char* vb = bq + B_V + (8 * fq + tq) * 128 + tp * 8;
#pragma unroll
                for (int kk = 0; kk < 2; ++kk) { fa[kk] = *(const LAS bf16x8*)(bq + B_A + gla_o128(16 * it + fr, 4 * kk + fq)); fk[kk] = *(const LAS bf16x8*)(bq + B_KST + gla_o128(16 * wv_ + fr, 4 * kk + fq));
#pragma unroll
                    for (int et = 0; et < 4; ++et) { LAS unsigned char* va = vb + kk * 4096 + ((et ^ fx) << 5);
                        const s4v lo4 = __builtin_amdgcn_ds_read_tr16_b64_v4i16((LAS s4v*)va), hi4 = __builtin_amdgcn_ds_read_tr16_b64_v4i16((LAS s4v*)(va + 512));
                        fv[kk][et] = __builtin_shufflevector(lo4, hi4, 0, 1, 2, 3, 4, 5, 6, 7); }
 }
#pragma unroll
                for (int kk = 0; kk < 4; ++kk) { fq4[kk] = *(const LAS bf16x8*)(bq + B_QD + gla_o256(16 * it + fr, 4 * kk + fq));
#pragma unroll
                    for (int jj = 0; jj < 2; ++jj) fs[kk][jj] = *(const LAS bf16x8*)(ST + gla_o256(16 * (e0 + jj) + fr, 4 * kk + fq)); }
                const f32x4 clv = *(const LAS f32x4*)(bq + B_CL + (16 * wv_ + 4 * fq) * 4);
                asm volatile("s_waitcnt lgkmcnt(0)" ::: "memory");
                __syncthreads();
                if (s + 2 < 68) GLAS_DMA(s + 2);
                f32x4 o2[2] = {(f32x4){0.f, 0.f, 0.f, 0.f}, (f32x4){0.f, 0.f, 0.f, 0.f}};
                if (wv_ & 1) {
#pragma unroll
                    for (int kk = 0; kk < 2; ++kk)
#pragma unroll
                        for (int jj = 0; jj < 2; ++jj) o2[jj] = __builtin_amdgcn_mfma_f32_16x16x32_bf16(fv[kk][2 + jj], fa[kk], o2[jj], 0, 0, 0);
                } else {
#pragma unroll
                    for (int kk = 0; kk < 2; ++kk)
#pragma unroll
                        for (int jj = 0; jj < 2; ++jj) o2[jj] = __builtin_amdgcn_mfma_f32_16x16x32_bf16(fv[kk][jj], fa[kk], o2[jj], 0, 0, 0);
                }
#pragma unroll
                for (int kk = 0; kk < 4; ++kk)
#pragma unroll
                    for (int jj = 0; jj < 2; ++jj) o2[jj] = __builtin_amdgcn_mfma_f32_16x16x32_bf16(fs[kk][jj], fq4[kk], o2[jj], 0, 0, 0);
                const f32x4 dec = (f32x4){__builtin_amdgcn_exp2f(clv[0]), __builtin_amdgcn_exp2f(clv[1]), __builtin_amdgcn_exp2f(clv[2]), __builtin_amdgcn_exp2f(clv[3])};
#pragma unroll
                for (int et = 0; et < 4; ++et) sacc[et] = sacc[et] * dec;
#pragma unroll
                for (int kk = 0; kk < 2; ++kk)
#pragma unroll
                    for (int et = 0; et < 4; ++et) sacc[et] = __builtin_amdgcn_mfma_f32_16x16x32_bf16(fk[kk], fv[kk][et], sacc[et], 0, 0, 0);
#pragma unroll
                for (int jj = 0; jj < 2; ++jj) { const int et = e0 + jj;
                    *(GAS u32x2*)(O + (size_t)(rowc + 16 * it + fr) * 1024 + h * 256 + sl * 64 + 16 * et + 4 * fq) = (u32x2){pg8::cvt_pk_bf16(o2[jj][0], o2[jj][1]), pg8::cvt_pk_bf16(o2[jj][2], o2[jj][3])}; }
            }
#pragma unroll
            for (int et = 0; et < 4; ++et) { const int d0 = 16 * wv_ + 4 * fq; *(LAS u32x2*)(ST + gla_o256(16 * et + fr, d0 >> 3) + (d0 & 7) * 2) = (u32x2){pg8::cvt_pk_bf16(sacc[et][0], sacc[et][1]), pg8::cvt_pk_bf16(sacc[et][2], sacc[et][3])}; }
        }
        __syncthreads();
#undef GLAS_DMA
    }
}

__device__ __forceinline__ void phase_gla_merge(const P& p, int layer, int vcu, int G, const int wv_) {
    unsigned char* ws = p.ws; asm volatile("" : "+s"(ws));
    const int lane = hw_tid(), wave = wv_;
    constexpr int NRW = 4;
    const bf16_t* OF = (const bf16_t*)(ws + WS_B2); const bf16_t* OB = OF + (size_t)68 * MiB / 2; bf16_t* O = (bf16_t*)(ws + WS_B2);
    const bf16_t* X = (const bf16_t*)(ws + WS_B1);
    const f32x4 gn = *(const f32x4*)(p.gla_o_norm + (layer >> 1) * 256 + lane * 4);
    for (int r0 = (vcu * NWAVES + wave) * NRW; r0 < NR; r0 += G * NWAVES * NRW) {
        u32x2 a[NRW][4], bb[NRW][4], og[NRW][4];
#pragma unroll
        for (int q = 0; q < NRW; ++q)
#pragma unroll
            for (int h = 0; h < 4; ++h) { const size_t i0 = (size_t)(r0 + q) * 1024 + h * 256 + lane * 4;
                a[q][h] = *(const u32x2*)(OF + i0); bb[q][h] = *(const u32x2*)(OB + i0); og[q][h] = *(const u32x2*)(X + (size_t)(r0 + q) * 3072 + 2048 + h * 256 + lane * 4); }
#pragma unroll
        for (int q = 0; q < NRW; ++q)
#pragma unroll
            for (int h = 0; h < 4; ++h) {
                float x[4];
                x[0] = __uint_as_float(a[q][h].x << 16) + __uint_as_float(bb[q][h].x << 16); x[1] = __uint_as_float(a[q][h].x & 0xffff0000u) + __uint_as_float(bb[q][h].x & 0xffff0000u);
                x[2] = __uint_as_float(a[q][h].y << 16) + __uint_as_float(bb[q][h].y << 16); x[3] = __uint_as_float(a[q][h].y & 0xffff0000u) + __uint_as_float(bb[q][h].y & 0xffff0000u);
                const float ss = wave_sum((x[0] * x[0] + x[1] * x[1]) + (x[2] * x[2] + x[3] * x[3]));
                const float rs = rsqrtf(ss * (1.f / 256.f) + EPS);
                const float ogf[4] = {__uint_as_float(og[q][h].x << 16), __uint_as_float(og[q][h].x & 0xffff0000u), __uint_as_float(og[q][h].y << 16), __uint_as_float(og[q][h].y & 0xffff0000u)};
                float r[4];
#pragma unroll
                for (int j = 0; j < 4; ++j) r[j] = x[j] * rs * gn[j] * silu_f(ogf[j]);
                *(u32x2*)(O + (size_t)(r0 + q) * 1024 + h * 256 + lane * 4) = (u32x2){pk2(r[0], r[1]), pk2(r[2], r[3])};
            }
    }
}

__device__ __forceinline__ int wave_sum_i(int v) {
    v += __builtin_amdgcn_ds_swizzle(v, (1 << 10) | 0x1f); v += __builtin_amdgcn_ds_swizzle(v, (2 << 10) | 0x1f); v += __builtin_amdgcn_ds_swizzle(v, (4 << 10) | 0x1f);
    v += __builtin_amdgcn_ds_swizzle(v, (8 << 10) | 0x1f); v += __builtin_amdgcn_ds_swizzle(v, (16 << 10) | 0x1f);
    auto rr = __builtin_amdgcn_permlane32_swap((unsigned)v, (unsigned)v, false, false);
    return (int)(rr[0] + rr[1]);
}
__device__ __forceinline__ void phase_topk(const P& p, LAS unsigned char* lds, int vcu, int G, const int wv_, const int nunits) {
    unsigned char* ws = p.ws; asm volatile("" : "+s"(ws));
    const int lane = hw_tid(), tid = (wv_ << 6) | lane;
    LAS int* red = (LAS int*)lds;
    const float* aff = (const float*)(ws + WS_AFF);
    int* idx = (int*)(ws + WS_IDX); float* gatev = (float*)(ws + WS_GATE); int* pos = (int*)(ws + WS_POS);
    for (int u = vcu; u < nunits; u += G) {
        const int s = u >> 4, e = u & 15, b = s & 7;
        const int n = s < 8 ? SEQ : CTXL, cap = n / 8;
        const int row0 = b * RPB + (s < 8 ? 0 : SEQ);
        unsigned key[8];
#pragma unroll
        for (int k = 0; k < 8; ++k) { const int i = tid * 8 + k; key[k] = i < n ? (__float_as_uint(aff[(size_t)(row0 + i) * 16 + e]) | 0x80000000u) : 0u; }
        unsigned T = 0u;
#pragma unroll 1
        for (int lo = 30; lo >= 0; lo -= 2) {
            const unsigned c1 = T | (1u << lo), c2 = T | (2u << lo), c3 = T | (3u << lo);
            int c = 0;
#pragma unroll
            for (int k = 0; k < 8; ++k) c += (key[k] >= c1 ? 1 : 0) + (key[k] >= c2 ? (1 << 10) : 0) + (key[k] >= c3 ? (1 << 20) : 0);
            c = wave_sum_i(c);
            LAS int* rb = red + ((lo >> 1) & 1) * 8;
            if (lane == 0) rb[wv_] = c;
            __syncthreads();
            int t1 = 0, t2 = 0, t3 = 0;
#pragma unroll
            for (int q = 0; q < 8; ++q) { const int v = rb[q]; t1 += v & 1023; t2 += (v >> 10) & 1023; t3 += (v >> 20) & 1023; }
            T = t3 >= cap ? c3 : (t2 >= cap ? c2 : (t1 >= cap ? c1 : T));
        }
        int mine = 0;
#pragma unroll
        for (int k = 0; k < 8; ++k) mine += (key[k] > T ? 1 : 0) + (key[k] == T ? 0x10000 : 0);
        int inc = mine;
#pragma unroll
        for (int o = 1; o < 64; o <<= 1) { const int t2 = __builtin_amdgcn_ds_bpermute(((lane - o) & 63) << 2, inc); if (lane >= o) inc += t2; }
        __syncthreads();
        if (lane == 63) red[16 + wv_] = inc;
        __syncthreads();
        int base = 0, total = 0;
#pragma unroll
        for (int q = 0; q < 8; ++q) { const int t2 = red[16 + q]; total += t2; if (q < wv_) base += t2; }
        int ex = base + inc - mine;
        const int m = total & 0xffff;
        const int slot0 = (s < 8 ? 0 : NSLOT_LAT) + (e * 8 + b) * cap;
#pragma unroll
        for (int k = 0; k < 8; ++k) {
            const int i = tid * 8 + k;
            if (i < n) {
                const int g = ex & 0xffff, q = ex >> 16;
                int sl = -1;
                if (key[k] > T) sl = g; else if (key[k] == T && m + q < cap) sl = m + q;
                const int row = row0 + i;
                if (sl >= 0) { idx[slot0 + sl] = row; gatev[slot0 + sl] = __uint_as_float(key[k] & 0x7fffffffu); }
                pos[(size_t)row * 16 + e] = sl >= 0 ? slot0 + sl : -1;
                ex += (key[k] > T ? 1 : 0) + (key[k] == T ? 0x10000 : 0);
            }
        }
        __syncthreads();
    }
}

constexpr int N_PHASES = 38;
__global__ void __launch_bounds__(NTHR, 2) mega_fwd(P p) {
    extern __shared__ __attribute__((aligned(16))) unsigned char lds_raw[];
    LAS unsigned char* lds = (LAS unsigned char*)lds_raw;
    volatile LAS unsigned* MISC = (volatile LAS unsigned*)(lds + MISC_OFF);
    const int tid = threadIdx.x;
    const int wv0 = __builtin_amdgcn_readfirstlane(tid >> 6);
    const int G = gridDim.x; const int bx0 = blockIdx.x;
    const int vcu0 = (G % 8 == 0) ? (bx0 % 8) * (G / 8) + bx0 / 8 : bx0;
    for (int u = tid; u < (LDS_BYTES - RING_BYTES) / 4; u += NTHR) ((LAS unsigned*)(lds + RING_BYTES))[u] = 0u;
    __syncthreads();
    const int lo = p.ph_lo, hi = p.ph_hi;
    unsigned* barw = (unsigned*)(p.ws + WS_CTL) + 4096 + p.seg * XCD_BAR_WORDS;
    XcdBarrier bar; bar.bar = barw; bar.x = 0; bar.st = MISC + 8;
    if (hi - lo > 1) bar = xcd_barrier_post(barw, MISC + 8);
#define IN(k) (lo <= (k) && (k) < hi)
#define SEAM(k) do { if ((k) + 1 < hi) xcd_barrier(bar, wv0); } while (0)
    if (IN(0)) { for (int rep_ = 0; rep_ < ((DUP_MASK >> 0) & 1) + 1; ++rep_) { phase_prologue(p, lds, vcu0, G, wv0); } SEAM(0); }
#pragma unroll 1
    for (int layer = 0; layer < 4; ++layer) {
        const int base = 1 + 9 * layer, li = layer >> 1;
        int bx = bx0, vcu = vcu0, wv = wv0; unsigned char* ws = p.ws; asm volatile("" : "+s"(bx), "+s"(vcu), "+s"(ws), "+s"(wv));
        if (IN(base + 0)) { if (layer == 0) phase_norm<0>(p, layer, lds, vcu, G, wv); else phase_norm<1>(p, layer, lds, vcu, G, wv); SEAM(base + 0); }
        if ((layer & 1) == 0) {
            if (IN(base + 1)) {
                pg8::Gemm g{(const bf16_t*)(ws + WS_U), (const bf16_t*)(ws + W_ATTN_IN) + (size_t)li * 2304 * 1024, NR, 2304, nullptr, 0};
                pg8::StaticOrder S; S.init(NR, 2304, G, bx);
                pg8::EpiQKV E{(bf16_t*)(ws + WS_B1), (const float*)(ws + WS_ROPE + 16384) + li * 256, (const float*)(ws + WS_ROPE)};
                for (int rep_ = 0; rep_ < ((DUP_MASK >> 1) & 1) + 1; ++rep_) { pg8::gemm_phase<pg8::EpiQKV, false, false>(lds, g, S, E, wv); }
                if (G == 256 && bx >= 200) moe_window(p, lds, layer, 0, bx - 200, wv);
                SEAM(base + 1);
            }
            if (IN(base + 3)) { for (int rep_ = 0; rep_ < ((DUP_MASK >> 2) & 1) + 1; ++rep_) { phase_attn_dense(p, (char*)lds_raw, vcu, G, wv); phase_attn_na(p, layer, (char*)lds_raw, vcu, G, wv); } SEAM(base + 3); }
        } else {
            if (IN(base + 1)) {
                pg8::Gemm g{(const bf16_t*)(ws + WS_U), (const bf16_t*)(ws + W_GLA_IN) + (size_t)li * 3328 * 1024, NR, 3328, nullptr, 0};
                pg8::StaticOrder S; S.init(NR, 3328, G, bx);
                pg8::EpiGlaIn E{(bf16_t*)(ws + WS_B1), (float*)(ws + WS_Z)};
                for (int rep_ = 0; rep_ < ((DUP_MASK >> 1) & 1) + 1; ++rep_) { pg8::gemm_phase<pg8::EpiGlaIn, false, false>(lds, g, S, E, wv); }
                if (G == 256 && bx >= 232) moe_window(p, lds, layer, 0, bx - 232, wv);
                SEAM(base + 1);
            }
            if (IN(base + 2)) { for (int rep_ = 0; rep_ < ((DUP_MASK >> 3) & 1) + 1; ++rep_) { phase_gla_pre(p, layer, lds, vcu, G, wv); } xcd_barrier(bar, wv0); phase_gla_scan(p, layer, lds, vcu, G, wv); SEAM(base + 2); }
            if (IN(base + 3)) { for (int rep_ = 0; rep_ < ((DUP_MASK >> 4) & 1) + 1; ++rep_) { phase_gla_merge(p, layer, vcu, G, wv); } SEAM(base + 3); }
        }
        if (IN(base + 4)) {
            const bf16_t* A = (const bf16_t*)(ws + WS_B2);
            const bf16_t* Bt = (layer & 1) ? (const bf16_t*)(ws + W_GLA_OUT) + (size_t)li * 1024 * 1024 : (const bf16_t*)(ws + W_ATTN_OUT) + (size_t)li * 1024 * 1024;
            pg8::Gemm g{A, Bt, NR, 1024, nullptr, 0};
            pg8::StaticOrder S; if (layer == 3) S.init(NB * SEQ, 1024, G, bx, 1); else S.init(NR, 1024, G, bx);
            pg8::EpiResid E{(bf16_t*)(ws + WS_HB), (const float*)(ws + WS_MODS) + (size_t)layer * 9 * 6144, layer == 0 ? p.x : nullptr, layer == 0 ? p.ctx : nullptr};
            pg8::gemm_phase<pg8::EpiResid, false, false>(lds, g, S, E, wv);
            if (layer < 3 && G == 256 && bx >= 32) moe_window(p, lds, layer, 1, bx - 32, wv);
            SEAM(base + 4);
        }
        if (IN(base + 5)) { for (int rep_ = 0; rep_ < ((DUP_MASK >> 5) & 1) + 1; ++rep_) { phase_norm<2>(p, layer, lds, vcu, G, wv, layer == 3); } SEAM(base + 5); }
        if (IN(base + 6)) { for (int rep_ = 0; rep_ < ((DUP_MASK >> 6) & 1) + 1; ++rep_) { phase_topk(p, lds, vcu, G, wv, layer == 3 ? 128 : 256); }
            if (G == 256 && vcu >= 128) moe_window(p, lds, layer, 2, vcu - 128, wv);        SEAM(base + 6); }
        if (IN(base + 7)) {
            pg8::Gemm g{(const bf16_t*)(ws + WS_U), (const bf16_t*)(ws + W_MOE_UP) + (size_t)layer * 16 * 2048 * 1024, NSLOT, 2048, (const int*)(ws + WS_IDX), (size_t)2048 * 1024 * 2};
            pg8::StaticOrder S; S.init(layer == 3 ? NSLOT_LAT : NSLOT, 2048, G, bx);
            pg8::EpiSwiGLU E{(bf16_t*)(ws + WS_B1)};
            for (int rep_ = 0; rep_ < ((DUP_MASK >> 7) & 1) + 1; ++rep_) { pg8::gemm_phase<pg8::EpiSwiGLU, true, true>(lds, g, S, E, wv); }
            if (layer < 3 && G == 256 && bx >= 128) moe_window(p, lds, layer, 3, bx - 128, wv);
            SEAM(base + 7);
        }
        if (IN(base + 8)) {
            pg8::Gemm g{(const bf16_t*)(ws + WS_B1), (const bf16_t*)(ws + W_MOE_DN) + (size_t)layer * 16 * 1024 * 1024, NSLOT, 1024, nullptr, (size_t)1024 * 1024 * 2};
            pg8::StaticOrder S; S.init(layer == 3 ? NSLOT_LAT : NSLOT, 1024, G, bx);
            pg8::EpiBf16 E{(bf16_t*)(ws + WS_B2), 1024, (const float*)(ws + WS_GATE)};
            for (int rep_ = 0; rep_ < ((DUP_MASK >> 8) & 1) + 1; ++rep_) { pg8::gemm_phase<pg8::EpiBf16, false, true>(lds, g, S, E, wv); }
            if (layer < 3 && G == 256 && bx >= 64) moe_window(p, lds, layer, 4, bx - 64, wv);
            SEAM(base + 8);
        }
    }
    if (IN(37)) phase_norm<3>(p, 3, lds, vcu0, G, wv0);
#undef IN
#undef SEAM
}
}

extern "C" void kernel_launch(void* const* d_in, const int* in_sizes, int n_in, void* d_out, int out_size, void* d_ws, size_t ws_size, hipStream_t stream) {
    static int grid = 0;
    if (grid == 0) {
        if (ws_size < WS_END) { fprintf(stderr, "kernel_launch: workspace too small: %zu < %zu\n", ws_size, (size_t)WS_END); grid = -1; return; }
        int dev = 0, cus = 0;
        if (hipGetDevice(&dev) != hipSuccess || hipDeviceGetAttribute(&cus, hipDeviceAttributeMultiprocessorCount, dev) != hipSuccess) { grid = -1; return; }
        if (hipFuncSetAttribute((const void*)mega_fwd, hipFuncAttributeMaxDynamicSharedMemorySize, LDS_BYTES) != hipSuccess) { fprintf(stderr, "kernel_launch: hipFuncSetAttribute failed\n"); grid = -1; return; }
        int per_cu = 0;
        if (hipOccupancyMaxActiveBlocksPerMultiprocessor(&per_cu, (const void*)mega_fwd, NTHR, LDS_BYTES) != hipSuccess || per_cu < 1) fprintf(stderr, "kernel_launch: occupancy query reports %d\n", per_cu);
        (void)hipGetLastError();
        grid = cus;
    }
    if (grid < 0) return;
    (void)hipMemsetAsync((char*)d_ws + WS_CTL, 0, CTL_ZERO_BYTES, stream);
    P p{};
    const float** pp = (const float**)&p;
    for (int i = 0; i < 26; ++i) pp[i] = (const float*)d_in[i];
    p.out = (float*)d_out; p.ws = (unsigned char*)d_ws;
    p.ph_lo = 0; p.ph_hi = N_PHASES; p.seg = 0;
    hipLaunchKernelGGL(mega_fwd, dim3(grid), dim3(NTHR), LDS_BYTES, stream, p);
}
```

```cpp
#include <hip/hip_runtime.h>
#include <stdint.h>
#include <math.h>
#include <cstdio>

#ifndef DUP_MASK
#define DUP_MASK 0
#endif

namespace {
#define LAS __attribute__((address_space(3)))
#define GAS __attribute__((address_space(1)))
typedef unsigned short bf16_t;
typedef short bf16x8 __attribute__((ext_vector_type(8)));
typedef float f32x4 __attribute__((ext_vector_type(4)));
typedef unsigned u32x4 __attribute__((ext_vector_type(4)));
typedef unsigned u32x2 __attribute__((ext_vector_type(2)));

constexpr int D = 1024, NB = 8, SEQ = 4096, CTXL = 256, RPB = 4352, NR = NB * RPB;
constexpr int NSLOT_LAT = 65536, NSLOT = 69632;
constexpr int NTHR = 512, NWAVES = 8;
constexpr size_t MiB = 1u << 20;
constexpr size_t WS_CTL = 0, CTL_ZERO_BYTES = 1 * MiB;
constexpr size_t WS_MODS = 2 * MiB;
constexpr size_t WS_ROPE = 3 * MiB;
constexpr size_t WS_AFF = 12 * MiB;
constexpr size_t WS_POS = 15 * MiB;
constexpr size_t WS_IDX = 18 * MiB;
constexpr size_t WS_GATE = 19 * MiB;
constexpr size_t WS_Z = 20 * MiB;
constexpr size_t WS_U = 32 * MiB;
constexpr size_t WS_B1 = 100 * MiB;
constexpr size_t WS_B2 = 304 * MiB;
constexpr size_t WS_HB = WS_B2 + 136 * MiB;
constexpr size_t WS_W = 508 * MiB;
constexpr size_t W_ATTN_IN = WS_W, W_ATTN_OUT = WS_W + 9 * MiB, W_GLA_IN = WS_W + 13 * MiB, W_GLA_OUT = WS_W + 26 * MiB, W_MOE_UP = WS_W + 30 * MiB, W_MOE_DN = WS_W + 286 * MiB;
constexpr size_t WS_GQD = WS_U;
constexpr size_t WS_GKS = WS_W + 414 * MiB;
constexpr size_t WS_GA = WS_GKS + 68 * MiB;
constexpr size_t WS_GCL = WS_GA + 34 * MiB;
constexpr size_t WS_END = WS_GCL + 3 * MiB;
constexpr float EPS = 1e-6f;
constexpr int LDS_BYTES = 147456;
constexpr int RING_BYTES = 131072, MISC_OFF = RING_BYTES + 320;

struct P {
    const float *x, *c, *ctx, *c_ctx, *ada_w, *ada_b, *norm1_g, *norm2_g, *attn_w_in, *attn_w_out,
        *a_q_norm, *a_k_norm, *b_q_norm, *b_k_norm, *na_rpb, *gla_w_in, *gk_w_f, *gk_b_f, *gk_w_b, *gk_b_b,
        *gla_o_norm, *gla_w_out, *moe_router, *moe_w_gate, *moe_w_up, *moe_w_down;
    float* out; unsigned char* ws;
    int ph_lo, ph_hi, seg, pad;
};

__device__ __forceinline__ float bf2f(bf16_t v) { return __uint_as_float(((unsigned)v) << 16); }
__device__ __forceinline__ unsigned f2bf(float f) { unsigned u = __float_as_uint(f); return (u + 0x7fffu + ((u >> 16) & 1u)) >> 16; }
__device__ __forceinline__ unsigned pk2(float lo, float hi) { return f2bf(lo) | (f2bf(hi) << 16); }
__device__ __forceinline__ int hw_tid() {
    int t; asm volatile("v_mbcnt_lo_u32_b32 %0, -1, 0\n\tv_mbcnt_hi_u32_b32 %0, -1, %0" : "=v"(t)); return t;
}
template <int X> __device__ __forceinline__ float swz_xor(float v) { return __uint_as_float((unsigned)__builtin_amdgcn_ds_swizzle((int)__float_as_uint(v), (X << 10) | 0x1f)); }
__device__ __forceinline__ float wave_sum(float v) {
    v += swz_xor<1>(v); v += swz_xor<2>(v); v += swz_xor<4>(v); v += swz_xor<8>(v); v += swz_xor<16>(v);
    auto rr = __builtin_amdgcn_permlane32_swap(__float_as_uint(v), __float_as_uint(v), false, false);
    return __uint_as_float(rr[0]) + __uint_as_float(rr[1]);
}
__device__ __forceinline__ float silu_f(float x) { return x / (1.f + __expf(-x)); }
__device__ __forceinline__ int mod_row(int row) { const int b = row / RPB, t = row - b * RPB; return t < SEQ ? b : 8; }

namespace pg8 {
constexpr int BM = 256, BK = 64, HALF = 128, HTB = HALF * BK * 2, STAGE_BYTES = 8 * HTB, NXCD = 8, WGM = 8;
__device__ __forceinline__ int lds_byte(int r, int c) { const int st = (r >> 4) * 2 + (c >> 5), rr = r & 15, cc = c & 31, ob = rr * 64 + cc * 2; return st * 1024 + (ob ^ (((ob >> 9) & 1) << 5)); }
__device__ __forceinline__ void stage_rc(int b, int& R, int& C) { const int st = b / 1024, sb = b % 1024, swz = sb ^ (((sb >> 9) & 1) << 5); R = (st >> 1) * 16 + swz / 64; C = (st & 1) * 32 + (swz % 64) / 2; }
__device__ __forceinline__ int perm32(int rho) { const int n = rho >> 4, i = rho & 15; return 8 * (i >> 2) + 4 * n + (i & 3); }
struct Unit { int pm, pn; };
struct Gemm { const bf16_t* A; const bf16_t* Bt; int M, N; const int* gather; size_t bgroup; };
struct StaticOrder {
    int nM, nN, nwg, G, c, skip17;
    __device__ void init(int M, int N, int G_, int c_, int skip17_ = 0) { nM = M / BM; nN = N / BM; nwg = nM * nN; G = G_; c = c_; skip17 = skip17_; }
    __device__ bool next(int i, Unit& u) const {
        const long L = (long)i * G + c; if (L >= nwg) return false;
        int wgid = (int)L; { const int q = nwg / NXCD, r = nwg % NXCD, xcd = wgid % NXCD, off = wgid / NXCD; wgid = (xcd < r ? xcd * (q + 1) : r * (q + 1) + (xcd - r) * q) + off; }
        const int nig = WGM * nN, gid = wgid / nig, fm = gid * WGM, gsz = (nM - fm) < WGM ? (nM - fm) : WGM;
        u.pm = fm + ((wgid % nig) % gsz); u.pn = (wgid % nig) / gsz; if (skip17) u.pm += u.pm >> 4; return true;
    }
};
typedef float f32x2_t_ __attribute__((ext_vector_type(2))); typedef __bf16 bf16x2_t_ __attribute__((ext_vector_type(2)));
__device__ __forceinline__ unsigned cvt_pk_bf16(float lo, float hi) { f32x2_t_ v = {lo, hi}; bf16x2_t_ b = __builtin_convertvector(v, bf16x2_t_); return __builtin_bit_cast(unsigned, b); }
__device__ __forceinline__ int expert_of_tile(int pm) { return pm < 256 ? (pm >> 4) : (pm - 256); }

struct EpiBf16 {
    static constexpr bool PERM = true;
    bf16_t* O; int ldc; const float* rowscale;
    __device__ __forceinline__ void operator()(const f32x4 (&acc)[2][2][4][2], const Unit& u, int wr, int wc, int fr, int fq) const {
        const int row0 = u.pm * BM + wr * 64 + fr, col0 = u.pn * BM + wc * 32 + 8 * fq;
#pragma unroll
        for (int ai = 0; ai < 2; ++ai)
#pragma unroll
            for (int m = 0; m < 4; ++m) { bf16_t* rowp = O + (size_t)(row0 + ai * HALF + m * 16) * ldc + col0;
                const float rsc = rowscale ? rowscale[row0 + ai * HALF + m * 16] : 1.f;
#pragma unroll
                for (int bj = 0; bj < 2; ++bj) { const f32x4 v0 = acc[ai][bj][m][0] * rsc, v1 = acc[ai][bj][m][1] * rsc;
                    u32x4 w; w.x = cvt_pk_bf16(v0[0], v0[1]); w.y = cvt_pk_bf16(v0[2], v0[3]); w.z = cvt_pk_bf16(v1[0], v1[1]); w.w = cvt_pk_bf16(v1[2], v1[3]);
                    *(u32x4*)(rowp + bj * HALF) = w; } }
    }
};
struct EpiQKV {
    static constexpr bool PERM = true;
    bf16_t* O; const float* qkg; const float* rope;
    __device__ __forceinline__ void operator()(const f32x4 (&acc)[2][2][4][2], const Unit& u, int wr, int wc, int fr, int fq) const {
        const int sg = 4 * u.pn + wc;
        const int b = u.pm / 17, tt = u.pm - b * 17;
        const int row0 = u.pm * BM + wr * 64 + fr, col0 = sg * 64 + 8 * fq;
        const bool is_q = sg < 8 || (sg >= 12 && sg < 20), is_v = sg == 10 || sg == 11 || sg >= 28;
        const bool do_rope = sg < 10 && tt < 16;
        const float* gp = qkg + 64 * (sg < 8 ? 0 : (sg < 10 ? 1 : (sg < 20 ? 2 : 3)));
        const float qsc = is_q ? 0.18033688011112042f : 1.f;
        const int lane_hi = fq >> 1;
#pragma unroll
        for (int ai = 0; ai < 2; ++ai)
#pragma unroll
            for (int m = 0; m < 4; ++m) {
                f32x4 v[2][2];
                float ss = 0.f;
#pragma unroll
                for (int bj = 0; bj < 2; ++bj)
#pragma unroll
                    for (int n = 0; n < 2; ++n) { v[bj][n] = acc[ai][bj][m][n]; ss += (v[bj][n][0] * v[bj][n][0] + v[bj][n][1] * v[bj][n][1]) + (v[bj][n][2] * v[bj][n][2] + v[bj][n][3] * v[bj][n][3]); }
                if (!is_v) {
                    ss += swz_xor<16>(ss);
                    { auto rr = __builtin_amdgcn_permlane32_swap(__float_as_uint(ss), __float_as_uint(ss), false, false); ss = __uint_as_float(rr[0]) + __uint_as_float(rr[1]); }
                    const float rs = rsqrtf(ss * (1.f / 64.f) + EPS) * qsc;
                    const float* gpl = gp + 8 * fq; asm volatile("" : "+v"(gpl));
#pragma unroll
                    for (int bj = 0; bj < 2; ++bj)
#pragma unroll
                        for (int n = 0; n < 2; ++n) v[bj][n] = v[bj][n] * rs * *(const f32x4*)(gpl + 32 * bj + 4 * n);
                    if (do_rope) {
                        const int posr = tt * 4 + 2 * ai + wr, posc = 16 * m + fr;
#pragma unroll
                        for (int bj = 0; bj < 2; ++bj) {
                            const float* tb = rope + (bj ? posc : posr) * 16 + 8 * (fq & 1);
#pragma unroll
                            for (int n = 0; n < 2; ++n) {
                                const f32x4 cs = *(const f32x4*)(tb + 4 * n), sn = *(const f32x4*)(tb + 1024 + 4 * n);
                                f32x4 ot;
#pragma unroll
                                for (int e = 0; e < 4; ++e) { auto rr = __builtin_amdgcn_permlane32_swap(__float_as_uint(v[bj][n][e]), __float_as_uint(v[bj][n][e]), false, false);
                                    const float other = __uint_as_float(lane_hi ? rr[0] : rr[1]); ot[e] = lane_hi ? other : -other; }
                                v[bj][n] = v[bj][n] * cs + ot * sn;
                            }
                        }
                    }
                }
                bf16_t* rowp = O + (size_t)(row0 + ai * HALF + m * 16) * 2304 + col0;
#pragma unroll
                for (int bj = 0; bj < 2; ++bj) { u32x4 w; w.x = cvt_pk_bf16(v[bj][0][0], v[bj][0][1]); w.y = cvt_pk_bf16(v[bj][0][2], v[bj][0][3]); w.z = cvt_pk_bf16(v[bj][1][0], v[bj][1][1]); w.w = cvt_pk_bf16(v[bj][1][2], v[bj][1][3]);
                    *(u32x4*)(rowp + 32 * bj) = w; }
            }
    }
};
struct EpiGlaIn {
    static constexpr bool PERM = true;
    bf16_t* O; float* Z;
    __device__ __forceinline__ void operator()(const f32x4 (&acc)[2][2][4][2], const Unit& u, int wr, int wc, int fr, int fq) const {
        const int row0 = u.pm * BM + wr * 64 + fr;
        if (u.pn < 12) {
            const int col0 = u.pn * BM + wc * 32 + 8 * fq;
#pragma unroll
            for (int ai = 0; ai < 2; ++ai)
#pragma unroll
                for (int m = 0; m < 4; ++m) { bf16_t* rowp = O + (size_t)(row0 + ai * HALF + m * 16) * 3072 + col0;
#pragma unroll
                    for (int bj = 0; bj < 2; ++bj) { const f32x4 v0 = acc[ai][bj][m][0], v1 = acc[ai][bj][m][1];
                        u32x4 w; w.x = cvt_pk_bf16(v0[0], v0[1]); w.y = cvt_pk_bf16(v0[2], v0[3]); w.z = cvt_pk_bf16(v1[0], v1[1]); w.w = cvt_pk_bf16(v1[2], v1[3]);
                        *(u32x4*)(rowp + bj * HALF) = w; } }
        } else if (wc == 0) {
#pragma unroll
            for (int ai = 0; ai < 2; ++ai)
#pragma unroll
                for (int m = 0; m < 4; ++m) { float* zp = Z + (size_t)(row0 + ai * HALF + m * 16) * 32 + 8 * fq;
                    *(f32x4*)(zp) = acc[ai][0][m][0]; *(f32x4*)(zp + 4) = acc[ai][0][m][1]; }
        }
    }
};
struct EpiResid {
    static constexpr bool PERM = true;
    bf16_t* hb; const float* mods_l; const float* slat; const float* sctx;
    __device__ __forceinline__ void operator()(const f32x4 (&acc)[2][2][4][2], const Unit& u, int wr, int wc, int fr, int fq) const {
        const int b = u.pm / 17, tt = u.pm - b * 17;
        const int mr = tt < 16 ? b : 8;
        const int col0 = u.pn * BM + wc * 32 + 8 * fq;
        bf16_t* base = hb + (size_t)(u.pm * BM + wr * 64 + fr) * D + col0;
        const float* g2 = mods_l + (size_t)mr * 6144 + 2 * 1024 + col0;
        f32x4 gv[2][2];
#pragma unroll
        for (int bj = 0; bj < 2; ++bj)
#pragma unroll
            for (int n = 0; n < 2; ++n) gv[bj][n] = *(const f32x4*)(g2 + bj * HALF + n * 4);
        if (slat != nullptr) {
            const float* sbase = (tt < 16 ? slat + (size_t)(b * SEQ + tt * 256) * D : sctx + (size_t)(b * CTXL) * D) + (size_t)(wr * 64 + fr) * D + col0;
#pragma unroll
            for (int ai = 0; ai < 2; ++ai) {
                f32x4 hv[4][2][2];
#pragma unroll
                for (int m = 0; m < 4; ++m) { const float* rowp = sbase + (size_t)(ai * HALF + m * 16) * D;
#pragma unroll
                    for (int bj = 0; bj < 2; ++bj)
#pragma unroll
                        for (int n = 0; n < 2; ++n) hv[m][bj][n] = *(const f32x4*)(rowp + bj * HALF + n * 4); }
#pragma unroll
                for (int m = 0; m < 4; ++m) { bf16_t* rowp = base + (size_t)(ai * HALF + m * 16) * D;
#pragma unroll
                    for (int bj = 0; bj < 2; ++bj) { const f32x4 r0 = hv[m][bj][0] + gv[bj][0] * acc[ai][bj][m][0], r1 = hv[m][bj][1] + gv[bj][1] * acc[ai][bj][m][1];
                        *(u32x4*)(rowp + bj * HALF) = (u32x4){cvt_pk_bf16(r0[0], r0[1]), cvt_pk_bf16(r0[2], r0[3]), cvt_pk_bf16(r1[0], r1[1]), cvt_pk_bf16(r1[2], r1[3])}; } }
            }
        } else {
#pragma unroll
            for (int ai = 0; ai < 2; ++ai) {
                u32x4 hv[4][2];
#pragma unroll
                for (int m = 0; m < 4; ++m) { const bf16_t* rowp = base + (size_t)(ai * HALF + m * 16) * D;
#pragma unroll
                    for (int bj = 0; bj < 2; ++bj) hv[m][bj] = *(const u32x4*)(rowp + bj * HALF); }
#pragma unroll
                for (int m = 0; m < 4; ++m) { bf16_t* rowp = base + (size_t)(ai * HALF + m * 16) * D;
#pragma unroll
                    for (int bj = 0; bj < 2; ++bj) { const u32x4 t = hv[m][bj];
                        const f32x4 h0 = (f32x4){__uint_as_float(t.x << 16), __uint_as_float(t.x & 0xffff0000u), __uint_as_float(t.y << 16), __uint_as_float(t.y & 0xffff0000u)};
                        const f32x4 h1 = (f32x4){__uint_as_float(t.z << 16), __uint_as_float(t.z & 0xffff0000u), __uint_as_float(t.w << 16), __uint_as_float(t.w & 0xffff0000u)};
                        const f32x4 r0 = h0 + gv[bj][0] * acc[ai][bj][m][0], r1 = h1 + gv[bj][1] * acc[ai][bj][m][1];
                        *(u32x4*)(rowp + bj * HALF) = (u32x4){cvt_pk_bf16(r0[0], r0[1]), cvt_pk_bf16(r0[2], r0[3]), cvt_pk_bf16(r1[0], r1[1]), cvt_pk_bf16(r1[2], r1[3])}; } }
            }
        }
    }
};
struct EpiSwiGLU {
    static constexpr bool PERM = true;
    bf16_t* O;
    __device__ __forceinline__ void operator()(const f32x4 (&acc)[2][2][4][2], const Unit& u, int wr, int wc, int fr, int fq) const {
        const int row0 = u.pm * BM + wr * 64 + fr, col0 = u.pn * HALF + wc * 32 + 8 * fq;
#pragma unroll
        for (int ai = 0; ai < 2; ++ai)
#pragma unroll
            for (int m = 0; m < 4; ++m) { bf16_t* rowp = O + (size_t)(row0 + ai * HALF + m * 16) * 1024 + col0;
                float r[8];
#pragma unroll
                for (int n = 0; n < 2; ++n)
#pragma unroll
                    for (int e = 0; e < 4; ++e) { const float g = acc[ai][0][m][n][e], up = acc[ai][1][m][n][e]; r[n * 4 + e] = g * __builtin_amdgcn_rcpf(1.f + __expf(-g)) * up; }
                u32x4 w; w.x = cvt_pk_bf16(r[0], r[1]); w.y = cvt_pk_bf16(r[2], r[3]); w.z = cvt_pk_bf16(r[4], r[5]); w.w = cvt_pk_bf16(r[6], r[7]);
                *(u32x4*)rowp = w; }
    }
};

__device__ __forceinline__ void glds16_s(const char* sbase, unsigned voff, unsigned lds_dst) { unsigned keep;
    asm volatile("s_nop 4\n\ts_mov_b32 %0, m0\n\ts_mov_b32 m0, %3\n\ts_nop 0\n\tglobal_load_lds_dwordx4 %1, %2\n\ts_mov_b32 m0, %0" : "=&s"(keep) : "v"(voff), "s"(sbase), "s"(lds_dst) : "memory"); }
template <class Epi, bool GATHER, bool GROUPED>
__device__ __forceinline__ void gemm_phase(LAS unsigned char* lds, const Gemm g, const StaticOrder& S, const Epi& E, const int wv_) {
    const int tid = (wv_ << 6) | hw_tid();
    const int wid = wv_, lane = tid & 63, wr = wid >> 2, wc = wid & 3, fr = lane & 15, fq = lane >> 4;
    constexpr int K = 1024, nt = K / BK;
    unsigned voffA[2], voffB[2];
#pragma unroll
    for (int i = 0; i < 2; ++i) { int R, C; stage_rc(tid * 16 + i * 8192, R, C); const int Rb = Epi::PERM ? ((R & ~31) + perm32(R & 31)) : R;
        voffA[i] = (unsigned)(R * K + C) * 2u; voffB[i] = (unsigned)(Rb * K + C) * 2u; }
#define PG8_RA(i) ((int)(voffA[i] >> 11))
#define PG8_CA(i) (voffA[i] & 2047u)
    constexpr size_t kstep = (size_t)(BK * 2);
    constexpr size_t hstep = (size_t)HALF * K * 2;
    constexpr size_t tstep = 2 * hstep;
    const unsigned ldsw = (unsigned)wid * 1024u, lds0 = (unsigned)(size_t)lds;
    const int aoff = lds_byte(wr * 64 + fr, fq * 8), boff = lds_byte(wc * 32 + fr, fq * 8);
#define PG8_SA(b, h) (((b) * 2 + (h)) * HTB)
#define PG8_SB(b, h) ((4 + (b) * 2 + (h)) * HTB)
#define PG8_STAGE_B(bufoff, gbase) do { _Pragma("unroll") for (int _i = 0; _i < 2; ++_i) \
        glds16_s((const char*)(gbase), voffB[_i], lds0 + (unsigned)(bufoff) + ldsw + (unsigned)(_i * 8192)); } while (0)
#define PG8_STAGE_A(bufoff, kp, h, O) do { _Pragma("unroll") for (int _i = 0; _i < 2; ++_i) { \
        if (GATHER) glds16_s((const char*)(kp), (O)[h][_i], lds0 + (unsigned)(bufoff) + ldsw + (unsigned)(_i * 8192)); \
        else glds16_s((const char*)(kp) + (size_t)(h) * hstep, voffA[_i], lds0 + (unsigned)(bufoff) + ldsw + (unsigned)(_i * 8192)); } } while (0)
#define PG8_LDA(dst, b, h) do { _Pragma("unroll") for (int m = 0; m < 4; ++m) _Pragma("unroll") for (int k = 0; k < 2; ++k) dst[m][k] = *(const LAS bf16x8*)(lds + PG8_SA(b, h) + aoff + m * 2048 + k * 1024); } while (0)
#define PG8_LDB(dst, b, h) do { _Pragma("unroll") for (int n = 0; n < 2; ++n) _Pragma("unroll") for (int k = 0; k < 2; ++k) dst[n][k] = *(const LAS bf16x8*)(lds + PG8_SB(b, h) + boff + n * 2048 + k * 1024); } while (0)
#define PG8_MMA(ai, bj, At, Bt) do { __builtin_amdgcn_s_setprio(1); _Pragma("unroll") for (int m = 0; m < 4; ++m) _Pragma("unroll") for (int n = 0; n < 2; ++n) _Pragma("unroll") for (int k = 0; k < 2; ++k) \
        acc[ai][bj][m][n] = __builtin_amdgcn_mfma_f32_16x16x32_bf16(Bt[n][k], At[m][k], acc[ai][bj][m][n], 0, 0, 0); __builtin_amdgcn_s_setprio(0); } while (0)
#define PG8_WAIT_V(n) asm volatile("s_waitcnt vmcnt(" #n ")" ::: "memory")
#define PG8_WAIT_L(n) asm volatile("s_waitcnt lgkmcnt(" #n ")" ::: "memory")
#define PG8_BAR __builtin_amdgcn_s_barrier()
#define PG8_SCHED __builtin_amdgcn_sched_barrier(0)
#define PG8_BOF(u) ((const char*)g.Bt + (GROUPED ? (size_t)expert_of_tile((u).pm) * g.bgroup : (size_t)0) + (size_t)(u).pn * tstep)
#define PG8_AOF(u) (GATHER ? (const char*)g.A : (const char*)g.A + (size_t)(u).pm * tstep)
    Unit cur, nxt; int ui = 0;
    if (!S.next(0, cur)) return;
    unsigned oc[2][2], on[2][2]; unsigned rn[2];
#pragma unroll
    for (int h = 0; h < 2; ++h)
#pragma unroll
        for (int i = 0; i < 2; ++i) { oc[h][i] = 0u; on[h][i] = 0u; rn[h] = 0u; }
    if (GATHER) {
#pragma unroll
        for (int h = 0; h < 2; ++h)
#pragma unroll
            for (int i = 0; i < 2; ++i) { int row = g.gather[cur.pm * BM + h * HALF + PG8_RA(i)]; row = row < 0 ? 0 : (row >= NR ? NR - 1 : row); oc[h][i] = (unsigned)row * (unsigned)(K * 2) + PG8_CA(i); }
    }
    f32x4 acc[2][2][4][2];
#pragma unroll
    for (int a = 0; a < 2; ++a)
#pragma unroll
        for (int b = 0; b < 2; ++b)
#pragma unroll
            for (int m = 0; m < 4; ++m)
#pragma unroll
                for (int n = 0; n < 2; ++n) acc[a][b][m][n] = (f32x4){0.f, 0.f, 0.f, 0.f};
    bf16x8 At[4][2], B0[2][2], B1[2][2];
    const char* cA = PG8_AOF(cur); const char* cB = PG8_BOF(cur);
    PG8_STAGE_B(PG8_SB(0, 0), cB); PG8_STAGE_B(PG8_SB(0, 1), cB + hstep); PG8_STAGE_A(PG8_SA(0, 0), cA, 0, oc); PG8_STAGE_A(PG8_SA(0, 1), cA, 1, oc);
    if (wr == 1) PG8_BAR;
    PG8_WAIT_V(2); PG8_BAR;
    PG8_STAGE_B(PG8_SB(1, 0), cB + kstep); PG8_STAGE_A(PG8_SA(1, 0), cA + kstep, 0, oc); PG8_STAGE_B(PG8_SB(1, 1), cB + hstep + kstep);
    PG8_WAIT_V(6); PG8_BAR;
#define PG8_KBODY(LAST, O2) do { \
            const char* a1 = cA + (size_t)(t + 1) * kstep; \
            const char* a2 = (LAST) ? nA : cA + (size_t)(t + 2) * kstep; const char* b2 = (LAST) ? nB : cB + (size_t)(t + 2) * kstep; \
            const char* a3 = a2 + kstep; const char* b3 = b2 + kstep; \
            PG8_LDB(B0, 0, 0); PG8_LDB(B1, 0, 1); PG8_SCHED; PG8_LDA(At, 0, 0); PG8_STAGE_A(PG8_SA(1, 1), a1, 1, oc); \
            PG8_WAIT_V(8); PG8_WAIT_L(0); PG8_BAR; PG8_MMA(0, 0, At, B0); PG8_MMA(0, 1, At, B1); PG8_BAR; PG8_SCHED; \
            PG8_LDA(At, 0, 1); PG8_STAGE_B(PG8_SB(0, 0), b2); PG8_STAGE_B(PG8_SB(0, 1), b2 + hstep); PG8_STAGE_A(PG8_SA(0, 0), a2, 0, O2); \
            PG8_WAIT_V(8); PG8_WAIT_L(0); PG8_BAR; PG8_MMA(1, 0, At, B0); PG8_MMA(1, 1, At, B1); PG8_BAR; PG8_SCHED; \
            PG8_LDB(B0, 1, 0); PG8_LDB(B1, 1, 1); PG8_SCHED; PG8_LDA(At, 1, 0); PG8_STAGE_A(PG8_SA(0, 1), a2, 1, O2); \
            PG8_WAIT_V(8); PG8_WAIT_L(0); PG8_BAR; PG8_MMA(0, 0, At, B0); PG8_MMA(0, 1, At, B1); PG8_BAR; PG8_SCHED; \
            PG8_LDA(At, 1, 1); PG8_STAGE_B(PG8_SB(1, 0), b3); PG8_STAGE_B(PG8_SB(1, 1), b3 + hstep); PG8_STAGE_A(PG8_SA(1, 0), a3, 0, O2); \
            PG8_WAIT_V(8); PG8_WAIT_L(0); PG8_BAR; PG8_MMA(1, 0, At, B0); PG8_MMA(1, 1, At, B1); PG8_BAR; PG8_SCHED; \
        } while (0)
    for (;;) {
        const bool has_next = S.next(ui + 1, nxt);
        const char* nA = has_next ? PG8_AOF(nxt) : cA; const char* nB = has_next ? PG8_BOF(nxt) : cB;
        if (GATHER && has_next) {
            const int t2 = (wv_ << 6) | hw_tid();
            int R0, C0, R1, C1; stage_rc(t2 * 16, R0, C0); stage_rc(t2 * 16 + 8192, R1, C1);
            const int* gp = g.gather + nxt.pm * BM;
            rn[0] = ((unsigned)gp[R0] & 0xffffu) | ((unsigned)gp[R1] << 16); rn[1] = ((unsigned)gp[HALF + R0] & 0xffffu) | ((unsigned)gp[HALF + R1] << 16);
        }
        int t = 0;
#pragma unroll 1
        for (; t < nt - 2; t += 2) PG8_KBODY(false, oc);
        if (GATHER) {
#pragma unroll
            for (int h = 0; h < 2; ++h)
#pragma unroll
                for (int i = 0; i < 2; ++i) { int row = (int)(i ? (rn[h] >> 16) : (rn[h] & 0xffffu)); row = row >= NR ? NR - 1 : row; on[h][i] = has_next ? (unsigned)row * (unsigned)(K * 2) + (oc[h][i] & 2047u) : oc[h][i]; }
        }
        PG8_KBODY(true, on);
        if (wr == 0) PG8_BAR;
        { const int l2 = hw_tid(); E(acc, cur, wr, wc, l2 & 15, l2 >> 4); }
        if (!has_next) break;
#pragma unroll
        for (int a = 0; a < 2; ++a)
#pragma unroll
            for (int b = 0; b < 2; ++b)
#pragma unroll
                for (int m = 0; m < 4; ++m)
#pragma unroll
                    for (int n = 0; n < 2; ++n) acc[a][b][m][n] = (f32x4){0.f, 0.f, 0.f, 0.f};
        cur = nxt; cA = nA; cB = nB; ++ui;
        if (GATHER) {
#pragma unroll
            for (int h = 0; h < 2; ++h)
#pragma unroll
                for (int i = 0; i < 2; ++i) oc[h][i] = on[h][i];
        }
        if (wr == 1) PG8_BAR;
    }
    PG8_WAIT_V(0);
    PG8_BAR;
#undef PG8_KBODY
#undef PG8_RA
#undef PG8_CA
#undef PG8_SA
#undef PG8_SB
#undef PG8_STAGE_A
#undef PG8_STAGE_B
#undef PG8_LDA
#undef PG8_LDB
#undef PG8_MMA
#undef PG8_WAIT_V
#undef PG8_WAIT_L
#undef PG8_BAR
#undef PG8_SCHED
#undef PG8_BOF
#undef PG8_AOF
}
}

#define XB_TMO      128
#define XB_XCNT(j)  (256  + 64 * (j))
#define XB_XSUB(j)  (1280 + 64 * (j))
#define XB_XGEN(j)  (2304 + 64 * (j))
#define XB_TOP      3328
#define XB_TOPGEN   3392
#define XCD_BAR_WORDS 3456
#define XB_SPIN_CAP (1u << 22)
__device__ __forceinline__ unsigned xb_ld(unsigned* p)              { return __hip_atomic_load(p, __ATOMIC_RELAXED, __HIP_MEMORY_SCOPE_AGENT); }
__device__ __forceinline__ unsigned xb_add(unsigned* p, unsigned v) { return __hip_atomic_fetch_add(p, v, __ATOMIC_RELAXED, __HIP_MEMORY_SCOPE_AGENT); }
__device__ __forceinline__ unsigned xb_xcc_id() { return (unsigned)__builtin_amdgcn_s_getreg((3 << 11) | 20) & 0xFu; }
#define XB_SPIN(cond, bar) do { unsigned _sp = 0; while (cond) { __builtin_amdgcn_s_sleep(1); \
    if ((++_sp & 255u) == 0u) { if (xb_ld(&(bar)[XB_TMO])) break; if (_sp > XB_SPIN_CAP) { atomicAdd(&(bar)[XB_TMO], 1u); break; } } } } while (0)
struct XcdBarrier { unsigned* bar; unsigned x; volatile LAS unsigned* st; };
__device__ __forceinline__ XcdBarrier xcd_barrier_post(unsigned* bar, volatile LAS unsigned* st) {
    XcdBarrier b; b.bar = bar; b.x = xb_xcc_id(); b.st = st;
    if (threadIdx.x == 0) (void)xb_add(&bar[XB_XCNT(b.x)], 1u);
    return b;
}
__device__ __forceinline__ void xcd_barrier_complete(unsigned* bar, unsigned x, unsigned& nloc, unsigned& nx) {
    const unsigned G = gridDim.x * gridDim.y * gridDim.z;
    unsigned sum, cnt, mine, sp = 0u;
    for (;;) {
        sum = 0u; cnt = 0u; mine = 0u;
#pragma unroll
        for (unsigned j = 0; j < 16; ++j) { const unsigned c = xb_ld(&bar[XB_XCNT(j)]); sum += c; cnt += (c > 0u) ? 1u : 0u; mine = (j == x) ? c : mine; }
        if (sum == G) break;
        __builtin_amdgcn_s_sleep(1);
        if ((++sp & 255u) == 0u) { if (xb_ld(&bar[XB_TMO])) break; if (sp > XB_SPIN_CAP) { atomicAdd(&bar[XB_TMO], 1u); break; } }
    }
    nloc = mine > 0u ? mine : 1u; nx = cnt > 0u ? cnt : 1u;
}
__device__ __forceinline__ void xcd_barrier(const XcdBarrier& b, const int wv_) {
    asm volatile("s_waitcnt vmcnt(0)" ::: "memory");
    __syncthreads();
    if (wv_ == 0 && hw_tid() == 0) {
        unsigned* bar = b.bar; asm volatile("" : "+s"(bar));
        __builtin_amdgcn_s_waitcnt(0);
        unsigned nloc = b.st[0], nx = b.st[1];
        if (nloc == 0u) { xcd_barrier_complete(bar, b.x, nloc, nx); b.st[0] = nloc; b.st[1] = nx; }
        const unsigned old = xb_add(&bar[XB_XSUB(b.x)], 1u);
        const unsigned gen = old / nloc;
        if (old + 1u == (gen + 1u) * nloc) {
            __builtin_amdgcn_fence(__ATOMIC_RELEASE, "agent");
            asm volatile("s_waitcnt vmcnt(0)" ::: "memory");
            const unsigned og = xb_add(&bar[XB_TOP], 1u);
            const unsigned tg = og / nx;
            if (og + 1u == (tg + 1u) * nx) xb_add(&bar[XB_TOPGEN], 1u);
            else XB_SPIN(xb_ld(&bar[XB_TOPGEN]) == tg, bar);
            __builtin_amdgcn_fence(__ATOMIC_ACQUIRE, "agent");
            xb_add(&bar[XB_XGEN(b.x)], 1u);
            asm volatile("s_waitcnt vmcnt(0)" ::: "memory");
        } else {
            XB_SPIN(xb_ld(&bar[XB_XGEN(b.x)]) == gen, bar);
            __builtin_amdgcn_fence(__ATOMIC_ACQUIRE, "agent");
            asm volatile("s_waitcnt vmcnt(0)" ::: "memory");
        }
    }
    __syncthreads();
}

__device__ __forceinline__ void p0_transpose_item(const float* W, int N, int kb, int n0, bf16_t* WTrow0  , LAS float* scr, int lane) {
    const int k0 = 64 * kb;
    const int kq = lane >> 3, nq = (lane & 7) * 4;
    f32x4 tv[8];
#pragma unroll
    for (int i = 0; i < 8; ++i) tv[i] = *(const GAS f32x4*)(W + (size_t)(k0 + 8 * i + kq) * N + n0 + nq);
#pragma unroll
    for (int i = 0; i < 8; ++i) { LAS float* d = scr + (8 * i + kq) * 33 + nq; d[0] = tv[i][0]; d[1] = tv[i][1]; d[2] = tv[i][2]; d[3] = tv[i][3]; }
    asm volatile("s_waitcnt lgkmcnt(0)" ::: "memory");
    const int c = lane & 7;
#pragma unroll
    for (int j = 0; j < 4; ++j) { const int n = (lane >> 3) + 8 * j; const LAS float* s = scr + (8 * c) * 33 + n;
        u32x4 o; o.x = pk2(s[0 * 33], s[1 * 33]); o.y = pk2(s[2 * 33], s[3 * 33]); o.z = pk2(s[4 * 33], s[5 * 33]); o.w = pk2(s[6 * 33], s[7 * 33]);
        *(u32x4*)(WTrow0 + (size_t)n * 1024 + k0 + 8 * c) = o; }
    asm volatile("s_waitcnt lgkmcnt(0)" ::: "memory");
}
constexpr int MOE_ITEMS = 48 * 512, MOE_ALL = 4 * MOE_ITEMS;
constexpr int MOE_PRO = 6144, WIN_B = 224 * 8 * 4, WIN_C = 128 * 8 * 5, WIN_D = 128 * 8 * 7, WIN_E = 192 * 8 * 5;
__device__ __forceinline__ int win_capA(int layer) { return (layer & 1) ? 24 * 8 * 8 : 56 * 8 * 8; }
__device__ __forceinline__ int win_layer_start(int layer) {
    const int full_even = 56 * 8 * 8 + WIN_B + WIN_C + WIN_D + WIN_E, full_odd = 24 * 8 * 8 + WIN_B + WIN_C + WIN_D + WIN_E;
    return MOE_PRO + (layer > 0 ? full_even : 0) + (layer > 1 ? full_odd : 0) + (layer > 2 ? full_even : 0);
}
__device__ __forceinline__ void moe_item_decode(const P& p, unsigned char* ws, int layer, int q, const float*& src, bf16_t*& dst) {
    const int mat = q >> 9, rr = q & 511, kb = rr >> 5, n0 = (rr & 31) * 32, kind = mat >> 4, le = layer * 16 + (mat & 15);
    if (kind < 2) {
        src = (kind == 0 ? p.moe_w_gate : p.moe_w_up) + (size_t)le * 1024 * 1024 + (size_t)(64 * kb) * 1024 + n0;
        dst = (bf16_t*)(ws + W_MOE_UP) + (size_t)le * 2048 * 1024 + (size_t)((n0 >> 7) * 256 + (n0 & 127) + kind * 128) * 1024 + 64 * kb;
    } else {
        src = p.moe_w_down + (size_t)le * 1024 * 1024 + (size_t)(64 * kb) * 1024 + n0;
        dst = (bf16_t*)(ws + W_MOE_DN) + (size_t)le * 1024 * 1024 + (size_t)n0 * 1024 + 64 * kb;
    }
}
__device__ __forceinline__ void moe_convert_win(const P& p, LAS unsigned char* lds, int g0, int npw, int gend, const int wv_) {
    unsigned char* ws = p.ws; asm volatile("" : "+s"(ws));
    const int lane = hw_tid();
    LAS float* scr = (LAS float*)(lds + wv_ * 16384);
    f32x4 va[8], vb[8]; bf16_t* da; bf16_t* db;
    const int kq = lane >> 3, nq = (lane & 7) * 4;
    int g = g0 + wv_;
    if (gend > MOE_ALL) gend = MOE_ALL;
    if (g < gend) { const float* sa; moe_item_decode(p, ws, g / MOE_ITEMS, g % MOE_ITEMS, sa, da); sa += (size_t)kq * 1024 + nq;
#pragma unroll
        for (int i = 0; i < 8; ++i) va[i] = *(const GAS f32x4*)(sa + (size_t)(8 * i) * 1024); }
#pragma unroll 1
    for (int k = 0; k < npw; ++k, g += 8) {
        if (g >= gend) break;
        const bool more = k + 1 < npw && g + 8 < gend;
        if (more) { const float* sb; moe_item_decode(p, ws, (g + 8) / MOE_ITEMS, (g + 8) % MOE_ITEMS, sb, db); sb += (size_t)kq * 1024 + nq;
#pragma unroll
            for (int i = 0; i < 8; ++i) vb[i] = *(const GAS f32x4*)(sb + (size_t)(8 * i) * 1024); }
#pragma unroll
        for (int i = 0; i < 8; ++i) { LAS float* d = scr + (8 * i + kq) * 33 + nq; d[0] = va[i][0]; d[1] = va[i][1]; d[2] = va[i][2]; d[3] = va[i][3]; }
        asm volatile("s_waitcnt lgkmcnt(0)" ::: "memory");
        const int c = lane & 7;
#pragma unroll
        for (int j = 0; j < 4; ++j) { const int n = (lane >> 3) + 8 * j; const LAS float* s2 = scr + (8 * c) * 33 + n;
            u32x4 o; o.x = pk2(s2[0 * 33], s2[1 * 33]); o.y = pk2(s2[2 * 33], s2[3 * 33]); o.z = pk2(s2[4 * 33], s2[5 * 33]); o.w = pk2(s2[6 * 33], s2[7 * 33]);
            *(u32x4*)(da + (size_t)n * 1024 + 8 * c) = o; }
        asm volatile("s_waitcnt lgkmcnt(0)" ::: "memory");
        if (more) {
#pragma unroll
            for (int i = 0; i < 8; ++i) va[i] = vb[i];
            da = db; }
    }
}
__device__ __forceinline__ void moe_window(const P& p, LAS unsigned char* lds, int layer, int kind, int blk, const int wv_) {
    const int capA = win_capA(layer), s0 = win_layer_start(layer);
    int start, cap, npw;
    if (kind == 0) { start = s0; cap = capA; npw = 8; }
    else if (kind == 1) { start = s0 + capA; cap = WIN_B; npw = 4; }
    else if (kind == 2) { start = s0 + capA + (layer < 3 ? WIN_B : 0); cap = WIN_C; npw = 5; }
    else if (kind == 3) { start = s0 + capA + WIN_B + WIN_C; cap = WIN_D; npw = 7; }
    else { start = s0 + capA + WIN_B + WIN_C + WIN_D; cap = WIN_E; npw = 5; }
    moe_convert_win(p, lds, start + blk * 8 * npw, npw, start + cap, wv_);
}
__device__ __forceinline__ void phase_prologue(const P& p, LAS unsigned char* lds, int vcu, int G, const int wv_) {
    unsigned char* ws = p.ws; asm volatile("" : "+s"(ws));
    const int tid = (wv_ << 6) | hw_tid();
    const int lane = tid & 63, wave = wv_;
    LAS float* scr = (LAS float*)(lds + wave * 16384);
    const int gw = vcu * NWAVES + wave, NGW = G * NWAVES;
    constexpr int I_AI = 16 * 72, I_AO = 16 * 32, I_GI = 16 * 97, I_GO = 16 * 32, I_SMALL = 2 * (I_AI + I_AO + I_GI + I_GO), I_MOE = 16 * 32;
    const int NITEMS = I_SMALL + (G == 256 ? MOE_PRO : MOE_ALL);
    for (int it = gw; it < NITEMS; it += NGW) {
        int r = it;
        if (r < I_SMALL) {
            const int i = r >= I_SMALL / 2 ? 1 : 0; r -= i * (I_SMALL / 2);
            if (r < I_AI) { const int kb = r / 72, nb = r % 72, n0 = nb * 32, drow = (n0 & ~255) + 128 * ((n0 >> 5) & 1) + 32 * ((n0 >> 6) & 3);
                p0_transpose_item(p.attn_w_in + (size_t)i * 1024 * 2304, 2304, kb, n0, (bf16_t*)(ws + W_ATTN_IN) + (size_t)i * 2304 * 1024 + (size_t)drow * 1024, scr, lane); continue; } r -= I_AI;
            if (r < I_AO) { const int kb = r / 32, nb = r % 32; p0_transpose_item(p.attn_w_out + (size_t)i * 1024 * 1024, 1024, kb, nb * 32, (bf16_t*)(ws + W_ATTN_OUT) + (size_t)i * 1024 * 1024 + (size_t)nb * 32 * 1024, scr, lane); continue; } r -= I_AO;
            if (r < I_GI) { const int kb = r / 97, nb = r % 97; p0_transpose_item(p.gla_w_in + (size_t)i * 1024 * 3104, 3104, kb, nb * 32, (bf16_t*)(ws + W_GLA_IN) + (size_t)i * 3328 * 1024 + (size_t)nb * 32 * 1024, scr, lane); continue; } r -= I_GI;
            { const int kb = r / 32, nb = r % 32; p0_transpose_item(p.gla_w_out + (size_t)i * 1024 * 1024, 1024, kb, nb * 32, (bf16_t*)(ws + W_GLA_OUT) + (size_t)i * 1024 * 1024 + (size_t)nb * 32 * 1024, scr, lane); continue; }
        }
        r -= I_SMALL;
        { int layer_, q_;
          layer_ = r / MOE_ITEMS; q_ = r % MOE_ITEMS;
          const float* src_; bf16_t* dst_; moe_item_decode(p, ws, layer_, q_, src_, dst_); p0_transpose_item(src_, 1024, 0, 0, dst_, scr, lane); }
    }
    for (int it = gw; it < 2 * 224; it += NGW) { const int i = it / 224, rr = 3104 + it % 224; u32x4* dst = (u32x4*)((bf16_t*)(ws + W_GLA_IN) + (size_t)i * 3328 * 1024 + (size_t)rr * 1024);
        dst[lane] = (u32x4){0u, 0u, 0u, 0u}; dst[lane + 64] = (u32x4){0u, 0u, 0u, 0u}; }
    __syncthreads();
    {
        LAS float* s = (LAS float*)lds;
        LAS float* red = (LAS float*)(lds + 9 * 1024 * 4);
        for (int i = tid; i < 9 * 1024; i += NTHR) { const int r = i >> 10, k = i & 1023; const float v = r < 8 ? p.c[r * 1024 + k] : p.c_ctx[k]; s[i] = v / (1.f + expf(-v)); }
        __syncthreads();
        float* mods = (float*)(ws + WS_MODS);
        for (int u = vcu; u < 384; u += G) {
            const int l = u / 96, cb = u % 96, cl = tid & 63, ks = tid >> 6, col = cb * 64 + cl;
            float acc[9];
#pragma unroll
            for (int r = 0; r < 9; ++r) acc[r] = 0.f;
            const float* w = p.ada_w + (size_t)l * 1024 * 6144 + col;
            for (int k = ks * 128; k < ks * 128 + 128; ++k) { const float wv = w[(size_t)k * 6144];
#pragma unroll
                for (int r = 0; r < 9; ++r) acc[r] += s[r * 1024 + k] * wv; }
#pragma unroll
            for (int r = 0; r < 9; ++r) red[(ks * 9 + r) * 64 + cl] = acc[r];
            __syncthreads();
            for (int i = tid; i < 9 * 64; i += NTHR) { const int r = i >> 6, c2 = i & 63; float v = 0.f;
#pragma unroll
                for (int q = 0; q < 8; ++q) v += red[(q * 9 + r) * 64 + c2];
                const int cc = cb * 64 + c2, chunk = cc >> 10; v += p.ada_b[l * 6144 + cc];
                if (chunk == 1) v = p.norm1_g[l * 1024 + (cc & 1023)] * (1.f + v); else if (chunk == 4) v = p.norm2_g[l * 1024 + (cc & 1023)] * (1.f + v);
                mods[(size_t)(l * 9 + r) * 6144 + cc] = v; }
            __syncthreads();
        }
    }
    if (vcu == 1 % G) { float* qkg = (float*)(ws + WS_ROPE + 16384);
        for (int i = tid; i < 512; i += NTHR) { const int l = i >> 8, ty = (i >> 6) & 3, d = i & 63; const float* src = ty == 0 ? p.a_q_norm : (ty == 1 ? p.a_k_norm : (ty == 2 ? p.b_q_norm : p.b_k_norm)); qkg[i] = src[l * 64 + d]; } }
    if (vcu == 0) { float* tab = (float*)(ws + WS_ROPE);
        for (int i = tid; i < 1024; i += NTHR) { const int pos = i >> 4, j = i & 15; const float inv = powf(10000.f, -(float)j / 16.f); const float a = (float)pos * inv; tab[i] = cosf(a); tab[1024 + i] = sinf(a); } }
}

template <int WHICH> __device__ __forceinline__ void phase_norm(const P& p, int layer, LAS unsigned char* lds, int vcu, int G, const int wv_, const bool lat_only = false) {
    unsigned char* ws = p.ws; asm volatile("" : "+s"(ws));
    const int lane = hw_tid(), tid = (wv_ << 6) | lane, wave = wv_;
    constexpr int NRW = 2;
    const float* mods = (const float*)(ws + WS_MODS);
    constexpr int UT_PITCH = 2064;
    LAS unsigned char* ut_hi = lds; LAS unsigned char* ut_lo = lds + 16 * UT_PITCH; LAS float* rpart0 = (LAS float*)(lds + 32 * UT_PITCH);
    int rstepi = 0;
    bf16x8 wfh[4], wfl[4];
    if (WHICH == 2) {
        const float* rwt = p.moe_router + (size_t)layer * 1024 * 16;
        const int fr = lane & 15, fq = lane >> 4;
#pragma unroll
        for (int ks = 0; ks < 4; ++ks) {
            float wv[8];
#pragma unroll
            for (int i = 0; i < 8; ++i) wv[i] = rwt[(size_t)(128 * wave + 32 * ks + 8 * fq + i) * 16 + fr];
            unsigned hh[4], ll[4];
#pragma unroll
            for (int i = 0; i < 4; ++i) { const unsigned h0 = f2bf(wv[2 * i]), h1 = f2bf(wv[2 * i + 1]); hh[i] = h0 | (h1 << 16);
                ll[i] = pk2(wv[2 * i] - __uint_as_float(h0 << 16), wv[2 * i + 1] - __uint_as_float(h1 << 16)); }
            wfh[ks] = __builtin_bit_cast(bf16x8, (u32x4){hh[0], hh[1], hh[2], hh[3]}); wfl[ks] = __builtin_bit_cast(bf16x8, (u32x4){ll[0], ll[1], ll[2], ll[3]});
        }
    }
    const int nrows = (WHICH == 3 || lat_only) ? NB * SEQ : NR;
    constexpr bool COMB = WHICH == 3 || WHICH == 1;
#define NIX(j) (2 * (lane + 64 * ((j) >> 1)) + ((j) & 1))
#define NIP(jp) (lane + 64 * (jp))
    f32x4 vn[NRW][4]; u32x4 vnb[NRW][2]; int slotn[NRW];
#define NORM_ROWMAP(rr_) do { if (WHICH == 3 || lat_only) { const int b_ = (rr_) / SEQ, t_ = (rr_) - b_ * SEQ; (rr_) = b_ * RPB + t_; } } while (0)
#define NORM_LOAD(r0_, V_, S_) do { _Pragma("unroll") for (int q = 0; q < NRW; ++q) { int rr = (r0_) + q; NORM_ROWMAP(rr); const int b = rr / RPB, t = rr - b * RPB; \
            if constexpr (WHICH == 0) { const float* src = t < SEQ ? p.x + (size_t)(b * SEQ + t) * D : p.ctx + (size_t)(b * CTXL + (t - SEQ)) * D; \
                _Pragma("unroll") for (int j = 0; j < 4; ++j) V_[q][j] = ((const GAS f32x4*)src)[NIX(j)]; } \
            else { const bf16_t* src = (const bf16_t*)(ws + WS_HB) + (size_t)rr * D; (void)b; (void)t; \
                _Pragma("unroll") for (int jp = 0; jp < 2; ++jp) V_##b[q][jp] = ((const GAS u32x4*)src)[NIP(jp)]; } \
            if (COMB) S_[q] = lane < 16 ? ((const GAS int*)(ws + WS_POS))[(size_t)rr * 16 + lane] : -1; } } while (0)
    constexpr int rstep = NWAVES * NRW;
    const int ngrp = nrows / rstep;
    unsigned Gd = (unsigned)G; asm volatile("" : "+s"(Gd));
    int r0 = (int)((unsigned)(vcu * ngrp) / Gd) * rstep + wave * NRW;
    const int rend = (int)((unsigned)((vcu + 1) * ngrp) / Gd) * rstep;
    int mr_cur = -1; f32x4 shv[4], scv[4], m5v[4];
#pragma unroll
    for (int j = 0; j < 4; ++j) { shv[j] = (f32x4){0.f, 0.f, 0.f, 0.f}; scv[j] = shv[j]; m5v[j] = shv[j]; }
    if (r0 < rend) NORM_LOAD(r0, vn, slotn);
    for (; r0 < rend; r0 += rstep) {
        int row[NRW], mr[NRW]; f32x4 v[NRW][4]; int slot[NRW];
#pragma unroll
        for (int q = 0; q < NRW; ++q) {
            int rr = r0 + q; NORM_ROWMAP(rr);
            row[q] = rr;
            const int b = rr / RPB, t = rr - b * RPB;
            mr[q] = t < SEQ ? b : 8;
            slot[q] = slotn[q];
#pragma unroll
            for (int j = 0; j < 4; ++j) {
                if constexpr (WHICH == 0) v[q][j] = vn[q][j];
                else { const u32x4 t4 = vnb[q][j >> 1]; const unsigned ta = (j & 1) ? t4.z : t4.x, tb = (j & 1) ? t4.w : t4.y; v[q][j] = (f32x4){__uint_as_float(ta << 16), __uint_as_float(ta & 0xffff0000u), __uint_as_float(tb << 16), __uint_as_float(tb & 0xffff0000u)}; }
            }
        }
        if (mr[0] != mr_cur) {
            mr_cur = mr[0];
            if (WHICH != 3) { const float* shift = mods + (size_t)(layer * 9 + mr_cur) * 6144 + (WHICH <= 1 ? 0 : 3) * 1024;
#pragma unroll
                for (int j = 0; j < 4; ++j) { shv[j] = ((const GAS f32x4*)shift)[NIX(j)]; scv[j] = ((const GAS f32x4*)(shift + 1024))[NIX(j)]; } }
            if (WHICH == 1 || WHICH == 3) { const float* m5 = mods + (size_t)((WHICH == 3 ? 3 : layer - 1) * 9 + mr_cur) * 6144 + 5 * 1024;
#pragma unroll
                for (int j = 0; j < 4; ++j) m5v[j] = ((const GAS f32x4*)m5)[NIX(j)]; }
#pragma unroll
            for (int j = 0; j < 4; ++j) asm volatile("" : "+v"(shv[j]), "+v"(scv[j]), "+v"(m5v[j]));
        }
        if (r0 + rstep < rend) NORM_LOAD(r0 + rstep, vn, slotn);
        if (WHICH == 1 || WHICH == 3) {
            const int pl = WHICH == 3 ? 3 : layer - 1;
            const float* gatev = (const float*)(ws + WS_GATE);
            const bf16_t* Y = (const bf16_t*)(ws + WS_B2);
#pragma unroll
            for (int q = 0; q < NRW; ++q) { if (slot[q] >= NSLOT) slot[q] = -1; }
            unsigned long long mskq[NRW]; int sl4[NRW][4]; u32x4 yv4[NRW][4][2];
#pragma unroll
            for (int q = 0; q < NRW; ++q) { mskq[q] = __ballot(slot[q] >= 0);
#pragma unroll
                for (int i = 0; i < 4; ++i) { sl4[q][i] = -1;
                    if (mskq[q]) { const int e = __builtin_ctzll(mskq[q]); mskq[q] &= mskq[q] - 1; sl4[q][i] = __builtin_amdgcn_readlane(slot[q], e); } } }
#pragma unroll
            for (int q = 0; q < NRW; ++q)
#pragma unroll
                for (int i = 0; i < 4; ++i) if (sl4[q][i] >= 0) { const bf16_t* yr = Y + (size_t)sl4[q][i] * 1024;
#pragma unroll
                    for (int jp = 0; jp < 2; ++jp) yv4[q][i][jp] = ((const GAS u32x4*)yr)[NIP(jp)]; }
#pragma unroll
            for (int q = 0; q < NRW; ++q) {
                f32x4 acc[4];
#pragma unroll
                for (int j = 0; j < 4; ++j) acc[j] = (f32x4){0.f, 0.f, 0.f, 0.f};
#pragma unroll
                for (int i = 0; i < 4; ++i) if (sl4[q][i] >= 0) {
#pragma unroll
                    for (int j = 0; j < 4; ++j) { const u32x4 y4 = yv4[q][i][j >> 1]; const u32x2 yv = (j & 1) ? (u32x2){y4.z, y4.w} : (u32x2){y4.x, y4.y};
                        acc[j][0] += __uint_as_float(yv.x << 16); acc[j][1] += __uint_as_float(yv.x & 0xffff0000u); acc[j][2] += __uint_as_float(yv.y << 16); acc[j][3] += __uint_as_float(yv.y & 0xffff0000u); } }
                unsigned long long msk = mskq[q];
                while (msk) {
                    const int e = __builtin_ctzll(msk); msk &= msk - 1;
                    const int sl = __builtin_amdgcn_readlane(slot[q], e);
                    const bf16_t* yr = Y + (size_t)sl * 1024;
#pragma unroll
                    for (int j = 0; j < 4; ++j) { const u32x2 yv = ((const GAS u32x2*)yr)[NIX(j)];
                        acc[j][0] += __uint_as_float(yv.x << 16); acc[j][1] += __uint_as_float(yv.x & 0xffff0000u); acc[j][2] += __uint_as_float(yv.y << 16); acc[j][3] += __uint_as_float(yv.y & 0xffff0000u); }
                }
#pragma unroll
                for (int j = 0; j < 4; ++j) v[q][j] = v[q][j] + m5v[j] * acc[j];
            }
        }
        if (WHICH == 1) {
#pragma unroll
            for (int q = 0; q < NRW; ++q) { bf16_t* hb = (bf16_t*)(ws + WS_HB) + (size_t)row[q] * D;
#pragma unroll
                for (int jp = 0; jp < 2; ++jp) ((GAS u32x4*)hb)[NIP(jp)] = (u32x4){pg8::cvt_pk_bf16(v[q][2 * jp][0], v[q][2 * jp][1]), pg8::cvt_pk_bf16(v[q][2 * jp][2], v[q][2 * jp][3]), pg8::cvt_pk_bf16(v[q][2 * jp + 1][0], v[q][2 * jp + 1][1]), pg8::cvt_pk_bf16(v[q][2 * jp + 1][2], v[q][2 * jp + 1][3])}; }
        }
        if (WHICH == 3) {
#pragma unroll
            for (int q = 0; q < NRW; ++q) { const int b = row[q] / RPB, t = row[q] - b * RPB; float* orow = p.out + (size_t)(b * SEQ + t) * D;
#pragma unroll
                for (int j = 0; j < 4; ++j) ((GAS f32x4*)orow)[NIX(j)] = v[q][j]; }
        }
        if (WHICH == 3) continue;
        {
            float rs[NRW];
#pragma unroll
            for (int q = 0; q < NRW; ++q) {
                float ss = 0.f;
#pragma unroll
                for (int j = 0; j < 4; ++j) ss += v[q][j][0] * v[q][j][0] + v[q][j][1] * v[q][j][1] + v[q][j][2] * v[q][j][2] + v[q][j][3] * v[q][j][3];
                ss = wave_sum(ss);
                rs[q] = rsqrtf(ss * (1.f / 1024.f) + EPS);
            }
#pragma unroll
            for (int j = 0; j < 4; ++j) {
                const f32x4 sh = shv[j], sc = scv[j];
#pragma unroll
                for (int q = 0; q < NRW; ++q) v[q][j] = v[q][j] * rs[q] * sc + sh;
            }
#pragma unroll
            for (int q = 0; q < NRW; ++q)
#pragma unroll
                for (int jp = 0; jp < 2; ++jp)
                    ((GAS u32x4*)((bf16_t*)(ws + WS_U) + (size_t)row[q] * 1024))[NIP(jp)] = (u32x4){pg8::cvt_pk_bf16(v[q][2 * jp][0], v[q][2 * jp][1]), pg8::cvt_pk_bf16(v[q][2 * jp][2], v[q][2 * jp][3]), pg8::cvt_pk_bf16(v[q][2 * jp + 1][0], v[q][2 * jp + 1][1]), pg8::cvt_pk_bf16(v[q][2 * jp + 1][2], v[q][2 * jp + 1][3])};
        }
        if (WHICH == 2) {
#pragma unroll
            for (int q = 0; q < NRW; ++q) {
                LAS unsigned char* th = ut_hi + (wave * 2 + q) * UT_PITCH; LAS unsigned char* tl = ut_lo + (wave * 2 + q) * UT_PITCH;
#pragma unroll
                for (int j = 0; j < 4; ++j) {
                    const unsigned h01 = pg8::cvt_pk_bf16(v[q][j][0], v[q][j][1]), h23 = pg8::cvt_pk_bf16(v[q][j][2], v[q][j][3]);
                    const float l0 = v[q][j][0] - __uint_as_float(h01 << 16), l1 = v[q][j][1] - __uint_as_float(h01 & 0xffff0000u), l2 = v[q][j][2] - __uint_as_float(h23 << 16), l3 = v[q][j][3] - __uint_as_float(h23 & 0xffff0000u);
                    *(LAS u32x2*)(th + NIX(j) * 8) = (u32x2){h01, h23};
                    *(LAS u32x2*)(tl + NIX(j) * 8) = (u32x2){pg8::cvt_pk_bf16(l0, l1), pg8::cvt_pk_bf16(l2, l3)};
                }
            }
            __syncthreads();
            {
                const int fr = lane & 15, fq = lane >> 4;
                bf16x8 xh[4], xl[4];
#pragma unroll
                for (int ks = 0; ks < 4; ++ks) { xh[ks] = *(const LAS bf16x8*)(ut_hi + fr * UT_PITCH + (128 * wave + 32 * ks + 8 * fq) * 2); xl[ks] = *(const LAS bf16x8*)(ut_lo + fr * UT_PITCH + (128 * wave + 32 * ks + 8 * fq) * 2); }
                f32x4 pc = (f32x4){0.f, 0.f, 0.f, 0.f};
#pragma unroll
                for (int ks = 0; ks < 4; ++ks) { pc = __builtin_amdgcn_mfma_f32_16x16x32_bf16(wfh[ks], xh[ks], pc, 0, 0, 0); pc = __builtin_amdgcn_mfma_f32_16x16x32_bf16(wfl[ks], xh[ks], pc, 0, 0, 0); pc = __builtin_amdgcn_mfma_f32_16x16x32_bf16(wfh[ks], xl[ks], pc, 0, 0, 0); }
                *(LAS f32x4*)(rpart0 + (rstepi & 1) * 2048 + (wave * 16 + fr) * 16 + 4 * fq) = pc;
            }
            __syncthreads();
            if (tid < 256) {
                const int rr_ = tid >> 4, ee = tid & 15;
                float x = 0.f;
#pragma unroll
                for (int w8 = 0; w8 < 8; ++w8) x += rpart0[(rstepi & 1) * 2048 + (w8 * 16 + rr_) * 16 + ee];
                float mx = x; mx = fmaxf(mx, swz_xor<1>(mx)); mx = fmaxf(mx, swz_xor<2>(mx)); mx = fmaxf(mx, swz_xor<4>(mx)); mx = fmaxf(mx, swz_xor<8>(mx));
                const float ex = expf(x - mx);
                float sm = ex; sm += swz_xor<1>(sm); sm += swz_xor<2>(sm); sm += swz_xor<4>(sm); sm += swz_xor<8>(sm);
                int grow = (r0 - wave * NRW) + rr_;
                NORM_ROWMAP(grow);
                ((GAS float*)(ws + WS_AFF))[(size_t)grow * 16 + ee] = ex / sm;
            }
            ++rstepi;
        }
    }
    if (WHICH == 2) __syncthreads();
#undef NORM_ROWMAP
#undef NORM_LOAD
#undef NIX
#undef NIP
}

__device__ __forceinline__ void phase_qkprep(const P& p, int layer, int vcu, int G, const int wv_) {
    unsigned char* ws = p.ws; asm volatile("" : "+s"(ws));
    const int tid = (wv_ << 6) | hw_tid();
    const int lane = tid & 63, wave = wv_;
    const int li = layer >> 1;
    const float* tab = (const float*)(ws + WS_ROPE);
    for (int wid = vcu * NWAVES + wave; wid < NR * 26; wid += G * NWAVES) {
        const int row = wid / 26, hs = wid - row * 26;
        int col; const float* g; bool rope;
        if (hs < 8) { col = hs * 64; g = p.a_q_norm + li * 64; rope = true; }
        else if (hs < 10) { col = 512 + (hs - 8) * 64; g = p.a_k_norm + li * 64; rope = true; }
        else if (hs < 18) { col = 768 + (hs - 10) * 64; g = p.b_q_norm + li * 64; rope = false; }
        else { col = 1280 + (hs - 18) * 64; g = p.b_k_norm + li * 64; rope = false; }
        bf16_t* q = (bf16_t*)(ws + WS_B1) + (size_t)row * 2304 + col;
        const float x = bf2f(q[lane]);
        const float ss = wave_sum(x * x);
        float y = x * rsqrtf(ss * (1.f / 64.f) + EPS) * g[lane];
        const int b = row / RPB, t = row - b * RPB;
        if (rope && t < SEQ) {
            const int half = lane >> 5, j = lane & 31;
            const int pos = half == 0 ? (t >> 6) : (t & 63);
            const float cs = tab[pos * 16 + (j & 15)], sn = tab[1024 + pos * 16 + (j & 15)];
            const float other = swz_xor<16>(y);
            y = y * cs + (j < 16 ? -other : other) * sn;
        }
        if (hs < 8 || (hs >= 10 && hs < 18)) y *= 0.18033688011112042f;
        q[lane] = (bf16_t)f2bf(y);
    }
}

namespace attn_body {
using bf16=unsigned short;
using bf16x8=__attribute__((ext_vector_type(8)))short;
using s16x4=__attribute__((ext_vector_type(4)))short;
using f32x16=__attribute__((ext_vector_type(16)))float;
using u32x4=__attribute__((ext_vector_type(4)))unsigned;
constexpr int D=64;
constexpr int NW=8,QBLK=32,QB=QBLK*NW,KVBLK=64;
__device__ __forceinline__ int crow(int r,int hi){return (r&3)+8*(r>>2)+4*hi;}
#define SBAR() __builtin_amdgcn_sched_barrier(0)
#define CINIT (MODE==1?f32x16{}:negm)
struct NaArgs { int ctx_row0, win_row0, r0, wr0; };
constexpr int LDS_NAT_OFF = 86016;
__device__ __forceinline__ void na_mask(f32x16&p0,f32x16&p1,int j,const NaArgs&na,const char*shm,int wid,int r32,int hi,float mhat){
  const float NEG=-INFINITY;
  const int r=na.r0+(wid>>1), c=32*(wid&1)+r32;
  int rs=r-4; rs=rs<0?0:(rs>56?56:rs);
  int cs=c-8; cs=cs<0?0:(cs>48?48:cs);
  const int kr=na.wr0+j, di=kr-rs;
  if(di<0||di>=8){
    #pragma unroll
    for(int q=0;q<16;++q){p0[q]=NEG;p1[q]=NEG;}
  } else {
    const int dr=kr-r+7;
    const float*T=reinterpret_cast<const float*>(shm+LDS_NAT_OFF)+dr*128+63-c+4*hi;
    const int a=4*hi-cs;
    #pragma unroll
    for(int q=0;q<16;++q){ const int kc0=(q&3)+8*(q>>2);
      const float b0=T[kc0], b1=T[kc0+32];
      p0[q]=((unsigned)(a+kc0)<16u)?p0[q]+(b0-mhat):NEG; p1[q]=((unsigned)(a+kc0+32)<16u)?p1[q]+(b1-mhat):NEG;
      if((q&1)==1) SBAR(); }
  }
}
constexpr int NSLOT=3, SLOTB=8192;
constexpr int LDS_K=0, LDS_V=NSLOT*SLOTB, LDS_WS=2*NSLOT*SLOTB, LDS_OST=LDS_WS+NW*64*4, LDS_BYTES=LDS_OST+NW*4096;
constexpr float C2=0.125f*1.4426950408889634f;
__device__ __forceinline__ void glds16(const void*gsrc,unsigned lds_dst){unsigned keep;
  asm volatile("s_mov_b32 %0, m0\n\ts_mov_b32 m0, %2\n\ts_nop 0\n\tglobal_load_lds_dwordx4 %1, off\n\ts_mov_b32 m0, %0":"=&s"(keep):"v"(gsrc),"s"(lds_dst):"memory");}
__device__ __forceinline__ float max3f(float a,float b,float c){float r;asm("v_max3_f32 %0, %1, %2, %3":"=v"(r):"v"(a),"v"(b),"v"(c));return r;}
__device__ __forceinline__ float max2f(float a,float b){float r;asm("v_max_f32_e32 %0, %1, %2":"=v"(r):"v"(a),"v"(b));return r;}
__device__ __forceinline__ float fadd_s(float a,float b){float r;asm("v_add_f32_e32 %0, %1, %2":"=v"(r):"v"(a),"v"(b));return r;}
__device__ __forceinline__ float fsub_s(float a,float b){float r;asm("v_sub_f32_e32 %0, %1, %2":"=v"(r):"v"(a),"v"(b));return r;}
typedef float f32x2_t __attribute__((ext_vector_type(2))); typedef __bf16 bf16x2_t __attribute__((ext_vector_type(2)));
__device__ __forceinline__ unsigned cvtpk_s(float lo,float hi){f32x2_t v={lo,hi};bf16x2_t b=__builtin_convertvector(v,bf16x2_t);return __builtin_bit_cast(unsigned,b);}
#define WAIT_BAR(N) asm volatile("s_waitcnt vmcnt(" #N ") lgkmcnt(0)\n\ts_barrier":::"memory")

__device__ __forceinline__ void qkt(f32x16&p0,f32x16&p1,const char*Kslot,const bf16x8*qr,const f32x16&negm,int r32,int hi){
  const char*kb=Kslot+hi*1024+r32*16;
  #pragma unroll
  for(int d0=0;d0<4;++d0){
    const bf16x8 b0=*reinterpret_cast<const bf16x8*>(kb+d0*2048);
    const bf16x8 b1=*reinterpret_cast<const bf16x8*>(kb+d0*2048+512);
    if(d0==0){p0=__builtin_amdgcn_mfma_f32_32x32x16_bf16(b0,qr[0],negm,0,0,0);p1=__builtin_amdgcn_mfma_f32_32x32x16_bf16(b1,qr[0],negm,0,0,0);}
    else{p0=__builtin_amdgcn_mfma_f32_32x32x16_bf16(b0,qr[d0],p0,0,0,0);p1=__builtin_amdgcn_mfma_f32_32x32x16_bf16(b1,qr[d0],p1,0,0,0);}}
}
typedef __attribute__((address_space(3))) const char* lds_cptr;
typedef short v4i16_t __attribute__((ext_vector_type(4)));
__device__ __forceinline__ void kload8(bf16x8*kf,lds_cptr kp){
  kf[0]=*(const __attribute__((address_space(3))) bf16x8*)(kp);      kf[1]=*(const __attribute__((address_space(3))) bf16x8*)(kp+512);
  kf[2]=*(const __attribute__((address_space(3))) bf16x8*)(kp+2048); kf[3]=*(const __attribute__((address_space(3))) bf16x8*)(kp+2560);
  kf[4]=*(const __attribute__((address_space(3))) bf16x8*)(kp+4096); kf[5]=*(const __attribute__((address_space(3))) bf16x8*)(kp+4608);
  kf[6]=*(const __attribute__((address_space(3))) bf16x8*)(kp+6144); kf[7]=*(const __attribute__((address_space(3))) bf16x8*)(kp+6656);
}
__device__ __forceinline__ void kload2(bf16x8*kf,lds_cptr kp,int j){ kf[2*j]=*(const __attribute__((address_space(3))) bf16x8*)(kp+j*2048); kf[2*j+1]=*(const __attribute__((address_space(3))) bf16x8*)(kp+j*2048+512); }
__device__ __forceinline__ s16x4 vtr(lds_cptr p){ return __builtin_bit_cast(s16x4,__builtin_amdgcn_ds_read_tr16_b64_v4i16((__attribute__((address_space(3))) v4i16_t*)p)); }
__device__ __forceinline__ float rowmax(const f32x16&p0,const f32x16&p1){
  float a=max3f(p0[0],p0[1],p1[0]),b=max3f(p0[2],p0[3],p1[1]);a=max3f(a,p1[2],p1[3]);
  #pragma unroll
  for(int r=4;r<16;r+=4){a=max3f(a,p0[r],p0[r+1]);b=max3f(b,p0[r+2],p0[r+3]);a=max3f(a,p1[r],p1[r+1]);b=max3f(b,p1[r+2],p1[r+3]);}
  const float m=max2f(a,b);
  auto rr=__builtin_amdgcn_permlane32_swap(__float_as_uint(m),__float_as_uint(m),false,false);
  return max2f(__uint_as_float(rr[0]),__uint_as_float(rr[1]));
}
__device__ __forceinline__ void pv(f32x16*o,int vb,bf16x8 pa0,bf16x8 pa1,bf16x8 pa2,bf16x8 pa3){
  #pragma unroll
  for(int d0=0;d0<2;++d0){s16x4 lo[4],hi[4];
    #pragma unroll
    for(int ks=0;ks<4;++ks){
      asm volatile("ds_read_b64_tr_b16 %0,%1 offset:%c2":"=&v"(lo[ks]):"v"(vb),"i"(d0*4096+ks*1024):"memory");
      asm volatile("ds_read_b64_tr_b16 %0,%1 offset:%c2":"=&v"(hi[ks]):"v"(vb),"i"(d0*4096+ks*1024+512):"memory");}
    asm volatile("s_waitcnt lgkmcnt(0)":::"memory");SBAR();
    #define PK(k) (bf16x8){lo[k][0],lo[k][1],lo[k][2],lo[k][3],hi[k][0],hi[k][1],hi[k][2],hi[k][3]}
    o[d0]=__builtin_amdgcn_mfma_f32_32x32x16_bf16(pa0,PK(0),o[d0],0,0,0);
    o[d0]=__builtin_amdgcn_mfma_f32_32x32x16_bf16(pa1,PK(1),o[d0],0,0,0);
    o[d0]=__builtin_amdgcn_mfma_f32_32x32x16_bf16(pa2,PK(2),o[d0],0,0,0);
    o[d0]=__builtin_amdgcn_mfma_f32_32x32x16_bf16(pa3,PK(3),o[d0],0,0,0);
    #undef PK
  }
}

#ifndef ATTN_STORE16
#define ATTN_STORE16(p,v) (*(u32x4*)(p)=(v))
#endif
template<int THRL,int QP,int OP,int MODE> __device__ __forceinline__ void attn_unit(const bf16*Qu,const bf16*__restrict__ Kh,const bf16*__restrict__ Vh,bf16*Ou,const int NT,char*shm,const int wid,const int lane,const NaArgs na){
  const int r32=lane&31,hi=lane>>5;
  const bf16*Qw=Qu+(long)(wid*QBLK)*QP;
  const unsigned lds0=(unsigned)(uintptr_t)shm;
  float*wsf=(float*)(shm+LDS_WS)+wid*64;
  const bf16*ksrc=Kh+(long)lane*QP+wid*8;
  const bf16*vsrc=Vh+(long)(16*(wid&3)+(lane>>2))*QP+(wid>>2)*32+(lane&3)*8;
  const unsigned kdst=lds0+LDS_K+wid*1024, vdst=lds0+LDS_V+wid*1024;
  #define TROW(t) (MODE==0?(long)(t)*KVBLK:((t)<4?(long)na.ctx_row0+(long)(t)*KVBLK:(long)na.win_row0+(long)((t)-4)*KVBLK))
  #define DMA_K(t,slot) glds16(ksrc+TROW(t)*QP,(unsigned)__builtin_amdgcn_readfirstlane(kdst+(slot)))
  #define DMA_V(t,slot) glds16(vsrc+TROW(t)*QP,(unsigned)__builtin_amdgcn_readfirstlane(vdst+(slot)))
  const int vb0=(int)(lds0+LDS_V)+((lane>>4)&1)*32+(lane&3)*8+(4*hi+((lane&15)>>2))*64;
  const char*Kbase=shm+LDS_K; bf16x8 kf[8];
  const lds_cptr shm3=(lds_cptr)shm; const lds_cptr kp0=shm3+LDS_K+hi*1024+r32*16; const lds_cptr vp0=shm3+LDS_V+((lane>>4)&1)*32+(lane&3)*8+(4*hi+((lane&15)>>2))*64;
  DMA_K(0,0);DMA_V(0,0);DMA_K(1,SLOTB);
  bf16x8 qr[4];
  #pragma unroll
  for(int d0=0;d0<4;++d0)qr[d0]=*reinterpret_cast<const bf16x8*>(&Qw[(long)r32*QP+d0*16+hi*8]);
  float mhat=0.f,l_reg=0.f;f32x16 o[2],negm; { float z_=0.f; asm volatile("":"+v"(z_));
    _Pragma("unroll") for(int r=0;r<16;++r){o[0][r]=z_;o[1][r]=z_;negm[r]=z_;} } if(MODE==0)asm volatile("":"+v"(negm));
  #define CMASK(P0,P1,t) do{ if(MODE==1){ if((t)>=4) na_mask(P0,P1,(t)-4,na,shm,wid,r32,hi,mhat); else { _Pragma("unroll") for(int r_=0;r_<16;++r_){P0[r_]-=mhat;P1[r_]-=mhat;} } } }while(0)
  bool resc=false;
  #define START(P0,P1) do{ const float rm=rowmax(P0,P1); resc=false; \
    { const float dl=rm; mhat=fadd_s(mhat,dl); \
      _Pragma("unroll") for(int r=0;r<16;++r){P0[r]=fsub_s(P0[r],dl);P1[r]=fsub_s(P1[r],dl);} \
      if(MODE==0){ _Pragma("unroll") for(int r=0;r<16;++r)negm[r]=-mhat; asm volatile("":"+v"(negm)); } } \
    _Pragma("unroll") for(int r=0;r<16;++r)P0[r]=__builtin_amdgcn_exp2f(P0[r]); }while(0)
  #define RESC() do{ if(resc){ asm volatile("s_waitcnt lgkmcnt(0)":::"memory"); \
      _Pragma("unroll") for(int d_=0;d_<2;++d_) _Pragma("unroll") for(int r=0;r<16;++r)o[d_][r]*=wsf[crow(r,hi)]; } }while(0)
  f32x16 pA0,pA1,pB0,pB1;
  int sl_prev=0,sl_cur=0,sl_next=SLOTB;
  #define ROT() do{sl_prev=sl_cur;sl_cur=sl_next;sl_next=(sl_next==(NSLOT-1)*SLOTB)?0:sl_next+SLOTB;}while(0)
  DMA_K(2,2*SLOTB);
  WAIT_BAR(3);
  qkt(pA0,pA1,Kbase,qr,CINIT,r32,hi);asm volatile("s_nop 15\n\ts_nop 7":"+v"(pA0),"+v"(pA1));CMASK(pA0,pA1,0);
  START(pA0,pA1);
  _Pragma("unroll") for(int r=0;r<16;++r)pA1[r]=__builtin_amdgcn_exp2f(pA1[r]);
  WAIT_BAR(0);
  DMA_K(3,0);DMA_V(1,SLOTB);
  ROT();
  kload8(kf,kp0+sl_cur);
  WAIT_BAR(2);
  s16x4 vlo[8],vhi[8]; u32x4 pw0,pw1,pw2,pw3;
  #define PKW(P,B) cvtpk_s(P[B],P[B+1])
  #define PAF(k) __builtin_bit_cast(bf16x8,pw##k)
  #define VFR(i) (bf16x8){vlo[i][0],vlo[i][1],vlo[i][2],vlo[i][3],vhi[i][0],vhi[i][1],vhi[i][2],vhi[i][3]}
  #define PIN(x) asm volatile("":"+v"(x))
  #define MX3(a,b,c) __builtin_fmaxf(__builtin_fmaxf((a),(b)),(c))
  #define GAPA(MF,A0,A1,A2,A3,W0,W1,PW) do{ MF; sacc+=A0; sacc+=A1; sacc+=A2; sacc+=A3; PIN(sacc); W0; W1; PIN(PW); SBAR(); }while(0)
  #define EX(v) __builtin_amdgcn_exp2f(v)
  #define GAPB(MF,X,B) do{ MF; X[B]=EX(X[B]); X[B+1]=EX(X[B+1]); X[B+2]=EX(X[B+2]); X[B+3]=EX(X[B+3]); PIN(X); SBAR(); }while(0)
  #define VRD(i) do{ vlo[i]=vtr(vp_+(((i)>>2)*4096+((i)&3)*1024)); vhi[i]=vtr(vp_+(((i)>>2)*4096+((i)&3)*1024+512)); }while(0)
  #define KRD(G,j) do{ if(G){ kload2(kf,kp0+sl_next,j); SBAR(); } }while(0)
  #define STEP(C0,C1,P0,P1,t,GK,GV,GL) do{ SBAR(); \
    const lds_cptr vp_=vp0+sl_prev; \
    VRD(0); SBAR(); float sacc=(P0[0]+P0[1]); \
    GAPA(C0=__builtin_amdgcn_mfma_f32_32x32x16_bf16(kf[0],qr[0],CINIT,0,0,0), P0[2],P0[3],P0[4],P0[5],     pw0[0]=PKW(P0,0), pw0[1]=PKW(P0,2), pw0); \
    VRD(4); SBAR(); GAPA(C1=__builtin_amdgcn_mfma_f32_32x32x16_bf16(kf[1],qr[0],CINIT,0,0,0), P0[6],P0[7],P0[8],P0[9],     pw0[2]=PKW(P0,4), pw0[3]=PKW(P0,6), pw0); \
    VRD(1); SBAR(); GAPA(C0=__builtin_amdgcn_mfma_f32_32x32x16_bf16(kf[2],qr[1],C0,0,0,0),   P0[10],P0[11],P0[12],P0[13], pw1[0]=PKW(P0,8), pw1[1]=PKW(P0,10), pw1); \
    VRD(5); SBAR(); GAPA(C1=__builtin_amdgcn_mfma_f32_32x32x16_bf16(kf[3],qr[1],C1,0,0,0),   P0[14],P0[15],P1[0],P1[1],   pw1[2]=PKW(P0,12),pw1[3]=PKW(P0,14), pw1); \
    VRD(2); SBAR(); GAPA(C0=__builtin_amdgcn_mfma_f32_32x32x16_bf16(kf[4],qr[2],C0,0,0,0),   P1[2],P1[3],P1[4],P1[5],     pw2[0]=PKW(P1,0), pw2[1]=PKW(P1,2), pw2); \
    VRD(6); SBAR(); GAPA(C1=__builtin_amdgcn_mfma_f32_32x32x16_bf16(kf[5],qr[2],C1,0,0,0),   P1[6],P1[7],P1[8],P1[9],     pw2[2]=PKW(P1,4), pw2[3]=PKW(P1,6), pw2); \
    VRD(3); SBAR(); GAPA(C0=__builtin_amdgcn_mfma_f32_32x32x16_bf16(kf[6],qr[3],C0,0,0,0),   P1[10],P1[11],P1[12],P1[13], pw3[0]=PKW(P1,8), pw3[1]=PKW(P1,10), pw3); \
    VRD(7); SBAR(); GAPA(C1=__builtin_amdgcn_mfma_f32_32x32x16_bf16(kf[7],qr[3],C1,0,0,0),   P1[14],P1[15],0.f,0.f,       pw3[2]=PKW(P1,12),pw3[3]=PKW(P1,14), pw3); \
    l_reg+=sacc; \
    if(GK){DMA_K((t)+3,sl_cur);} if(GV){DMA_V((t)+1,sl_next);} \
    CMASK(C0,C1,t); \
    { float a=MX3(C0[0],C0[1],C1[0]),b=MX3(C0[2],C0[3],C1[1]); a=MX3(a,C1[2],C1[3]); \
      _Pragma("unroll") for(int r=4;r<16;r+=4){a=MX3(a,C0[r],C0[r+1]);b=MX3(b,C0[r+2],C0[r+3]);a=MX3(a,C1[r],C1[r+1]);b=MX3(b,C1[r+2],C1[r+3]);} \
      float rm=__builtin_fmaxf(a,b); { auto rr=__builtin_amdgcn_permlane32_swap(__float_as_uint(rm),__float_as_uint(rm),false,false); rm=__builtin_fmaxf(__uint_as_float(rr[0]),__uint_as_float(rr[1])); } \
      resc=false; \
      if(__builtin_expect(__any(rm>(float)THRL),0)){ const float dl=__builtin_fmaxf(rm,0.f); mhat+=dl; \
        _Pragma("unroll") for(int r=0;r<16;++r){C0[r]-=dl;C1[r]-=dl;} \
        if(MODE==0){ _Pragma("unroll") for(int r=0;r<16;++r)negm[r]=-mhat; asm volatile("":"+v"(negm)); } \
        const float f=__builtin_amdgcn_exp2f(-dl); l_reg*=f; if(hi==0)wsf[r32]=f; resc=true; } } \
    SBAR(); \
    GAPB(o[0]=__builtin_amdgcn_mfma_f32_32x32x16_bf16(PAF(0),VFR(0),o[0],0,0,0), C0,0); \
    GAPB(o[1]=__builtin_amdgcn_mfma_f32_32x32x16_bf16(PAF(0),VFR(4),o[1],0,0,0), C0,4); \
    KRD(GL,0); GAPB(o[0]=__builtin_amdgcn_mfma_f32_32x32x16_bf16(PAF(1),VFR(1),o[0],0,0,0), C0,8); \
    KRD(GL,1); GAPB(o[1]=__builtin_amdgcn_mfma_f32_32x32x16_bf16(PAF(1),VFR(5),o[1],0,0,0), C0,12); \
    KRD(GL,2); GAPB(o[0]=__builtin_amdgcn_mfma_f32_32x32x16_bf16(PAF(2),VFR(2),o[0],0,0,0), C1,0); \
    KRD(GL,3); GAPB(o[1]=__builtin_amdgcn_mfma_f32_32x32x16_bf16(PAF(2),VFR(6),o[1],0,0,0), C1,4); \
    GAPB(o[0]=__builtin_amdgcn_mfma_f32_32x32x16_bf16(PAF(3),VFR(3),o[0],0,0,0), C1,8); \
    GAPB(o[1]=__builtin_amdgcn_mfma_f32_32x32x16_bf16(PAF(3),VFR(7),o[1],0,0,0), C1,12); \
    }while(0)
  int t=1;
  for(;t+5<NT;t+=2){
    STEP(pB0,pB1,pA0,pA1,t,true,true,true);     WAIT_BAR(2); RESC(); ROT();
    STEP(pA0,pA1,pB0,pB1,t+1,true,true,true);   WAIT_BAR(2); RESC(); ROT();
  }
  #define ENDW(tt) do{ if((tt)+3<NT){WAIT_BAR(2);} else if((tt)+2<NT){WAIT_BAR(1);} else {WAIT_BAR(0);} }while(0)
  for(;t+1<NT;t+=2){
    STEP(pB0,pB1,pA0,pA1,t,(t+3<NT),(t+1<NT),(t+1<NT));       ENDW(t);   RESC(); ROT();
    STEP(pA0,pA1,pB0,pB1,t+1,(t+4<NT),(t+2<NT),(t+2<NT));     ENDW(t+1); RESC(); ROT();
  }
  STEP(pB0,pB1,pA0,pA1,NT-1,false,false,false); RESC();
  { float sacc=pB0[0]+pB0[1]; _Pragma("unroll") for(int r=2;r<16;++r)sacc+=pB0[r]; _Pragma("unroll") for(int r=0;r<16;++r)sacc+=pB1[r]; l_reg+=sacc;
    pw0=(u32x4){PKW(pB0,0),PKW(pB0,2),PKW(pB0,4),PKW(pB0,6)};pw1=(u32x4){PKW(pB0,8),PKW(pB0,10),PKW(pB0,12),PKW(pB0,14)};pw2=(u32x4){PKW(pB1,0),PKW(pB1,2),PKW(pB1,4),PKW(pB1,6)};pw3=(u32x4){PKW(pB1,8),PKW(pB1,10),PKW(pB1,12),PKW(pB1,14)};
    SBAR(); pv(o,vb0+sl_cur,PAF(0),PAF(1),PAF(2),PAF(3)); }
  #undef PKW
  #undef PAF
  #undef VFR
  #undef PIN
  #undef MX3
  #undef GAPA
  #undef GAPB
  #undef EX
  #undef VRD
  #undef KRD
  #undef STEP
  #undef ENDW
  {auto rr=__builtin_amdgcn_permlane32_swap(__float_as_uint(l_reg),__float_as_uint(l_reg),false,false);l_reg=__uint_as_float(rr[0])+__uint_as_float(rr[1]);}
  if(hi==0)wsf[32+r32]=l_reg;asm volatile("s_waitcnt lgkmcnt(0)":::"memory");
  float rli[16];
  #pragma unroll
  for(int r=0;r<16;++r)rli[r]=__builtin_amdgcn_rcpf(wsf[32+crow(r,hi)]);
  bf16*Ow=Ou+(long)(wid*QBLK)*OP;
  { bf16*stg=(bf16*)(shm+LDS_OST)+wid*2048;
    #pragma unroll
    for(int r=0;r<16;++r){const int orow=crow(r,hi);
      #pragma unroll
      for(int d0=0;d0<2;++d0)stg[orow*64+d0*32+r32]=(bf16)f2bf(o[d0][r]*rli[r]);}
    asm volatile("s_waitcnt lgkmcnt(0)":::"memory");
    #pragma unroll
    for(int i=0;i<4;++i){const int row=i*8+(lane>>3),ch=lane&7; const u32x4 v=*(const u32x4*)(stg+row*64+ch*8); ATTN_STORE16(Ow+(long)row*OP+ch*8,v);} }
  asm volatile("s_waitcnt lgkmcnt(0)\n\ts_barrier":::"memory");
  #undef DMA_K
  #undef DMA_V
  #undef TROW
  #undef CMASK
  #undef START
  #undef RESC
  #undef ROT
}
#undef SBAR
#undef WAIT_BAR
}

__device__ __forceinline__ void phase_attn_dense(const P& p, char* shm, int vcu, int G, const int wv_) {
    unsigned char* ws = p.ws; asm volatile("" : "+s"(ws));
    const int lane = hw_tid();
    const attn_body::bf16* QKV = (const attn_body::bf16*)(ws + WS_B1);
    attn_body::bf16* O = (attn_body::bf16*)(ws + WS_B2);
    const attn_body::NaArgs na{0, 0, 0, 0};
    for (int L = vcu; L < 1024 + 128; L += G) {
        size_t qo, ko, vo, oo; int ntile;
        if (L < 1024) {
            const int i = L >> 8, v = L & 255, xcd = v >> 5, j = v & 31;
            const int grp = 2 * xcd + (i >> 1), b = grp >> 1, kvh = grp & 1, u = (i & 1) * 32 + j, h = kvh * 4 + (u >> 4), qb = u & 15;
            const size_t rb = (size_t)b * RPB;
            qo = (rb + qb * 256) * 2304 + 64 * h; ko = rb * 2304 + 512 + 64 * kvh; vo = rb * 2304 + 640 + 64 * kvh; oo = (rb + qb * 256) * 1024 + 64 * h; ntile = 68;
        } else {
            const int u = L - 1024, typ = u >> 6, b = (u >> 3) & 7, h = u & 7;
            const size_t rc = (size_t)b * RPB + SEQ;
            const int qcol = typ ? 768 + 64 * h : 64 * h, kcol = typ ? 1280 + 64 * h : 512 + 64 * (h >> 2), vcol = typ ? 1792 + 64 * h : 640 + 64 * (h >> 2), ocol = typ ? 512 + 64 * h : 64 * h;
            qo = rc * 2304 + qcol; ko = rc * 2304 + kcol; vo = rc * 2304 + vcol; oo = rc * 1024 + ocol; ntile = 4;
        }
        attn_body::attn_unit<8, 2304, 1024, 0>(QKV + qo, QKV + ko, QKV + vo, O + oo, ntile, shm, wv_, lane, na);
    }
}

__device__ __forceinline__ void phase_attn_na(const P& p, int layer, char* shm, int vcu, int G, const int wv_) {
    unsigned char* ws = p.ws; asm volatile("" : "+s"(ws));
    const int lane = hw_tid(), tid = (wv_ << 6) | lane;
    const attn_body::bf16* QKV = (const attn_body::bf16*)(ws + WS_B1);
    attn_body::bf16* O = (attn_body::bf16*)(ws + WS_B2);
    float* T = (float*)(shm + attn_body::LDS_NAT_OFF);
    for (int L = vcu; L < 1024; L += G) {
        const int i = L >> 8, v = L & 255, xcd = v >> 5, j = v & 31;
        const int grp = (i * 8 + xcd) * 2 + (j >> 4), rblk = j & 15, b = grp >> 3, h = grp & 7;
        const float* rpb = p.na_rpb + (size_t)((layer >> 1) * 8 + h) * 15 * 31;
        for (int e = tid; e < 15 * 128; e += NTHR) { const int dr = e >> 7, d = (e & 127) - 63; T[e] = (d >= -15 && d <= 15) ? rpb[dr * 31 + d + 15] * 1.4426950408889634f : -INFINITY; }
        const int r0 = rblk * 4; int wr0 = r0 - 4; wr0 = wr0 < 0 ? 0 : (wr0 > 52 ? 52 : wr0);
        const size_t rb = (size_t)b * RPB;
        const attn_body::NaArgs na{SEQ, wr0 * 64, r0, wr0};
        attn_body::attn_unit<8, 2304, 1024, 1>(QKV + (rb + r0 * 64) * 2304 + 768 + 64 * h, QKV + rb * 2304 + 1280 + 64 * h, QKV + rb * 2304 + 1792 + 64 * h, O + (rb + r0 * 64) * 1024 + 512 + 64 * h, 16, shm, wv_, lane, na);
    }
}

__device__ __forceinline__ int gla_o256(int row, int ch) { return row * 256 + ((ch ^ (row & 15)) << 4); }
__device__ __forceinline__ int gla_o128(int row, int ch) { return (row >> 1) * 256 + (((((row & 1) << 3) | ch) ^ ((row >> 1) & 7)) << 4); }
__device__ __forceinline__ int gla_task(int b, int h, int dir, int s) { return ((b * 4 + h) * 2 + dir) * 68 + s; }
__device__ __forceinline__ int gla_rowc(int b, int dir, int s) { return b * RPB + (s < 4 ? SEQ + 64 * (dir ? 3 - s : s) : 64 * (dir ? 67 - s : s - 4)); }

__device__ __forceinline__ void phase_gla_pre(const P& p, int layer, LAS unsigned char* lds, int vcu, int G, const int wv_) {
    unsigned char* ws = p.ws; asm volatile("" : "+s"(ws));
    const int lane = hw_tid(), tid = (wv_ << 6) | lane, fr = lane & 15, fq = lane >> 4;
    constexpr int L_QD = 0, L_KI = 16384, L_KST = 32768, L_A = 49152, L_SB = 57344, SB_BYTES = 36864, SB_K = 16384, SB_Z = 32768, L_CL = RING_BYTES + 8192;
    static_assert(L_SB + 2 * SB_BYTES <= RING_BYTES && L_CL + 512 <= LDS_BYTES, "gla pre LDS map");
    LAS unsigned char* qd = lds + L_QD; LAS unsigned char* ki = lds + L_KI; LAS unsigned char* ksT = lds + L_KST; LAS unsigned char* Al = lds + L_A;
    LAS float* cls = (LAS float*)(lds + L_CL);
    const unsigned lds0 = (unsigned)(size_t)lds;
    const int li = layer >> 1;
    const bf16_t* X = (const bf16_t*)(ws + WS_B1);
    const float* Z = (const float*)(ws + WS_Z);
    const int pd = 16 * wv_ + fr;
#define GLAP_TASK(i_, bhd_, s_) const int bhd_ = ((i_) & 255) >> 2, s_ = 17 * ((i_) & 3) + ((i_) >> 8)
#define GLAP_DMA(i_, buf_) do { GLAP_TASK((i_), bhd__, s__); const int dir__ = bhd__ & 1, h__ = (bhd__ >> 1) & 3, b__ = bhd__ >> 3; const int rc_ = gla_rowc(b__, dir__, s__); \
        const unsigned sb_ = lds0 + L_SB + (unsigned)(buf_) * SB_BYTES; \
        _Pragma("unroll") for (int jj = 0; jj < 4; ++jj) { const int j = 4 * wv_ + jj;        \
            pg8::glds16_s((const char*)(X + (size_t)(rc_ + 4 * (j & 15)) * 3072 + h__ * 128 + (j >> 4) * 512), (unsigned)((lane >> 4) * 6144 + (((lane & 15) ^ (2 * (j & 3))) << 4)), sb_ + (unsigned)j * 1024u); } \
        if (wv_ < 4) pg8::glds16_s((const char*)(Z + (size_t)(rc_ + 16 * wv_) * 32 + dir__ * 16), (unsigned)((lane >> 2) * 128 + (lane & 3) * 16), sb_ + SB_Z + (unsigned)wv_ * 1024u); } while (0)
    int ti = vcu, kk_ = 0;
    if (ti < 4352) GLAP_DMA(ti, 0);
    int bhd_cur = -1; bf16x8 wx1 = (bf16x8){0, 0, 0, 0, 0, 0, 0, 0}, wx2 = wx1; float gbias = 0.f;
    for (; ti < 4352; ti += G, ++kk_) {
        GLAP_TASK(ti, bhd, s_chunk);
        const int dir = bhd & 1, h = (bhd >> 1) & 3, t = bhd * 68 + s_chunk;
        if (bhd != bhd_cur) {
            bhd_cur = bhd;
            const float* gw = (dir ? p.gk_w_b : p.gk_w_f) + (size_t)li * 16 * 512 + h * 128 + pd + (size_t)(8 * (fq & 1)) * 512;
            float wv8[8];
#pragma unroll
            for (int e = 0; e < 8; ++e) wv8[e] = gw[e * 512];
            gbias = ((dir ? p.gk_b_b : p.gk_b_f) + li * 512)[h * 128 + pd];
            unsigned hh[4], ll[4];
#pragma unroll
            for (int e = 0; e < 4; ++e) { hh[e] = pg8::cvt_pk_bf16(wv8[2 * e], wv8[2 * e + 1]);
                ll[e] = pg8::cvt_pk_bf16(wv8[2 * e] - __uint_as_float(hh[e] << 16), wv8[2 * e + 1] - __uint_as_float(hh[e] & 0xffff0000u)); if (fq >= 2) ll[e] = 0u; }
            wx1 = __builtin_bit_cast(bf16x8, (u32x4){hh[0], hh[1], hh[2], hh[3]}); wx2 = __builtin_bit_cast(bf16x8, (u32x4){ll[0], ll[1], ll[2], ll[3]});
        }
        if (kk_ == 0) asm volatile("s_waitcnt vmcnt(0)" ::: "memory"); else asm volatile("s_waitcnt vmcnt(5)" ::: "memory");
        __syncthreads();
        if (ti + G < 4352) GLAP_DMA(ti + G, (kk_ + 1) & 1);
        LAS unsigned char* sb = lds + L_SB + (kk_ & 1) * SB_BYTES;
        {
            float c[16];
#pragma unroll
            for (int T = 0; T < 4; ++T) {
                const LAS f32x4* zp = (const LAS f32x4*)(sb + SB_Z + (16 * T + fr) * 64 + (fq & 1) * 32);
                const f32x4 za = zp[0], zb = zp[1];
                unsigned zy[4];
#pragma unroll
                for (int e = 0; e < 4; ++e) { const float z0 = e < 2 ? za[2 * e] : zb[2 * e - 4], z1 = e < 2 ? za[2 * e + 1] : zb[2 * e - 3];
                    const unsigned hz = pg8::cvt_pk_bf16(z0, z1), lz = pg8::cvt_pk_bf16(z0 - __uint_as_float(hz << 16), z1 - __uint_as_float(hz & 0xffff0000u)); zy[e] = fq < 2 ? hz : lz; }
                const bf16x8 zf = __builtin_bit_cast(bf16x8, (u32x4){zy[0], zy[1], zy[2], zy[3]});
                f32x4 xa = (f32x4){gbias, gbias, gbias, gbias};
                xa = __builtin_amdgcn_mfma_f32_16x16x32_bf16(zf, wx1, xa, 0, 0, 0);
                xa = __builtin_amdgcn_mfma_f32_16x16x32_bf16(zf, wx2, xa, 0, 0, 0);
#pragma unroll
                for (int i = 0; i < 4; ++i) { const float x = xa[i];
                    const float l = __builtin_amdgcn_logf(1.f + __builtin_amdgcn_exp2f(-fabsf(x) * 1.4426950408889634f));
                    c[4 * T + i] = (fminf(x, 0.f) * 1.4426950408889634f - l) * (1.f / 16.f); }
            }
            float cl = 0.f;
            if (dir == 0) {
#pragma unroll
                for (int T = 0; T < 4; ++T) {
                    c[4 * T + 1] += c[4 * T]; c[4 * T + 2] += c[4 * T + 1]; c[4 * T + 3] += c[4 * T + 2];
                    const float R = c[4 * T + 3];
                    const float p1 = swz_xor<16>(R), pair = R + p1;
                    auto rr = __builtin_amdgcn_permlane32_swap(__float_as_uint(pair), __float_as_uint(pair), false, false);
                    const float q = __uint_as_float(fq >= 2 ? rr[0] : rr[1]);
                    const float ex = ((fq & 1) ? p1 : 0.f) + ((fq & 2) ? q : 0.f) + cl;
#pragma unroll
                    for (int i = 0; i < 4; ++i) c[4 * T + i] += ex;
                    cl += pair + q;
                }
            } else {
#pragma unroll
                for (int T = 3; T >= 0; --T) {
                    c[4 * T + 2] += c[4 * T + 3]; c[4 * T + 1] += c[4 * T + 2]; c[4 * T] += c[4 * T + 1];
                    const float R = c[4 * T];
                    const float p1 = swz_xor<16>(R), pair = R + p1;
                    auto rr = __builtin_amdgcn_permlane32_swap(__float_as_uint(pair), __float_as_uint(pair), false, false);
                    const float q = __uint_as_float(fq >= 2 ? rr[0] : rr[1]);
                    const float ex = ((fq & 1) ? 0.f : p1) + ((fq & 2) ? 0.f : q) + cl;
#pragma unroll
                    for (int i = 0; i < 4; ++i) c[4 * T + i] += ex;
                    cl += pair + q;
                }
            }
            if (fq == 0) cls[pd] = cl;
            const float qs = 0.08838834764831845f, ecl = __builtin_amdgcn_exp2f(cl);
            const int dch = pd >> 3, dlo = (pd & 7) * 2;
            const LAS unsigned char* qsrc = sb + fq * 1024 + ((dch ^ (2 * fq)) << 4) + dlo;
#pragma unroll
            for (int T = 0; T < 4; ++T) {
                unsigned kw[2];
#pragma unroll
                for (int i = 0; i < 4; i += 2) {
                    const int n = 4 * T + i;
                    const float c0 = c[n], c1 = c[n + 1];
                    const float e0 = __builtin_amdgcn_exp2f(c0), e1 = __builtin_amdgcn_exp2f(c1);
                    const float r0 = __builtin_amdgcn_rcpf(e0), r1 = __builtin_amdgcn_rcpf(e1);
                    const float q0 = bf2f(*(const LAS bf16_t*)(qsrc + 4096 * T + 256 * i)), q1 = bf2f(*(const LAS bf16_t*)(qsrc + 4096 * T + 256 * (i + 1)));
                    const float k0 = bf2f(*(const LAS bf16_t*)(qsrc + SB_K + 4096 * T + 256 * i)), k1 = bf2f(*(const LAS bf16_t*)(qsrc + SB_K + 4096 * T + 256 * (i + 1)));
                    const int tk0 = 16 * T + 4 * fq + i;
                    const unsigned qq = pg8::cvt_pk_bf16(q0 * qs * e0, q1 * qs * e1), kk2 = pg8::cvt_pk_bf16(k0 * r0, k1 * r1);
                    *(LAS bf16_t*)(qd + gla_o256(tk0, dch) + dlo) = (bf16_t)(qq & 0xffffu); *(LAS bf16_t*)(qd + gla_o256(tk0 + 1, dch) + dlo) = (bf16_t)(qq >> 16);
                    *(LAS bf16_t*)(ki + gla_o256(tk0, dch) + dlo) = (bf16_t)(kk2 & 0xffffu); *(LAS bf16_t*)(ki + gla_o256(tk0 + 1, dch) + dlo) = (bf16_t)(kk2 >> 16);
                    kw[i >> 1] = pg8::cvt_pk_bf16(k0 * (ecl * r0), k1 * (ecl * r1));
                }
                *(LAS u32x2*)(ksT + gla_o128(pd, 2 * T + (fq >> 1)) + (fq & 1) * 8) = (u32x2){kw[0], kw[1]};
            }
        }
        __syncthreads();
        {
            const int it = wv_ >> 1;
            f32x4 a2[2] = {(f32x4){0.f, 0.f, 0.f, 0.f}, (f32x4){0.f, 0.f, 0.f, 0.f}};
#pragma unroll
            for (int kk = 0; kk < 4; ++kk) {
                const bf16x8 xa = *(const LAS bf16x8*)(qd + gla_o256(16 * it + fr, 4 * kk + fq));
#pragma unroll
                for (int jj = 0; jj < 2; ++jj) { const int jt = 2 * (wv_ & 1) + jj;
                    const bf16x8 yb = *(const LAS bf16x8*)(ki + gla_o256(16 * jt + fr, 4 * kk + fq));
                    a2[jj] = __builtin_amdgcn_mfma_f32_16x16x32_bf16(yb, xa, a2[jj], 0, 0, 0); }
            }
#pragma unroll
            for (int jj = 0; jj < 2; ++jj) { const int jt = 2 * (wv_ & 1) + jj; const int i = 16 * it + fr, j0 = 16 * jt + 4 * fq;
                float m4[4];
#pragma unroll
                for (int cc = 0; cc < 4; ++cc) { const int j = j0 + cc; const bool keep = dir ? (j >= i) : (j <= i); m4[cc] = keep ? a2[jj][cc] : 0.f; }
                *(LAS u32x2*)(Al + gla_o128(i, j0 >> 3) + (j0 & 7) * 2) = (u32x2){pg8::cvt_pk_bf16(m4[0], m4[1]), pg8::cvt_pk_bf16(m4[2], m4[3])}; }
        }
        __syncthreads();
        {
            GAS u32x4* gq = (GAS u32x4*)(ws + WS_GQD + (size_t)t * 16384); GAS u32x4* gk = (GAS u32x4*)(ws + WS_GKS + (size_t)t * 16384); GAS u32x4* ga = (GAS u32x4*)(ws + WS_GA + (size_t)t * 8192); GAS u32x4* gc = (GAS u32x4*)(ws + WS_GCL + (size_t)t * 512);
            gq[tid] = *(const LAS u32x4*)(qd + tid * 16); gq[tid + 512] = *(const LAS u32x4*)(qd + (tid + 512) * 16);
            gk[tid] = *(const LAS u32x4*)(ksT + tid * 16); gk[tid + 512] = *(const LAS u32x4*)(ksT + (tid + 512) * 16);
            ga[tid] = *(const LAS u32x4*)(Al + tid * 16);
            if (tid < 32) gc[tid] = *(const LAS u32x4*)((LAS unsigned char*)cls + tid * 16);
        }
        __syncthreads();
    }
    asm volatile("s_waitcnt vmcnt(0)" ::: "memory");
#undef GLAP_DMA
#undef GLAP_TASK
}

__device__ __forceinline__ void phase_gla_scan(const P& p, int layer, LAS unsigned char* lds, int vcu, int G, const int wv_) {
    unsigned char* ws = p.ws; asm volatile("" : "+s"(ws));
    const int lane = hw_tid(), tid = (wv_ << 6) | lane, fr = lane & 15, fq = lane >> 4;
    constexpr int B_QD = 0, B_KST = 16384, B_A = 32768, B_V = 40960, B_CL = 49152, BUF = 50176, L_ST = 2 * BUF;
    static_assert(L_ST + 16384 <= RING_BYTES, "gla scan LDS map");
    LAS unsigned char* ST = lds + L_ST;
    const unsigned lds0 = (unsigned)(size_t)lds;
    const bf16_t* X = (const bf16_t*)(ws + WS_B1);
    for (int u = vcu; u < 256; u += G) {
        const int b = u >> 5, h = (u >> 3) & 3, dir = (u >> 2) & 1, sl = u & 3;
        bf16_t* O = (bf16_t*)(ws + WS_B2) + (dir ? (size_t)68 * MiB / 2 : 0);
        const int tk0 = gla_task(b, h, dir, 0);
        f32x4 sacc[4];
#pragma unroll
        for (int et = 0; et < 4; ++et) sacc[et] = (f32x4){0.f, 0.f, 0.f, 0.f};
        for (int e = tid; e < 4096; e += NTHR) ((LAS unsigned*)ST)[e] = 0u;
#define GLAS_DMA(s_) do { const int s__ = (s_); const unsigned bo_ = lds0 + (unsigned)((s__ & 1) * BUF); const size_t tk_ = (size_t)(tk0 + s__); const unsigned lo_ = (unsigned)lane * 16u; \
            pg8::glds16_s((const char*)(ws + WS_GQD) + tk_ * 16384 + (2 * wv_) * 1024, lo_, bo_ + B_QD + (2 * wv_) * 1024); pg8::glds16_s((const char*)(ws + WS_GQD) + tk_ * 16384 + (2 * wv_ + 1) * 1024, lo_, bo_ + B_QD + (2 * wv_ + 1) * 1024); \
            pg8::glds16_s((const char*)(ws + WS_GKS) + tk_ * 16384 + (2 * wv_) * 1024, lo_, bo_ + B_KST + (2 * wv_) * 1024); pg8::glds16_s((const char*)(ws + WS_GKS) + tk_ * 16384 + (2 * wv_ + 1) * 1024, lo_, bo_ + B_KST + (2 * wv_ + 1) * 1024); \
            pg8::glds16_s((const char*)(ws + WS_GA) + tk_ * 8192 + wv_ * 1024, lo_, bo_ + B_A + wv_ * 1024); \
            pg8::glds16_s((const char*)(X + (size_t)(gla_rowc(b, dir, s__) + 8 * wv_) * 3072 + 1024 + h * 256 + sl * 64), (unsigned)((lane >> 3) * 6144 + (((lane & 7) ^ (2 * (((lane >> 4) & 1) | ((wv_ & 1) << 1)))) << 4)), bo_ + B_V + wv_ * 1024); \
            if (wv_ == 0 && lane < 32) pg8::glds16_s((const char*)(ws + WS_GCL) + tk_ * 512, lo_, bo_ + B_CL); } while (0)
        GLAS_DMA(0); GLAS_DMA(1);
        __syncthreads();
#pragma unroll 1
        for (int s = 0; s < 68; ++s) {
            LAS unsigned char* bq = lds + (s & 1) * BUF;
            const int rowc = gla_rowc(b, dir, s);
            if (s == 0) asm volatile("s_waitcnt vmcnt(6)" ::: "memory");
            else if (s == 1) { if (wv_ == 0) asm volatile("s_waitcnt vmcnt(9)" ::: "memory"); else asm volatile("s_waitcnt vmcnt(8)" ::: "memory"); }
            else if (s + 1 < 68) { if (wv_ == 0) asm volatile("s_waitcnt vmcnt(11)" ::: "memory"); else asm volatile("s_waitcnt vmcnt(10)" ::: "memory"); }
            else asm volatile("s_waitcnt vmcnt(4)" ::: "memory");
            __syncthreads();
            {
                const int it = wv_ >> 1, e0 = 2 * (wv_ & 1);
                bf16x8 fa[2], fq4[4], fv[2][4], fs[4][2], fk[2];
                typedef short s4v __attribute__((ext_vector_type(4)));
                const int tq = fr >> 2, tp = fr & 3, fx = ((tq >> 1) & 1) | ((fq & 1) << 1);
                LAS unsigned char* vb = bq + B_V + (8 * fq + tq) * 128 + tp * 8;
#pragma unroll
                for (int kk = 0; kk < 2; ++kk) { fa[kk] = *(const LAS bf16x8*)(bq + B_A + gla_o128(16 * it + fr, 4 * kk + fq)); fk[kk] = *(const LAS bf16x8*)(bq + B_KST + gla_o128(16 * wv_ + fr, 4 * kk + fq));
#pragma unroll
                    for (int et = 0; et < 4; ++et) { LAS unsigned char* va = vb + kk * 4096 + ((et ^ fx) << 5);
                        const s4v lo4 = __builtin_amdgcn_ds_read_tr16_b64_v4i16((LAS s4v*)va), hi4 = __builtin_amdgcn_ds_read_tr16_b64_v4i16((LAS s4v*)(va + 512));
                        fv[kk][et] = __builtin_shufflevector(lo4, hi4, 0, 1, 2, 3, 4, 5, 6, 7); }
 }
#pragma unroll
                for (int kk = 0; kk < 4; ++kk) { fq4[kk] = *(const LAS bf16x8*)(bq + B_QD + gla_o256(16 * it + fr, 4 * kk + fq));
#pragma unroll
                    for (int jj = 0; jj < 2; ++jj) fs[kk][jj] = *(const LAS bf16x8*)(ST + gla_o256(16 * (e0 + jj) + fr, 4 * kk + fq)); }
                const f32x4 clv = *(const LAS f32x4*)(bq + B_CL + (16 * wv_ + 4 * fq) * 4);
                asm volatile("s_waitcnt lgkmcnt(0)" ::: "memory");
                __syncthreads();
                if (s + 2 < 68) GLAS_DMA(s + 2);
                f32x4 o2[2] = {(f32x4){0.f, 0.f, 0.f, 0.f}, (f32x4){0.f, 0.f, 0.f, 0.f}};
                if (wv_ & 1) {
#pragma unroll
                    for (int kk = 0; kk < 2; ++kk)
#pragma unroll
                        for (int jj = 0; jj < 2; ++jj) o2[jj] = __builtin_amdgcn_mfma_f32_16x16x32_bf16(fv[kk][2 + jj], fa[kk], o2[jj], 0, 0, 0);
                } else {
#pragma unroll
                    for (int kk = 0; kk < 2; ++kk)
#pragma unroll
                        for (int jj = 0; jj < 2; ++jj) o2[jj] = __builtin_amdgcn_mfma_f32_16x16x32_bf16(fv[kk][jj], fa[kk], o2[jj], 0, 0, 0);
                }
#pragma unroll
                for (int kk = 0; kk < 4; ++kk)
#pragma unroll
                    for (int jj = 0; jj < 2; ++jj) o2[jj] = __builtin_amdgcn_mfma_f32_16x16x32_bf16(fs[kk][jj], fq4[kk], o2[jj], 0, 0, 0);
                const f32x4 dec = (f32x4){__builtin_amdgcn_exp2f(clv[0]), __builtin_amdgcn_exp2f(clv[1]), __builtin_amdgcn_exp2f(clv[2]), __builtin_amdgcn_exp2f(clv[3])};
#pragma unroll
                for (int et = 0; et < 4; ++et) sacc[et] = sacc[et] * dec;
#pragma unroll
                for (int kk = 0; kk < 2; ++kk)
#pragma unroll
                    for (int et = 0; et < 4; ++et) sacc[et] = __builtin_amdgcn_mfma_f32_16x16x32_bf16(fk[kk], fv[kk][et], sacc[et], 0, 0, 0);
#pragma unroll
                for (int jj = 0; jj < 2; ++jj) { const int et = e0 + jj;
                    *(GAS u32x2*)(O + (size_t)(rowc + 16 * it + fr) * 1024 + h * 256 + sl * 64 + 16 * et + 4 * fq) = (u32x2){pg8::cvt_pk_bf16(o2[jj][0], o2[jj][1]), pg8::cvt_pk_bf16(o2[jj][2], o2[jj][3])}; }
            }
#pragma unroll
            for (int et = 0; et < 4; ++et) { const int d0 = 16 * wv_ + 4 * fq; *(LAS u32x2*)(ST + gla_o256(16 * et + fr, d0 >> 3) + (d0 & 7) * 2) = (u32x2){pg8::cvt_pk_bf16(sacc[et][0], sacc[et][1]), pg8::cvt_pk_bf16(sacc[et][2], sacc[et][3])}; }
        }
        __syncthreads();
#undef GLAS_DMA
    }
}

__device__ __forceinline__ float half_sum(float v) { v += swz_xor<1>(v); v += swz_xor<2>(v); v += swz_xor<4>(v); v += swz_xor<8>(v); v += swz_xor<16>(v); return v; }
__device__ __forceinline__ void phase_gla_merge(const P& p, int layer, int vcu, int G, const int wv_) {
    unsigned char* ws = p.ws; asm volatile("" : "+s"(ws));
    const int lane = hw_tid(), wave = wv_;
    constexpr int NRW = 4;
    const bf16_t* OF = (const bf16_t*)(ws + WS_B2); const bf16_t* OB = OF + (size_t)68 * MiB / 2; bf16_t* O = (bf16_t*)(ws + WS_B2);
    const bf16_t* X = (const bf16_t*)(ws + WS_B1);
    for (int r0 = (vcu * NWAVES + wave) * NRW; r0 < NR; r0 += G * NWAVES * NRW) {
        const float* gnp = p.gla_o_norm + (layer >> 1) * 256 + (lane & 31) * 8;
        const f32x4 gn0 = *(const GAS f32x4*)gnp, gn1 = *(const GAS f32x4*)(gnp + 4);
        u32x4 a[NRW][2], bb[NRW][2], og[NRW][2];
#pragma unroll
        for (int q = 0; q < NRW; ++q)
#pragma unroll
            for (int hp = 0; hp < 2; ++hp) { const size_t i0 = (size_t)(r0 + q) * 1024 + 8 * (lane + 64 * hp);
                a[q][hp] = *(const GAS u32x4*)(OF + i0); bb[q][hp] = *(const GAS u32x4*)(OB + i0); og[q][hp] = *(const GAS u32x4*)(X + (size_t)(r0 + q) * 3072 + 2048 + 8 * (lane + 64 * hp)); }
#pragma unroll
        for (int q = 0; q < NRW; ++q)
#pragma unroll
            for (int hp = 0; hp < 2; ++hp) {
                float x[8]; float sq = 0.f;
#pragma unroll
                for (int w = 0; w < 4; ++w) { const unsigned ua = a[q][hp][w], ub = bb[q][hp][w];
                    x[2 * w] = __uint_as_float(ua << 16) + __uint_as_float(ub << 16); x[2 * w + 1] = __uint_as_float(ua & 0xffff0000u) + __uint_as_float(ub & 0xffff0000u);
                    sq += x[2 * w] * x[2 * w] + x[2 * w + 1] * x[2 * w + 1]; }
                const float rs = rsqrtf(half_sum(sq) * (1.f / 256.f) + EPS);
                unsigned ow[4];
#pragma unroll
                for (int w = 0; w < 4; ++w) { const unsigned ug = og[q][hp][w];
                    const float g0 = (w < 2 ? gn0[2 * w] : gn1[2 * w - 4]), g1 = (w < 2 ? gn0[2 * w + 1] : gn1[2 * w - 3]);
                    ow[w] = pk2(x[2 * w] * rs * g0 * silu_f(__uint_as_float(ug << 16)), x[2 * w + 1] * rs * g1 * silu_f(__uint_as_float(ug & 0xffff0000u))); }
                *(GAS u32x4*)(O + (size_t)(r0 + q) * 1024 + 8 * (lane + 64 * hp)) = (u32x4){ow[0], ow[1], ow[2], ow[3]};
            }
    }
}

__device__ __forceinline__ int wave_sum_i(int v) {
    v += __builtin_amdgcn_ds_swizzle(v, (1 << 10) | 0x1f); v += __builtin_amdgcn_ds_swizzle(v, (2 << 10) | 0x1f); v += __builtin_amdgcn_ds_swizzle(v, (4 << 10) | 0x1f);
    v += __builtin_amdgcn_ds_swizzle(v, (8 << 10) | 0x1f); v += __builtin_amdgcn_ds_swizzle(v, (16 << 10) | 0x1f);
    auto rr = __builtin_amdgcn_permlane32_swap((unsigned)v, (unsigned)v, false, false);
    return (int)(rr[0] + rr[1]);
}
__device__ __forceinline__ void phase_topk(const P& p, LAS unsigned char* lds, int vcu, int G, const int wv_, const int nunits) {
    unsigned char* ws = p.ws; asm volatile("" : "+s"(ws));
    const int lane = hw_tid(), tid = (wv_ << 6) | lane;
    LAS int* red = (LAS int*)lds;
    const float* aff = (const float*)(ws + WS_AFF);
    int* idx = (int*)(ws + WS_IDX); float* gatev = (float*)(ws + WS_GATE); int* pos = (int*)(ws + WS_POS);
    for (int u = vcu; u < nunits; u += G) {
        const int s = u >> 4, e = u & 15, b = s & 7;
        const int n = s < 8 ? SEQ : CTXL, cap = n / 8;
        const int row0 = b * RPB + (s < 8 ? 0 : SEQ);
        unsigned key[8];
#pragma unroll
        for (int k = 0; k < 8; ++k) { const int i = tid * 8 + k; key[k] = i < n ? (__float_as_uint(aff[(size_t)(row0 + i) * 16 + e]) | 0x80000000u) : 0u; }
        unsigned T = 0u;
#pragma unroll 1
        for (int lo = 30; lo >= 0; lo -= 2) {
            const unsigned c1 = T | (1u << lo), c2 = T | (2u << lo), c3 = T | (3u << lo);
            int c = 0;
#pragma unroll
            for (int k = 0; k < 8; ++k) c += (key[k] >= c1 ? 1 : 0) + (key[k] >= c2 ? (1 << 10) : 0) + (key[k] >= c3 ? (1 << 20) : 0);
            c = wave_sum_i(c);
            LAS int* rb = red + ((lo >> 1) & 1) * 8;
            if (lane == 0) rb[wv_] = c;
            __syncthreads();
            int t1 = 0, t2 = 0, t3 = 0;
#pragma unroll
            for (int q = 0; q < 8; ++q) { const int v = rb[q]; t1 += v & 1023; t2 += (v >> 10) & 1023; t3 += (v >> 20) & 1023; }
            T = t3 >= cap ? c3 : (t2 >= cap ? c2 : (t1 >= cap ? c1 : T));
        }
        int mine = 0;
#pragma unroll
        for (int k = 0; k < 8; ++k) mine += (key[k] > T ? 1 : 0) + (key[k] == T ? 0x10000 : 0);
        int inc = mine;
#pragma unroll
        for (int o = 1; o < 64; o <<= 1) { const int t2 = __builtin_amdgcn_ds_bpermute(((lane - o) & 63) << 2, inc); if (lane >= o) inc += t2; }
        __syncthreads();
        if (lane == 63) red[16 + wv_] = inc;
        __syncthreads();
        int base = 0, total = 0;
#pragma unroll
        for (int q = 0; q < 8; ++q) { const int t2 = red[16 + q]; total += t2; if (q < wv_) base += t2; }
        int ex = base + inc - mine;
        const int m = total & 0xffff;
        const int slot0 = (s < 8 ? 0 : NSLOT_LAT) + (e * 8 + b) * cap;
#pragma unroll
        for (int k = 0; k < 8; ++k) {
            const int i = tid * 8 + k;
            if (i < n) {
                const int g = ex & 0xffff, q = ex >> 16;
                int sl = -1;
                if (key[k] > T) sl = g; else if (key[k] == T && m + q < cap) sl = m + q;
                const int row = row0 + i;
                if (sl >= 0) { idx[slot0 + sl] = row; gatev[slot0 + sl] = __uint_as_float(key[k] & 0x7fffffffu); }
                pos[(size_t)row * 16 + e] = sl >= 0 ? slot0 + sl : -1;
                ex += (key[k] > T ? 1 : 0) + (key[k] == T ? 0x10000 : 0);
            }
        }
        __syncthreads();
    }
}

constexpr int N_PHASES = 38;
__global__ void __launch_bounds__(NTHR, 2) mega_fwd(P p) {
    extern __shared__ __attribute__((aligned(16))) unsigned char lds_raw[];
    LAS unsigned char* lds = (LAS unsigned char*)lds_raw;
    volatile LAS unsigned* MISC = (volatile LAS unsigned*)(lds + MISC_OFF);
    const int tid = threadIdx.x;
    const int wv0 = __builtin_amdgcn_readfirstlane(tid >> 6);
    const int G = gridDim.x; const int bx0 = blockIdx.x;
    const int vcu0 = (G % 8 == 0) ? (bx0 % 8) * (G / 8) + bx0 / 8 : bx0;
    for (int u = tid; u < (LDS_BYTES - RING_BYTES) / 4; u += NTHR) ((LAS unsigned*)(lds + RING_BYTES))[u] = 0u;
    __syncthreads();
    const int lo = p.ph_lo, hi = p.ph_hi;
    unsigned* barw = (unsigned*)(p.ws + WS_CTL) + 4096 + p.seg * XCD_BAR_WORDS;
    XcdBarrier bar; bar.bar = barw; bar.x = 0; bar.st = MISC + 8;
    if (hi - lo > 1) bar = xcd_barrier_post(barw, MISC + 8);
#define IN(k) (lo <= (k) && (k) < hi)
#define SEAM(k) do { if ((k) + 1 < hi) xcd_barrier(bar, wv0); } while (0)
    if (IN(0)) { for (int rep_ = 0; rep_ < ((DUP_MASK >> 0) & 1) + 1; ++rep_) { phase_prologue(p, lds, vcu0, G, wv0); } SEAM(0); }
#pragma unroll 1
    for (int layer = 0; layer < 4; ++layer) {
        const int base = 1 + 9 * layer, li = layer >> 1;
        int bx = bx0, vcu = vcu0, wv = wv0; unsigned char* ws = p.ws; asm volatile("" : "+s"(bx), "+s"(vcu), "+s"(ws), "+s"(wv));
        if (IN(base + 0)) { if (layer == 0) phase_norm<0>(p, layer, lds, vcu, G, wv); else phase_norm<1>(p, layer, lds, vcu, G, wv); SEAM(base + 0); }
        if ((layer & 1) == 0) {
            if (IN(base + 1)) {
                pg8::Gemm g{(const bf16_t*)(ws + WS_U), (const bf16_t*)(ws + W_ATTN_IN) + (size_t)li * 2304 * 1024, NR, 2304, nullptr, 0};
                pg8::StaticOrder S; S.init(NR, 2304, G, bx);
                pg8::EpiQKV E{(bf16_t*)(ws + WS_B1), (const float*)(ws + WS_ROPE + 16384) + li * 256, (const float*)(ws + WS_ROPE)};
                for (int rep_ = 0; rep_ < ((DUP_MASK >> 1) & 1) + 1; ++rep_) { pg8::gemm_phase<pg8::EpiQKV, false, false>(lds, g, S, E, wv); }
                if (G == 256 && bx >= 200) moe_window(p, lds, layer, 0, bx - 200, wv);
                SEAM(base + 1);
            }
            if (IN(base + 3)) { for (int rep_ = 0; rep_ < ((DUP_MASK >> 2) & 1) + 1; ++rep_) { phase_attn_dense(p, (char*)lds_raw, vcu, G, wv); phase_attn_na(p, layer, (char*)lds_raw, vcu, G, wv); } SEAM(base + 3); }
        } else {
            if (IN(base + 1)) {
                pg8::Gemm g{(const bf16_t*)(ws + WS_U), (const bf16_t*)(ws + W_GLA_IN) + (size_t)li * 3328 * 1024, NR, 3328, nullptr, 0};
                pg8::StaticOrder S; S.init(NR, 3328, G, bx);
                pg8::EpiGlaIn E{(bf16_t*)(ws + WS_B1), (float*)(ws + WS_Z)};
                for (int rep_ = 0; rep_ < ((DUP_MASK >> 1) & 1) + 1; ++rep_) { pg8::gemm_phase<pg8::EpiGlaIn, false, false>(lds, g, S, E, wv); }
                if (G == 256 && bx >= 232) moe_window(p, lds, layer, 0, bx - 232, wv);
                SEAM(base + 1);
            }
            if (IN(base + 2)) { for (int rep_ = 0; rep_ < ((DUP_MASK >> 3) & 1) + 1; ++rep_) { phase_gla_pre(p, layer, lds, vcu, G, wv); } xcd_barrier(bar, wv0); phase_gla_scan(p, layer, lds, vcu, G, wv); SEAM(base + 2); }
            if (IN(base + 3)) { for (int rep_ = 0; rep_ < ((DUP_MASK >> 4) & 1) + 1; ++rep_) { phase_gla_merge(p, layer, vcu, G, wv); } SEAM(base + 3); }
        }
        if (IN(base + 4)) {
            const bf16_t* A = (const bf16_t*)(ws + WS_B2);
            const bf16_t* Bt = (layer & 1) ? (const bf16_t*)(ws + W_GLA_OUT) + (size_t)li * 1024 * 1024 : (const bf16_t*)(ws + W_ATTN_OUT) + (size_t)li * 1024 * 1024;
            pg8::Gemm g{A, Bt, NR, 1024, nullptr, 0};
            pg8::StaticOrder S; if (layer == 3) S.init(NB * SEQ, 1024, G, bx, 1); else S.init(NR, 1024, G, bx);
            pg8::EpiResid E{(bf16_t*)(ws + WS_HB), (const float*)(ws + WS_MODS) + (size_t)layer * 9 * 6144, layer == 0 ? p.x : nullptr, layer == 0 ? p.ctx : nullptr};
            pg8::gemm_phase<pg8::EpiResid, false, false>(lds, g, S, E, wv);
            if (layer < 3 && G == 256 && bx >= 32) moe_window(p, lds, layer, 1, bx - 32, wv);
            SEAM(base + 4);
        }
        if (IN(base + 5)) { for (int rep_ = 0; rep_ < ((DUP_MASK >> 5) & 1) + 1; ++rep_) { phase_norm<2>(p, layer, lds, vcu, G, wv, layer == 3); } SEAM(base + 5); }
        if (IN(base + 6)) { for (int rep_ = 0; rep_ < ((DUP_MASK >> 6) & 1) + 1; ++rep_) { phase_topk(p, lds, vcu, G, wv, layer == 3 ? 128 : 256); }
            if (G == 256 && vcu >= 128) moe_window(p, lds, layer, 2, vcu - 128, wv);        SEAM(base + 6); }
        if (IN(base + 7)) {
            pg8::Gemm g{(const bf16_t*)(ws + WS_U), (const bf16_t*)(ws + W_MOE_UP) + (size_t)layer * 16 * 2048 * 1024, NSLOT, 2048, (const int*)(ws + WS_IDX), (size_t)2048 * 1024 * 2};
            pg8::StaticOrder S; S.init(layer == 3 ? NSLOT_LAT : NSLOT, 2048, G, bx);
            pg8::EpiSwiGLU E{(bf16_t*)(ws + WS_B1)};
            for (int rep_ = 0; rep_ < ((DUP_MASK >> 7) & 1) + 1; ++rep_) { pg8::gemm_phase<pg8::EpiSwiGLU, true, true>(lds, g, S, E, wv); }
            if (layer < 3 && G == 256 && bx >= 128) moe_window(p, lds, layer, 3, bx - 128, wv);
            SEAM(base + 7);
        }
        if (IN(base + 8)) {
            pg8::Gemm g{(const bf16_t*)(ws + WS_B1), (const bf16_t*)(ws + W_MOE_DN) + (size_t)layer * 16 * 1024 * 1024, NSLOT, 1024, nullptr, (size_t)1024 * 1024 * 2};
            pg8::StaticOrder S; S.init(layer == 3 ? NSLOT_LAT : NSLOT, 1024, G, bx);
            pg8::EpiBf16 E{(bf16_t*)(ws + WS_B2), 1024, (const float*)(ws + WS_GATE)};
            for (int rep_ = 0; rep_ < ((DUP_MASK >> 8) & 1) + 1; ++rep_) { pg8::gemm_phase<pg8::EpiBf16, false, true>(lds, g, S, E, wv); }
            if (layer < 3 && G == 256 && bx >= 64) moe_window(p, lds, layer, 4, bx - 64, wv);
            SEAM(base + 8);
        }
    }
    if (IN(37)) phase_norm<3>(p, 3, lds, vcu0, G, wv0);
#undef IN
#undef SEAM
}
}

extern "C" void kernel_launch(void* const* d_in, const int* in_sizes, int n_in, void* d_out, int out_size, void* d_ws, size_t ws_size, hipStream_t stream) {
    static int grid = 0;
    if (grid == 0) {
        if (ws_size < WS_END) { fprintf(stderr, "kernel_launch: workspace too small: %zu < %zu\n", ws_size, (size_t)WS_END); grid = -1; return; }
        int dev = 0, cus = 0;
        if (hipGetDevice(&dev) != hipSuccess || hipDeviceGetAttribute(&cus, hipDeviceAttributeMultiprocessorCount, dev) != hipSuccess) { grid = -1; return; }
        if (hipFuncSetAttribute((const void*)mega_fwd, hipFuncAttributeMaxDynamicSharedMemorySize, LDS_BYTES) != hipSuccess) { fprintf(stderr, "kernel_launch: hipFuncSetAttribute failed\n"); grid = -1; return; }
        int per_cu = 0;
        if (hipOccupancyMaxActiveBlocksPerMultiprocessor(&per_cu, (const void*)mega_fwd, NTHR, LDS_BYTES) != hipSuccess || per_cu < 1) fprintf(stderr, "kernel_launch: occupancy query reports %d\n", per_cu);
        (void)hipGetLastError();
        grid = cus;
    }
    if (grid < 0) return;
    (void)hipMemsetAsync((char*)d_ws + WS_CTL, 0, CTL_ZERO_BYTES, stream);
    P p{};
    const float** pp = (const float**)&p;
    for (int i = 0; i < 26; ++i) pp[i] = (const float*)d_in[i];
    p.out = (float*)d_out; p.ws = (unsigned char*)d_ws;
    p.ph_lo = 0; p.ph_hi = N_PHASES; p.seg = 0;
    hipLaunchKernelGGL(mega_fwd, dim3(grid), dim3(NTHR), LDS_BYTES, stream, p);
}
```

```cpp
#include <hip/hip_runtime.h>
#include <stdint.h>
#include <math.h>
#include <cstdio>

#ifndef DUP_MASK
#define DUP_MASK 0
#endif

namespace {
#define LAS __attribute__((address_space(3)))
#define GAS __attribute__((address_space(1)))
typedef unsigned short bf16_t;
typedef short bf16x8 __attribute__((ext_vector_type(8)));
typedef float f32x4 __attribute__((ext_vector_type(4)));
typedef unsigned u32x4 __attribute__((ext_vector_type(4)));
typedef unsigned u32x2 __attribute__((ext_vector_type(2)));

constexpr int D = 1024, NB = 8, SEQ = 4096, CTXL = 256, RPB = 4352, NR = NB * RPB;
constexpr int NSLOT_LAT = 65536, NSLOT = 69632;
constexpr int NTHR = 512, NWAVES = 8;
constexpr size_t MiB = 1u << 20;
constexpr size_t WS_CTL = 0, CTL_ZERO_BYTES = 1 * MiB;
constexpr size_t WS_MODS = 2 * MiB;
constexpr size_t WS_ROPE = 3 * MiB;
constexpr size_t WS_AFF = 12 * MiB;
constexpr size_t WS_POS = 15 * MiB;
constexpr size_t WS_IDX = 18 * MiB;
constexpr size_t WS_GATE = 19 * MiB;
constexpr size_t WS_Z = 20 * MiB;
constexpr size_t WS_U = 32 * MiB;
constexpr size_t WS_B1 = 100 * MiB;
constexpr size_t WS_B2 = 304 * MiB;
constexpr size_t WS_HB = WS_B2 + 136 * MiB;
constexpr size_t WS_W = 508 * MiB;
constexpr size_t W_ATTN_IN = WS_W, W_ATTN_OUT = WS_W + 9 * MiB, W_GLA_IN = WS_W + 13 * MiB, W_GLA_OUT = WS_W + 26 * MiB, W_MOE_UP = WS_W + 30 * MiB, W_MOE_DN = WS_W + 286 * MiB;
constexpr size_t WS_GQD = WS_U;
constexpr size_t WS_GKS = WS_W + 414 * MiB;
constexpr size_t WS_GA = WS_GKS + 68 * MiB;
constexpr size_t WS_GCL = WS_GA + 34 * MiB;
constexpr size_t WS_END = WS_GCL + 3 * MiB;
constexpr float EPS = 1e-6f;
constexpr int LDS_BYTES = 147456;
constexpr int RING_BYTES = 131072, MISC_OFF = RING_BYTES + 320;

struct P {
    const float *x, *c, *ctx, *c_ctx, *ada_w, *ada_b, *norm1_g, *norm2_g, *attn_w_in, *attn_w_out,
        *a_q_norm, *a_k_norm, *b_q_norm, *b_k_norm, *na_rpb, *gla_w_in, *gk_w_f, *gk_b_f, *gk_w_b, *gk_b_b,
        *gla_o_norm, *gla_w_out, *moe_router, *moe_w_gate, *moe_w_up, *moe_w_down;
    float* out; unsigned char* ws;
    int ph_lo, ph_hi, seg, pad;
};

__device__ __forceinline__ float bf2f(bf16_t v) { return __uint_as_float(((unsigned)v) << 16); }
__device__ __forceinline__ unsigned f2bf(float f) { unsigned u = __float_as_uint(f); return (u + 0x7fffu + ((u >> 16) & 1u)) >> 16; }
__device__ __forceinline__ unsigned pk2(float lo, float hi) { return f2bf(lo) | (f2bf(hi) << 16); }
__device__ __forceinline__ int hw_tid() {
    int t; asm volatile("v_mbcnt_lo_u32_b32 %0, -1, 0\n\tv_mbcnt_hi_u32_b32 %0, -1, %0" : "=v"(t)); return t;
}
template <int X> __device__ __forceinline__ float swz_xor(float v) { return __uint_as_float((unsigned)__builtin_amdgcn_ds_swizzle((int)__float_as_uint(v), (X << 10) | 0x1f)); }
__device__ __forceinline__ float wave_sum(float v) {
    v += swz_xor<1>(v); v += swz_xor<2>(v); v += swz_xor<4>(v); v += swz_xor<8>(v); v += swz_xor<16>(v);
    auto rr = __builtin_amdgcn_permlane32_swap(__float_as_uint(v), __float_as_uint(v), false, false);
    return __uint_as_float(rr[0]) + __uint_as_float(rr[1]);
}
__device__ __forceinline__ float silu_f(float x) { return x / (1.f + __expf(-x)); }
__device__ __forceinline__ int mod_row(int row) { const int b = row / RPB, t = row - b * RPB; return t < SEQ ? b : 8; }

namespace pg8 {
constexpr int BM = 256, BK = 64, HALF = 128, HTB = HALF * BK * 2, STAGE_BYTES = 8 * HTB, NXCD = 8, WGM = 8;
__device__ __forceinline__ int lds_byte(int r, int c) { const int st = (r >> 4) * 2 + (c >> 5), rr = r & 15, cc = c & 31, ob = rr * 64 + cc * 2; return st * 1024 + (ob ^ (((ob >> 9) & 1) << 5)); }
__device__ __forceinline__ void stage_rc(int b, int& R, int& C) { const int st = b / 1024, sb = b % 1024, swz = sb ^ (((sb >> 9) & 1) << 5); R = (st >> 1) * 16 + swz / 64; C = (st & 1) * 32 + (swz % 64) / 2; }
__device__ __forceinline__ int perm32(int rho) { const int n = rho >> 4, i = rho & 15; return 8 * (i >> 2) + 4 * n + (i & 3); }
struct Unit { int pm, pn; };
struct Gemm { const bf16_t* A; const bf16_t* Bt; int M, N; const int* gather; size_t bgroup; };
struct StaticOrder {
    int nM, nN, nwg, G, c, skip17;
    __device__ void init(int M, int N, int G_, int c_, int skip17_ = 0) { nM = M / BM; nN = N / BM; nwg = nM * nN; G = G_; c = c_; skip17 = skip17_; }
    __device__ bool next(int i, Unit& u) const {
        const long L = (long)i * G + c; if (L >= nwg) return false;
        int wgid = (int)L; { const int q = nwg / NXCD, r = nwg % NXCD, xcd = wgid % NXCD, off = wgid / NXCD; wgid = (xcd < r ? xcd * (q + 1) : r * (q + 1) + (xcd - r) * q) + off; }
        const int nig = WGM * nN, gid = wgid / nig, fm = gid * WGM, gsz = (nM - fm) < WGM ? (nM - fm) : WGM;
        u.pm = fm + ((wgid % nig) % gsz); u.pn = (wgid % nig) / gsz; if (skip17) u.pm += u.pm >> 4; return true;
    }
};
typedef float f32x2_t_ __attribute__((ext_vector_type(2))); typedef __bf16 bf16x2_t_ __attribute__((ext_vector_type(2)));
__device__ __forceinline__ unsigned cvt_pk_bf16(float lo, float hi) { f32x2_t_ v = {lo, hi}; bf16x2_t_ b = __builtin_convertvector(v, bf16x2_t_); return __builtin_bit_cast(unsigned, b); }
__device__ __forceinline__ int expert_of_tile(int pm) { return pm < 256 ? (pm >> 4) : (pm - 256); }

struct EpiBf16 {
    static constexpr bool PERM = true;
    bf16_t* O; int ldc; const float* rowscale;
    __device__ __forceinline__ void operator()(const f32x4 (&acc)[2][2][4][2], const Unit& u, int wr, int wc, int fr, int fq) const {
        const int row0 = u.pm * BM + wr * 64 + fr, col0 = u.pn * BM + wc * 32 + 8 * fq;
#pragma unroll
        for (int ai = 0; ai < 2; ++ai)
#pragma unroll
            for (int m = 0; m < 4; ++m) { bf16_t* rowp = O + (size_t)(row0 + ai * HALF + m * 16) * ldc + col0;
                const float rsc = rowscale ? rowscale[row0 + ai * HALF + m * 16] : 1.f;
#pragma unroll
                for (int bj = 0; bj < 2; ++bj) { const f32x4 v0 = acc[ai][bj][m][0] * rsc, v1 = acc[ai][bj][m][1] * rsc;
                    u32x4 w; w.x = cvt_pk_bf16(v0[0], v0[1]); w.y = cvt_pk_bf16(v0[2], v0[3]); w.z = cvt_pk_bf16(v1[0], v1[1]); w.w = cvt_pk_bf16(v1[2], v1[3]);
                    *(u32x4*)(rowp + bj * HALF) = w; } }
    }
};
struct EpiQKV {
    static constexpr bool PERM = true;
    bf16_t* O; const float* qkg; const float* rope;
    __device__ __forceinline__ void operator()(const f32x4 (&acc)[2][2][4][2], const Unit& u, int wr, int wc, int fr, int fq) const {
        const int sg = 4 * u.pn + wc;
        const int b = u.pm / 17, tt = u.pm - b * 17;
        const int row0 = u.pm * BM + wr * 64 + fr, col0 = sg * 64 + 8 * fq;
        const bool is_q = sg < 8 || (sg >= 12 && sg < 20), is_v = sg == 10 || sg == 11 || sg >= 28;
        const bool do_rope = sg < 10 && tt < 16;
        const float* gp = qkg + 64 * (sg < 8 ? 0 : (sg < 10 ? 1 : (sg < 20 ? 2 : 3)));
        const float qsc = is_q ? 0.18033688011112042f : 1.f;
        const int lane_hi = fq >> 1;
#pragma unroll
        for (int ai = 0; ai < 2; ++ai)
#pragma unroll
            for (int m = 0; m < 4; ++m) {
                f32x4 v[2][2];
                float ss = 0.f;
#pragma unroll
                for (int bj = 0; bj < 2; ++bj)
#pragma unroll
                    for (int n = 0; n < 2; ++n) { v[bj][n] = acc[ai][bj][m][n]; ss += (v[bj][n][0] * v[bj][n][0] + v[bj][n][1] * v[bj][n][1]) + (v[bj][n][2] * v[bj][n][2] + v[bj][n][3] * v[bj][n][3]); }
                if (!is_v) {
                    ss += swz_xor<16>(ss);
                    { auto rr = __builtin_amdgcn_permlane32_swap(__float_as_uint(ss), __float_as_uint(ss), false, false); ss = __uint_as_float(rr[0]) + __uint_as_float(rr[1]); }
                    const float rs = rsqrtf(ss * (1.f / 64.f) + EPS) * qsc;
                    const float* gpl = gp + 8 * fq; asm volatile("" : "+v"(gpl));
#pragma unroll
                    for (int bj = 0; bj < 2; ++bj)
#pragma unroll
                        for (int n = 0; n < 2; ++n) v[bj][n] = v[bj][n] * rs * *(const f32x4*)(gpl + 32 * bj + 4 * n);
                    if (do_rope) {
                        const int posr = tt * 4 + 2 * ai + wr, posc = 16 * m + fr;
#pragma unroll
                        for (int bj = 0; bj < 2; ++bj) {
                            const float* tb = rope + (bj ? posc : posr) * 16 + 8 * (fq & 1);
#pragma unroll
                            for (int n = 0; n < 2; ++n) {
                                const f32x4 cs = *(const f32x4*)(tb + 4 * n), sn = *(const f32x4*)(tb + 1024 + 4 * n);
                                f32x4 ot;
#pragma unroll
                                for (int e = 0; e < 4; ++e) { auto rr = __builtin_amdgcn_permlane32_swap(__float_as_uint(v[bj][n][e]), __float_as_uint(v[bj][n][e]), false, false);
                                    const float other = __uint_as_float(lane_hi ? rr[0] : rr[1]); ot[e] = lane_hi ? other : -other; }
                                v[bj][n] = v[bj][n] * cs + ot * sn;
                            }
                        }
                    }
                }
                bf16_t* rowp = O + (size_t)(row0 + ai * HALF + m * 16) * 2304 + col0;
#pragma unroll
                for (int bj = 0; bj < 2; ++bj) { u32x4 w; w.x = cvt_pk_bf16(v[bj][0][0], v[bj][0][1]); w.y = cvt_pk_bf16(v[bj][0][2], v[bj][0][3]); w.z = cvt_pk_bf16(v[bj][1][0], v[bj][1][1]); w.w = cvt_pk_bf16(v[bj][1][2], v[bj][1][3]);
                    *(u32x4*)(rowp + 32 * bj) = w; }
            }
    }
};
struct EpiGlaIn {
    static constexpr bool PERM = true;
    bf16_t* O; float* Z;
    __device__ __forceinline__ void operator()(const f32x4 (&acc)[2][2][4][2], const Unit& u, int wr, int wc, int fr, int fq) const {
        const int row0 = u.pm * BM + wr * 64 + fr;
        if (u.pn < 12) {
            const int col0 = u.pn * BM + wc * 32 + 8 * fq;
#pragma unroll
            for (int ai = 0; ai < 2; ++ai)
#pragma unroll
                for (int m = 0; m < 4; ++m) { bf16_t* rowp = O + (size_t)(row0 + ai * HALF + m * 16) * 3072 + col0;
#pragma unroll
                    for (int bj = 0; bj < 2; ++bj) { const f32x4 v0 = acc[ai][bj][m][0], v1 = acc[ai][bj][m][1];
                        u32x4 w; w.x = cvt_pk_bf16(v0[0], v0[1]); w.y = cvt_pk_bf16(v0[2], v0[3]); w.z = cvt_pk_bf16(v1[0], v1[1]); w.w = cvt_pk_bf16(v1[2], v1[3]);
                        *(u32x4*)(rowp + bj * HALF) = w; } }
        } else if (wc == 0) {
#pragma unroll
            for (int ai = 0; ai < 2; ++ai)
#pragma unroll
                for (int m = 0; m < 4; ++m) { float* zp = Z + (size_t)(row0 + ai * HALF + m * 16) * 32 + 8 * fq;
                    *(f32x4*)(zp) = acc[ai][0][m][0]; *(f32x4*)(zp + 4) = acc[ai][0][m][1]; }
        }
    }
};
struct EpiResid {
    static constexpr bool PERM = true;
    bf16_t* hb; const float* mods_l; const float* slat; const float* sctx;
    __device__ __forceinline__ void operator()(const f32x4 (&acc)[2][2][4][2], const Unit& u, int wr, int wc, int fr, int fq) const {
        const int b = u.pm / 17, tt = u.pm - b * 17;
        const int mr = tt < 16 ? b : 8;
        const int col0 = u.pn * BM + wc * 32 + 8 * fq;
        bf16_t* base = hb + (size_t)(u.pm * BM + wr * 64 + fr) * D + col0;
        const float* g2 = mods_l + (size_t)mr * 6144 + 2 * 1024 + col0;
        f32x4 gv[2][2];
#pragma unroll
        for (int bj = 0; bj < 2; ++bj)
#pragma unroll
            for (int n = 0; n < 2; ++n) gv[bj][n] = *(const f32x4*)(g2 + bj * HALF + n * 4);
        if (slat != nullptr) {
            const float* sbase = (tt < 16 ? slat + (size_t)(b * SEQ + tt * 256) * D : sctx + (size_t)(b * CTXL) * D) + (size_t)(wr * 64 + fr) * D + col0;
#pragma unroll
            for (int ai = 0; ai < 2; ++ai) {
                f32x4 hv[4][2][2];
#pragma unroll
                for (int m = 0; m < 4; ++m) { const float* rowp = sbase + (size_t)(ai * HALF + m * 16) * D;
#pragma unroll
                    for (int bj = 0; bj < 2; ++bj)
#pragma unroll
                        for (int n = 0; n < 2; ++n) hv[m][bj][n] = *(const f32x4*)(rowp + bj * HALF + n * 4); }
#pragma unroll
                for (int m = 0; m < 4; ++m) { bf16_t* rowp = base + (size_t)(ai * HALF + m * 16) * D;
#pragma unroll
                    for (int bj = 0; bj < 2; ++bj) { const f32x4 r0 = hv[m][bj][0] + gv[bj][0] * acc[ai][bj][m][0], r1 = hv[m][bj][1] + gv[bj][1] * acc[ai][bj][m][1];
                        *(u32x4*)(rowp + bj * HALF) = (u32x4){cvt_pk_bf16(r0[0], r0[1]), cvt_pk_bf16(r0[2], r0[3]), cvt_pk_bf16(r1[0], r1[1]), cvt_pk_bf16(r1[2], r1[3])}; } }
            }
        } else {
#pragma unroll
            for (int ai = 0; ai < 2; ++ai) {
                u32x4 hv[4][2];
#pragma unroll
                for (int m = 0; m < 4; ++m) { const bf16_t* rowp = base + (size_t)(ai * HALF + m * 16) * D;
#pragma unroll
                    for (int bj = 0; bj < 2; ++bj) hv[m][bj] = *(const u32x4*)(rowp + bj * HALF); }
#pragma unroll
                for (int m = 0; m < 4; ++m) { bf16_t* rowp = base + (size_t)(ai * HALF + m * 16) * D;
#pragma unroll
                    for (int bj = 0; bj < 2; ++bj) { const u32x4 t = hv[m][bj];
                        const f32x4 h0 = (f32x4){__uint_as_float(t.x << 16), __uint_as_float(t.x & 0xffff0000u), __uint_as_float(t.y << 16), __uint_as_float(t.y & 0xffff0000u)};
                        const f32x4 h1 = (f32x4){__uint_as_float(t.z << 16), __uint_as_float(t.z & 0xffff0000u), __uint_as_float(t.w << 16), __uint_as_float(t.w & 0xffff0000u)};
                        const f32x4 r0 = h0 + gv[bj][0] * acc[ai][bj][m][0], r1 = h1 + gv[bj][1] * acc[ai][bj][m][1];
                        *(u32x4*)(rowp + bj * HALF) = (u32x4){cvt_pk_bf16(r0[0], r0[1]), cvt_pk_bf16(r0[2], r0[3]), cvt_pk_bf16(r1[0], r1[1]), cvt_pk_bf16(r1[2], r1[3])}; } }
            }
        }
    }
};
struct EpiSwiGLU {
    static constexpr bool PERM = true;
    bf16_t* O;
    __device__ __forceinline__ void operator()(const f32x4 (&acc)[2][2][4][2], const Unit& u, int wr, int wc, int fr, int fq) const {
        const int row0 = u.pm * BM + wr * 64 + fr, col0 = u.pn * HALF + wc * 32 + 8 * fq;
#pragma unroll
        for (int ai = 0; ai < 2; ++ai)
#pragma unroll
            for (int m = 0; m < 4; ++m) { bf16_t* rowp = O + (size_t)(row0 + ai * HALF + m * 16) * 1024 + col0;
                float r[8];
#pragma unroll
                for (int n = 0; n < 2; ++n)
#pragma unroll
                    for (int e = 0; e < 4; ++e) { const float g = acc[ai][0][m][n][e], up = acc[ai][1][m][n][e]; r[n * 4 + e] = g * __builtin_amdgcn_rcpf(1.f + __expf(-g)) * up; }
                u32x4 w; w.x = cvt_pk_bf16(r[0], r[1]); w.y = cvt_pk_bf16(r[2], r[3]); w.z = cvt_pk_bf16(r[4], r[5]); w.w = cvt_pk_bf16(r[6], r[7]);
                *(u32x4*)rowp = w; }
    }
};

__device__ __forceinline__ void glds16_s(const char* sbase, unsigned voff, unsigned lds_dst) { unsigned keep;
    asm volatile("s_nop 4\n\ts_mov_b32 %0, m0\n\ts_mov_b32 m0, %3\n\ts_nop 0\n\tglobal_load_lds_dwordx4 %1, %2\n\ts_mov_b32 m0, %0" : "=&s"(keep) : "v"(voff), "s"(sbase), "s"(lds_dst) : "memory"); }
template <class Epi, bool GATHER, bool GROUPED>
__device__ __forceinline__ void gemm_phase(LAS unsigned char* lds, const Gemm g, const StaticOrder& S, const Epi& E, const int wv_) {
    const int tid = (wv_ << 6) | hw_tid();
    const int wid = wv_, lane = tid & 63, wr = wid >> 2, wc = wid & 3, fr = lane & 15, fq = lane >> 4;
    constexpr int K = 1024, nt = K / BK;
    unsigned voffA[2], voffB[2];
#pragma unroll
    for (int i = 0; i < 2; ++i) { int R, C; stage_rc(tid * 16 + i * 8192, R, C); const int Rb = Epi::PERM ? ((R & ~31) + perm32(R & 31)) : R;
        voffA[i] = (unsigned)(R * K + C) * 2u; voffB[i] = (unsigned)(Rb * K + C) * 2u; }
#define PG8_RA(i) ((int)(voffA[i] >> 11))
#define PG8_CA(i) (voffA[i] & 2047u)
    constexpr size_t kstep = (size_t)(BK * 2);
    constexpr size_t hstep = (size_t)HALF * K * 2;
    constexpr size_t tstep = 2 * hstep;
    const unsigned ldsw = (unsigned)wid * 1024u, lds0 = (unsigned)(size_t)lds;
    const int aoff = lds_byte(wr * 64 + fr, fq * 8), boff = lds_byte(wc * 32 + fr, fq * 8);
#define PG8_SA(b, h) (((b) * 2 + (h)) * HTB)
#define PG8_SB(b, h) ((4 + (b) * 2 + (h)) * HTB)
#define PG8_STAGE_B(bufoff, gbase) do { _Pragma("unroll") for (int _i = 0; _i < 2; ++_i) \
        glds16_s((const char*)(gbase), voffB[_i], lds0 + (unsigned)(bufoff) + ldsw + (unsigned)(_i * 8192)); } while (0)
#define PG8_STAGE_A(bufoff, kp, h, O) do { _Pragma("unroll") for (int _i = 0; _i < 2; ++_i) { \
        if (GATHER) glds16_s((const char*)(kp), (O)[h][_i], lds0 + (unsigned)(bufoff) + ldsw + (unsigned)(_i * 8192)); \
        else glds16_s((const char*)(kp) + (size_t)(h) * hstep, voffA[_i], lds0 + (unsigned)(bufoff) + ldsw + (unsigned)(_i * 8192)); } } while (0)
#define PG8_LDA(dst, b, h) do { _Pragma("unroll") for (int m = 0; m < 4; ++m) _Pragma("unroll") for (int k = 0; k < 2; ++k) dst[m][k] = *(const LAS bf16x8*)(lds + PG8_SA(b, h) + aoff + m * 2048 + k * 1024); } while (0)
#define PG8_LDB(dst, b, h) do { _Pragma("unroll") for (int n = 0; n < 2; ++n) _Pragma("unroll") for (int k = 0; k < 2; ++k) dst[n][k] = *(const LAS bf16x8*)(lds + PG8_SB(b, h) + boff + n * 2048 + k * 1024); } while (0)
#define PG8_MMA(ai, bj, At, Bt) do { __builtin_amdgcn_s_setprio(1); _Pragma("unroll") for (int m = 0; m < 4; ++m) _Pragma("unroll") for (int n = 0; n < 2; ++n) _Pragma("unroll") for (int k = 0; k < 2; ++k) \
        acc[ai][bj][m][n] = __builtin_amdgcn_mfma_f32_16x16x32_bf16(Bt[n][k], At[m][k], acc[ai][bj][m][n], 0, 0, 0); __builtin_amdgcn_s_setprio(0); } while (0)
#define PG8_WAIT_V(n) asm volatile("s_waitcnt vmcnt(" #n ")" ::: "memory")
#define PG8_WAIT_L(n) asm volatile("s_waitcnt lgkmcnt(" #n ")" ::: "memory")
#define PG8_BAR __builtin_amdgcn_s_barrier()
#define PG8_SCHED __builtin_amdgcn_sched_barrier(0)
#define PG8_BOF(u) ((const char*)g.Bt + (GROUPED ? (size_t)expert_of_tile((u).pm) * g.bgroup : (size_t)0) + (size_t)(u).pn * tstep)
#define PG8_AOF(u) (GATHER ? (const char*)g.A : (const char*)g.A + (size_t)(u).pm * tstep)
    Unit cur, nxt; int ui = 0;
    if (!S.next(0, cur)) return;
    unsigned oc[2][2], on[2][2]; unsigned rn[2];
#pragma unroll
    for (int h = 0; h < 2; ++h)
#pragma unroll
        for (int i = 0; i < 2; ++i) { oc[h][i] = 0u; on[h][i] = 0u; rn[h] = 0u; }
    if (GATHER) {
#pragma unroll
        for (int h = 0; h < 2; ++h)
#pragma unroll
            for (int i = 0; i < 2; ++i) { int row = g.gather[cur.pm * BM + h * HALF + PG8_RA(i)]; row = row < 0 ? 0 : (row >= NR ? NR - 1 : row); oc[h][i] = (unsigned)row * (unsigned)(K * 2) + PG8_CA(i); }
    }
    f32x4 acc[2][2][4][2];
#pragma unroll
    for (int a = 0; a < 2; ++a)
#pragma unroll
        for (int b = 0; b < 2; ++b)
#pragma unroll
            for (int m = 0; m < 4; ++m)
#pragma unroll
                for (int n = 0; n < 2; ++n) acc[a][b][m][n] = (f32x4){0.f, 0.f, 0.f, 0.f};
    bf16x8 At[4][2], B0[2][2], B1[2][2];
    const char* cA = PG8_AOF(cur); const char* cB = PG8_BOF(cur);
    PG8_STAGE_B(PG8_SB(0, 0), cB); PG8_STAGE_B(PG8_SB(0, 1), cB + hstep); PG8_STAGE_A(PG8_SA(0, 0), cA, 0, oc); PG8_STAGE_A(PG8_SA(0, 1), cA, 1, oc);
    if (wr == 1) PG8_BAR;
    PG8_WAIT_V(2); PG8_BAR;
    PG8_STAGE_B(PG8_SB(1, 0), cB + kstep); PG8_STAGE_A(PG8_SA(1, 0), cA + kstep, 0, oc); PG8_STAGE_B(PG8_SB(1, 1), cB + hstep + kstep);
    PG8_WAIT_V(6); PG8_BAR;
#define PG8_KBODY(LAST, O2) do { \
            const char* a1 = cA + (size_t)(t + 1) * kstep; \
            const char* a2 = (LAST) ? nA : cA + (size_t)(t + 2) * kstep; const char* b2 = (LAST) ? nB : cB + (size_t)(t + 2) * kstep; \
            const char* a3 = a2 + kstep; const char* b3 = b2 + kstep; \
            PG8_LDB(B0, 0, 0); PG8_LDB(B1, 0, 1); PG8_SCHED; PG8_LDA(At, 0, 0); PG8_STAGE_A(PG8_SA(1, 1), a1, 1, oc); \
            PG8_WAIT_V(8); PG8_WAIT_L(0); PG8_BAR; PG8_MMA(0, 0, At, B0); PG8_MMA(0, 1, At, B1); PG8_BAR; PG8_SCHED; \
            PG8_LDA(At, 0, 1); PG8_STAGE_B(PG8_SB(0, 0), b2); PG8_STAGE_B(PG8_SB(0, 1), b2 + hstep); PG8_STAGE_A(PG8_SA(0, 0), a2, 0, O2); \
            PG8_WAIT_V(8); PG8_WAIT_L(0); PG8_BAR; PG8_MMA(1, 0, At, B0); PG8_MMA(1, 1, At, B1); PG8_BAR; PG8_SCHED; \
            PG8_LDB(B0, 1, 0); PG8_LDB(B1, 1, 1); PG8_SCHED; PG8_LDA(At, 1, 0); PG8_STAGE_A(PG8_SA(0, 1), a2, 1, O2); \
            PG8_WAIT_V(8); PG8_WAIT_L(0); PG8_BAR; PG8_MMA(0, 0, At, B0); PG8_MMA(0, 1, At, B1); PG8_BAR; PG8_SCHED; \
            PG8_LDA(At, 1, 1); PG8_STAGE_B(PG8_SB(1, 0), b3); PG8_STAGE_B(PG8_SB(1, 1), b3 + hstep); PG8_STAGE_A(PG8_SA(1, 0), a3, 0, O2); \
            PG8_WAIT_V(8); PG8_WAIT_L(0); PG8_BAR; PG8_MMA(1, 0, At, B0); PG8_MMA(1, 1, At, B1); PG8_BAR; PG8_SCHED; \
        } while (0)
    for (;;) {
        const bool has_next = S.next(ui + 1, nxt);
        const char* nA = has_next ? PG8_AOF(nxt) : cA; const char* nB = has_next ? PG8_BOF(nxt) : cB;
        if (GATHER && has_next) {
            const int t2 = (wv_ << 6) | hw_tid();
            int R0, C0, R1, C1; stage_rc(t2 * 16, R0, C0); stage_rc(t2 * 16 + 8192, R1, C1);
            const int* gp = g.gather + nxt.pm * BM;
            rn[0] = ((unsigned)gp[R0] & 0xffffu) | ((unsigned)gp[R1] << 16); rn[1] = ((unsigned)gp[HALF + R0] & 0xffffu) | ((unsigned)gp[HALF + R1] << 16);
        }
        int t = 0;
#pragma unroll 1
        for (; t < nt - 2; t += 2) PG8_KBODY(false, oc);
        if (GATHER) {
#pragma unroll
            for (int h = 0; h < 2; ++h)
#pragma unroll
                for (int i = 0; i < 2; ++i) { int row = (int)(i ? (rn[h] >> 16) : (rn[h] & 0xffffu)); row = row >= NR ? NR - 1 : row; on[h][i] = has_next ? (unsigned)row * (unsigned)(K * 2) + (oc[h][i] & 2047u) : oc[h][i]; }
        }
        PG8_KBODY(true, on);
        if (wr == 0) PG8_BAR;
        { const int l2 = hw_tid(); E(acc, cur, wr, wc, l2 & 15, l2 >> 4); }
        if (!has_next) break;
#pragma unroll
        for (int a = 0; a < 2; ++a)
#pragma unroll
            for (int b = 0; b < 2; ++b)
#pragma unroll
                for (int m = 0; m < 4; ++m)
#pragma unroll
                    for (int n = 0; n < 2; ++n) acc[a][b][m][n] = (f32x4){0.f, 0.f, 0.f, 0.f};
        cur = nxt; cA = nA; cB = nB; ++ui;
        if (GATHER) {
#pragma unroll
            for (int h = 0; h < 2; ++h)
#pragma unroll
                for (int i = 0; i < 2; ++i) oc[h][i] = on[h][i];
        }
        if (wr == 1) PG8_BAR;
    }
    PG8_WAIT_V(0);
    PG8_BAR;
#undef PG8_KBODY
#undef PG8_RA
#undef PG8_CA
#undef PG8_SA
#undef PG8_SB
#undef PG8_STAGE_A
#undef PG8_STAGE_B
#undef PG8_LDA
#undef PG8_LDB
#undef PG8_MMA
#undef PG8_WAIT_V
#undef PG8_WAIT_L
#undef PG8_BAR
#undef PG8_SCHED
#undef PG8_BOF
#undef PG8_AOF
}
}

#define XB_TMO      128
#define XB_XCNT(j)  (256  + 64 * (j))
#define XB_XSUB(j)  (1280 + 64 * (j))
#define XB_XGEN(j)  (2304 + 64 * (j))
#define XB_TOP      3328
#define XB_TOPGEN   3392
#define XCD_BAR_WORDS 3456
#define XB_SPIN_CAP (1u << 22)
__device__ __forceinline__ unsigned xb_ld(unsigned* p)              { return __hip_atomic_load(p, __ATOMIC_RELAXED, __HIP_MEMORY_SCOPE_AGENT); }
__device__ __forceinline__ unsigned xb_add(unsigned* p, unsigned v) { return __hip_atomic_fetch_add(p, v, __ATOMIC_RELAXED, __HIP_MEMORY_SCOPE_AGENT); }
__device__ __forceinline__ unsigned xb_xcc_id() { return (unsigned)__builtin_amdgcn_s_getreg((3 << 11) | 20) & 0xFu; }
#define XB_SPIN(cond, bar) do { unsigned _sp = 0; while (cond) { __builtin_amdgcn_s_sleep(1); \
    if ((++_sp & 255u) == 0u) { if (xb_ld(&(bar)[XB_TMO])) break; if (_sp > XB_SPIN_CAP) { atomicAdd(&(bar)[XB_TMO], 1u); break; } } } } while (0)
struct XcdBarrier { unsigned* bar; unsigned x; volatile LAS unsigned* st; };
__device__ __forceinline__ XcdBarrier xcd_barrier_post(unsigned* bar, volatile LAS unsigned* st) {
    XcdBarrier b; b.bar = bar; b.x = xb_xcc_id(); b.st = st;
    if (threadIdx.x == 0) (void)xb_add(&bar[XB_XCNT(b.x)], 1u);
    return b;
}
__device__ __forceinline__ void xcd_barrier_complete(unsigned* bar, unsigned x, unsigned& nloc, unsigned& nx) {
    const unsigned G = gridDim.x * gridDim.y * gridDim.z;
    unsigned sum, cnt, mine, sp = 0u;
    for (;;) {
        sum = 0u; cnt = 0u; mine = 0u;
#pragma unroll
        for (unsigned j = 0; j < 16; ++j) { const unsigned c = xb_ld(&bar[XB_XCNT(j)]); sum += c; cnt += (c > 0u) ? 1u : 0u; mine = (j == x) ? c : mine; }
        if (sum == G) break;
        __builtin_amdgcn_s_sleep(1);
        if ((++sp & 255u) == 0u) { if (xb_ld(&bar[XB_TMO])) break; if (sp > XB_SPIN_CAP) { atomicAdd(&bar[XB_TMO], 1u); break; } }
    }
    nloc = mine > 0u ? mine : 1u; nx = cnt > 0u ? cnt : 1u;
}
__device__ __forceinline__ void xcd_barrier(const XcdBarrier& b, const int wv_) {
    asm volatile("s_waitcnt vmcnt(0)" ::: "memory");
    __syncthreads();
    if (wv_ == 0 && hw_tid() == 0) {
        unsigned* bar = b.bar; asm volatile("" : "+s"(bar));
        __builtin_amdgcn_s_waitcnt(0);
        unsigned nloc = b.st[0], nx = b.st[1];
        if (nloc == 0u) { xcd_barrier_complete(bar, b.x, nloc, nx); b.st[0] = nloc; b.st[1] = nx; }
        const unsigned old = xb_add(&bar[XB_XSUB(b.x)], 1u);
        const unsigned gen = old / nloc;
        if (old + 1u == (gen + 1u) * nloc) {
            __builtin_amdgcn_fence(__ATOMIC_RELEASE, "agent");
            asm volatile("s_waitcnt vmcnt(0)" ::: "memory");
            const unsigned og = xb_add(&bar[XB_TOP], 1u);
            const unsigned tg = og / nx;
            if (og + 1u == (tg + 1u) * nx) xb_add(&bar[XB_TOPGEN], 1u);
            else XB_SPIN(xb_ld(&bar[XB_TOPGEN]) == tg, bar);
            __builtin_amdgcn_fence(__ATOMIC_ACQUIRE, "agent");
            xb_add(&bar[XB_XGEN(b.x)], 1u);
            asm volatile("s_waitcnt vmcnt(0)" ::: "memory");
        } else {
            XB_SPIN(xb_ld(&bar[XB_XGEN(b.x)]) == gen, bar);
            __builtin_amdgcn_fence(__ATOMIC_ACQUIRE, "agent");
            asm volatile("s_waitcnt vmcnt(0)" ::: "memory");
        }
    }
    __syncthreads();
}

__device__ __forceinline__ void p0_transpose_item(const float* W, int N, int kb, int n0, bf16_t* WTrow0  , LAS float* scr, int lane) {
    const int k0 = 64 * kb;
    const int kq = lane >> 3, nq = (lane & 7) * 4;
    f32x4 tv[8];
#pragma unroll
    for (int i = 0; i < 8; ++i) tv[i] = *(const GAS f32x4*)(W + (size_t)(k0 + 8 * i + kq) * N + n0 + nq);
#pragma unroll
    for (int i = 0; i < 8; ++i) { LAS float* d = scr + (8 * i + kq) * 33 + nq; d[0] = tv[i][0]; d[1] = tv[i][1]; d[2] = tv[i][2]; d[3] = tv[i][3]; }
    asm volatile("s_waitcnt lgkmcnt(0)" ::: "memory");
    const int c = lane & 7;
#pragma unroll
    for (int j = 0; j < 4; ++j) { const int n = (lane >> 3) + 8 * j; const LAS float* s = scr + (8 * c) * 33 + n;
        u32x4 o; o.x = pk2(s[0 * 33], s[1 * 33]); o.y = pk2(s[2 * 33], s[3 * 33]); o.z = pk2(s[4 * 33], s[5 * 33]); o.w = pk2(s[6 * 33], s[7 * 33]);
        *(u32x4*)(WTrow0 + (size_t)n * 1024 + k0 + 8 * c) = o; }
    asm volatile("s_waitcnt lgkmcnt(0)" ::: "memory");
}
constexpr int MOE_ITEMS = 48 * 512, MOE_ALL = 4 * MOE_ITEMS;
constexpr int MOE_PRO = 6144, WIN_B = 224 * 8 * 4, WIN_C = 128 * 8 * 5, WIN_D = 128 * 8 * 7, WIN_E = 192 * 8 * 5;
__device__ __forceinline__ int win_capA(int layer) { return (layer & 1) ? 24 * 8 * 8 : 56 * 8 * 8; }
__device__ __forceinline__ int win_layer_start(int layer) {
    const int full_even = 56 * 8 * 8 + WIN_B + WIN_C + WIN_D + WIN_E, full_odd = 24 * 8 * 8 + WIN_B + WIN_C + WIN_D + WIN_E;
    return MOE_PRO + (layer > 0 ? full_even : 0) + (layer > 1 ? full_odd : 0) + (layer > 2 ? full_even : 0);
}
__device__ __forceinline__ void moe_item_decode(const P& p, unsigned char* ws, int layer, int q, const float*& src, bf16_t*& dst) {
    const int mat = q >> 9, rr = q & 511, kb = rr >> 5, n0 = (rr & 31) * 32, kind = mat >> 4, le = layer * 16 + (mat & 15);
    if (kind < 2) {
        src = (kind == 0 ? p.moe_w_gate : p.moe_w_up) + (size_t)le * 1024 * 1024 + (size_t)(64 * kb) * 1024 + n0;
        dst = (bf16_t*)(ws + W_MOE_UP) + (size_t)le * 2048 * 1024 + (size_t)((n0 >> 7) * 256 + (n0 & 127) + kind * 128) * 1024 + 64 * kb;
    } else {
        src = p.moe_w_down + (size_t)le * 1024 * 1024 + (size_t)(64 * kb) * 1024 + n0;
        dst = (bf16_t*)(ws + W_MOE_DN) + (size_t)le * 1024 * 1024 + (size_t)n0 * 1024 + 64 * kb;
    }
}
__device__ __forceinline__ void moe_convert_win(const P& p, LAS unsigned char* lds, int g0, int npw, int gend, const int wv_) {
    unsigned char* ws = p.ws; asm volatile("" : "+s"(ws));
    const int lane = hw_tid();
    LAS float* scr = (LAS float*)(lds + wv_ * 16384);
    f32x4 va[8], vb[8]; bf16_t* da; bf16_t* db;
    const int kq = lane >> 3, nq = (lane & 7) * 4;
    int g = g0 + wv_;
    if (gend > MOE_ALL) gend = MOE_ALL;
    if (g < gend) { const float* sa; moe_item_decode(p, ws, g / MOE_ITEMS, g % MOE_ITEMS, sa, da); sa += (size_t)kq * 1024 + nq;
#pragma unroll
        for (int i = 0; i < 8; ++i) va[i] = *(const GAS f32x4*)(sa + (size_t)(8 * i) * 1024); }
#pragma unroll 1
    for (int k = 0; k < npw; ++k, g += 8) {
        if (g >= gend) break;
        const bool more = k + 1 < npw && g + 8 < gend;
        if (more) { const float* sb; moe_item_decode(p, ws, (g + 8) / MOE_ITEMS, (g + 8) % MOE_ITEMS, sb, db); sb += (size_t)kq * 1024 + nq;
#pragma unroll
            for (int i = 0; i < 8; ++i) vb[i] = *(const GAS f32x4*)(sb + (size_t)(8 * i) * 1024); }
#pragma unroll
        for (int i = 0; i < 8; ++i) { LAS float* d = scr + (8 * i + kq) * 33 + nq; d[0] = va[i][0]; d[1] = va[i][1]; d[2] = va[i][2]; d[3] = va[i][3]; }
        asm volatile("s_waitcnt lgkmcnt(0)" ::: "memory");
        const int c = lane & 7;
#pragma unroll
        for (int j = 0; j < 4; ++j) { const int n = (lane >> 3) + 8 * j; const LAS float* s2 = scr + (8 * c) * 33 + n;
            u32x4 o; o.x = pk2(s2[0 * 33], s2[1 * 33]); o.y = pk2(s2[2 * 33], s2[3 * 33]); o.z = pk2(s2[4 * 33], s2[5 * 33]); o.w = pk2(s2[6 * 33], s2[7 * 33]);
            *(u32x4*)(da + (size_t)n * 1024 + 8 * c) = o; }
        asm volatile("s_waitcnt lgkmcnt(0)" ::: "memory");
        if (more) {
#pragma unroll
            for (int i = 0; i < 8; ++i) va[i] = vb[i];
            da = db; }
    }
}
__device__ __forceinline__ void moe_window(const P& p, LAS unsigned char* lds, int layer, int kind, int blk, const int wv_) {
    const int capA = win_capA(layer), s0 = win_layer_start(layer);
    int start, cap, npw;
    if (kind == 0) { start = s0; cap = capA; npw = 8; }
    else if (kind == 1) { start = s0 + capA; cap = WIN_B; npw = 4; }
    else if (kind == 2) { start = s0 + capA + (layer < 3 ? WIN_B : 0); cap = WIN_C; npw = 5; }
    else if (kind == 3) { start = s0 + capA + WIN_B + WIN_C; cap = WIN_D; npw = 7; }
    else { start = s0 + capA + WIN_B + WIN_C + WIN_D; cap = WIN_E; npw = 5; }
    moe_convert_win(p, lds, start + blk * 8 * npw, npw, start + cap, wv_);
}
__device__ __forceinline__ void phase_prologue(const P& p, LAS unsigned char* lds, int vcu, int G, const int wv_) {
    unsigned char* ws = p.ws; asm volatile("" : "+s"(ws));
    const int tid = (wv_ << 6) | hw_tid();
    const int lane = tid & 63, wave = wv_;
    LAS float* scr = (LAS float*)(lds + wave * 16384);
    const int gw = vcu * NWAVES + wave, NGW = G * NWAVES;
    constexpr int I_AI = 16 * 72, I_AO = 16 * 32, I_GI = 16 * 97, I_GO = 16 * 32, I_SMALL = 2 * (I_AI + I_AO + I_GI + I_GO), I_MOE = 16 * 32;
    const int NITEMS = I_SMALL + (G == 256 ? MOE_PRO : MOE_ALL);
    for (int it = gw; it < NITEMS; it += NGW) {
        int r = it;
        if (r < I_SMALL) {
            const int i = r >= I_SMALL / 2 ? 1 : 0; r -= i * (I_SMALL / 2);
            if (r < I_AI) { const int kb = r / 72, nb = r % 72, n0 = nb * 32, drow = (n0 & ~255) + 128 * ((n0 >> 5) & 1) + 32 * ((n0 >> 6) & 3);
                p0_transpose_item(p.attn_w_in + (size_t)i * 1024 * 2304, 2304, kb, n0, (bf16_t*)(ws + W_ATTN_IN) + (size_t)i * 2304 * 1024 + (size_t)drow * 1024, scr, lane); continue; } r -= I_AI;
            if (r < I_AO) { const int kb = r / 32, nb = r % 32; p0_transpose_item(p.attn_w_out + (size_t)i * 1024 * 1024, 1024, kb, nb * 32, (bf16_t*)(ws + W_ATTN_OUT) + (size_t)i * 1024 * 1024 + (size_t)nb * 32 * 1024, scr, lane); continue; } r -= I_AO;
            if (r < I_GI) { const int kb = r / 97, nb = r % 97; p0_transpose_item(p.gla_w_in + (size_t)i * 1024 * 3104, 3104, kb, nb * 32, (bf16_t*)(ws + W_GLA_IN) + (size_t)i * 3328 * 1024 + (size_t)nb * 32 * 1024, scr, lane); continue; } r -= I_GI;
            { const int kb = r / 32, nb = r % 32; p0_transpose_item(p.gla_w_out + (size_t)i * 1024 * 1024, 1024, kb, nb * 32, (bf16_t*)(ws + W_GLA_OUT) + (size_t)i * 1024 * 1024 + (size_t)nb * 32 * 1024, scr, lane); continue; }
        }
        r -= I_SMALL;
        { int layer_, q_;
          layer_ = r / MOE_ITEMS; q_ = r % MOE_ITEMS;
          const float* src_; bf16_t* dst_; moe_item_decode(p, ws, layer_, q_, src_, dst_); p0_transpose_item(src_, 1024, 0, 0, dst_, scr, lane); }
    }
    for (int it = gw; it < 2 * 224; it += NGW) { const int i = it / 224, rr = 3104 + it % 224; u32x4* dst = (u32x4*)((bf16_t*)(ws + W_GLA_IN) + (size_t)i * 3328 * 1024 + (size_t)rr * 1024);
        dst[lane] = (u32x4){0u, 0u, 0u, 0u}; dst[lane + 64] = (u32x4){0u, 0u, 0u, 0u}; }
    __syncthreads();
    {
        LAS float* s = (LAS float*)lds;
        LAS float* red = (LAS float*)(lds + 9 * 1024 * 4);
        for (int i = tid; i < 9 * 1024; i += NTHR) { const int r = i >> 10, k = i & 1023; const float v = r < 8 ? p.c[r * 1024 + k] : p.c_ctx[k]; s[i] = v / (1.f + expf(-v)); }
        __syncthreads();
        float* mods = (float*)(ws + WS_MODS);
        for (int u = vcu; u < 384; u += G) {
            const int l = u / 96, cb = u % 96, cl = tid & 63, ks = tid >> 6, col = cb * 64 + cl;
            float acc[9];
#pragma unroll
            for (int r = 0; r < 9; ++r) acc[r] = 0.f;
            const float* w = p.ada_w + (size_t)l * 1024 * 6144 + col;
            for (int k = ks * 128; k < ks * 128 + 128; ++k) { const float wv = w[(size_t)k * 6144];
#pragma unroll
                for (int r = 0; r < 9; ++r) acc[r] += s[r * 1024 + k] * wv; }
#pragma unroll
            for (int r = 0; r < 9; ++r) red[(ks * 9 + r) * 64 + cl] = acc[r];
            __syncthreads();
            for (int i = tid; i < 9 * 64; i += NTHR) { const int r = i >> 6, c2 = i & 63; float v = 0.f;
#pragma unroll
                for (int q = 0; q < 8; ++q) v += red[(q * 9 + r) * 64 + c2];
                const int cc = cb * 64 + c2, chunk = cc >> 10; v += p.ada_b[l * 6144 + cc];
                if (chunk == 1) v = p.norm1_g[l * 1024 + (cc & 1023)] * (1.f + v); else if (chunk == 4) v = p.norm2_g[l * 1024 + (cc & 1023)] * (1.f + v);
                mods[(size_t)(l * 9 + r) * 6144 + cc] = v; }
            __syncthreads();
        }
    }
    if (vcu == 1 % G) { float* qkg = (float*)(ws + WS_ROPE + 16384);
        for (int i = tid; i < 512; i += NTHR) { const int l = i >> 8, ty = (i >> 6) & 3, d = i & 63; const float* src = ty == 0 ? p.a_q_norm : (ty == 1 ? p.a_k_norm : (ty == 2 ? p.b_q_norm : p.b_k_norm)); qkg[i] = src[l * 64 + d]; } }
    if (vcu == 0) { float* tab = (float*)(ws + WS_ROPE);
        for (int i = tid; i < 1024; i += NTHR) { const int pos = i >> 4, j = i & 15; const float inv = powf(10000.f, -(float)j / 16.f); const float a = (float)pos * inv; tab[i] = cosf(a); tab[1024 + i] = sinf(a); } }
}

template <int WHICH> __device__ __forceinline__ void phase_norm(const P& p, int layer, LAS unsigned char* lds, int vcu, int G, const int wv_, const bool lat_only = false) {
    unsigned char* ws = p.ws; asm volatile("" : "+s"(ws));
    const int lane = hw_tid(), tid = (wv_ << 6) | lane, wave = wv_;
    constexpr int NRW = 2;
    const float* mods = (const float*)(ws + WS_MODS);
    constexpr int UT_PITCH = 2064;
    LAS unsigned char* ut_hi = lds; LAS unsigned char* ut_lo = lds + 16 * UT_PITCH; LAS float* rpart0 = (LAS float*)(lds + 32 * UT_PITCH);
    int rstepi = 0;
    bf16x8 wfh[4], wfl[4];
    if (WHICH == 2) {
        const float* rwt = p.moe_router + (size_t)layer * 1024 * 16;
        const int fr = lane & 15, fq = lane >> 4;
#pragma unroll
        for (int ks = 0; ks < 4; ++ks) {
            float wv[8];
#pragma unroll
            for (int i = 0; i < 8; ++i) wv[i] = rwt[(size_t)(128 * wave + 32 * ks + 8 * fq + i) * 16 + fr];
            unsigned hh[4], ll[4];
#pragma unroll
            for (int i = 0; i < 4; ++i) { const unsigned h0 = f2bf(wv[2 * i]), h1 = f2bf(wv[2 * i + 1]); hh[i] = h0 | (h1 << 16);
                ll[i] = pk2(wv[2 * i] - __uint_as_float(h0 << 16), wv[2 * i + 1] - __uint_as_float(h1 << 16)); }
            wfh[ks] = __builtin_bit_cast(bf16x8, (u32x4){hh[0], hh[1], hh[2], hh[3]}); wfl[ks] = __builtin_bit_cast(bf16x8, (u32x4){ll[0], ll[1], ll[2], ll[3]});
        }
    }
    const int nrows = (WHICH == 3 || lat_only) ? NB * SEQ : NR;
    constexpr bool COMB = WHICH == 3 || WHICH == 1;
#define NIX(j) (2 * (lane + 64 * ((j) >> 1)) + ((j) & 1))
#define NIP(jp) (lane + 64 * (jp))
    f32x4 vn[NRW][4]; u32x4 vnb[NRW][2]; int slotn[NRW];
#define NORM_ROWMAP(rr_) do { if (WHICH == 3 || lat_only) { const int b_ = (rr_) / SEQ, t_ = (rr_) - b_ * SEQ; (rr_) = b_ * RPB + t_; } } while (0)
#define NORM_LOAD(r0_, V_, S_) do { _Pragma("unroll") for (int q = 0; q < NRW; ++q) { int rr = (r0_) + q; NORM_ROWMAP(rr); const int b = rr / RPB, t = rr - b * RPB; \
            if constexpr (WHICH == 0) { const float* src = t < SEQ ? p.x + (size_t)(b * SEQ + t) * D : p.ctx + (size_t)(b * CTXL + (t - SEQ)) * D; \
                _Pragma("unroll") for (int j = 0; j < 4; ++j) V_[q][j] = ((const GAS f32x4*)src)[NIX(j)]; } \
            else { const bf16_t* src = (const bf16_t*)(ws + WS_HB) + (size_t)rr * D; (void)b; (void)t; \
                _Pragma("unroll") for (int jp = 0; jp < 2; ++jp) V_##b[q][jp] = ((const GAS u32x4*)src)[NIP(jp)]; } \
            if (COMB) S_[q] = lane < 16 ? ((const GAS int*)(ws + WS_POS))[(size_t)rr * 16 + lane] : -1; } } while (0)
    constexpr int rstep = NWAVES * NRW;
    const int ngrp = nrows / rstep;
    unsigned Gd = (unsigned)G; asm volatile("" : "+s"(Gd));
    int r0 = (int)((unsigned)(vcu * ngrp) / Gd) * rstep + wave * NRW;
    const int rend = (int)((unsigned)((vcu + 1) * ngrp) / Gd) * rstep;
    int mr_cur = -1; f32x4 shv[4], scv[4], m5v[4];
#pragma unroll
    for (int j = 0; j < 4; ++j) { shv[j] = (f32x4){0.f, 0.f, 0.f, 0.f}; scv[j] = shv[j]; m5v[j] = shv[j]; }
    if (r0 < rend) NORM_LOAD(r0, vn, slotn);
    for (; r0 < rend; r0 += rstep) {
        int row[NRW], mr[NRW]; f32x4 v[NRW][4]; int slot[NRW];
#pragma unroll
        for (int q = 0; q < NRW; ++q) {
            int rr = r0 + q; NORM_ROWMAP(rr);
            row[q] = rr;
            const int b = rr / RPB, t = rr - b * RPB;
            mr[q] = t < SEQ ? b : 8;
            slot[q] = slotn[q];
#pragma unroll
            for (int j = 0; j < 4; ++j) {
                if constexpr (WHICH == 0) v[q][j] = vn[q][j];
                else { const u32x4 t4 = vnb[q][j >> 1]; const unsigned ta = (j & 1) ? t4.z : t4.x, tb = (j & 1) ? t4.w : t4.y; v[q][j] = (f32x4){__uint_as_float(ta << 16), __uint_as_float(ta & 0xffff0000u), __uint_as_float(tb << 16), __uint_as_float(tb & 0xffff0000u)}; }
            }
        }
        if (mr[0] != mr_cur) {
            mr_cur = mr[0];
            if (WHICH != 3) { const float* shift = mods + (size_t)(layer * 9 + mr_cur) * 6144 + (WHICH <= 1 ? 0 : 3) * 1024;
#pragma unroll
                for (int j = 0; j < 4; ++j) { shv[j] = ((const GAS f32x4*)shift)[NIX(j)]; scv[j] = ((const GAS f32x4*)(shift + 1024))[NIX(j)]; } }
            if (WHICH == 1 || WHICH == 3) { const float* m5 = mods + (size_t)((WHICH == 3 ? 3 : layer - 1) * 9 + mr_cur) * 6144 + 5 * 1024;
#pragma unroll
                for (int j = 0; j < 4; ++j) m5v[j] = ((const GAS f32x4*)m5)[NIX(j)]; }
#pragma unroll
            for (int j = 0; j < 4; ++j) asm volatile("" : "+v"(shv[j]), "+v"(scv[j]), "+v"(m5v[j]));
        }
        if (r0 + rstep < rend) NORM_LOAD(r0 + rstep, vn, slotn);
        if (WHICH == 1 || WHICH == 3) {
            const int pl = WHICH == 3 ? 3 : layer - 1;
            const float* gatev = (const float*)(ws + WS_GATE);
            const bf16_t* Y = (const bf16_t*)(ws + WS_B2);
#pragma unroll
            for (int q = 0; q < NRW; ++q) { if (slot[q] >= NSLOT) slot[q] = -1; }
            unsigned long long mskq[NRW]; int sl4[NRW][4]; u32x4 yv4[NRW][4][2];
#pragma unroll
            for (int q = 0; q < NRW; ++q) { mskq[q] = __ballot(slot[q] >= 0);
#pragma unroll
                for (int i = 0; i < 4; ++i) { sl4[q][i] = -1;
                    if (mskq[q]) { const int e = __builtin_ctzll(mskq[q]); mskq[q] &= mskq[q] - 1; sl4[q][i] = __builtin_amdgcn_readlane(slot[q], e); } } }
#pragma unroll
            for (int q = 0; q < NRW; ++q)
#pragma unroll
                for (int i = 0; i < 4; ++i) if (sl4[q][i] >= 0) { const bf16_t* yr = Y + (size_t)sl4[q][i] * 1024;
#pragma unroll
                    for (int jp = 0; jp < 2; ++jp) yv4[q][i][jp] = ((const GAS u32x4*)yr)[NIP(jp)]; }
#pragma unroll
            for (int q = 0; q < NRW; ++q) {
                f32x4 acc[4];
#pragma unroll
                for (int j = 0; j < 4; ++j) acc[j] = (f32x4){0.f, 0.f, 0.f, 0.f};
#pragma unroll
                for (int i = 0; i < 4; ++i) if (sl4[q][i] >= 0) {
#pragma unroll
                    for (int j = 0; j < 4; ++j) { const u32x4 y4 = yv4[q][i][j >> 1]; const u32x2 yv = (j & 1) ? (u32x2){y4.z, y4.w} : (u32x2){y4.x, y4.y};
                        acc[j][0] += __uint_as_float(yv.x << 16); acc[j][1] += __uint_as_float(yv.x & 0xffff0000u); acc[j][2] += __uint_as_float(yv.y << 16); acc[j][3] += __uint_as_float(yv.y & 0xffff0000u); } }
                unsigned long long msk = mskq[q];
                while (msk) {
                    const int e = __builtin_ctzll(msk); msk &= msk - 1;
                    const int sl = __builtin_amdgcn_readlane(slot[q], e);
                    const bf16_t* yr = Y + (size_t)sl * 1024;
#pragma unroll
                    for (int j = 0; j < 4; ++j) { const u32x2 yv = ((const GAS u32x2*)yr)[NIX(j)];
                        acc[j][0] += __uint_as_float(yv.x << 16); acc[j][1] += __uint_as_float(yv.x & 0xffff0000u); acc[j][2] += __uint_as_float(yv.y << 16); acc[j][3] += __uint_as_float(yv.y & 0xffff0000u); }
                }
#pragma unroll
                for (int j = 0; j < 4; ++j) v[q][j] = v[q][j] + m5v[j] * acc[j];
            }
        }
        if (WHICH == 1) {
#pragma unroll
            for (int q = 0; q < NRW; ++q) { bf16_t* hb = (bf16_t*)(ws + WS_HB) + (size_t)row[q] * D;
#pragma unroll
                for (int jp = 0; jp < 2; ++jp) ((GAS u32x4*)hb)[NIP(jp)] = (u32x4){pg8::cvt_pk_bf16(v[q][2 * jp][0], v[q][2 * jp][1]), pg8::cvt_pk_bf16(v[q][2 * jp][2], v[q][2 * jp][3]), pg8::cvt_pk_bf16(v[q][2 * jp + 1][0], v[q][2 * jp + 1][1]), pg8::cvt_pk_bf16(v[q][2 * jp + 1][2], v[q][2 * jp + 1][3])}; }
        }
        if (WHICH == 3) {
#pragma unroll
            for (int q = 0; q < NRW; ++q) { const int b = row[q] / RPB, t = row[q] - b * RPB; float* orow = p.out + (size_t)(b * SEQ + t) * D;
#pragma unroll
                for (int j = 0; j < 4; ++j) ((GAS f32x4*)orow)[NIX(j)] = v[q][j]; }
        }
        if (WHICH == 3) continue;
        {
            float rs[NRW];
#pragma unroll
            for (int q = 0; q < NRW; ++q) {
                float ss = 0.f;
#pragma unroll
                for (int j = 0; j < 4; ++j) ss += v[q][j][0] * v[q][j][0] + v[q][j][1] * v[q][j][1] + v[q][j][2] * v[q][j][2] + v[q][j][3] * v[q][j][3];
                ss = wave_sum(ss);
                rs[q] = rsqrtf(ss * (1.f / 1024.f) + EPS);
            }
#pragma unroll
            for (int j = 0; j < 4; ++j) {
                const f32x4 sh = shv[j], sc = scv[j];
#pragma unroll
                for (int q = 0; q < NRW; ++q) v[q][j] = v[q][j] * rs[q] * sc + sh;
            }
#pragma unroll
            for (int q = 0; q < NRW; ++q)
#pragma unroll
                for (int jp = 0; jp < 2; ++jp)
                    ((GAS u32x4*)((bf16_t*)(ws + WS_U) + (size_t)row[q] * 1024))[NIP(jp)] = (u32x4){pg8::cvt_pk_bf16(v[q][2 * jp][0], v[q][2 * jp][1]), pg8::cvt_pk_bf16(v[q][2 * jp][2], v[q][2 * jp][3]), pg8::cvt_pk_bf16(v[q][2 * jp + 1][0], v[q][2 * jp + 1][1]), pg8::cvt_pk_bf16(v[q][2 * jp + 1][2], v[q][2 * jp + 1][3])};
        }
        if (WHICH == 2) {
#pragma unroll
            for (int q = 0; q < NRW; ++q) {
                LAS unsigned char* th = ut_hi + (wave * 2 + q) * UT_PITCH; LAS unsigned char* tl = ut_lo + (wave * 2 + q) * UT_PITCH;
#pragma unroll
                for (int j = 0; j < 4; ++j) {
                    const unsigned h01 = pg8::cvt_pk_bf16(v[q][j][0], v[q][j][1]), h23 = pg8::cvt_pk_bf16(v[q][j][2], v[q][j][3]);
                    const float l0 = v[q][j][0] - __uint_as_float(h01 << 16), l1 = v[q][j][1] - __uint_as_float(h01 & 0xffff0000u), l2 = v[q][j][2] - __uint_as_float(h23 << 16), l3 = v[q][j][3] - __uint_as_float(h23 & 0xffff0000u);
                    *(LAS u32x2*)(th + NIX(j) * 8) = (u32x2){h01, h23};
                    *(LAS u32x2*)(tl + NIX(j) * 8) = (u32x2){pg8::cvt_pk_bf16(l0, l1), pg8::cvt_pk_bf16(l2, l3)};
                }
            }
            __syncthreads();
            {
                const int fr = lane & 15, fq = lane >> 4;
                bf16x8 xh[4], xl[4];
#pragma unroll
                for (int ks = 0; ks < 4; ++ks) { xh[ks] = *(const LAS bf16x8*)(ut_hi + fr * UT_PITCH + (128 * wave + 32 * ks + 8 * fq) * 2); xl[ks] = *(const LAS bf16x8*)(ut_lo + fr * UT_PITCH + (128 * wave + 32 * ks + 8 * fq) * 2); }
                f32x4 pc = (f32x4){0.f, 0.f, 0.f, 0.f};
#pragma unroll
                for (int ks = 0; ks < 4; ++ks) { pc = __builtin_amdgcn_mfma_f32_16x16x32_bf16(wfh[ks], xh[ks], pc, 0, 0, 0); pc = __builtin_amdgcn_mfma_f32_16x16x32_bf16(wfl[ks], xh[ks], pc, 0, 0, 0); pc = __builtin_amdgcn_mfma_f32_16x16x32_bf16(wfh[ks], xl[ks], pc, 0, 0, 0); }
                *(LAS f32x4*)(rpart0 + (rstepi & 1) * 2048 + (wave * 16 + fr) * 16 + 4 * fq) = pc;
            }
            __syncthreads();
            if (tid < 256) {
                const int rr_ = tid >> 4, ee = tid & 15;
                float x = 0.f;
#pragma unroll
                for (int w8 = 0; w8 < 8; ++w8) x += rpart0[(rstepi & 1) * 2048 + (w8 * 16 + rr_) * 16 + ee];
                float mx = x; mx = fmaxf(mx, swz_xor<1>(mx)); mx = fmaxf(mx, swz_xor<2>(mx)); mx = fmaxf(mx, swz_xor<4>(mx)); mx = fmaxf(mx, swz_xor<8>(mx));
                const float ex = expf(x - mx);
                float sm = ex; sm += swz_xor<1>(sm); sm += swz_xor<2>(sm); sm += swz_xor<4>(sm); sm += swz_xor<8>(sm);
                int grow = (r0 - wave * NRW) + rr_;
                NORM_ROWMAP(grow);
                { const int b_ = grow / RPB, t_ = grow - b_ * RPB;
                  const size_t ao_ = t_ < SEQ ? ((size_t)(b_ * 16 + ee) * SEQ + t_) : ((size_t)NB * 16 * SEQ + (size_t)(b_ * 16 + ee) * CTXL + (t_ - SEQ));
                  ((GAS float*)(ws + WS_AFF))[ao_] = ex / sm; }
            }
            ++rstepi;
        }
    }
    if (WHICH == 2) __syncthreads();
#undef NORM_ROWMAP
#undef NORM_LOAD
#undef NIX
#undef NIP
}

__device__ __forceinline__ void phase_qkprep(const P& p, int layer, int vcu, int G, const int wv_) {
    unsigned char* ws = p.ws; asm volatile("" : "+s"(ws));
    const int tid = (wv_ << 6) | hw_tid();
    const int lane = tid & 63, wave = wv_;
    const int li = layer >> 1;
    const float* tab = (const float*)(ws + WS_ROPE);
    for (int wid = vcu * NWAVES + wave; wid < NR * 26; wid += G * NWAVES) {
        const int row = wid / 26, hs = wid - row * 26;
        int col; const float* g; bool rope;
        if (hs < 8) { col = hs * 64; g = p.a_q_norm + li * 64; rope = true; }
        else if (hs < 10) { col = 512 + (hs - 8) * 64; g = p.a_k_norm + li * 64; rope = true; }
        else if (hs < 18) { col = 768 + (hs - 10) * 64; g = p.b_q_norm + li * 64; rope = false; }
        else { col = 1280 + (hs - 18) * 64; g = p.b_k_norm + li * 64; rope = false; }
        bf16_t* q = (bf16_t*)(ws + WS_B1) + (size_t)row * 2304 + col;
        const float x = bf2f(q[lane]);
        const float ss = wave_sum(x * x);
        float y = x * rsqrtf(ss * (1.f / 64.f) + EPS) * g[lane];
        const int b = row / RPB, t = row - b * RPB;
        if (rope && t < SEQ) {
            const int half = lane >> 5, j = lane & 31;
            const int pos = half == 0 ? (t >> 6) : (t & 63);
            const float cs = tab[pos * 16 + (j & 15)], sn = tab[1024 + pos * 16 + (j & 15)];
            const float other = swz_xor<16>(y);
            y = y * cs + (j < 16 ? -other : other) * sn;
        }
        if (hs < 8 || (hs >= 10 && hs < 18)) y *= 0.18033688011112042f;
        q[lane] = (bf16_t)f2bf(y);
    }
}

namespace attn_body {
using bf16=unsigned short;
using bf16x8=__attribute__((ext_vector_type(8)))short;
using s16x4=__attribute__((ext_vector_type(4)))short;
using f32x16=__attribute__((ext_vector_type(16)))float;
using u32x4=__attribute__((ext_vector_type(4)))unsigned;
constexpr int D=64;
constexpr int NW=8,QBLK=32,QB=QBLK*NW,KVBLK=64;
__device__ __forceinline__ int crow(int r,int hi){return (r&3)+8*(r>>2)+4*hi;}
#define SBAR() __builtin_amdgcn_sched_barrier(0)
#define CINIT (MODE==1?f32x16{}:negm)
struct NaArgs { int ctx_row0, win_row0, r0, wr0; };
constexpr int LDS_NAT_OFF = 86016;
__device__ __forceinline__ void na_mask(f32x16&p0,f32x16&p1,int j,const NaArgs&na,const char*shm,int wid,int r32,int hi,float mhat){
  const float NEG=-INFINITY;
  const int r=na.r0+(wid>>1), c=32*(wid&1)+r32;
  int rs=r-4; rs=rs<0?0:(rs>56?56:rs);
  int cs=c-8; cs=cs<0?0:(cs>48?48:cs);
  const int kr=na.wr0+j, di=kr-rs;
  if(di<0||di>=8){
    #pragma unroll
    for(int q=0;q<16;++q){p0[q]=NEG;p1[q]=NEG;}
  } else {
    const int dr=kr-r+7;
    const float*T=reinterpret_cast<const float*>(shm+LDS_NAT_OFF)+dr*128+63-c+4*hi;
    const int a=4*hi-cs;
    #pragma unroll
    for(int q=0;q<16;++q){ const int kc0=(q&3)+8*(q>>2);
      const float b0=T[kc0], b1=T[kc0+32];
      p0[q]=((unsigned)(a+kc0)<16u)?p0[q]+(b0-mhat):NEG; p1[q]=((unsigned)(a+kc0+32)<16u)?p1[q]+(b1-mhat):NEG;
      if((q&1)==1) SBAR(); }
  }
}
constexpr int NSLOT=3, SLOTB=8192;
constexpr int LDS_K=0, LDS_V=NSLOT*SLOTB, LDS_WS=2*NSLOT*SLOTB, LDS_OST=LDS_WS+NW*64*4, LDS_BYTES=LDS_OST+NW*4096;
constexpr float C2=0.125f*1.4426950408889634f;
__device__ __forceinline__ void glds16(const void*gsrc,unsigned lds_dst){unsigned keep;
  asm volatile("s_mov_b32 %0, m0\n\ts_mov_b32 m0, %2\n\ts_nop 0\n\tglobal_load_lds_dwordx4 %1, off\n\ts_mov_b32 m0, %0":"=&s"(keep):"v"(gsrc),"s"(lds_dst):"memory");}
__device__ __forceinline__ float max3f(float a,float b,float c){float r;asm("v_max3_f32 %0, %1, %2, %3":"=v"(r):"v"(a),"v"(b),"v"(c));return r;}
__device__ __forceinline__ float max2f(float a,float b){float r;asm("v_max_f32_e32 %0, %1, %2":"=v"(r):"v"(a),"v"(b));return r;}
__device__ __forceinline__ float fadd_s(float a,float b){float r;asm("v_add_f32_e32 %0, %1, %2":"=v"(r):"v"(a),"v"(b));return r;}
__device__ __forceinline__ float fsub_s(float a,float b){float r;asm("v_sub_f32_e32 %0, %1, %2":"=v"(r):"v"(a),"v"(b));return r;}
typedef float f32x2_t __attribute__((ext_vector_type(2))); typedef __bf16 bf16x2_t __attribute__((ext_vector_type(2)));
__device__ __forceinline__ unsigned cvtpk_s(float lo,float hi){f32x2_t v={lo,hi};bf16x2_t b=__builtin_convertvector(v,bf16x2_t);return __builtin_bit_cast(unsigned,b);}
#define WAIT_BAR(N) asm volatile("s_waitcnt vmcnt(" #N ") lgkmcnt(0)\n\ts_barrier":::"memory")

__device__ __forceinline__ void qkt(f32x16&p0,f32x16&p1,const char*Kslot,const bf16x8*qr,const f32x16&negm,int r32,int hi){
  const char*kb=Kslot+hi*1024+r32*16;
  #pragma unroll
  for(int d0=0;d0<4;++d0){
    const bf16x8 b0=*reinterpret_cast<const bf16x8*>(kb+d0*2048);
    const bf16x8 b1=*reinterpret_cast<const bf16x8*>(kb+d0*2048+512);
    if(d0==0){p0=__builtin_amdgcn_mfma_f32_32x32x16_bf16(b0,qr[0],negm,0,0,0);p1=__builtin_amdgcn_mfma_f32_32x32x16_bf16(b1,qr[0],negm,0,0,0);}
    else{p0=__builtin_amdgcn_mfma_f32_32x32x16_bf16(b0,qr[d0],p0,0,0,0);p1=__builtin_amdgcn_mfma_f32_32x32x16_bf16(b1,qr[d0],p1,0,0,0);}}
}
typedef __attribute__((address_space(3))) const char* lds_cptr;
typedef short v4i16_t __attribute__((ext_vector_type(4)));
__device__ __forceinline__ void kload8(bf16x8*kf,lds_cptr kp){
  kf[0]=*(const __attribute__((address_space(3))) bf16x8*)(kp);      kf[1]=*(const __attribute__((address_space(3))) bf16x8*)(kp+512);
  kf[2]=*(const __attribute__((address_space(3))) bf16x8*)(kp+2048); kf[3]=*(const __attribute__((address_space(3))) bf16x8*)(kp+2560);
  kf[4]=*(const __attribute__((address_space(3))) bf16x8*)(kp+4096); kf[5]=*(const __attribute__((address_space(3))) bf16x8*)(kp+4608);
  kf[6]=*(const __attribute__((address_space(3))) bf16x8*)(kp+6144); kf[7]=*(const __attribute__((address_space(3))) bf16x8*)(kp+6656);
}
__device__ __forceinline__ void kload2(bf16x8*kf,lds_cptr kp,int j){ kf[2*j]=*(const __attribute__((address_space(3))) bf16x8*)(kp+j*2048); kf[2*j+1]=*(const __attribute__((address_space(3))) bf16x8*)(kp+j*2048+512); }
__device__ __forceinline__ s16x4 vtr(lds_cptr p){ return __builtin_bit_cast(s16x4,__builtin_amdgcn_ds_read_tr16_b64_v4i16((__attribute__((address_space(3))) v4i16_t*)p)); }
__device__ __forceinline__ float rowmax(const f32x16&p0,const f32x16&p1){
  float a=max3f(p0[0],p0[1],p1[0]),b=max3f(p0[2],p0[3],p1[1]);a=max3f(a,p1[2],p1[3]);
  #pragma unroll
  for(int r=4;r<16;r+=4){a=max3f(a,p0[r],p0[r+1]);b=max3f(b,p0[r+2],p0[r+3]);a=max3f(a,p1[r],p1[r+1]);b=max3f(b,p1[r+2],p1[r+3]);}
  const float m=max2f(a,b);
  auto rr=__builtin_amdgcn_permlane32_swap(__float_as_uint(m),__float_as_uint(m),false,false);
  return max2f(__uint_as_float(rr[0]),__uint_as_float(rr[1]));
}
__device__ __forceinline__ void pv(f32x16*o,int vb,bf16x8 pa0,bf16x8 pa1,bf16x8 pa2,bf16x8 pa3){
  #pragma unroll
  for(int d0=0;d0<2;++d0){s16x4 lo[4],hi[4];
    #pragma unroll
    for(int ks=0;ks<4;++ks){
      asm volatile("ds_read_b64_tr_b16 %0,%1 offset:%c2":"=&v"(lo[ks]):"v"(vb),"i"(d0*4096+ks*1024):"memory");
      asm volatile("ds_read_b64_tr_b16 %0,%1 offset:%c2":"=&v"(hi[ks]):"v"(vb),"i"(d0*4096+ks*1024+512):"memory");}
    asm volatile("s_waitcnt lgkmcnt(0)":::"memory");SBAR();
    #define PK(k) (bf16x8){lo[k][0],lo[k][1],lo[k][2],lo[k][3],hi[k][0],hi[k][1],hi[k][2],hi[k][3]}
    o[d0]=__builtin_amdgcn_mfma_f32_32x32x16_bf16(pa0,PK(0),o[d0],0,0,0);
    o[d0]=__builtin_amdgcn_mfma_f32_32x32x16_bf16(pa1,PK(1),o[d0],0,0,0);
    o[d0]=__builtin_amdgcn_mfma_f32_32x32x16_bf16(pa2,PK(2),o[d0],0,0,0);
    o[d0]=__builtin_amdgcn_mfma_f32_32x32x16_bf16(pa3,PK(3),o[d0],0,0,0);
    #undef PK
  }
}

#ifndef ATTN_STORE16
#define ATTN_STORE16(p,v) (*(u32x4*)(p)=(v))
#endif
template<int THRL,int QP,int OP,int MODE> __device__ __forceinline__ void attn_unit(const bf16*Qu,const bf16*__restrict__ Kh,const bf16*__restrict__ Vh,bf16*Ou,const int NT,char*shm,const int wid,const int lane,const NaArgs na){
  const int r32=lane&31,hi=lane>>5;
  const bf16*Qw=Qu+(long)(wid*QBLK)*QP;
  const unsigned lds0=(unsigned)(uintptr_t)shm;
  float*wsf=(float*)(shm+LDS_WS)+wid*64;
  const bf16*ksrc=Kh+(long)lane*QP+wid*8;
  const bf16*vsrc=Vh+(long)(16*(wid&3)+(lane>>2))*QP+(wid>>2)*32+(lane&3)*8;
  const unsigned kdst=lds0+LDS_K+wid*1024, vdst=lds0+LDS_V+wid*1024;
  #define TROW(t) (MODE==0?(long)(t)*KVBLK:((t)<4?(long)na.ctx_row0+(long)(t)*KVBLK:(long)na.win_row0+(long)((t)-4)*KVBLK))
  #define DMA_K(t,slot) glds16(ksrc+TROW(t)*QP,(unsigned)__builtin_amdgcn_readfirstlane(kdst+(slot)))
  #define DMA_V(t,slot) glds16(vsrc+TROW(t)*QP,(unsigned)__builtin_amdgcn_readfirstlane(vdst+(slot)))
  const int vb0=(int)(lds0+LDS_V)+((lane>>4)&1)*32+(lane&3)*8+(4*hi+((lane&15)>>2))*64;
  const char*Kbase=shm+LDS_K; bf16x8 kf[8];
  const lds_cptr shm3=(lds_cptr)shm; const lds_cptr kp0=shm3+LDS_K+hi*1024+r32*16; const lds_cptr vp0=shm3+LDS_V+((lane>>4)&1)*32+(lane&3)*8+(4*hi+((lane&15)>>2))*64;
  DMA_K(0,0);DMA_V(0,0);DMA_K(1,SLOTB);
  bf16x8 qr[4];
  #pragma unroll
  for(int d0=0;d0<4;++d0)qr[d0]=*reinterpret_cast<const bf16x8*>(&Qw[(long)r32*QP+d0*16+hi*8]);
  float mhat=0.f,l_reg=0.f;f32x16 o[2],negm; { float z_=0.f; asm volatile("":"+v"(z_));
    _Pragma("unroll") for(int r=0;r<16;++r){o[0][r]=z_;o[1][r]=z_;negm[r]=z_;} } if(MODE==0)asm volatile("":"+v"(negm));
  #define CMASK(P0,P1,t) do{ if(MODE==1){ if((t)>=4) na_mask(P0,P1,(t)-4,na,shm,wid,r32,hi,mhat); else { _Pragma("unroll") for(int r_=0;r_<16;++r_){P0[r_]-=mhat;P1[r_]-=mhat;} } } }while(0)
  bool resc=false;
  #define START(P0,P1) do{ const float rm=rowmax(P0,P1); resc=false; \
    { const float dl=rm; mhat=fadd_s(mhat,dl); \
      _Pragma("unroll") for(int r=0;r<16;++r){P0[r]=fsub_s(P0[r],dl);P1[r]=fsub_s(P1[r],dl);} \
      if(MODE==0){ _Pragma("unroll") for(int r=0;r<16;++r)negm[r]=-mhat; asm volatile("":"+v"(negm)); } } \
    _Pragma("unroll") for(int r=0;r<16;++r)P0[r]=__builtin_amdgcn_exp2f(P0[r]); }while(0)
  #define RESC() do{ if(resc){ asm volatile("s_waitcnt lgkmcnt(0)":::"memory"); \
      _Pragma("unroll") for(int d_=0;d_<2;++d_) _Pragma("unroll") for(int r=0;r<16;++r)o[d_][r]*=wsf[crow(r,hi)]; } }while(0)
  f32x16 pA0,pA1,pB0,pB1;
  int sl_prev=0,sl_cur=0,sl_next=SLOTB;
  #define ROT() do{sl_prev=sl_cur;sl_cur=sl_next;sl_next=(sl_next==(NSLOT-1)*SLOTB)?0:sl_next+SLOTB;}while(0)
  DMA_K(2,2*SLOTB);
  WAIT_BAR(3);
  qkt(pA0,pA1,Kbase,qr,CINIT,r32,hi);asm volatile("s_nop 15\n\ts_nop 7":"+v"(pA0),"+v"(pA1));CMASK(pA0,pA1,0);
  START(pA0,pA1);
  _Pragma("unroll") for(int r=0;r<16;++r)pA1[r]=__builtin_amdgcn_exp2f(pA1[r]);
  WAIT_BAR(0);
  DMA_K(3,0);DMA_V(1,SLOTB);
  ROT();
  kload8(kf,kp0+sl_cur);
  WAIT_BAR(2);
  s16x4 vlo[8],vhi[8]; u32x4 pw0,pw1,pw2,pw3;
  #define PKW(P,B) cvtpk_s(P[B],P[B+1])
  #define PAF(k) __builtin_bit_cast(bf16x8,pw##k)
  #define VFR(i) (bf16x8){vlo[i][0],vlo[i][1],vlo[i][2],vlo[i][3],vhi[i][0],vhi[i][1],vhi[i][2],vhi[i][3]}
  #define PIN(x) asm volatile("":"+v"(x))
  #define MX3(a,b,c) __builtin_fmaxf(__builtin_fmaxf((a),(b)),(c))
  #define GAPA(MF,A0,A1,A2,A3,W0,W1,PW) do{ MF; sacc+=A0; sacc+=A1; sacc+=A2; sacc+=A3; PIN(sacc); W0; W1; PIN(PW); SBAR(); }while(0)
  #define EX(v) __builtin_amdgcn_exp2f(v)
  #define GAPB(MF,X,B) do{ MF; X[B]=EX(X[B]); X[B+1]=EX(X[B+1]); X[B+2]=EX(X[B+2]); X[B+3]=EX(X[B+3]); PIN(X); SBAR(); }while(0)
  #define VRD(i) do{ vlo[i]=vtr(vp_+(((i)>>2)*4096+((i)&3)*1024)); vhi[i]=vtr(vp_+(((i)>>2)*4096+((i)&3)*1024+512)); }while(0)
  #define KRD(G,j) do{ if(G){ kload2(kf,kp0+sl_next,j); SBAR(); } }while(0)
  #define STEP(C0,C1,P0,P1,t,GK,GV,GL) do{ SBAR(); \
    const lds_cptr vp_=vp0+sl_prev; \
    VRD(0); SBAR(); float sacc=(P0[0]+P0[1]); \
    GAPA(C0=__builtin_amdgcn_mfma_f32_32x32x16_bf16(kf[0],qr[0],CINIT,0,0,0), P0[2],P0[3],P0[4],P0[5],     pw0[0]=PKW(P0,0), pw0[1]=PKW(P0,2), pw0); \
    VRD(4); SBAR(); GAPA(C1=__builtin_amdgcn_mfma_f32_32x32x16_bf16(kf[1],qr[0],CINIT,0,0,0), P0[6],P0[7],P0[8],P0[9],     pw0[2]=PKW(P0,4), pw0[3]=PKW(P0,6), pw0); \
    VRD(1); SBAR(); GAPA(C0=__builtin_amdgcn_mfma_f32_32x32x16_bf16(kf[2],qr[1],C0,0,0,0),   P0[10],P0[11],P0[12],P0[13], pw1[0]=PKW(P0,8), pw1[1]=PKW(P0,10), pw1); \
    VRD(5); SBAR(); GAPA(C1=__builtin_amdgcn_mfma_f32_32x32x16_bf16(kf[3],qr[1],C1,0,0,0),   P0[14],P0[15],P1[0],P1[1],   pw1[2]=PKW(P0,12),pw1[3]=PKW(P0,14), pw1); \
    VRD(2); SBAR(); GAPA(C0=__builtin_amdgcn_mfma_f32_32x32x16_bf16(kf[4],qr[2],C0,0,0,0),   P1[2],P1[3],P1[4],P1[5],     pw2[0]=PKW(P1,0), pw2[1]=PKW(P1,2), pw2); \
    VRD(6); SBAR(); GAPA(C1=__builtin_amdgcn_mfma_f32_32x32x16_bf16(kf[5],qr[2],C1,0,0,0),   P1[6],P1[7],P1[8],P1[9],     pw2[2]=PKW(P1,4), pw2[3]=PKW(P1,6), pw2); \
    VRD(3); SBAR(); GAPA(C0=__builtin_amdgcn_mfma_f32_32x32x16_bf16(kf[6],qr[3],C0,0,0,0),   P1[10],P1[11],P1[12],P1[13], pw3[0]=PKW(P1,8), pw3[1]=PKW(P1,10), pw3); \
    VRD(7); SBAR(); GAPA(C1=__builtin_amdgcn_mfma_f32_32x32x16_bf16(kf[7],qr[3],C1,0,0,0),   P1[14],P1[15],0.f,0.f,       pw3[2]=PKW(P1,12),pw3[3]=PKW(P1,14), pw3); \
    l_reg+=sacc; \
    if(GK){DMA_K((t)+3,sl_cur);} if(GV){DMA_V((t)+1,sl_next);} \
    CMASK(C0,C1,t); \
    { float a=MX3(C0[0],C0[1],C1[0]),b=MX3(C0[2],C0[3],C1[1]); a=MX3(a,C1[2],C1[3]); \
      _Pragma("unroll") for(int r=4;r<16;r+=4){a=MX3(a,C0[r],C0[r+1]);b=MX3(b,C0[r+2],C0[r+3]);a=MX3(a,C1[r],C1[r+1]);b=MX3(b,C1[r+2],C1[r+3]);} \
      float rm=__builtin_fmaxf(a,b); { auto rr=__builtin_amdgcn_permlane32_swap(__float_as_uint(rm),__float_as_uint(rm),false,false); rm=__builtin_fmaxf(__uint_as_float(rr[0]),__uint_as_float(rr[1])); } \
      resc=false; \
      if(__builtin_expect(__any(rm>(float)THRL),0)){ const float dl=__builtin_fmaxf(rm,0.f); mhat+=dl; \
        _Pragma("unroll") for(int r=0;r<16;++r){C0[r]-=dl;C1[r]-=dl;} \
        if(MODE==0){ _Pragma("unroll") for(int r=0;r<16;++r)negm[r]=-mhat; asm volatile("":"+v"(negm)); } \
        const float f=__builtin_amdgcn_exp2f(-dl); l_reg*=f; if(hi==0)wsf[r32]=f; resc=true; } } \
    SBAR(); \
    GAPB(o[0]=__builtin_amdgcn_mfma_f32_32x32x16_bf16(PAF(0),VFR(0),o[0],0,0,0), C0,0); \
    GAPB(o[1]=__builtin_amdgcn_mfma_f32_32x32x16_bf16(PAF(0),VFR(4),o[1],0,0,0), C0,4); \
    KRD(GL,0); GAPB(o[0]=__builtin_amdgcn_mfma_f32_32x32x16_bf16(PAF(1),VFR(1),o[0],0,0,0), C0,8); \
    KRD(GL,1); GAPB(o[1]=__builtin_amdgcn_mfma_f32_32x32x16_bf16(PAF(1),VFR(5),o[1],0,0,0), C0,12); \
    KRD(GL,2); GAPB(o[0]=__builtin_amdgcn_mfma_f32_32x32x16_bf16(PAF(2),VFR(2),o[0],0,0,0), C1,0); \
    KRD(GL,3); GAPB(o[1]=__builtin_amdgcn_mfma_f32_32x32x16_bf16(PAF(2),VFR(6),o[1],0,0,0), C1,4); \
    GAPB(o[0]=__builtin_amdgcn_mfma_f32_32x32x16_bf16(PAF(3),VFR(3),o[0],0,0,0), C1,8); \
    GAPB(o[1]=__builtin_amdgcn_mfma_f32_32x32x16_bf16(PAF(3),VFR(7),o[1],0,0,0), C1,12); \
    }while(0)
  int t=1;
  for(;t+5<NT;t+=2){
    STEP(pB0,pB1,pA0,pA1,t,true,true,true);     WAIT_BAR(2); RESC(); ROT();
    STEP(pA0,pA1,pB0,pB1,t+1,true,true,true);   WAIT_BAR(2); RESC(); ROT();
  }
  #define ENDW(tt) do{ if((tt)+3<NT){WAIT_BAR(2);} else if((tt)+2<NT){WAIT_BAR(1);} else {WAIT_BAR(0);} }while(0)
  for(;t+1<NT;t+=2){
    STEP(pB0,pB1,pA0,pA1,t,(t+3<NT),(t+1<NT),(t+1<NT));       ENDW(t);   RESC(); ROT();
    STEP(pA0,pA1,pB0,pB1,t+1,(t+4<NT),(t+2<NT),(t+2<NT));     ENDW(t+1); RESC(); ROT();
  }
  STEP(pB0,pB1,pA0,pA1,NT-1,false,false,false); RESC();
  { float sacc=pB0[0]+pB0[1]; _Pragma("unroll") for(int r=2;r<16;++r)sacc+=pB0[r]; _Pragma("unroll") for(int r=0;r<16;++r)sacc+=pB1[r]; l_reg+=sacc;
    pw0=(u32x4){PKW(pB0,0),PKW(pB0,2),PKW(pB0,4),PKW(pB0,6)};pw1=(u32x4){PKW(pB0,8),PKW(pB0,10),PKW(pB0,12),PKW(pB0,14)};pw2=(u32x4){PKW(pB1,0),PKW(pB1,2),PKW(pB1,4),PKW(pB1,6)};pw3=(u32x4){PKW(pB1,8),PKW(pB1,10),PKW(pB1,12),PKW(pB1,14)};
    SBAR(); pv(o,vb0+sl_cur,PAF(0),PAF(1),PAF(2),PAF(3)); }
  #undef PKW
  #undef PAF
  #undef VFR
  #undef PIN
  #undef MX3
  #undef GAPA
  #undef GAPB
  #undef EX
  #undef VRD
  #undef KRD
  #undef STEP
  #undef ENDW
  {auto rr=__builtin_amdgcn_permlane32_swap(__float_as_uint(l_reg),__float_as_uint(l_reg),false,false);l_reg=__uint_as_float(rr[0])+__uint_as_float(rr[1]);}
  if(hi==0)wsf[32+r32]=l_reg;asm volatile("s_waitcnt lgkmcnt(0)":::"memory");
  float rli[16];
  #pragma unroll
  for(int r=0;r<16;++r)rli[r]=__builtin_amdgcn_rcpf(wsf[32+crow(r,hi)]);
  bf16*Ow=Ou+(long)(wid*QBLK)*OP;
  { bf16*stg=(bf16*)(shm+LDS_OST)+wid*2048;
    #pragma unroll
    for(int r=0;r<16;++r){const int orow=crow(r,hi);
      #pragma unroll
      for(int d0=0;d0<2;++d0)stg[orow*64+d0*32+r32]=(bf16)f2bf(o[d0][r]*rli[r]);}
    asm volatile("s_waitcnt lgkmcnt(0)":::"memory");
    #pragma unroll
    for(int i=0;i<4;++i){const int row=i*8+(lane>>3),ch=lane&7; const u32x4 v=*(const u32x4*)(stg+row*64+ch*8); ATTN_STORE16(Ow+(long)row*OP+ch*8,v);} }
  asm volatile("s_waitcnt lgkmcnt(0)\n\ts_barrier":::"memory");
  #undef DMA_K
  #undef DMA_V
  #undef TROW
  #undef CMASK
  #undef START
  #undef RESC
  #undef ROT
}
#undef SBAR
#undef WAIT_BAR
}

__device__ __forceinline__ void phase_attn_dense(const P& p, char* shm, int vcu, int G, const int wv_) {
    unsigned char* ws = p.ws; asm volatile("" : "+s"(ws));
    const int lane = hw_tid();
    const attn_body::bf16* QKV = (const attn_body::bf16*)(ws + WS_B1);
    attn_body::bf16* O = (attn_body::bf16*)(ws + WS_B2);
    const attn_body::NaArgs na{0, 0, 0, 0};
    for (int L = vcu; L < 1024 + 128; L += G) {
        size_t qo, ko, vo, oo; int ntile;
        if (L < 1024) {
            const int i = L >> 8, v = L & 255, xcd = v >> 5, j = v & 31;
            const int grp = 2 * xcd + (i >> 1), b = grp >> 1, kvh = grp & 1, u = (i & 1) * 32 + j, h = kvh * 4 + (u >> 4), qb = u & 15;
            const size_t rb = (size_t)b * RPB;
            qo = (rb + qb * 256) * 2304 + 64 * h; ko = rb * 2304 + 512 + 64 * kvh; vo = rb * 2304 + 640 + 64 * kvh; oo = (rb + qb * 256) * 1024 + 64 * h; ntile = 68;
        } else {
            const int u = L - 1024, typ = u >> 6, b = (u >> 3) & 7, h = u & 7;
            const size_t rc = (size_t)b * RPB + SEQ;
            const int qcol = typ ? 768 + 64 * h : 64 * h, kcol = typ ? 1280 + 64 * h : 512 + 64 * (h >> 2), vcol = typ ? 1792 + 64 * h : 640 + 64 * (h >> 2), ocol = typ ? 512 + 64 * h : 64 * h;
            qo = rc * 2304 + qcol; ko = rc * 2304 + kcol; vo = rc * 2304 + vcol; oo = rc * 1024 + ocol; ntile = 4;
        }
        attn_body::attn_unit<8, 2304, 1024, 0>(QKV + qo, QKV + ko, QKV + vo, O + oo, ntile, shm, wv_, lane, na);
    }
}

__device__ __forceinline__ void phase_attn_na(const P& p, int layer, char* shm, int vcu, int G, const int wv_) {
    unsigned char* ws = p.ws; asm volatile("" : "+s"(ws));
    const int lane = hw_tid(), tid = (wv_ << 6) | lane;
    const attn_body::bf16* QKV = (const attn_body::bf16*)(ws + WS_B1);
    attn_body::bf16* O = (attn_body::bf16*)(ws + WS_B2);
    float* T = (float*)(shm + attn_body::LDS_NAT_OFF);
    for (int L = vcu; L < 1024; L += G) {
        const int i = L >> 8, v = L & 255, xcd = v >> 5, j = v & 31;
        const int grp = (i * 8 + xcd) * 2 + (j >> 4), rblk = j & 15, b = grp >> 3, h = grp & 7;
        const float* rpb = p.na_rpb + (size_t)((layer >> 1) * 8 + h) * 15 * 31;
        for (int e = tid; e < 15 * 128; e += NTHR) { const int dr = e >> 7, d = (e & 127) - 63; T[e] = (d >= -15 && d <= 15) ? rpb[dr * 31 + d + 15] * 1.4426950408889634f : -INFINITY; }
        const int r0 = rblk * 4; int wr0 = r0 - 4; wr0 = wr0 < 0 ? 0 : (wr0 > 52 ? 52 : wr0);
        const size_t rb = (size_t)b * RPB;
        const attn_body::NaArgs na{SEQ, wr0 * 64, r0, wr0};
        attn_body::attn_unit<8, 2304, 1024, 1>(QKV + (rb + r0 * 64) * 2304 + 768 + 64 * h, QKV + rb * 2304 + 1280 + 64 * h, QKV + rb * 2304 + 1792 + 64 * h, O + (rb + r0 * 64) * 1024 + 512 + 64 * h, 16, shm, wv_, lane, na);
    }
}

__device__ __forceinline__ int gla_o256(int row, int ch) { return row * 256 + ((ch ^ (row & 15)) << 4); }
__device__ __forceinline__ int gla_o128(int row, int ch) { return (row >> 1) * 256 + (((((row & 1) << 3) | ch) ^ ((row >> 1) & 7)) << 4); }
__device__ __forceinline__ int gla_task(int b, int h, int dir, int s) { return ((b * 4 + h) * 2 + dir) * 68 + s; }
__device__ __forceinline__ int gla_rowc(int b, int dir, int s) { return b * RPB + (s < 4 ? SEQ + 64 * (dir ? 3 - s : s) : 64 * (dir ? 67 - s : s - 4)); }

__device__ __forceinline__ void phase_gla_pre(const P& p, int layer, LAS unsigned char* lds, int vcu, int G, const int wv_) {
    unsigned char* ws = p.ws; asm volatile("" : "+s"(ws));
    const int lane = hw_tid(), tid = (wv_ << 6) | lane, fr = lane & 15, fq = lane >> 4;
    constexpr int L_QD = 0, L_KI = 16384, L_KST = 32768, L_A = 49152, L_SB = 57344, SB_BYTES = 36864, SB_K = 16384, SB_Z = 32768, L_CL = RING_BYTES + 8192;
    static_assert(L_SB + 2 * SB_BYTES <= RING_BYTES && L_CL + 512 <= LDS_BYTES, "gla pre LDS map");
    LAS unsigned char* qd = lds + L_QD; LAS unsigned char* ki = lds + L_KI; LAS unsigned char* ksT = lds + L_KST; LAS unsigned char* Al = lds + L_A;
    LAS float* cls = (LAS float*)(lds + L_CL);
    const unsigned lds0 = (unsigned)(size_t)lds;
    const int li = layer >> 1;
    const bf16_t* X = (const bf16_t*)(ws + WS_B1);
    const float* Z = (const float*)(ws + WS_Z);
    const int pd = 16 * wv_ + fr;
#define GLAP_TASK(i_, bhd_, s_) const int bhd_ = ((i_) & 255) >> 2, s_ = 17 * ((i_) & 3) + ((i_) >> 8)
#define GLAP_DMA(i_, buf_) do { GLAP_TASK((i_), bhd__, s__); const int dir__ = bhd__ & 1, h__ = (bhd__ >> 1) & 3, b__ = bhd__ >> 3; const int rc_ = gla_rowc(b__, dir__, s__); \
        const unsigned sb_ = lds0 + L_SB + (unsigned)(buf_) * SB_BYTES; \
        _Pragma("unroll") for (int jj = 0; jj < 4; ++jj) { const int j = 4 * wv_ + jj;        \
            pg8::glds16_s((const char*)(X + (size_t)(rc_ + 4 * (j & 15)) * 3072 + h__ * 128 + (j >> 4) * 512), (unsigned)((lane >> 4) * 6144 + (((lane & 15) ^ (2 * (j & 3))) << 4)), sb_ + (unsigned)j * 1024u); } \
        if (wv_ < 4) pg8::glds16_s((const char*)(Z + (size_t)(rc_ + 16 * wv_) * 32 + dir__ * 16), (unsigned)((lane >> 2) * 128 + (lane & 3) * 16), sb_ + SB_Z + (unsigned)wv_ * 1024u); } while (0)
    int ti = vcu, kk_ = 0;
    if (ti < 4352) GLAP_DMA(ti, 0);
    int bhd_cur = -1; bf16x8 wx1 = (bf16x8){0, 0, 0, 0, 0, 0, 0, 0}, wx2 = wx1; float gbias = 0.f;
    for (; ti < 4352; ti += G, ++kk_) {
        GLAP_TASK(ti, bhd, s_chunk);
        const int dir = bhd & 1, h = (bhd >> 1) & 3, t = bhd * 68 + s_chunk;
        if (bhd != bhd_cur) {
            bhd_cur = bhd;
            const float* gw = (dir ? p.gk_w_b : p.gk_w_f) + (size_t)li * 16 * 512 + h * 128 + pd + (size_t)(8 * (fq & 1)) * 512;
            float wv8[8];
#pragma unroll
            for (int e = 0; e < 8; ++e) wv8[e] = gw[e * 512];
            gbias = ((dir ? p.gk_b_b : p.gk_b_f) + li * 512)[h * 128 + pd];
            unsigned hh[4], ll[4];
#pragma unroll
            for (int e = 0; e < 4; ++e) { hh[e] = pg8::cvt_pk_bf16(wv8[2 * e], wv8[2 * e + 1]);
                ll[e] = pg8::cvt_pk_bf16(wv8[2 * e] - __uint_as_float(hh[e] << 16), wv8[2 * e + 1] - __uint_as_float(hh[e] & 0xffff0000u)); if (fq >= 2) ll[e] = 0u; }
            wx1 = __builtin_bit_cast(bf16x8, (u32x4){hh[0], hh[1], hh[2], hh[3]}); wx2 = __builtin_bit_cast(bf16x8, (u32x4){ll[0], ll[1], ll[2], ll[3]});
        }
        if (kk_ == 0) asm volatile("s_waitcnt vmcnt(0)" ::: "memory"); else asm volatile("s_waitcnt vmcnt(5)" ::: "memory");
        __syncthreads();
        if (ti + G < 4352) GLAP_DMA(ti + G, (kk_ + 1) & 1);
        LAS unsigned char* sb = lds + L_SB + (kk_ & 1) * SB_BYTES;
        {
            float c[16];
#pragma unroll
            for (int T = 0; T < 4; ++T) {
                const LAS f32x4* zp = (const LAS f32x4*)(sb + SB_Z + (16 * T + fr) * 64 + (fq & 1) * 32);
                const f32x4 za = zp[0], zb = zp[1];
                unsigned zy[4];
#pragma unroll
                for (int e = 0; e < 4; ++e) { const float z0 = e < 2 ? za[2 * e] : zb[2 * e - 4], z1 = e < 2 ? za[2 * e + 1] : zb[2 * e - 3];
                    const unsigned hz = pg8::cvt_pk_bf16(z0, z1), lz = pg8::cvt_pk_bf16(z0 - __uint_as_float(hz << 16), z1 - __uint_as_float(hz & 0xffff0000u)); zy[e] = fq < 2 ? hz : lz; }
                const bf16x8 zf = __builtin_bit_cast(bf16x8, (u32x4){zy[0], zy[1], zy[2], zy[3]});
                f32x4 xa = (f32x4){gbias, gbias, gbias, gbias};
                xa = __builtin_amdgcn_mfma_f32_16x16x32_bf16(zf, wx1, xa, 0, 0, 0);
                xa = __builtin_amdgcn_mfma_f32_16x16x32_bf16(zf, wx2, xa, 0, 0, 0);
#pragma unroll
                for (int i = 0; i < 4; ++i) { const float x = xa[i];
                    const float l = __builtin_amdgcn_logf(1.f + __builtin_amdgcn_exp2f(-fabsf(x) * 1.4426950408889634f));
                    c[4 * T + i] = (fminf(x, 0.f) * 1.4426950408889634f - l) * (1.f / 16.f); }
            }
            float cl = 0.f;
            if (dir == 0) {
#pragma unroll
                for (int T = 0; T < 4; ++T) {
                    c[4 * T + 1] += c[4 * T]; c[4 * T + 2] += c[4 * T + 1]; c[4 * T + 3] += c[4 * T + 2];
                    const float R = c[4 * T + 3];
                    const float p1 = swz_xor<16>(R), pair = R + p1;
                    auto rr = __builtin_amdgcn_permlane32_swap(__float_as_uint(pair), __float_as_uint(pair), false, false);
                    const float q = __uint_as_float(fq >= 2 ? rr[0] : rr[1]);
                    const float ex = ((fq & 1) ? p1 : 0.f) + ((fq & 2) ? q : 0.f) + cl;
#pragma unroll
                    for (int i = 0; i < 4; ++i) c[4 * T + i] += ex;
                    cl += pair + q;
                }
            } else {
#pragma unroll
                for (int T = 3; T >= 0; --T) {
                    c[4 * T + 2] += c[4 * T + 3]; c[4 * T + 1] += c[4 * T + 2]; c[4 * T] += c[4 * T + 1];
                    const float R = c[4 * T];
                    const float p1 = swz_xor<16>(R), pair = R + p1;
                    auto rr = __builtin_amdgcn_permlane32_swap(__float_as_uint(pair), __float_as_uint(pair), false, false);
                    const float q = __uint_as_float(fq >= 2 ? rr[0] : rr[1]);
                    const float ex = ((fq & 1) ? 0.f : p1) + ((fq & 2) ? 0.f : q) + cl;
#pragma unroll
                    for (int i = 0; i < 4; ++i) c[4 * T + i] += ex;
                    cl += pair + q;
                }
            }
            if (fq == 0) cls[pd] = cl;
            const float qs = 0.08838834764831845f, ecl = __builtin_amdgcn_exp2f(cl);
            const int dch = pd >> 3, dlo = (pd & 7) * 2;
            const LAS unsigned char* qsrc = sb + fq * 1024 + ((dch ^ (2 * fq)) << 4) + dlo;
#pragma unroll
            for (int T = 0; T < 4; ++T) {
                unsigned kw[2];
#pragma unroll
                for (int i = 0; i < 4; i += 2) {
                    const int n = 4 * T + i;
                    const float c0 = c[n], c1 = c[n + 1];
                    const float e0 = __builtin_amdgcn_exp2f(c0), e1 = __builtin_amdgcn_exp2f(c1);
                    const float r0 = __builtin_amdgcn_rcpf(e0), r1 = __builtin_amdgcn_rcpf(e1);
                    const float q0 = bf2f(*(const LAS bf16_t*)(qsrc + 4096 * T + 256 * i)), q1 = bf2f(*(const LAS bf16_t*)(qsrc + 4096 * T + 256 * (i + 1)));
                    const float k0 = bf2f(*(const LAS bf16_t*)(qsrc + SB_K + 4096 * T + 256 * i)), k1 = bf2f(*(const LAS bf16_t*)(qsrc + SB_K + 4096 * T + 256 * (i + 1)));
                    const int tk0 = 16 * T + 4 * fq + i;
                    const unsigned qq = pg8::cvt_pk_bf16(q0 * qs * e0, q1 * qs * e1), kk2 = pg8::cvt_pk_bf16(k0 * r0, k1 * r1);
                    *(LAS bf16_t*)(qd + gla_o256(tk0, dch) + dlo) = (bf16_t)(qq & 0xffffu); *(LAS bf16_t*)(qd + gla_o256(tk0 + 1, dch) + dlo) = (bf16_t)(qq >> 16);
                    *(LAS bf16_t*)(ki + gla_o256(tk0, dch) + dlo) = (bf16_t)(kk2 & 0xffffu); *(LAS bf16_t*)(ki + gla_o256(tk0 + 1, dch) + dlo) = (bf16_t)(kk2 >> 16);
                    kw[i >> 1] = pg8::cvt_pk_bf16(k0 * (ecl * r0), k1 * (ecl * r1));
                }
                *(LAS u32x2*)(ksT + gla_o128(pd, 2 * T + (fq >> 1)) + (fq & 1) * 8) = (u32x2){kw[0], kw[1]};
            }
        }
        __syncthreads();
        {
            const int it = wv_ >> 1;
            f32x4 a2[2] = {(f32x4){0.f, 0.f, 0.f, 0.f}, (f32x4){0.f, 0.f, 0.f, 0.f}};
#pragma unroll
            for (int kk = 0; kk < 4; ++kk) {
                const bf16x8 xa = *(const LAS bf16x8*)(qd + gla_o256(16 * it + fr, 4 * kk + fq));
#pragma unroll
                for (int jj = 0; jj < 2; ++jj) { const int jt = 2 * (wv_ & 1) + jj;
                    const bf16x8 yb = *(const LAS bf16x8*)(ki + gla_o256(16 * jt + fr, 4 * kk + fq));
                    a2[jj] = __builtin_amdgcn_mfma_f32_16x16x32_bf16(yb, xa, a2[jj], 0, 0, 0); }
            }
#pragma unroll
            for (int jj = 0; jj < 2; ++jj) { const int jt = 2 * (wv_ & 1) + jj; const int i = 16 * it + fr, j0 = 16 * jt + 4 * fq;
                float m4[4];
#pragma unroll
                for (int cc = 0; cc < 4; ++cc) { const int j = j0 + cc; const bool keep = dir ? (j >= i) : (j <= i); m4[cc] = keep ? a2[jj][cc] : 0.f; }
                *(LAS u32x2*)(Al + gla_o128(i, j0 >> 3) + (j0 & 7) * 2) = (u32x2){pg8::cvt_pk_bf16(m4[0], m4[1]), pg8::cvt_pk_bf16(m4[2], m4[3])}; }
        }
        __syncthreads();
        {
            GAS u32x4* gq = (GAS u32x4*)(ws + WS_GQD + (size_t)t * 16384); GAS u32x4* gk = (GAS u32x4*)(ws + WS_GKS + (size_t)t * 16384); GAS u32x4* ga = (GAS u32x4*)(ws + WS_GA + (size_t)t * 8192); GAS u32x4* gc = (GAS u32x4*)(ws + WS_GCL + (size_t)t * 512);
            gq[tid] = *(const LAS u32x4*)(qd + tid * 16); gq[tid + 512] = *(const LAS u32x4*)(qd + (tid + 512) * 16);
            gk[tid] = *(const LAS u32x4*)(ksT + tid * 16); gk[tid + 512] = *(const LAS u32x4*)(ksT + (tid + 512) * 16);
            ga[tid] = *(const LAS u32x4*)(Al + tid * 16);
            if (tid < 32) gc[tid] = *(const LAS u32x4*)((LAS unsigned char*)cls + tid * 16);
        }
        __syncthreads();
    }
    asm volatile("s_waitcnt vmcnt(0)" ::: "memory");
#undef GLAP_DMA
#undef GLAP_TASK
}

__device__ __forceinline__ void phase_gla_scan(const P& p, int layer, LAS unsigned char* lds, int vcu, int G, const int wv_) {
    unsigned char* ws = p.ws; asm volatile("" : "+s"(ws));
    const int lane = hw_tid(), tid = (wv_ << 6) | lane, fr = lane & 15, fq = lane >> 4;
    constexpr int B_QD = 0, B_KST = 16384, B_A = 32768, B_V = 40960, B_CL = 49152, BUF = 50176, L_ST = 2 * BUF;
    static_assert(L_ST + 16384 <= RING_BYTES, "gla scan LDS map");
    LAS unsigned char* ST = lds + L_ST;
    const unsigned lds0 = (unsigned)(size_t)lds;
    const bf16_t* X = (const bf16_t*)(ws + WS_B1);
    for (int u = vcu; u < 256; u += G) {
        const int b = u >> 5, h = (u >> 3) & 3, dir = (u >> 2) & 1, sl = u & 3;
        bf16_t* O = (bf16_t*)(ws + WS_B2) + (dir ? (size_t)68 * MiB / 2 : 0);
        const int tk0 = gla_task(b, h, dir, 0);
        f32x4 sacc[4];
#pragma unroll
        for (int et = 0; et < 4; ++et) sacc[et] = (f32x4){0.f, 0.f, 0.f, 0.f};
        for (int e = tid; e < 4096; e += NTHR) ((LAS unsigned*)ST)[e] = 0u;
#define GLAS_DMA(s_) do { const int s__ = (s_); const unsigned bo_ = lds0 + (unsigned)((s__ & 1) * BUF); const size_t tk_ = (size_t)(tk0 + s__); const unsigned lo_ = (unsigned)lane * 16u; \
            pg8::glds16_s((const char*)(ws + WS_GQD) + tk_ * 16384 + (2 * wv_) * 1024, lo_, bo_ + B_QD + (2 * wv_) * 1024); pg8::glds16_s((const char*)(ws + WS_GQD) + tk_ * 16384 + (2 * wv_ + 1) * 1024, lo_, bo_ + B_QD + (2 * wv_ + 1) * 1024); \
            pg8::glds16_s((const char*)(ws + WS_GKS) + tk_ * 16384 + (2 * wv_) * 1024, lo_, bo_ + B_KST + (2 * wv_) * 1024); pg8::glds16_s((const char*)(ws + WS_GKS) + tk_ * 16384 + (2 * wv_ + 1) * 1024, lo_, bo_ + B_KST + (2 * wv_ + 1) * 1024); \
            pg8::glds16_s((const char*)(ws + WS_GA) + tk_ * 8192 + wv_ * 1024, lo_, bo_ + B_A + wv_ * 1024); \
            pg8::glds16_s((const char*)(X + (size_t)(gla_rowc(b, dir, s__) + 8 * wv_) * 3072 + 1024 + h * 256 + sl * 64), (unsigned)((lane >> 3) * 6144 + (((lane & 7) ^ (2 * (((lane >> 4) & 1) | ((wv_ & 1) << 1)))) << 4)), bo_ + B_V + wv_ * 1024); \
            if (wv_ == 0 && lane < 32) pg8::glds16_s((const char*)(ws + WS_GCL) + tk_ * 512, lo_, bo_ + B_CL); } while (0)
        GLAS_DMA(0); GLAS_DMA(1);
        __syncthreads();
#pragma unroll 1
        for (int s = 0; s < 68; ++s) {
            LAS unsigned char* bq = lds + (s & 1) * BUF;
            const int rowc = gla_rowc(b, dir, s);
            if (s == 0) asm volatile("s_waitcnt vmcnt(6)" ::: "memory");
            else if (s == 1) { if (wv_ == 0) asm volatile("s_waitcnt vmcnt(9)" ::: "memory"); else asm volatile("s_waitcnt vmcnt(8)" ::: "memory"); }
            else if (s + 1 < 68) { if (wv_ == 0) asm volatile("s_waitcnt vmcnt(11)" ::: "memory"); else asm volatile("s_waitcnt vmcnt(10)" ::: "memory"); }
            else asm volatile("s_waitcnt vmcnt(4)" ::: "memory");
            __syncthreads();
            {
                const int it = wv_ >> 1, e0 = 2 * (wv_ & 1);
                bf16x8 fa[2], fq4[4], fv[2][4], fs[4][2], fk[2];
                typedef short s4v __attribute__((ext_vector_type(4)));
                const int tq = fr >> 2, tp = fr & 3, fx = ((tq >> 1) & 1) | ((fq & 1) << 1);
                LAS unsigned char* vb = bq + B_V + (8 * fq + tq) * 128 + tp * 8;
#pragma unroll
                for (int kk = 0; kk < 2; ++kk) { fa[kk] = *(const LAS bf16x8*)(bq + B_A + gla_o128(16 * it + fr, 4 * kk + fq)); fk[kk] = *(const LAS bf16x8*)(bq + B_KST + gla_o128(16 * wv_ + fr, 4 * kk + fq));
#pragma unroll
                    for (int et = 0; et < 4; ++et) { LAS unsigned char* va = vb + kk * 4096 + ((et ^ fx) << 5);
                        const s4v lo4 = __builtin_amdgcn_ds_read_tr16_b64_v4i16((LAS s4v*)va), hi4 = __builtin_amdgcn_ds_read_tr16_b64_v4i16((LAS s4v*)(va + 512));
                        fv[kk][et] = __builtin_shufflevector(lo4, hi4, 0, 1, 2, 3, 4, 5, 6, 7); }
 }
#pragma unroll
                for (int kk = 0; kk < 4; ++kk) { fq4[kk] = *(const LAS bf16x8*)(bq + B_QD + gla_o256(16 * it + fr, 4 * kk + fq));
#pragma unroll
                    for (int jj = 0; jj < 2; ++jj) fs[kk][jj] = *(const LAS bf16x8*)(ST + gla_o256(16 * (e0 + jj) + fr, 4 * kk + fq)); }
                const f32x4 clv = *(const LAS f32x4*)(bq + B_CL + (16 * wv_ + 4 * fq) * 4);
                asm volatile("s_waitcnt lgkmcnt(0)" ::: "memory");
                __syncthreads();
                if (s + 2 < 68) GLAS_DMA(s + 2);
                f32x4 o2[2] = {(f32x4){0.f, 0.f, 0.f, 0.f}, (f32x4){0.f, 0.f, 0.f, 0.f}};
                if (wv_ & 1) {
#pragma unroll
                    for (int kk = 0; kk < 2; ++kk)
#pragma unroll
                        for (int jj = 0; jj < 2; ++jj) o2[jj] = __builtin_amdgcn_mfma_f32_16x16x32_bf16(fv[kk][2 + jj], fa[kk], o2[jj], 0, 0, 0);
                } else {
#pragma unroll
                    for (int kk = 0; kk < 2; ++kk)
#pragma unroll
                        for (int jj = 0; jj < 2; ++jj) o2[jj] = __builtin_amdgcn_mfma_f32_16x16x32_bf16(fv[kk][jj], fa[kk], o2[jj], 0, 0, 0);
                }
#pragma unroll
                for (int kk = 0; kk < 4; ++kk)
#pragma unroll
                    for (int jj = 0; jj < 2; ++jj) o2[jj] = __builtin_amdgcn_mfma_f32_16x16x32_bf16(fs[kk][jj], fq4[kk], o2[jj], 0, 0, 0);
                const f32x4 dec = (f32x4){__builtin_amdgcn_exp2f(clv[0]), __builtin_amdgcn_exp2f(clv[1]), __builtin_amdgcn_exp2f(clv[2]), __builtin_amdgcn_exp2f(clv[3])};
#pragma unroll
                for (int et = 0; et < 4; ++et) sacc[et] = sacc[et] * dec;
#pragma unroll
                for (int kk = 0; kk < 2; ++kk)
#pragma unroll
                    for (int et = 0; et < 4; ++et) sacc[et] = __builtin_amdgcn_mfma_f32_16x16x32_bf16(fk[kk], fv[kk][et], sacc[et], 0, 0, 0);
#pragma unroll
                for (int jj = 0; jj < 2; ++jj) { const int et = e0 + jj;
                    *(GAS u32x2*)(O + (size_t)(rowc + 16 * it + fr) * 1024 + h * 256 + sl * 64 + 16 * et + 4 * fq) = (u32x2){pg8::cvt_pk_bf16(o2[jj][0], o2[jj][1]), pg8::cvt_pk_bf16(o2[jj][2], o2[jj][3])}; }
            }
#pragma unroll
            for (int et = 0; et < 4; ++et) { const int d0 = 16 * wv_ + 4 * fq; *(LAS u32x2*)(ST + gla_o256(16 * et + fr, d0 >> 3) + (d0 & 7) * 2) = (u32x2){pg8::cvt_pk_bf16(sacc[et][0], sacc[et][1]), pg8::cvt_pk_bf16(sacc[et][2], sacc[et][3])}; }
        }
        __syncthreads();
#undef GLAS_DMA
    }
}

__device__ __forceinline__ float half_sum(float v) { v += swz_xor<1>(v); v += swz_xor<2>(v); v += swz_xor<4>(v); v += swz_xor<8>(v); v += swz_xor<16>(v); return v; }
__device__ __forceinline__ void phase_gla_merge(const P& p, int layer, int vcu, int G, const int wv_) {
    unsigned char* ws = p.ws; asm volatile("" : "+s"(ws));
    const int lane = hw_tid(), wave = wv_;
    constexpr int NRW = 4;
    const bf16_t* OF = (const bf16_t*)(ws + WS_B2); const bf16_t* OB = OF + (size_t)68 * MiB / 2; bf16_t* O = (bf16_t*)(ws + WS_B2);
    const bf16_t* X = (const bf16_t*)(ws + WS_B1);
    for (int r0 = (vcu * NWAVES + wave) * NRW; r0 < NR; r0 += G * NWAVES * NRW) {
        const float* gnp = p.gla_o_norm + (layer >> 1) * 256 + (lane & 31) * 8;
        const f32x4 gn0 = *(const GAS f32x4*)gnp, gn1 = *(const GAS f32x4*)(gnp + 4);
        u32x4 a[NRW][2], bb[NRW][2], og[NRW][2];
#pragma unroll
        for (int q = 0; q < NRW; ++q)
#pragma unroll
            for (int hp = 0; hp < 2; ++hp) { const size_t i0 = (size_t)(r0 + q) * 1024 + 8 * (lane + 64 * hp);
                a[q][hp] = *(const GAS u32x4*)(OF + i0); bb[q][hp] = *(const GAS u32x4*)(OB + i0); og[q][hp] = *(const GAS u32x4*)(X + (size_t)(r0 + q) * 3072 + 2048 + 8 * (lane + 64 * hp)); }
#pragma unroll
        for (int q = 0; q < NRW; ++q)
#pragma unroll
            for (int hp = 0; hp < 2; ++hp) {
                float x[8]; float sq = 0.f;
#pragma unroll
                for (int w = 0; w < 4; ++w) { const unsigned ua = a[q][hp][w], ub = bb[q][hp][w];
                    x[2 * w] = __uint_as_float(ua << 16) + __uint_as_float(ub << 16); x[2 * w + 1] = __uint_as_float(ua & 0xffff0000u) + __uint_as_float(ub & 0xffff0000u);
                    sq += x[2 * w] * x[2 * w] + x[2 * w + 1] * x[2 * w + 1]; }
                const float rs = rsqrtf(half_sum(sq) * (1.f / 256.f) + EPS);
                unsigned ow[4];
#pragma unroll
                for (int w = 0; w < 4; ++w) { const unsigned ug = og[q][hp][w];
                    const float g0 = (w < 2 ? gn0[2 * w] : gn1[2 * w - 4]), g1 = (w < 2 ? gn0[2 * w + 1] : gn1[2 * w - 3]);
                    ow[w] = pk2(x[2 * w] * rs * g0 * silu_f(__uint_as_float(ug << 16)), x[2 * w + 1] * rs * g1 * silu_f(__uint_as_float(ug & 0xffff0000u))); }
                *(GAS u32x4*)(O + (size_t)(r0 + q) * 1024 + 8 * (lane + 64 * hp)) = (u32x4){ow[0], ow[1], ow[2], ow[3]};
            }
    }
}

__device__ __forceinline__ int wave_sum_i(int v) {
    v += __builtin_amdgcn_ds_swizzle(v, (1 << 10) | 0x1f); v += __builtin_amdgcn_ds_swizzle(v, (2 << 10) | 0x1f); v += __builtin_amdgcn_ds_swizzle(v, (4 << 10) | 0x1f);
    v += __builtin_amdgcn_ds_swizzle(v, (8 << 10) | 0x1f); v += __builtin_amdgcn_ds_swizzle(v, (16 << 10) | 0x1f);
    auto rr = __builtin_amdgcn_permlane32_swap((unsigned)v, (unsigned)v, false, false);
    return (int)(rr[0] + rr[1]);
}
__device__ __forceinline__ void phase_topk(const P& p, LAS unsigned char* lds, int vcu, int G, const int wv_, const int nunits) {
    unsigned char* ws = p.ws; asm volatile("" : "+s"(ws));
    const int lane = hw_tid(), tid = (wv_ << 6) | lane;
    LAS int* red = (LAS int*)lds;
    const float* aff = (const float*)(ws + WS_AFF);
    int* idx = (int*)(ws + WS_IDX); float* gatev = (float*)(ws + WS_GATE); int* pos = (int*)(ws + WS_POS);
    for (int u = vcu; u < nunits; u += G) {
        const int s = u >> 4, e = u & 15, b = s & 7;
        const int n = s < 8 ? SEQ : CTXL, cap = n / 8;
        const int row0 = b * RPB + (s < 8 ? 0 : SEQ);
        unsigned key[8];
        { const float* ak = aff + (s < 8 ? (size_t)(b * 16 + e) * SEQ : (size_t)NB * 16 * SEQ + (size_t)(b * 16 + e) * CTXL) + tid * 8;
          f32x4 k0 = (f32x4){0.f, 0.f, 0.f, 0.f}, k1 = k0; if (tid * 8 < n) { k0 = *(const GAS f32x4*)ak; k1 = *(const GAS f32x4*)(ak + 4); }
#pragma unroll
          for (int k = 0; k < 8; ++k) { const float kv = k < 4 ? k0[k] : k1[k - 4]; key[k] = tid * 8 + k < n ? (__float_as_uint(kv) | 0x80000000u) : 0u; } }
        unsigned T = 0u;
#pragma unroll 1
        for (int lo = 30; lo >= 0; lo -= 2) {
            const unsigned c1 = T | (1u << lo), c2 = T | (2u << lo), c3 = T | (3u << lo);
            int c = 0;
#pragma unroll
            for (int k = 0; k < 8; ++k) c += (key[k] >= c1 ? 1 : 0) + (key[k] >= c2 ? (1 << 10) : 0) + (key[k] >= c3 ? (1 << 20) : 0);
            c = wave_sum_i(c);
            LAS int* rb = red + ((lo >> 1) & 1) * 8;
            if (lane == 0) rb[wv_] = c;
            __syncthreads();
            int t1 = 0, t2 = 0, t3 = 0;
#pragma unroll
            for (int q = 0; q < 8; ++q) { const int v = rb[q]; t1 += v & 1023; t2 += (v >> 10) & 1023; t3 += (v >> 20) & 1023; }
            T = t3 >= cap ? c3 : (t2 >= cap ? c2 : (t1 >= cap ? c1 : T));
        }
        int mine = 0;
#pragma unroll
        for (int k = 0; k < 8; ++k) mine += (key[k] > T ? 1 : 0) + (key[k] == T ? 0x10000 : 0);
        int inc = mine;
#pragma unroll
        for (int o = 1; o < 64; o <<= 1) { const int t2 = __builtin_amdgcn_ds_bpermute(((lane - o) & 63) << 2, inc); if (lane >= o) inc += t2; }
        __syncthreads();
        if (lane == 63) red[16 + wv_] = inc;
        __syncthreads();
        int base = 0, total = 0;
#pragma unroll
        for (int q = 0; q < 8; ++q) { const int t2 = red[16 + q]; total += t2; if (q < wv_) base += t2; }
        int ex = base + inc - mine;
        const int m = total & 0xffff;
        const int slot0 = (s < 8 ? 0 : NSLOT_LAT) + (e * 8 + b) * cap;
#pragma unroll
        for (int k = 0; k < 8; ++k) {
            const int i = tid * 8 + k;
            if (i < n) {
                const int g = ex & 0xffff, q = ex >> 16;
                int sl = -1;
                if (key[k] > T) sl = g; else if (key[k] == T && m + q < cap) sl = m + q;
                const int row = row0 + i;
                if (sl >= 0) { idx[slot0 + sl] = row; gatev[slot0 + sl] = __uint_as_float(key[k] & 0x7fffffffu); }
                pos[(size_t)row * 16 + e] = sl >= 0 ? slot0 + sl : -1;
                ex += (key[k] > T ? 1 : 0) + (key[k] == T ? 0x10000 : 0);
            }
        }
        __syncthreads();
    }
}

constexpr int N_PHASES = 38;
__global__ void __launch_bounds__(NTHR, 2) mega_fwd(P p) {
    extern __shared__ __attribute__((aligned(16))) unsigned char lds_raw[];
    LAS unsigned char* lds = (LAS unsigned char*)lds_raw;
    volatile LAS unsigned* MISC = (volatile LAS unsigned*)(lds + MISC_OFF);
    const int tid = threadIdx.x;
    const int wv0 = __builtin_amdgcn_readfirstlane(tid >> 6);
    const int G = gridDim.x; const int bx0 = blockIdx.x;
    const int vcu0 = (G % 8 == 0) ? (bx0 % 8) * (G / 8) + bx0 / 8 : bx0;
    for (int u = tid; u < (LDS_BYTES - RING_BYTES) / 4; u += NTHR) ((LAS unsigned*)(lds + RING_BYTES))[u] = 0u;
    __syncthreads();
    const int lo = p.ph_lo, hi = p.ph_hi;
    unsigned* barw = (unsigned*)(p.ws + WS_CTL) + 4096 + p.seg * XCD_BAR_WORDS;
    XcdBarrier bar; bar.bar = barw; bar.x = 0; bar.st = MISC + 8;
    if (hi - lo > 1) bar = xcd_barrier_post(barw, MISC + 8);
#define IN(k) (lo <= (k) && (k) < hi)
#define SEAM(k) do { if ((k) + 1 < hi) xcd_barrier(bar, wv0); } while (0)
    if (IN(0)) { for (int rep_ = 0; rep_ < ((DUP_MASK >> 0) & 1) + 1; ++rep_) { phase_prologue(p, lds, vcu0, G, wv0); } SEAM(0); }
#pragma unroll 1
    for (int layer = 0; layer < 4; ++layer) {
        const int base = 1 + 9 * layer, li = layer >> 1;
        int bx = bx0, vcu = vcu0, wv = wv0; unsigned char* ws = p.ws; asm volatile("" : "+s"(bx), "+s"(vcu), "+s"(ws), "+s"(wv));
        if (IN(base + 0)) { if (layer == 0) phase_norm<0>(p, layer, lds, vcu, G, wv); else phase_norm<1>(p, layer, lds, vcu, G, wv); SEAM(base + 0); }
        if ((layer & 1) == 0) {
            if (IN(base + 1)) {
                pg8::Gemm g{(const bf16_t*)(ws + WS_U), (const bf16_t*)(ws + W_ATTN_IN) + (size_t)li * 2304 * 1024, NR, 2304, nullptr, 0};
                pg8::StaticOrder S; S.init(NR, 2304, G, bx);
                pg8::EpiQKV E{(bf16_t*)(ws + WS_B1), (const float*)(ws + WS_ROPE + 16384) + li * 256, (const float*)(ws + WS_ROPE)};
                for (int rep_ = 0; rep_ < ((DUP_MASK >> 1) & 1) + 1; ++rep_) { pg8::gemm_phase<pg8::EpiQKV, false, false>(lds, g, S, E, wv); }
                if (G == 256 && bx >= 200) moe_window(p, lds, layer, 0, bx - 200, wv);
                SEAM(base + 1);
            }
            if (IN(base + 3)) { for (int rep_ = 0; rep_ < ((DUP_MASK >> 2) & 1) + 1; ++rep_) { phase_attn_dense(p, (char*)lds_raw, vcu, G, wv); phase_attn_na(p, layer, (char*)lds_raw, vcu, G, wv); } SEAM(base + 3); }
        } else {
            if (IN(base + 1)) {
                pg8::Gemm g{(const bf16_t*)(ws + WS_U), (const bf16_t*)(ws + W_GLA_IN) + (size_t)li * 3328 * 1024, NR, 3328, nullptr, 0};
                pg8::StaticOrder S; S.init(NR, 3328, G, bx);
                pg8::EpiGlaIn E{(bf16_t*)(ws + WS_B1), (float*)(ws + WS_Z)};
                for (int rep_ = 0; rep_ < ((DUP_MASK >> 1) & 1) + 1; ++rep_) { pg8::gemm_phase<pg8::EpiGlaIn, false, false>(lds, g, S, E, wv); }
                if (G == 256 && bx >= 232) moe_window(p, lds, layer, 0, bx - 232, wv);
                SEAM(base + 1);
            }
            if (IN(base + 2)) { for (int rep_ = 0; rep_ < ((DUP_MASK >> 3) & 1) + 1; ++rep_) { phase_gla_pre(p, layer, lds, vcu, G, wv); } xcd_barrier(bar, wv0); phase_gla_scan(p, layer, lds, vcu, G, wv); SEAM(base + 2); }
            if (IN(base + 3)) { for (int rep_ = 0; rep_ < ((DUP_MASK >> 4) & 1) + 1; ++rep_) { phase_gla_merge(p, layer, vcu, G, wv); } SEAM(base + 3); }
        }
        if (IN(base + 4)) {
            const bf16_t* A = (const bf16_t*)(ws + WS_B2);
            const bf16_t* Bt = (layer & 1) ? (const bf16_t*)(ws + W_GLA_OUT) + (size_t)li * 1024 * 1024 : (const bf16_t*)(ws + W_ATTN_OUT) + (size_t)li * 1024 * 1024;
            pg8::Gemm g{A, Bt, NR, 1024, nullptr, 0};
            pg8::StaticOrder S; if (layer == 3) S.init(NB * SEQ, 1024, G, bx, 1); else S.init(NR, 1024, G, bx);
            pg8::EpiResid E{(bf16_t*)(ws + WS_HB), (const float*)(ws + WS_MODS) + (size_t)layer * 9 * 6144, layer == 0 ? p.x : nullptr, layer == 0 ? p.ctx : nullptr};
            pg8::gemm_phase<pg8::EpiResid, false, false>(lds, g, S, E, wv);
            if (layer < 3 && G == 256 && bx >= 32) moe_window(p, lds, layer, 1, bx - 32, wv);
            SEAM(base + 4);
        }
        if (IN(base + 5)) { for (int rep_ = 0; rep_ < ((DUP_MASK >> 5) & 1) + 1; ++rep_) { phase_norm<2>(p, layer, lds, vcu, G, wv, layer == 3); } SEAM(base + 5); }
        if (IN(base + 6)) { for (int rep_ = 0; rep_ < ((DUP_MASK >> 6) & 1) + 1; ++rep_) { phase_topk(p, lds, vcu, G, wv, layer == 3 ? 128 : 256); }
            if (G == 256 && vcu >= 128) moe_window(p, lds, layer, 2, vcu - 128, wv);        SEAM(base + 6); }
        if (IN(base + 7)) {
            pg8::Gemm g{(const bf16_t*)(ws + WS_U), (const bf16_t*)(ws + W_MOE_UP) + (size_t)layer * 16 * 2048 * 1024, NSLOT, 2048, (const int*)(ws + WS_IDX), (size_t)2048 * 1024 * 2};
            pg8::StaticOrder S; S.init(layer == 3 ? NSLOT_LAT : NSLOT, 2048, G, bx);
            pg8::EpiSwiGLU E{(bf16_t*)(ws + WS_B1)};
            for (int rep_ = 0; rep_ < ((DUP_MASK >> 7) & 1) + 1; ++rep_) { pg8::gemm_phase<pg8::EpiSwiGLU, true, true>(lds, g, S, E, wv); }
            if (layer < 3 && G == 256 && bx >= 128) moe_window(p, lds, layer, 3, bx - 128, wv);
            SEAM(base + 7);
        }
        if (IN(base + 8)) {
            pg8::Gemm g{(const bf16_t*)(ws + WS_B1), (const bf16_t*)(ws + W_MOE_DN) + (size_t)layer * 16 * 1024 * 1024, NSLOT, 1024, nullptr, (size_t)1024 * 1024 * 2};
            pg8::StaticOrder S; S.init(layer == 3 ? NSLOT_LAT : NSLOT, 1024, G, bx);
            pg8::EpiBf16 E{(bf16_t*)(ws + WS_B2), 1024, (const float*)(ws + WS_GATE)};
            for (int rep_ = 0; rep_ < ((DUP_MASK >> 8) & 1) + 1; ++rep_) { pg8::gemm_phase<pg8::EpiBf16, false, true>(lds, g, S, E, wv); }
            if (layer < 3 && G == 256 && bx >= 64) moe_window(p, lds, layer, 4, bx - 64, wv);
            SEAM(base + 8);
        }
    }
    if (IN(37)) phase_norm<3>(p, 3, lds, vcu0, G, wv0);
#undef IN
#undef SEAM
}
}

extern "C" void kernel_launch(void* const* d_in, const int* in_sizes, int n_in, void* d_out, int out_size, void* d_ws, size_t ws_size, hipStream_t stream) {
    static int grid = 0;
    if (grid == 0) {
        if (ws_size < WS_END) { fprintf(stderr, "kernel_launch: workspace too small: %zu < %zu\n", ws_size, (size_t)WS_END); grid = -1; return; }
        int dev = 0, cus = 0;
        if (hipGetDevice(&dev) != hipSuccess || hipDeviceGetAttribute(&cus, hipDeviceAttributeMultiprocessorCount, dev) != hipSuccess) { grid = -1; return; }
        if (hipFuncSetAttribute((const void*)mega_fwd, hipFuncAttributeMaxDynamicSharedMemorySize, LDS_BYTES) != hipSuccess) { fprintf(stderr, "kernel_launch: hipFuncSetAttribute failed\n"); grid = -1; return; }
        int per_cu = 0;
        if (hipOccupancyMaxActiveBlocksPerMultiprocessor(&per_cu, (const void*)mega_fwd, NTHR, LDS_BYTES) != hipSuccess || per_cu < 1) fprintf(stderr, "kernel_launch: occupancy query reports %d\n", per_cu);
        (void)hipGetLastError();
        grid = cus;
    }
    if (grid < 0) return;
    (void)hipMemsetAsync((char*)d_ws + WS_CTL, 0, CTL_ZERO_BYTES, stream);
    P p{};
    const float** pp = (const float**)&p;
    for (int i = 0; i < 26; ++i) pp[i] = (const float*)d_in[i];
    p.out = (float*)d_out; p.ws = (unsigned char*)d_ws;
    p.ph_lo = 0; p.ph_hi = N_PHASES; p.seg = 0;
    hipLaunchKernelGGL(mega_fwd, dim3(grid), dim3(NTHR), LDS_BYTES, stream, p);
}
```

```cpp
#include <hip/hip_runtime.h>
#include <stdint.h>
#include <math.h>
#include <cstdio>

#ifndef DUP_MASK
#define DUP_MASK 0
#endif

namespace {
#define LAS __attribute__((address_space(3)))
#define GAS __attribute__((address_space(1)))
typedef unsigned short bf16_t;
typedef short bf16x8 __attribute__((ext_vector_type(8)));
typedef float f32x4 __attribute__((ext_vector_type(4)));
typedef unsigned u32x4 __attribute__((ext_vector_type(4)));
typedef unsigned u32x2 __attribute__((ext_vector_type(2)));

constexpr int D = 1024, NB = 8, SEQ = 4096, CTXL = 256, RPB = 4352, NR = NB * RPB;
constexpr int NSLOT_LAT = 65536, NSLOT = 69632;
constexpr int NTHR = 512, NWAVES = 8;
constexpr size_t MiB = 1u << 20;
constexpr size_t WS_CTL = 0, CTL_ZERO_BYTES = 1 * MiB;
constexpr size_t WS_MODS = 2 * MiB;
constexpr size_t WS_ROPE = 3 * MiB;
constexpr size_t WS_AFF = 12 * MiB;
constexpr size_t WS_POS = 15 * MiB;
constexpr size_t WS_IDX = 18 * MiB;
constexpr size_t WS_GATE = 19 * MiB;
constexpr size_t WS_Z = 20 * MiB;
constexpr size_t WS_U = 32 * MiB;
constexpr size_t WS_B1 = 100 * MiB;
constexpr size_t WS_B2 = 304 * MiB;
constexpr size_t WS_HB = WS_B2 + 136 * MiB;
constexpr size_t WS_W = 508 * MiB;
constexpr size_t W_ATTN_IN = WS_W, W_ATTN_OUT = WS_W + 9 * MiB, W_GLA_IN = WS_W + 13 * MiB, W_GLA_OUT = WS_W + 26 * MiB, W_MOE_UP = WS_W + 30 * MiB, W_MOE_DN = WS_W + 286 * MiB;
constexpr size_t WS_GQD = WS_U;
constexpr size_t WS_GKS = WS_W + 414 * MiB;
constexpr size_t WS_GA = WS_GKS + 68 * MiB;
constexpr size_t WS_GCL = WS_GA + 34 * MiB;
constexpr size_t WS_END = WS_GCL + 3 * MiB;
constexpr float EPS = 1e-6f;
constexpr int LDS_BYTES = 147456;
constexpr int RING_BYTES = 131072, MISC_OFF = RING_BYTES + 320;

struct P {
    const float *x, *c, *ctx, *c_ctx, *ada_w, *ada_b, *norm1_g, *norm2_g, *attn_w_in, *attn_w_out,
        *a_q_norm, *a_k_norm, *b_q_norm, *b_k_norm, *na_rpb, *gla_w_in, *gk_w_f, *gk_b_f, *gk_w_b, *gk_b_b,
        *gla_o_norm, *gla_w_out, *moe_router, *moe_w_gate, *moe_w_up, *moe_w_down;
    float* out; unsigned char* ws;
    int ph_lo, ph_hi, seg, pad;
};

__device__ __forceinline__ float bf2f(bf16_t v) { return __uint_as_float(((unsigned)v) << 16); }
__device__ __forceinline__ unsigned f2bf(float f) { unsigned u = __float_as_uint(f); return (u + 0x7fffu + ((u >> 16) & 1u)) >> 16; }
__device__ __forceinline__ unsigned pk2(float lo, float hi) { return f2bf(lo) | (f2bf(hi) << 16); }
__device__ __forceinline__ int hw_tid() {
    int t; asm volatile("v_mbcnt_lo_u32_b32 %0, -1, 0\n\tv_mbcnt_hi_u32_b32 %0, -1, %0" : "=v"(t)); return t;
}
template <int X> __device__ __forceinline__ float swz_xor(float v) { return __uint_as_float((unsigned)__builtin_amdgcn_ds_swizzle((int)__float_as_uint(v), (X << 10) | 0x1f)); }
__device__ __forceinline__ float wave_sum(float v) {
    v += swz_xor<1>(v); v += swz_xor<2>(v); v += swz_xor<4>(v); v += swz_xor<8>(v); v += swz_xor<16>(v);
    auto rr = __builtin_amdgcn_permlane32_swap(__float_as_uint(v), __float_as_uint(v), false, false);
    return __uint_as_float(rr[0]) + __uint_as_float(rr[1]);
}
__device__ __forceinline__ float silu_f(float x) { return x / (1.f + __expf(-x)); }
__device__ __forceinline__ int mod_row(int row) { const int b = row / RPB, t = row - b * RPB; return t < SEQ ? b : 8; }

namespace pg8 {
constexpr int BM = 256, BK = 64, HALF = 128, HTB = HALF * BK * 2, STAGE_BYTES = 8 * HTB, NXCD = 8, WGM = 8;
__device__ __forceinline__ int lds_byte(int r, int c) { const int st = (r >> 4) * 2 + (c >> 5), rr = r & 15, cc = c & 31, ob = rr * 64 + cc * 2; return st * 1024 + (ob ^ (((ob >> 9) & 1) << 5)); }
__device__ __forceinline__ void stage_rc(int b, int& R, int& C) { const int st = b / 1024, sb = b % 1024, swz = sb ^ (((sb >> 9) & 1) << 5); R = (st >> 1) * 16 + swz / 64; C = (st & 1) * 32 + (swz % 64) / 2; }
__device__ __forceinline__ int perm32(int rho) { const int n = rho >> 4, i = rho & 15; return 8 * (i >> 2) + 4 * n + (i & 3); }
struct Unit { int pm, pn; };
struct Gemm { const bf16_t* A; const bf16_t* Bt; int M, N; const int* gather; size_t bgroup; };
struct StaticOrder {
    int nM, nN, nwg, G, c, skip17;
    __device__ void init(int M, int N, int G_, int c_, int skip17_ = 0) { nM = M / BM; nN = N / BM; nwg = nM * nN; G = G_; c = c_; skip17 = skip17_; }
    __device__ bool next(int i, Unit& u) const {
        const long L = (long)i * G + c; if (L >= nwg) return false;
        int wgid = (int)L; { const int q = nwg / NXCD, r = nwg % NXCD, xcd = wgid % NXCD, off = wgid / NXCD; wgid = (xcd < r ? xcd * (q + 1) : r * (q + 1) + (xcd - r) * q) + off; }
        const int nig = WGM * nN, gid = wgid / nig, fm = gid * WGM, gsz = (nM - fm) < WGM ? (nM - fm) : WGM;
        u.pm = fm + ((wgid % nig) % gsz); u.pn = (wgid % nig) / gsz; if (skip17) u.pm += u.pm >> 4; return true;
    }
};
typedef float f32x2_t_ __attribute__((ext_vector_type(2))); typedef __bf16 bf16x2_t_ __attribute__((ext_vector_type(2)));
__device__ __forceinline__ unsigned cvt_pk_bf16(float lo, float hi) { f32x2_t_ v = {lo, hi}; bf16x2_t_ b = __builtin_convertvector(v, bf16x2_t_); return __builtin_bit_cast(unsigned, b); }
__device__ __forceinline__ int expert_of_tile(int pm) { return pm < 256 ? (pm >> 4) : (pm - 256); }

struct EpiBf16 {
    static constexpr bool PERM = true;
    bf16_t* O; int ldc; const float* rowscale;
    __device__ __forceinline__ void operator()(const f32x4 (&acc)[2][2][4][2], const Unit& u, int wr, int wc, int fr, int fq) const {
        const int row0 = u.pm * BM + wr * 64 + fr, col0 = u.pn * BM + wc * 32 + 8 * fq;
#pragma unroll
        for (int ai = 0; ai < 2; ++ai)
#pragma unroll
            for (int m = 0; m < 4; ++m) { bf16_t* rowp = O + (size_t)(row0 + ai * HALF + m * 16) * ldc + col0;
                const float rsc = rowscale ? rowscale[row0 + ai * HALF + m * 16] : 1.f;
#pragma unroll
                for (int bj = 0; bj < 2; ++bj) { const f32x4 v0 = acc[ai][bj][m][0] * rsc, v1 = acc[ai][bj][m][1] * rsc;
                    u32x4 w; w.x = cvt_pk_bf16(v0[0], v0[1]); w.y = cvt_pk_bf16(v0[2], v0[3]); w.z = cvt_pk_bf16(v1[0], v1[1]); w.w = cvt_pk_bf16(v1[2], v1[3]);
                    *(u32x4*)(rowp + bj * HALF) = w; } }
    }
};
struct EpiQKV {
    static constexpr bool PERM = true;
    bf16_t* O; const float* qkg; const float* rope;
    __device__ __forceinline__ void operator()(const f32x4 (&acc)[2][2][4][2], const Unit& u, int wr, int wc, int fr, int fq) const {
        const int sg = 4 * u.pn + wc;
        const int b = u.pm / 17, tt = u.pm - b * 17;
        const int row0 = u.pm * BM + wr * 64 + fr, col0 = sg * 64 + 8 * fq;
        const bool is_q = sg < 8 || (sg >= 12 && sg < 20), is_v = sg == 10 || sg == 11 || sg >= 28;
        const bool do_rope = sg < 10 && tt < 16;
        const float* gp = qkg + 64 * (sg < 8 ? 0 : (sg < 10 ? 1 : (sg < 20 ? 2 : 3)));
        const float qsc = is_q ? 0.18033688011112042f : 1.f;
        const int lane_hi = fq >> 1;
#pragma unroll
        for (int ai = 0; ai < 2; ++ai)
#pragma unroll
            for (int m = 0; m < 4; ++m) {
                f32x4 v[2][2];
                float ss = 0.f;
#pragma unroll
                for (int bj = 0; bj < 2; ++bj)
#pragma unroll
                    for (int n = 0; n < 2; ++n) { v[bj][n] = acc[ai][bj][m][n]; ss += (v[bj][n][0] * v[bj][n][0] + v[bj][n][1] * v[bj][n][1]) + (v[bj][n][2] * v[bj][n][2] + v[bj][n][3] * v[bj][n][3]); }
                if (!is_v) {
                    ss += swz_xor<16>(ss);
                    { auto rr = __builtin_amdgcn_permlane32_swap(__float_as_uint(ss), __float_as_uint(ss), false, false); ss = __uint_as_float(rr[0]) + __uint_as_float(rr[1]); }
                    const float rs = rsqrtf(ss * (1.f / 64.f) + EPS) * qsc;
                    const float* gpl = gp + 8 * fq; asm volatile("" : "+v"(gpl));
#pragma unroll
                    for (int bj = 0; bj < 2; ++bj)
#pragma unroll
                        for (int n = 0; n < 2; ++n) v[bj][n] = v[bj][n] * rs * *(const f32x4*)(gpl + 32 * bj + 4 * n);
                    if (do_rope) {
                        const int posr = tt * 4 + 2 * ai + wr, posc = 16 * m + fr;
#pragma unroll
                        for (int bj = 0; bj < 2; ++bj) {
                            const float* tb = rope + (bj ? posc : posr) * 16 + 8 * (fq & 1);
#pragma unroll
                            for (int n = 0; n < 2; ++n) {
                                const f32x4 cs = *(const f32x4*)(tb + 4 * n), sn = *(const f32x4*)(tb + 1024 + 4 * n);
                                f32x4 ot;
#pragma unroll
                                for (int e = 0; e < 4; ++e) { auto rr = __builtin_amdgcn_permlane32_swap(__float_as_uint(v[bj][n][e]), __float_as_uint(v[bj][n][e]), false, false);
                                    const float other = __uint_as_float(lane_hi ? rr[0] : rr[1]); ot[e] = lane_hi ? other : -other; }
                                v[bj][n] = v[bj][n] * cs + ot * sn;
                            }
                        }
                    }
                }
                bf16_t* rowp = O + (size_t)(row0 + ai * HALF + m * 16) * 2304 + col0;
#pragma unroll
                for (int bj = 0; bj < 2; ++bj) { u32x4 w; w.x = cvt_pk_bf16(v[bj][0][0], v[bj][0][1]); w.y = cvt_pk_bf16(v[bj][0][2], v[bj][0][3]); w.z = cvt_pk_bf16(v[bj][1][0], v[bj][1][1]); w.w = cvt_pk_bf16(v[bj][1][2], v[bj][1][3]);
                    *(u32x4*)(rowp + 32 * bj) = w; }
            }
    }
};
struct EpiGlaIn {
    static constexpr bool PERM = true;
    bf16_t* O; float* Z;
    __device__ __forceinline__ void operator()(const f32x4 (&acc)[2][2][4][2], const Unit& u, int wr, int wc, int fr, int fq) const {
        const int row0 = u.pm * BM + wr * 64 + fr;
        if (u.pn < 12) {
            const int col0 = u.pn * BM + wc * 32 + 8 * fq;
#pragma unroll
            for (int ai = 0; ai < 2; ++ai)
#pragma unroll
                for (int m = 0; m < 4; ++m) { bf16_t* rowp = O + (size_t)(row0 + ai * HALF + m * 16) * 3072 + col0;
#pragma unroll
                    for (int bj = 0; bj < 2; ++bj) { const f32x4 v0 = acc[ai][bj][m][0], v1 = acc[ai][bj][m][1];
                        u32x4 w; w.x = cvt_pk_bf16(v0[0], v0[1]); w.y = cvt_pk_bf16(v0[2], v0[3]); w.z = cvt_pk_bf16(v1[0], v1[1]); w.w = cvt_pk_bf16(v1[2], v1[3]);
                        *(u32x4*)(rowp + bj * HALF) = w; } }
        } else if (wc == 0) {
#pragma unroll
            for (int ai = 0; ai < 2; ++ai)
#pragma unroll
                for (int m = 0; m < 4; ++m) { float* zp = Z + (size_t)(row0 + ai * HALF + m * 16) * 32 + 8 * fq;
                    *(f32x4*)(zp) = acc[ai][0][m][0]; *(f32x4*)(zp + 4) = acc[ai][0][m][1]; }
        }
    }
};
struct EpiResid {
    static constexpr bool PERM = true;
    bf16_t* hb; const float* mods_l; const float* slat; const float* sctx;
    __device__ __forceinline__ void operator()(const f32x4 (&acc)[2][2][4][2], const Unit& u, int wr, int wc, int fr, int fq) const {
        const int b = u.pm / 17, tt = u.pm - b * 17;
        const int mr = tt < 16 ? b : 8;
        const int col0 = u.pn * BM + wc * 32 + 8 * fq;
        bf16_t* base = hb + (size_t)(u.pm * BM + wr * 64 + fr) * D + col0;
        const float* g2 = mods_l + (size_t)mr * 6144 + 2 * 1024 + col0;
        f32x4 gv[2][2];
#pragma unroll
        for (int bj = 0; bj < 2; ++bj)
#pragma unroll
            for (int n = 0; n < 2; ++n) gv[bj][n] = *(const f32x4*)(g2 + bj * HALF + n * 4);
        if (slat != nullptr) {
            const float* sbase = (tt < 16 ? slat + (size_t)(b * SEQ + tt * 256) * D : sctx + (size_t)(b * CTXL) * D) + (size_t)(wr * 64 + fr) * D + col0;
#pragma unroll
            for (int ai = 0; ai < 2; ++ai) {
                f32x4 hv[4][2][2];
#pragma unroll
                for (int m = 0; m < 4; ++m) { const float* rowp = sbase + (size_t)(ai * HALF + m * 16) * D;
#pragma unroll
                    for (int bj = 0; bj < 2; ++bj)
#pragma unroll
                        for (int n = 0; n < 2; ++n) hv[m][bj][n] = *(const f32x4*)(rowp + bj * HALF + n * 4); }
#pragma unroll
                for (int m = 0; m < 4; ++m) { bf16_t* rowp = base + (size_t)(ai * HALF + m * 16) * D;
#pragma unroll
                    for (int bj = 0; bj < 2; ++bj) { const f32x4 r0 = hv[m][bj][0] + gv[bj][0] * acc[ai][bj][m][0], r1 = hv[m][bj][1] + gv[bj][1] * acc[ai][bj][m][1];
                        *(u32x4*)(rowp + bj * HALF) = (u32x4){cvt_pk_bf16(r0[0], r0[1]), cvt_pk_bf16(r0[2], r0[3]), cvt_pk_bf16(r1[0], r1[1]), cvt_pk_bf16(r1[2], r1[3])}; } }
            }
        } else {
#pragma unroll
            for (int ai = 0; ai < 2; ++ai) {
                u32x4 hv[4][2];
#pragma unroll
                for (int m = 0; m < 4; ++m) { const bf16_t* rowp = base + (size_t)(ai * HALF + m * 16) * D;
#pragma unroll
                    for (int bj = 0; bj < 2; ++bj) hv[m][bj] = *(const u32x4*)(rowp + bj * HALF); }
#pragma unroll
                for (int m = 0; m < 4; ++m) { bf16_t* rowp = base + (size_t)(ai * HALF + m * 16) * D;
#pragma unroll
                    for (int bj = 0; bj < 2; ++bj) { const u32x4 t = hv[m][bj];
                        const f32x4 h0 = (f32x4){__uint_as_float(t.x << 16), __uint_as_float(t.x & 0xffff0000u), __uint_as_float(t.y << 16), __uint_as_float(t.y & 0xffff0000u)};
                        const f32x4 h1 = (f32x4){__uint_as_float(t.z << 16), __uint_as_float(t.z & 0xffff0000u), __uint_as_float(t.w << 16), __uint_as_float(t.w & 0xffff0000u)};
                        const f32x4 r0 = h0 + gv[bj][0] * acc[ai][bj][m][0], r1 = h1 + gv[bj][1] * acc[ai][bj][m][1];
                        *(u32x4*)(rowp + bj * HALF) = (u32x4){cvt_pk_bf16(r0[0], r0[1]), cvt_pk_bf16(r0[2], r0[3]), cvt_pk_bf16(r1[0], r1[1]), cvt_pk_bf16(r1[2], r1[3])}; } }
            }
        }
    }
};
struct EpiSwiGLU {
    static constexpr bool PERM = true;
    bf16_t* O;
    __device__ __forceinline__ void operator()(const f32x4 (&acc)[2][2][4][2], const Unit& u, int wr, int wc, int fr, int fq) const {
        const int row0 = u.pm * BM + wr * 64 + fr, col0 = u.pn * HALF + wc * 32 + 8 * fq;
#pragma unroll
        for (int ai = 0; ai < 2; ++ai)
#pragma unroll
            for (int m = 0; m < 4; ++m) { bf16_t* rowp = O + (size_t)(row0 + ai * HALF + m * 16) * 1024 + col0;
                float r[8];
#pragma unroll
                for (int n = 0; n < 2; ++n)
#pragma unroll
                    for (int e = 0; e < 4; ++e) { const float g = acc[ai][0][m][n][e], up = acc[ai][1][m][n][e]; r[n * 4 + e] = g * __builtin_amdgcn_rcpf(1.f + __expf(-g)) * up; }
                u32x4 w; w.x = cvt_pk_bf16(r[0], r[1]); w.y = cvt_pk_bf16(r[2], r[3]); w.z = cvt_pk_bf16(r[4], r[5]); w.w = cvt_pk_bf16(r[6], r[7]);
                *(u32x4*)rowp = w; }
    }
};

__device__ __forceinline__ void glds16_s(const char* sbase, unsigned voff, unsigned lds_dst) { unsigned keep;
    asm volatile("s_nop 4\n\ts_mov_b32 %0, m0\n\ts_mov_b32 m0, %3\n\ts_nop 0\n\tglobal_load_lds_dwordx4 %1, %2\n\ts_mov_b32 m0, %0" : "=&s"(keep) : "v"(voff), "s"(sbase), "s"(lds_dst) : "memory"); }
template <class Epi, bool GATHER, bool GROUPED>
__device__ __forceinline__ void gemm_phase(LAS unsigned char* lds, const Gemm g, const StaticOrder& S, const Epi& E, const int wv_) {
    const int tid = (wv_ << 6) | hw_tid();
    const int wid = wv_, lane = tid & 63, wr = wid >> 2, wc = wid & 3, fr = lane & 15, fq = lane >> 4;
    constexpr int K = 1024, nt = K / BK;
    unsigned voffA[2], voffB[2];
#pragma unroll
    for (int i = 0; i < 2; ++i) { int R, C; stage_rc(tid * 16 + i * 8192, R, C); const int Rb = Epi::PERM ? ((R & ~31) + perm32(R & 31)) : R;
        voffA[i] = (unsigned)(R * K + C) * 2u; voffB[i] = (unsigned)(Rb * K + C) * 2u; }
#define PG8_RA(i) ((int)(voffA[i] >> 11))
#define PG8_CA(i) (voffA[i] & 2047u)
    constexpr size_t kstep = (size_t)(BK * 2);
    constexpr size_t hstep = (size_t)HALF * K * 2;
    constexpr size_t tstep = 2 * hstep;
    const unsigned ldsw = (unsigned)wid * 1024u, lds0 = (unsigned)(size_t)lds;
    const int aoff = lds_byte(wr * 64 + fr, fq * 8), boff = lds_byte(wc * 32 + fr, fq * 8);
#define PG8_SA(b, h) (((b) * 2 + (h)) * HTB)
#define PG8_SB(b, h) ((4 + (b) * 2 + (h)) * HTB)
#define PG8_STAGE_B(bufoff, gbase) do { _Pragma("unroll") for (int _i = 0; _i < 2; ++_i) \
        glds16_s((const char*)(gbase), voffB[_i], lds0 + (unsigned)(bufoff) + ldsw + (unsigned)(_i * 8192)); } while (0)
#define PG8_STAGE_A(bufoff, kp, h, O) do { _Pragma("unroll") for (int _i = 0; _i < 2; ++_i) { \
        if (GATHER) glds16_s((const char*)(kp), (O)[h][_i], lds0 + (unsigned)(bufoff) + ldsw + (unsigned)(_i * 8192)); \
        else glds16_s((const char*)(kp) + (size_t)(h) * hstep, voffA[_i], lds0 + (unsigned)(bufoff) + ldsw + (unsigned)(_i * 8192)); } } while (0)
#define PG8_LDA(dst, b, h) do { _Pragma("unroll") for (int m = 0; m < 4; ++m) _Pragma("unroll") for (int k = 0; k < 2; ++k) dst[m][k] = *(const LAS bf16x8*)(lds + PG8_SA(b, h) + aoff + m * 2048 + k * 1024); } while (0)
#define PG8_LDB(dst, b, h) do { _Pragma("unroll") for (int n = 0; n < 2; ++n) _Pragma("unroll") for (int k = 0; k < 2; ++k) dst[n][k] = *(const LAS bf16x8*)(lds + PG8_SB(b, h) + boff + n * 2048 + k * 1024); } while (0)
#define PG8_MMA(ai, bj, At, Bt) do { __builtin_amdgcn_s_setprio(1); _Pragma("unroll") for (int m = 0; m < 4; ++m) _Pragma("unroll") for (int n = 0; n < 2; ++n) _Pragma("unroll") for (int k = 0; k < 2; ++k) \
        acc[ai][bj][m][n] = __builtin_amdgcn_mfma_f32_16x16x32_bf16(Bt[n][k], At[m][k], acc[ai][bj][m][n], 0, 0, 0); __builtin_amdgcn_s_setprio(0); } while (0)
#define PG8_WAIT_V(n) asm volatile("s_waitcnt vmcnt(" #n ")" ::: "memory")
#define PG8_WAIT_L(n) asm volatile("s_waitcnt lgkmcnt(" #n ")" ::: "memory")
#define PG8_BAR __builtin_amdgcn_s_barrier()
#define PG8_SCHED __builtin_amdgcn_sched_barrier(0)
#define PG8_BOF(u) ((const char*)g.Bt + (GROUPED ? (size_t)expert_of_tile((u).pm) * g.bgroup : (size_t)0) + (size_t)(u).pn * tstep)
#define PG8_AOF(u) (GATHER ? (const char*)g.A : (const char*)g.A + (size_t)(u).pm * tstep)
    Unit cur, nxt; int ui = 0;
    if (!S.next(0, cur)) return;
    unsigned oc[2][2], on[2][2]; unsigned rn[2];
#pragma unroll
    for (int h = 0; h < 2; ++h)
#pragma unroll
        for (int i = 0; i < 2; ++i) { oc[h][i] = 0u; on[h][i] = 0u; rn[h] = 0u; }
    if (GATHER) {
#pragma unroll
        for (int h = 0; h < 2; ++h)
#pragma unroll
            for (int i = 0; i < 2; ++i) { int row = g.gather[cur.pm * BM + h * HALF + PG8_RA(i)]; row = row < 0 ? 0 : (row >= NR ? NR - 1 : row); oc[h][i] = (unsigned)row * (unsigned)(K * 2) + PG8_CA(i); }
    }
    f32x4 acc[2][2][4][2];
#pragma unroll
    for (int a = 0; a < 2; ++a)
#pragma unroll
        for (int b = 0; b < 2; ++b)
#pragma unroll
            for (int m = 0; m < 4; ++m)
#pragma unroll
                for (int n = 0; n < 2; ++n) acc[a][b][m][n] = (f32x4){0.f, 0.f, 0.f, 0.f};
    bf16x8 At[4][2], B0[2][2], B1[2][2];
    const char* cA = PG8_AOF(cur); const char* cB = PG8_BOF(cur);
    PG8_STAGE_B(PG8_SB(0, 0), cB); PG8_STAGE_B(PG8_SB(0, 1), cB + hstep); PG8_STAGE_A(PG8_SA(0, 0), cA, 0, oc); PG8_STAGE_A(PG8_SA(0, 1), cA, 1, oc);
    if (wr == 1) PG8_BAR;
    PG8_WAIT_V(2); PG8_BAR;
    PG8_STAGE_B(PG8_SB(1, 0), cB + kstep); PG8_STAGE_A(PG8_SA(1, 0), cA + kstep, 0, oc); PG8_STAGE_B(PG8_SB(1, 1), cB + hstep + kstep);
    PG8_WAIT_V(6); PG8_BAR;
#define PG8_KBODY(LAST, O2) do { \
            const char* a1 = cA + (size_t)(t + 1) * kstep; \
            const char* a2 = (LAST) ? nA : cA + (size_t)(t + 2) * kstep; const char* b2 = (LAST) ? nB : cB + (size_t)(t + 2) * kstep; \
            const char* a3 = a2 + kstep; const char* b3 = b2 + kstep; \
            PG8_LDB(B0, 0, 0); PG8_LDB(B1, 0, 1); PG8_SCHED; PG8_LDA(At, 0, 0); PG8_STAGE_A(PG8_SA(1, 1), a1, 1, oc); \
            PG8_WAIT_V(8); PG8_WAIT_L(0); PG8_BAR; PG8_MMA(0, 0, At, B0); PG8_MMA(0, 1, At, B1); PG8_BAR; PG8_SCHED; \
            PG8_LDA(At, 0, 1); PG8_STAGE_B(PG8_SB(0, 0), b2); PG8_STAGE_B(PG8_SB(0, 1), b2 + hstep); PG8_STAGE_A(PG8_SA(0, 0), a2, 0, O2); \
            PG8_WAIT_V(8); PG8_WAIT_L(0); PG8_BAR; PG8_MMA(1, 0, At, B0); PG8_MMA(1, 1, At, B1); PG8_BAR; PG8_SCHED; \
            PG8_LDB(B0, 1, 0); PG8_LDB(B1, 1, 1); PG8_SCHED; PG8_LDA(At, 1, 0); PG8_STAGE_A(PG8_SA(0, 1), a2, 1, O2); \
            PG8_WAIT_V(8); PG8_WAIT_L(0); PG8_BAR; PG8_MMA(0, 0, At, B0); PG8_MMA(0, 1, At, B1); PG8_BAR; PG8_SCHED; \
            PG8_LDA(At, 1, 1); PG8_STAGE_B(PG8_SB(1, 0), b3); PG8_STAGE_B(PG8_SB(1, 1), b3 + hstep); PG8_STAGE_A(PG8_SA(1, 0), a3, 0, O2); \
            PG8_WAIT_V(8); PG8_WAIT_L(0); PG8_BAR; PG8_MMA(1, 0, At, B0); PG8_MMA(1, 1, At, B1); PG8_BAR; PG8_SCHED; \
        } while (0)
    for (;;) {
        const bool has_next = S.next(ui + 1, nxt);
        const char* nA = has_next ? PG8_AOF(nxt) : cA; const char* nB = has_next ? PG8_BOF(nxt) : cB;
        if (GATHER && has_next) {
            const int t2 = (wv_ << 6) | hw_tid();
            int R0, C0, R1, C1; stage_rc(t2 * 16, R0, C0); stage_rc(t2 * 16 + 8192, R1, C1);
            const int* gp = g.gather + nxt.pm * BM;
            rn[0] = ((unsigned)gp[R0] & 0xffffu) | ((unsigned)gp[R1] << 16); rn[1] = ((unsigned)gp[HALF + R0] & 0xffffu) | ((unsigned)gp[HALF + R1] << 16);
        }
        int t = 0;
#pragma unroll 1
        for (; t < nt - 2; t += 2) PG8_KBODY(false, oc);
        if (GATHER) {
#pragma unroll
            for (int h = 0; h < 2; ++h)
#pragma unroll
                for (int i = 0; i < 2; ++i) { int row = (int)(i ? (rn[h] >> 16) : (rn[h] & 0xffffu)); row = row >= NR ? NR - 1 : row; on[h][i] = has_next ? (unsigned)row * (unsigned)(K * 2) + (oc[h][i] & 2047u) : oc[h][i]; }
        }
        PG8_KBODY(true, on);
        if (wr == 0) PG8_BAR;
        { const int l2 = hw_tid(); E(acc, cur, wr, wc, l2 & 15, l2 >> 4); }
        if (!has_next) break;
#pragma unroll
        for (int a = 0; a < 2; ++a)
#pragma unroll
            for (int b = 0; b < 2; ++b)
#pragma unroll
                for (int m = 0; m < 4; ++m)
#pragma unroll
                    for (int n = 0; n < 2; ++n) acc[a][b][m][n] = (f32x4){0.f, 0.f, 0.f, 0.f};
        cur = nxt; cA = nA; cB = nB; ++ui;
        if (GATHER) {
#pragma unroll
            for (int h = 0; h < 2; ++h)
#pragma unroll
                for (int i = 0; i < 2; ++i) oc[h][i] = on[h][i];
        }
        if (wr == 1) PG8_BAR;
    }
    PG8_WAIT_V(0);
    PG8_BAR;
#undef PG8_KBODY
#undef PG8_RA
#undef PG8_CA
#undef PG8_SA
#undef PG8_SB
#undef PG8_STAGE_A
#undef PG8_STAGE_B
#undef PG8_LDA
#undef PG8_LDB
#undef PG8_MMA
#undef PG8_WAIT_V
#undef PG8_WAIT_L
#undef PG8_BAR
#undef PG8_SCHED
#undef PG8_BOF
#undef PG8_AOF
}
}

#define XB_TMO      128
#define XB_XCNT(j)  (256  + 64 * (j))
#define XB_XSUB(j)  (1280 + 64 * (j))
#define XB_XGEN(j)  (2304 + 64 * (j))
#define XB_TOP      3328
#define XB_TOPGEN   3392
#define XCD_BAR_WORDS 3456
#define XB_SPIN_CAP (1u << 22)
__device__ __forceinline__ unsigned xb_ld(unsigned* p)              { return __hip_atomic_load(p, __ATOMIC_RELAXED, __HIP_MEMORY_SCOPE_AGENT); }
__device__ __forceinline__ unsigned xb_add(unsigned* p, unsigned v) { return __hip_atomic_fetch_add(p, v, __ATOMIC_RELAXED, __HIP_MEMORY_SCOPE_AGENT); }
__device__ __forceinline__ unsigned xb_xcc_id() { return (unsigned)__builtin_amdgcn_s_getreg((3 << 11) | 20) & 0xFu; }
#define XB_SPIN(cond, bar) do { unsigned _sp = 0; while (cond) { __builtin_amdgcn_s_sleep(1); \
    if ((++_sp & 255u) == 0u) { if (xb_ld(&(bar)[XB_TMO])) break; if (_sp > XB_SPIN_CAP) { atomicAdd(&(bar)[XB_TMO], 1u); break; } } } } while (0)
struct XcdBarrier { unsigned* bar; unsigned x; volatile LAS unsigned* st; };
__device__ __forceinline__ XcdBarrier xcd_barrier_post(unsigned* bar, volatile LAS unsigned* st) {
    XcdBarrier b; b.bar = bar; b.x = xb_xcc_id(); b.st = st;
    if (threadIdx.x == 0) (void)xb_add(&bar[XB_XCNT(b.x)], 1u);
    return b;
}
__device__ __forceinline__ void xcd_barrier_complete(unsigned* bar, unsigned x, unsigned& nloc, unsigned& nx) {
    const unsigned G = gridDim.x * gridDim.y * gridDim.z;
    unsigned sum, cnt, mine, sp = 0u;
    for (;;) {
        sum = 0u; cnt = 0u; mine = 0u;
#pragma unroll
        for (unsigned j = 0; j < 16; ++j) { const unsigned c = xb_ld(&bar[XB_XCNT(j)]); sum += c; cnt += (c > 0u) ? 1u : 0u; mine = (j == x) ? c : mine; }
        if (sum == G) break;
        __builtin_amdgcn_s_sleep(1);
        if ((++sp & 255u) == 0u) { if (xb_ld(&bar[XB_TMO])) break; if (sp > XB_SPIN_CAP) { atomicAdd(&bar[XB_TMO], 1u); break; } }
    }
    nloc = mine > 0u ? mine : 1u; nx = cnt > 0u ? cnt : 1u;
}
__device__ __forceinline__ void xcd_barrier(const XcdBarrier& b, const int wv_) {
    asm volatile("s_waitcnt vmcnt(0)" ::: "memory");
    __syncthreads();
    if (wv_ == 0 && hw_tid() == 0) {
        unsigned* bar = b.bar; asm volatile("" : "+s"(bar));
        __builtin_amdgcn_s_waitcnt(0);
        unsigned nloc = b.st[0], nx = b.st[1];
        if (nloc == 0u) { xcd_barrier_complete(bar, b.x, nloc, nx); b.st[0] = nloc; b.st[1] = nx; }
        const unsigned old = xb_add(&bar[XB_XSUB(b.x)], 1u);
        const unsigned gen = old / nloc;
        if (old + 1u == (gen + 1u) * nloc) {
            __builtin_amdgcn_fence(__ATOMIC_RELEASE, "agent");
            asm volatile("s_waitcnt vmcnt(0)" ::: "memory");
            const unsigned og = xb_add(&bar[XB_TOP], 1u);
            const unsigned tg = og / nx;
            if (og + 1u == (tg + 1u) * nx) xb_add(&bar[XB_TOPGEN], 1u);
            else XB_SPIN(xb_ld(&bar[XB_TOPGEN]) == tg, bar);
            __builtin_amdgcn_fence(__ATOMIC_ACQUIRE, "agent");
            xb_add(&bar[XB_XGEN(b.x)], 1u);
            asm volatile("s_waitcnt vmcnt(0)" ::: "memory");
        } else {
            XB_SPIN(xb_ld(&bar[XB_XGEN(b.x)]) == gen, bar);
            __builtin_amdgcn_fence(__ATOMIC_ACQUIRE, "agent");
            asm volatile("s_waitcnt vmcnt(0)" ::: "memory");
        }
    }
    __syncthreads();
}

__device__ __forceinline__ void p0_transpose_item(const float* W, int N, int kb, int n0, bf16_t* WTrow0  , LAS float* scr, int lane) {
    const int k0 = 64 * kb;
    const int kq = lane >> 3, nq = (lane & 7) * 4;
    f32x4 tv[8];
#pragma unroll
    for (int i = 0; i < 8; ++i) tv[i] = __builtin_nontemporal_load((const GAS f32x4*)(W + (size_t)(k0 + 8 * i + kq) * N + n0 + nq));
#pragma unroll
    for (int i = 0; i < 8; ++i) { LAS float* d = scr + (8 * i + kq) * 33 + nq; d[0] = tv[i][0]; d[1] = tv[i][1]; d[2] = tv[i][2]; d[3] = tv[i][3]; }
    asm volatile("s_waitcnt lgkmcnt(0)" ::: "memory");
    const int c = lane & 7;
#pragma unroll
    for (int j = 0; j < 4; ++j) { const int n = (lane >> 3) + 8 * j; const LAS float* s = scr + (8 * c) * 33 + n;
        u32x4 o; o.x = pk2(s[0 * 33], s[1 * 33]); o.y = pk2(s[2 * 33], s[3 * 33]); o.z = pk2(s[4 * 33], s[5 * 33]); o.w = pk2(s[6 * 33], s[7 * 33]);
        *(u32x4*)(WTrow0 + (size_t)n * 1024 + k0 + 8 * c) = o; }
    asm volatile("s_waitcnt lgkmcnt(0)" ::: "memory");
}
constexpr int MOE_ITEMS = 48 * 512, MOE_ALL = 4 * MOE_ITEMS;
constexpr int MOE_PRO = 6144, WIN_B = 224 * 8 * 4, WIN_C = 128 * 8 * 5, WIN_D = 128 * 8 * 7, WIN_E = 192 * 8 * 5;
__device__ __forceinline__ int win_capA(int layer) { return (layer & 1) ? 24 * 8 * 8 : 56 * 8 * 8; }
__device__ __forceinline__ int win_layer_start(int layer) {
    const int full_even = 56 * 8 * 8 + WIN_B + WIN_C + WIN_D + WIN_E, full_odd = 24 * 8 * 8 + WIN_B + WIN_C + WIN_D + WIN_E;
    return MOE_PRO + (layer > 0 ? full_even : 0) + (layer > 1 ? full_odd : 0) + (layer > 2 ? full_even : 0);
}
__device__ __forceinline__ void moe_item_decode(const P& p, unsigned char* ws, int layer, int q, const float*& src, bf16_t*& dst) {
    const int mat = q >> 9, rr = q & 511, kb = rr >> 5, n0 = (rr & 31) * 32, kind = mat >> 4, le = layer * 16 + (mat & 15);
    if (kind < 2) {
        src = (kind == 0 ? p.moe_w_gate : p.moe_w_up) + (size_t)le * 1024 * 1024 + (size_t)(64 * kb) * 1024 + n0;
        dst = (bf16_t*)(ws + W_MOE_UP) + (size_t)le * 2048 * 1024 + (size_t)((n0 >> 7) * 256 + (n0 & 127) + kind * 128) * 1024 + 64 * kb;
    } else {
        src = p.moe_w_down + (size_t)le * 1024 * 1024 + (size_t)(64 * kb) * 1024 + n0;
        dst = (bf16_t*)(ws + W_MOE_DN) + (size_t)le * 1024 * 1024 + (size_t)n0 * 1024 + 64 * kb;
    }
}
__device__ __forceinline__ void moe_convert_win(const P& p, LAS unsigned char* lds, int g0, int npw, int gend, const int wv_) {
    unsigned char* ws = p.ws; asm volatile("" : "+s"(ws));
    const int lane = hw_tid();
    LAS float* scr = (LAS float*)(lds + wv_ * 16384);
    f32x4 va[8], vb[8]; bf16_t* da; bf16_t* db;
    const int kq = lane >> 3, nq = (lane & 7) * 4;
    int g = g0 + wv_;
    if (gend > MOE_ALL) gend = MOE_ALL;
    if (g < gend) { const float* sa; moe_item_decode(p, ws, g / MOE_ITEMS, g % MOE_ITEMS, sa, da); sa += (size_t)kq * 1024 + nq;
#pragma unroll
        for (int i = 0; i < 8; ++i) va[i] = __builtin_nontemporal_load((const GAS f32x4*)(sa + (size_t)(8 * i) * 1024)); }
#pragma unroll 1
    for (int k = 0; k < npw; ++k, g += 8) {
        if (g >= gend) break;
        const bool more = k + 1 < npw && g + 8 < gend;
        if (more) { const float* sb; moe_item_decode(p, ws, (g + 8) / MOE_ITEMS, (g + 8) % MOE_ITEMS, sb, db); sb += (size_t)kq * 1024 + nq;
#pragma unroll
            for (int i = 0; i < 8; ++i) vb[i] = __builtin_nontemporal_load((const GAS f32x4*)(sb + (size_t)(8 * i) * 1024)); }
#pragma unroll
        for (int i = 0; i < 8; ++i) { LAS float* d = scr + (8 * i + kq) * 33 + nq; d[0] = va[i][0]; d[1] = va[i][1]; d[2] = va[i][2]; d[3] = va[i][3]; }
        asm volatile("s_waitcnt lgkmcnt(0)" ::: "memory");
        const int c = lane & 7;
#pragma unroll
        for (int j = 0; j < 4; ++j) { const int n = (lane >> 3) + 8 * j; const LAS float* s2 = scr + (8 * c) * 33 + n;
            u32x4 o; o.x = pk2(s2[0 * 33], s2[1 * 33]); o.y = pk2(s2[2 * 33], s2[3 * 33]); o.z = pk2(s2[4 * 33], s2[5 * 33]); o.w = pk2(s2[6 * 33], s2[7 * 33]);
            *(u32x4*)(da + (size_t)n * 1024 + 8 * c) = o; }
        asm volatile("s_waitcnt lgkmcnt(0)" ::: "memory");
        if (more) {
#pragma unroll
            for (int i = 0; i < 8; ++i) va[i] = vb[i];
            da = db; }
    }
}
__device__ __forceinline__ void moe_window(const P& p, LAS unsigned char* lds, int layer, int kind, int blk, const int wv_) {
    const int capA = win_capA(layer), s0 = win_layer_start(layer);
    int start, cap, npw;
    if (kind == 0) { start = s0; cap = capA; npw = 8; }
    else if (kind == 1) { start = s0 + capA; cap = WIN_B; npw = 4; }
    else if (kind == 2) { start = s0 + capA + (layer < 3 ? WIN_B : 0); cap = WIN_C; npw = 5; }
    else if (kind == 3) { start = s0 + capA + WIN_B + WIN_C; cap = WIN_D; npw = 7; }
    else { start = s0 + capA + WIN_B + WIN_C + WIN_D; cap = WIN_E; npw = 5; }
    moe_convert_win(p, lds, start + blk * 8 * npw, npw, start + cap, wv_);
}
__device__ __forceinline__ void phase_prologue(const P& p, LAS unsigned char* lds, int vcu, int G, const int wv_) {
    unsigned char* ws = p.ws; asm volatile("" : "+s"(ws));
    const int tid = (wv_ << 6) | hw_tid();
    const int lane = tid & 63, wave = wv_;
    LAS float* scr = (LAS float*)(lds + wave * 16384);
    const int gw = vcu * NWAVES + wave, NGW = G * NWAVES;
    constexpr int I_AI = 16 * 72, I_AO = 16 * 32, I_GI = 16 * 97, I_GO = 16 * 32, I_SMALL = 2 * (I_AI + I_AO + I_GI + I_GO), I_MOE = 16 * 32;
    const int NITEMS = I_SMALL + (G == 256 ? MOE_PRO : MOE_ALL);
    for (int it = gw; it < NITEMS; it += NGW) {
        int r = it;
        if (r < I_SMALL) {
            const int i = r >= I_SMALL / 2 ? 1 : 0; r -= i * (I_SMALL / 2);
            if (r < I_AI) { const int kb = r / 72, nb = r % 72, n0 = nb * 32, drow = (n0 & ~255) + 128 * ((n0 >> 5) & 1) + 32 * ((n0 >> 6) & 3);
                p0_transpose_item(p.attn_w_in + (size_t)i * 1024 * 2304, 2304, kb, n0, (bf16_t*)(ws + W_ATTN_IN) + (size_t)i * 2304 * 1024 + (size_t)drow * 1024, scr, lane); continue; } r -= I_AI;
            if (r < I_AO) { const int kb = r / 32, nb = r % 32; p0_transpose_item(p.attn_w_out + (size_t)i * 1024 * 1024, 1024, kb, nb * 32, (bf16_t*)(ws + W_ATTN_OUT) + (size_t)i * 1024 * 1024 + (size_t)nb * 32 * 1024, scr, lane); continue; } r -= I_AO;
            if (r < I_GI) { const int kb = r / 97, nb = r % 97; p0_transpose_item(p.gla_w_in + (size_t)i * 1024 * 3104, 3104, kb, nb * 32, (bf16_t*)(ws + W_GLA_IN) + (size_t)i * 3328 * 1024 + (size_t)nb * 32 * 1024, scr, lane); continue; } r -= I_GI;
            { const int kb = r / 32, nb = r % 32; p0_transpose_item(p.gla_w_out + (size_t)i * 1024 * 1024, 1024, kb, nb * 32, (bf16_t*)(ws + W_GLA_OUT) + (size_t)i * 1024 * 1024 + (size_t)nb * 32 * 1024, scr, lane); continue; }
        }
        r -= I_SMALL;
        { int layer_, q_;
          layer_ = r / MOE_ITEMS; q_ = r % MOE_ITEMS;
          const float* src_; bf16_t* dst_; moe_item_decode(p, ws, layer_, q_, src_, dst_); p0_transpose_item(src_, 1024, 0, 0, dst_, scr, lane); }
    }
    for (int it = gw; it < 2 * 224; it += NGW) { const int i = it / 224, rr = 3104 + it % 224; u32x4* dst = (u32x4*)((bf16_t*)(ws + W_GLA_IN) + (size_t)i * 3328 * 1024 + (size_t)rr * 1024);
        dst[lane] = (u32x4){0u, 0u, 0u, 0u}; dst[lane + 64] = (u32x4){0u, 0u, 0u, 0u}; }
    __syncthreads();
    {
        LAS float* s = (LAS float*)lds;
        LAS float* red = (LAS float*)(lds + 9 * 1024 * 4);
        for (int i = tid; i < 9 * 1024; i += NTHR) { const int r = i >> 10, k = i & 1023; const float v = r < 8 ? p.c[r * 1024 + k] : p.c_ctx[k]; s[i] = v / (1.f + expf(-v)); }
        __syncthreads();
        float* mods = (float*)(ws + WS_MODS);
        for (int u = vcu; u < 384; u += G) {
            const int l = u / 96, cb = u % 96, cl = tid & 63, ks = tid >> 6, col = cb * 64 + cl;
            float acc[9];
#pragma unroll
            for (int r = 0; r < 9; ++r) acc[r] = 0.f;
            const float* w = p.ada_w + (size_t)l * 1024 * 6144 + col;
            for (int k = ks * 128; k < ks * 128 + 128; ++k) { const float wv = w[(size_t)k * 6144];
#pragma unroll
                for (int r = 0; r < 9; ++r) acc[r] += s[r * 1024 + k] * wv; }
#pragma unroll
            for (int r = 0; r < 9; ++r) red[(ks * 9 + r) * 64 + cl] = acc[r];
            __syncthreads();
            for (int i = tid; i < 9 * 64; i += NTHR) { const int r = i >> 6, c2 = i & 63; float v = 0.f;
#pragma unroll
                for (int q = 0; q < 8; ++q) v += red[(q * 9 + r) * 64 + c2];
                const int cc = cb * 64 + c2, chunk = cc >> 10; v += p.ada_b[l * 6144 + cc];
                if (chunk == 1) v = p.norm1_g[l * 1024 + (cc & 1023)] * (1.f + v); else if (chunk == 4) v = p.norm2_g[l * 1024 + (cc & 1023)] * (1.f + v);
                mods[(size_t)(l * 9 + r) * 6144 + cc] = v; }
            __syncthreads();
        }
    }
    if (vcu == 1 % G) { float* qkg = (float*)(ws + WS_ROPE + 16384);
        for (int i = tid; i < 512; i += NTHR) { const int l = i >> 8, ty = (i >> 6) & 3, d = i & 63; const float* src = ty == 0 ? p.a_q_norm : (ty == 1 ? p.a_k_norm : (ty == 2 ? p.b_q_norm : p.b_k_norm)); qkg[i] = src[l * 64 + d]; } }
    if (vcu == 0) { float* tab = (float*)(ws + WS_ROPE);
        for (int i = tid; i < 1024; i += NTHR) { const int pos = i >> 4, j = i & 15; const float inv = powf(10000.f, -(float)j / 16.f); const float a = (float)pos * inv; tab[i] = cosf(a); tab[1024 + i] = sinf(a); } }
}

template <int WHICH> __device__ __forceinline__ void phase_norm(const P& p, int layer, LAS unsigned char* lds, int vcu, int G, const int wv_, const bool lat_only = false) {
    unsigned char* ws = p.ws; asm volatile("" : "+s"(ws));
    const int lane = hw_tid(), tid = (wv_ << 6) | lane, wave = wv_;
    constexpr int NRW = 2;
    const float* mods = (const float*)(ws + WS_MODS);
    constexpr int UT_PITCH = 2064;
    LAS unsigned char* ut_hi = lds; LAS unsigned char* ut_lo = lds + 16 * UT_PITCH; LAS float* rpart0 = (LAS float*)(lds + 32 * UT_PITCH);
    int rstepi = 0;
    bf16x8 wfh[4], wfl[4];
    if (WHICH == 2) {
        const float* rwt = p.moe_router + (size_t)layer * 1024 * 16;
        const int fr = lane & 15, fq = lane >> 4;
#pragma unroll
        for (int ks = 0; ks < 4; ++ks) {
            float wv[8];
#pragma unroll
            for (int i = 0; i < 8; ++i) wv[i] = rwt[(size_t)(128 * wave + 32 * ks + 8 * fq + i) * 16 + fr];
            unsigned hh[4], ll[4];
#pragma unroll
            for (int i = 0; i < 4; ++i) { const unsigned h0 = f2bf(wv[2 * i]), h1 = f2bf(wv[2 * i + 1]); hh[i] = h0 | (h1 << 16);
                ll[i] = pk2(wv[2 * i] - __uint_as_float(h0 << 16), wv[2 * i + 1] - __uint_as_float(h1 << 16)); }
            wfh[ks] = __builtin_bit_cast(bf16x8, (u32x4){hh[0], hh[1], hh[2], hh[3]}); wfl[ks] = __builtin_bit_cast(bf16x8, (u32x4){ll[0], ll[1], ll[2], ll[3]});
        }
    }
    const int nrows = (WHICH == 3 || lat_only) ? NB * SEQ : NR;
    constexpr bool COMB = WHICH == 3 || WHICH == 1;
#define NIX(j) (2 * (lane + 64 * ((j) >> 1)) + ((j) & 1))
#define NIP(jp) (lane + 64 * (jp))
    f32x4 vn[NRW][4]; u32x4 vnb[NRW][2]; int slotn[NRW];
#define NORM_ROWMAP(rr_) do { if (WHICH == 3 || lat_only) { const int b_ = (rr_) / SEQ, t_ = (rr_) - b_ * SEQ; (rr_) = b_ * RPB + t_; } } while (0)
#define NORM_LOAD(r0_, V_, S_) do { _Pragma("unroll") for (int q = 0; q < NRW; ++q) { int rr = (r0_) + q; NORM_ROWMAP(rr); const int b = rr / RPB, t = rr - b * RPB; \
            if constexpr (WHICH == 0) { const float* src = t < SEQ ? p.x + (size_t)(b * SEQ + t) * D : p.ctx + (size_t)(b * CTXL + (t - SEQ)) * D; \
                _Pragma("unroll") for (int j = 0; j < 4; ++j) V_[q][j] = ((const GAS f32x4*)src)[NIX(j)]; } \
            else { const bf16_t* src = (const bf16_t*)(ws + WS_HB) + (size_t)rr * D; (void)b; (void)t; \
                _Pragma("unroll") for (int jp = 0; jp < 2; ++jp) V_##b[q][jp] = ((const GAS u32x4*)src)[NIP(jp)]; } \
            if (COMB) S_[q] = lane < 16 ? ((const GAS int*)(ws + WS_POS))[(size_t)rr * 16 + lane] : -1; } } while (0)
    constexpr int rstep = NWAVES * NRW;
    const int ngrp = nrows / rstep;
    unsigned Gd = (unsigned)G; asm volatile("" : "+s"(Gd));
    int r0 = (int)((unsigned)(vcu * ngrp) / Gd) * rstep + wave * NRW;
    const int rend = (int)((unsigned)((vcu + 1) * ngrp) / Gd) * rstep;
    int mr_cur = -1; f32x4 shv[4], scv[4], m5v[4];
#pragma unroll
    for (int j = 0; j < 4; ++j) { shv[j] = (f32x4){0.f, 0.f, 0.f, 0.f}; scv[j] = shv[j]; m5v[j] = shv[j]; }
    if (r0 < rend) NORM_LOAD(r0, vn, slotn);
    for (; r0 < rend; r0 += rstep) {
        int row[NRW], mr[NRW]; f32x4 v[NRW][4]; int slot[NRW];
#pragma unroll
        for (int q = 0; q < NRW; ++q) {
            int rr = r0 + q; NORM_ROWMAP(rr);
            row[q] = rr;
            const int b = rr / RPB, t = rr - b * RPB;
            mr[q] = t < SEQ ? b : 8;
            slot[q] = slotn[q];
#pragma unroll
            for (int j = 0; j < 4; ++j) {
                if constexpr (WHICH == 0) v[q][j] = vn[q][j];
                else { const u32x4 t4 = vnb[q][j >> 1]; const unsigned ta = (j & 1) ? t4.z : t4.x, tb = (j & 1) ? t4.w : t4.y; v[q][j] = (f32x4){__uint_as_float(ta << 16), __uint_as_float(ta & 0xffff0000u), __uint_as_float(tb << 16), __uint_as_float(tb & 0xffff0000u)}; }
            }
        }
        if (mr[0] != mr_cur) {
            mr_cur = mr[0];
            if (WHICH != 3) { const float* shift = mods + (size_t)(layer * 9 + mr_cur) * 6144 + (WHICH <= 1 ? 0 : 3) * 1024;
#pragma unroll
                for (int j = 0; j < 4; ++j) { shv[j] = ((const GAS f32x4*)shift)[NIX(j)]; scv[j] = ((const GAS f32x4*)(shift + 1024))[NIX(j)]; } }
            if (WHICH == 1 || WHICH == 3) { const float* m5 = mods + (size_t)((WHICH == 3 ? 3 : layer - 1) * 9 + mr_cur) * 6144 + 5 * 1024;
#pragma unroll
                for (int j = 0; j < 4; ++j) m5v[j] = ((const GAS f32x4*)m5)[NIX(j)]; }
#pragma unroll
            for (int j = 0; j < 4; ++j) asm volatile("" : "+v"(shv[j]), "+v"(scv[j]), "+v"(m5v[j]));
        }
        if (r0 + rstep < rend) NORM_LOAD(r0 + rstep, vn, slotn);
        if (WHICH == 1 || WHICH == 3) {
            const int pl = WHICH == 3 ? 3 : layer - 1;
            const float* gatev = (const float*)(ws + WS_GATE);
            const bf16_t* Y = (const bf16_t*)(ws + WS_B2);
#pragma unroll
            for (int q = 0; q < NRW; ++q) { if (slot[q] >= NSLOT) slot[q] = -1; }
            unsigned long long mskq[NRW]; int sl4[NRW][4]; u32x4 yv4[NRW][4][2];
#pragma unroll
            for (int q = 0; q < NRW; ++q) { mskq[q] = __ballot(slot[q] >= 0);
#pragma unroll
                for (int i = 0; i < 4; ++i) { sl4[q][i] = -1;
                    if (mskq[q]) { const int e = __builtin_ctzll(mskq[q]); mskq[q] &= mskq[q] - 1; sl4[q][i] = __builtin_amdgcn_readlane(slot[q], e); } } }
#pragma unroll
            for (int q = 0; q < NRW; ++q)
#pragma unroll
                for (int i = 0; i < 4; ++i) if (sl4[q][i] >= 0) { const bf16_t* yr = Y + (size_t)sl4[q][i] * 1024;
#pragma unroll
                    for (int jp = 0; jp < 2; ++jp) yv4[q][i][jp] = __builtin_nontemporal_load(((const GAS u32x4*)yr) + NIP(jp)); }
#pragma unroll
            for (int q = 0; q < NRW; ++q) {
                f32x4 acc[4];
#pragma unroll
                for (int j = 0; j < 4; ++j) acc[j] = (f32x4){0.f, 0.f, 0.f, 0.f};
#pragma unroll
                for (int i = 0; i < 4; ++i) if (sl4[q][i] >= 0) {
#pragma unroll
                    for (int j = 0; j < 4; ++j) { const u32x4 y4 = yv4[q][i][j >> 1]; const u32x2 yv = (j & 1) ? (u32x2){y4.z, y4.w} : (u32x2){y4.x, y4.y};
                        acc[j][0] += __uint_as_float(yv.x << 16); acc[j][1] += __uint_as_float(yv.x & 0xffff0000u); acc[j][2] += __uint_as_float(yv.y << 16); acc[j][3] += __uint_as_float(yv.y & 0xffff0000u); } }
                unsigned long long msk = mskq[q];
                while (msk) {
                    const int e = __builtin_ctzll(msk); msk &= msk - 1;
                    const int sl = __builtin_amdgcn_readlane(slot[q], e);
                    const bf16_t* yr = Y + (size_t)sl * 1024;
#pragma unroll
                    for (int j = 0; j < 4; ++j) { const u32x2 yv = ((const GAS u32x2*)yr)[NIX(j)];
                        acc[j][0] += __uint_as_float(yv.x << 16); acc[j][1] += __uint_as_float(yv.x & 0xffff0000u); acc[j][2] += __uint_as_float(yv.y << 16); acc[j][3] += __uint_as_float(yv.y & 0xffff0000u); }
                }
#pragma unroll
                for (int j = 0; j < 4; ++j) v[q][j] = v[q][j] + m5v[j] * acc[j];
            }
        }
        if (WHICH == 1) {
#pragma unroll
            for (int q = 0; q < NRW; ++q) { bf16_t* hb = (bf16_t*)(ws + WS_HB) + (size_t)row[q] * D;
#pragma unroll
                for (int jp = 0; jp < 2; ++jp) ((GAS u32x4*)hb)[NIP(jp)] = (u32x4){pg8::cvt_pk_bf16(v[q][2 * jp][0], v[q][2 * jp][1]), pg8::cvt_pk_bf16(v[q][2 * jp][2], v[q][2 * jp][3]), pg8::cvt_pk_bf16(v[q][2 * jp + 1][0], v[q][2 * jp + 1][1]), pg8::cvt_pk_bf16(v[q][2 * jp + 1][2], v[q][2 * jp + 1][3])}; }
        }
        if (WHICH == 3) {
#pragma unroll
            for (int q = 0; q < NRW; ++q) { const int b = row[q] / RPB, t = row[q] - b * RPB; float* orow = p.out + (size_t)(b * SEQ + t) * D;
#pragma unroll
                for (int j = 0; j < 4; ++j) ((GAS f32x4*)orow)[NIX(j)] = v[q][j]; }
        }
        if (WHICH == 3) continue;
        {
            float rs[NRW];
#pragma unroll
            for (int q = 0; q < NRW; ++q) {
                float ss = 0.f;
#pragma unroll
                for (int j = 0; j < 4; ++j) ss += v[q][j][0] * v[q][j][0] + v[q][j][1] * v[q][j][1] + v[q][j][2] * v[q][j][2] + v[q][j][3] * v[q][j][3];
                ss = wave_sum(ss);
                rs[q] = rsqrtf(ss * (1.f / 1024.f) + EPS);
            }
#pragma unroll
            for (int j = 0; j < 4; ++j) {
                const f32x4 sh = shv[j], sc = scv[j];
#pragma unroll
                for (int q = 0; q < NRW; ++q) v[q][j] = v[q][j] * rs[q] * sc + sh;
            }
#pragma unroll
            for (int q = 0; q < NRW; ++q)
#pragma unroll
                for (int jp = 0; jp < 2; ++jp)
                    ((GAS u32x4*)((bf16_t*)(ws + WS_U) + (size_t)row[q] * 1024))[NIP(jp)] = (u32x4){pg8::cvt_pk_bf16(v[q][2 * jp][0], v[q][2 * jp][1]), pg8::cvt_pk_bf16(v[q][2 * jp][2], v[q][2 * jp][3]), pg8::cvt_pk_bf16(v[q][2 * jp + 1][0], v[q][2 * jp + 1][1]), pg8::cvt_pk_bf16(v[q][2 * jp + 1][2], v[q][2 * jp + 1][3])};
        }
        if (WHICH == 2) {
#pragma unroll
            for (int q = 0; q < NRW; ++q) {
                LAS unsigned char* th = ut_hi + (wave * 2 + q) * UT_PITCH; LAS unsigned char* tl = ut_lo + (wave * 2 + q) * UT_PITCH;
#pragma unroll
                for (int j = 0; j < 4; ++j) {
                    const unsigned h01 = pg8::cvt_pk_bf16(v[q][j][0], v[q][j][1]), h23 = pg8::cvt_pk_bf16(v[q][j][2], v[q][j][3]);
                    const float l0 = v[q][j][0] - __uint_as_float(h01 << 16), l1 = v[q][j][1] - __uint_as_float(h01 & 0xffff0000u), l2 = v[q][j][2] - __uint_as_float(h23 << 16), l3 = v[q][j][3] - __uint_as_float(h23 & 0xffff0000u);
                    *(LAS u32x2*)(th + NIX(j) * 8) = (u32x2){h01, h23};
                    *(LAS u32x2*)(tl + NIX(j) * 8) = (u32x2){pg8::cvt_pk_bf16(l0, l1), pg8::cvt_pk_bf16(l2, l3)};
                }
            }
            __syncthreads();
            {
                const int fr = lane & 15, fq = lane >> 4;
                bf16x8 xh[4], xl[4];
#pragma unroll
                for (int ks = 0; ks < 4; ++ks) { xh[ks] = *(const LAS bf16x8*)(ut_hi + fr * UT_PITCH + (128 * wave + 32 * ks + 8 * fq) * 2); xl[ks] = *(const LAS bf16x8*)(ut_lo + fr * UT_PITCH + (128 * wave + 32 * ks + 8 * fq) * 2); }
                f32x4 pc = (f32x4){0.f, 0.f, 0.f, 0.f};
#pragma unroll
                for (int ks = 0; ks < 4; ++ks) { pc = __builtin_amdgcn_mfma_f32_16x16x32_bf16(wfh[ks], xh[ks], pc, 0, 0, 0); pc = __builtin_amdgcn_mfma_f32_16x16x32_bf16(wfl[ks], xh[ks], pc, 0, 0, 0); pc = __builtin_amdgcn_mfma_f32_16x16x32_bf16(wfh[ks], xl[ks], pc, 0, 0, 0); }
                *(LAS f32x4*)(rpart0 + (rstepi & 1) * 2048 + (wave * 16 + fr) * 16 + 4 * fq) = pc;
            }
            __syncthreads();
            if (tid < 256) {
                const int rr_ = tid >> 4, ee = tid & 15;
                float x = 0.f;
#pragma unroll
                for (int w8 = 0; w8 < 8; ++w8) x += rpart0[(rstepi & 1) * 2048 + (w8 * 16 + rr_) * 16 + ee];
                float mx = x; mx = fmaxf(mx, swz_xor<1>(mx)); mx = fmaxf(mx, swz_xor<2>(mx)); mx = fmaxf(mx, swz_xor<4>(mx)); mx = fmaxf(mx, swz_xor<8>(mx));
                const float ex = expf(x - mx);
                float sm = ex; sm += swz_xor<1>(sm); sm += swz_xor<2>(sm); sm += swz_xor<4>(sm); sm += swz_xor<8>(sm);
                int grow = (r0 - wave * NRW) + rr_;
                NORM_ROWMAP(grow);
                { const int b_ = grow / RPB, t_ = grow - b_ * RPB;
                  const size_t ao_ = t_ < SEQ ? ((size_t)(b_ * 16 + ee) * SEQ + t_) : ((size_t)NB * 16 * SEQ + (size_t)(b_ * 16 + ee) * CTXL + (t_ - SEQ));
                  ((GAS float*)(ws + WS_AFF))[ao_] = ex / sm; }
            }
            ++rstepi;
        }
    }
    if (WHICH == 2) __syncthreads();
#undef NORM_ROWMAP
#undef NORM_LOAD
#undef NIX
#undef NIP
}

__device__ __forceinline__ void phase_qkprep(const P& p, int layer, int vcu, int G, const int wv_) {
    unsigned char* ws = p.ws; asm volatile("" : "+s"(ws));
    const int tid = (wv_ << 6) | hw_tid();
    const int lane = tid & 63, wave = wv_;
    const int li = layer >> 1;
    const float* tab = (const float*)(ws + WS_ROPE);
    for (int wid = vcu * NWAVES + wave; wid < NR * 26; wid += G * NWAVES) {
        const int row = wid / 26, hs = wid - row * 26;
        int col; const float* g; bool rope;
        if (hs < 8) { col = hs * 64; g = p.a_q_norm + li * 64; rope = true; }
        else if (hs < 10) { col = 512 + (hs - 8) * 64; g = p.a_k_norm + li * 64; rope = true; }
        else if (hs < 18) { col = 768 + (hs - 10) * 64; g = p.b_q_norm + li * 64; rope = false; }
        else { col = 1280 + (hs - 18) * 64; g = p.b_k_norm + li * 64; rope = false; }
        bf16_t* q = (bf16_t*)(ws + WS_B1) + (size_t)row * 2304 + col;
        const float x = bf2f(q[lane]);
        const float ss = wave_sum(x * x);
        float y = x * rsqrtf(ss * (1.f / 64.f) + EPS) * g[lane];
        const int b = row / RPB, t = row - b * RPB;
        if (rope && t < SEQ) {
            const int half = lane >> 5, j = lane & 31;
            const int pos = half == 0 ? (t >> 6) : (t & 63);
            const float cs = tab[pos * 16 + (j & 15)], sn = tab[1024 + pos * 16 + (j & 15)];
            const float other = swz_xor<16>(y);
            y = y * cs + (j < 16 ? -other : other) * sn;
        }
        if (hs < 8 || (hs >= 10 && hs < 18)) y *= 0.18033688011112042f;
        q[lane] = (bf16_t)f2bf(y);
    }
}

namespace attn_body {
using bf16=unsigned short;
using bf16x8=__attribute__((ext_vector_type(8)))short;
using s16x4=__attribute__((ext_vector_type(4)))short;
using f32x16=__attribute__((ext_vector_type(16)))float;
using u32x4=__attribute__((ext_vector_type(4)))unsigned;
constexpr int D=64;
constexpr int NW=8,QBLK=32,QB=QBLK*NW,KVBLK=64;
__device__ __forceinline__ int crow(int r,int hi){return (r&3)+8*(r>>2)+4*hi;}
#define SBAR() __builtin_amdgcn_sched_barrier(0)
#define CINIT (MODE==1?f32x16{}:negm)
struct NaArgs { int ctx_row0, win_row0, r0, wr0; };
constexpr int LDS_NAT_OFF = 86016;
__device__ __forceinline__ void na_mask(f32x16&p0,f32x16&p1,int j,const NaArgs&na,const char*shm,int wid,int r32,int hi,float mhat){
  const float NEG=-INFINITY;
  const int r=na.r0+(wid>>1), c=32*(wid&1)+r32;
  int rs=r-4; rs=rs<0?0:(rs>56?56:rs);
  int cs=c-8; cs=cs<0?0:(cs>48?48:cs);
  const int kr=na.wr0+j, di=kr-rs;
  if(di<0||di>=8){
    #pragma unroll
    for(int q=0;q<16;++q){p0[q]=NEG;p1[q]=NEG;}
  } else {
    const int dr=kr-r+7;
    const float*T=reinterpret_cast<const float*>(shm+LDS_NAT_OFF)+dr*128+63-c+4*hi;
    const int a=4*hi-cs;
    #pragma unroll
    for(int q=0;q<16;++q){ const int kc0=(q&3)+8*(q>>2);
      const float b0=T[kc0], b1=T[kc0+32];
      p0[q]=((unsigned)(a+kc0)<16u)?p0[q]+(b0-mhat):NEG; p1[q]=((unsigned)(a+kc0+32)<16u)?p1[q]+(b1-mhat):NEG;
      if((q&1)==1) SBAR(); }
  }
}
constexpr int NSLOT=3, SLOTB=8192;
constexpr int LDS_K=0, LDS_V=NSLOT*SLOTB, LDS_WS=2*NSLOT*SLOTB, LDS_OST=LDS_WS+NW*64*4, LDS_BYTES=LDS_OST+NW*4096;
constexpr float C2=0.125f*1.4426950408889634f;
__device__ __forceinline__ void glds16(const void*gsrc,unsigned lds_dst){unsigned keep;
  asm volatile("s_mov_b32 %0, m0\n\ts_mov_b32 m0, %2\n\ts_nop 0\n\tglobal_load_lds_dwordx4 %1, off\n\ts_mov_b32 m0, %0":"=&s"(keep):"v"(gsrc),"s"(lds_dst):"memory");}
__device__ __forceinline__ float max3f(float a,float b,float c){float r;asm("v_max3_f32 %0, %1, %2, %3":"=v"(r):"v"(a),"v"(b),"v"(c));return r;}
__device__ __forceinline__ float max2f(float a,float b){float r;asm("v_max_f32_e32 %0, %1, %2":"=v"(r):"v"(a),"v"(b));return r;}
__device__ __forceinline__ float fadd_s(float a,float b){float r;asm("v_add_f32_e32 %0, %1, %2":"=v"(r):"v"(a),"v"(b));return r;}
__device__ __forceinline__ float fsub_s(float a,float b){float r;asm("v_sub_f32_e32 %0, %1, %2":"=v"(r):"v"(a),"v"(b));return r;}
typedef float f32x2_t __attribute__((ext_vector_type(2))); typedef __bf16 bf16x2_t __attribute__((ext_vector_type(2)));
__device__ __forceinline__ unsigned cvtpk_s(float lo,float hi){f32x2_t v={lo,hi};bf16x2_t b=__builtin_convertvector(v,bf16x2_t);return __builtin_bit_cast(unsigned,b);}
#define WAIT_BAR(N) asm volatile("s_waitcnt vmcnt(" #N ") lgkmcnt(0)\n\ts_barrier":::"memory")

__device__ __forceinline__ void qkt(f32x16&p0,f32x16&p1,const char*Kslot,const bf16x8*qr,const f32x16&negm,int r32,int hi){
  const char*kb=Kslot+hi*1024+r32*16;
  #pragma unroll
  for(int d0=0;d0<4;++d0){
    const bf16x8 b0=*reinterpret_cast<const bf16x8*>(kb+d0*2048);
    const bf16x8 b1=*reinterpret_cast<const bf16x8*>(kb+d0*2048+512);
    if(d0==0){p0=__builtin_amdgcn_mfma_f32_32x32x16_bf16(b0,qr[0],negm,0,0,0);p1=__builtin_amdgcn_mfma_f32_32x32x16_bf16(b1,qr[0],negm,0,0,0);}
    else{p0=__builtin_amdgcn_mfma_f32_32x32x16_bf16(b0,qr[d0],p0,0,0,0);p1=__builtin_amdgcn_mfma_f32_32x32x16_bf16(b1,qr[d0],p1,0,0,0);}}
}
typedef __attribute__((address_space(3))) const char* lds_cptr;
typedef short v4i16_t __attribute__((ext_vector_type(4)));
__device__ __forceinline__ void kload8(bf16x8*kf,lds_cptr kp){
  kf[0]=*(const __attribute__((address_space(3))) bf16x8*)(kp);      kf[1]=*(const __attribute__((address_space(3))) bf16x8*)(kp+512);
  kf[2]=*(const __attribute__((address_space(3))) bf16x8*)(kp+2048); kf[3]=*(const __attribute__((address_space(3))) bf16x8*)(kp+2560);
  kf[4]=*(const __attribute__((address_space(3))) bf16x8*)(kp+4096); kf[5]=*(const __attribute__((address_space(3))) bf16x8*)(kp+4608);
  kf[6]=*(const __attribute__((address_space(3))) bf16x8*)(kp+6144); kf[7]=*(const __attribute__((address_space(3))) bf16x8*)(kp+6656);
}
__device__ __forceinline__ void kload2(bf16x8*kf,lds_cptr kp,int j){ kf[2*j]=*(const __attribute__((address_space(3))) bf16x8*)(kp+j*2048); kf[2*j+1]=*(const __attribute__((address_space(3))) bf16x8*)(kp+j*2048+512); }
__device__ __forceinline__ s16x4 vtr(lds_cptr p){ return __builtin_bit_cast(s16x4,__builtin_amdgcn_ds_read_tr16_b64_v4i16((__attribute__((address_space(3))) v4i16_t*)p)); }
__device__ __forceinline__ float rowmax(const f32x16&p0,const f32x16&p1){
  float a=max3f(p0[0],p0[1],p1[0]),b=max3f(p0[2],p0[3],p1[1]);a=max3f(a,p1[2],p1[3]);
  #pragma unroll
  for(int r=4;r<16;r+=4){a=max3f(a,p0[r],p0[r+1]);b=max3f(b,p0[r+2],p0[r+3]);a=max3f(a,p1[r],p1[r+1]);b=max3f(b,p1[r+2],p1[r+3]);}
  const float m=max2f(a,b);
  auto rr=__builtin_amdgcn_permlane32_swap(__float_as_uint(m),__float_as_uint(m),false,false);
  return max2f(__uint_as_float(rr[0]),__uint_as_float(rr[1]));
}
__device__ __forceinline__ void pv(f32x16*o,int vb,bf16x8 pa0,bf16x8 pa1,bf16x8 pa2,bf16x8 pa3){
  #pragma unroll
  for(int d0=0;d0<2;++d0){s16x4 lo[4],hi[4];
    #pragma unroll
    for(int ks=0;ks<4;++ks){
      asm volatile("ds_read_b64_tr_b16 %0,%1 offset:%c2":"=&v"(lo[ks]):"v"(vb),"i"(d0*4096+ks*1024):"memory");
      asm volatile("ds_read_b64_tr_b16 %0,%1 offset:%c2":"=&v"(hi[ks]):"v"(vb),"i"(d0*4096+ks*1024+512):"memory");}
    asm volatile("s_waitcnt lgkmcnt(0)":::"memory");SBAR();
    #define PK(k) (bf16x8){lo[k][0],lo[k][1],lo[k][2],lo[k][3],hi[k][0],hi[k][1],hi[k][2],hi[k][3]}
    o[d0]=__builtin_amdgcn_mfma_f32_32x32x16_bf16(pa0,PK(0),o[d0],0,0,0);
    o[d0]=__builtin_amdgcn_mfma_f32_32x32x16_bf16(pa1,PK(1),o[d0],0,0,0);
    o[d0]=__builtin_amdgcn_mfma_f32_32x32x16_bf16(pa2,PK(2),o[d0],0,0,0);
    o[d0]=__builtin_amdgcn_mfma_f32_32x32x16_bf16(pa3,PK(3),o[d0],0,0,0);
    #undef PK
  }
}

#ifndef ATTN_STORE16
#define ATTN_STORE16(p,v) (*(u32x4*)(p)=(v))
#endif
template<int THRL,int QP,int OP,int MODE> __device__ __forceinline__ void attn_unit(const bf16*Qu,const bf16*__restrict__ Kh,const bf16*__restrict__ Vh,bf16*Ou,const int NT,char*shm,const int wid,const int lane,const NaArgs na){
  const int r32=lane&31,hi=lane>>5;
  const bf16*Qw=Qu+(long)(wid*QBLK)*QP;
  const unsigned lds0=(unsigned)(uintptr_t)shm;
  float*wsf=(float*)(shm+LDS_WS)+wid*64;
  const bf16*ksrc=Kh+(long)lane*QP+wid*8;
  const bf16*vsrc=Vh+(long)(16*(wid&3)+(lane>>2))*QP+(wid>>2)*32+(lane&3)*8;
  const unsigned kdst=lds0+LDS_K+wid*1024, vdst=lds0+LDS_V+wid*1024;
  #define TROW(t) (MODE==0?(long)(t)*KVBLK:((t)<4?(long)na.ctx_row0+(long)(t)*KVBLK:(long)na.win_row0+(long)((t)-4)*KVBLK))
  #define DMA_K(t,slot) glds16(ksrc+TROW(t)*QP,(unsigned)__builtin_amdgcn_readfirstlane(kdst+(slot)))
  #define DMA_V(t,slot) glds16(vsrc+TROW(t)*QP,(unsigned)__builtin_amdgcn_readfirstlane(vdst+(slot)))
  const int vb0=(int)(lds0+LDS_V)+((lane>>4)&1)*32+(lane&3)*8+(4*hi+((lane&15)>>2))*64;
  const char*Kbase=shm+LDS_K; bf16x8 kf[8];
  const lds_cptr shm3=(lds_cptr)shm; const lds_cptr kp0=shm3+LDS_K+hi*1024+r32*16; const lds_cptr vp0=shm3+LDS_V+((lane>>4)&1)*32+(lane&3)*8+(4*hi+((lane&15)>>2))*64;
  DMA_K(0,0);DMA_V(0,0);DMA_K(1,SLOTB);
  bf16x8 qr[4];
  #pragma unroll
  for(int d0=0;d0<4;++d0)qr[d0]=*reinterpret_cast<const bf16x8*>(&Qw[(long)r32*QP+d0*16+hi*8]);
  float mhat=0.f,l_reg=0.f;f32x16 o[2],negm; { float z_=0.f; asm volatile("":"+v"(z_));
    _Pragma("unroll") for(int r=0;r<16;++r){o[0][r]=z_;o[1][r]=z_;negm[r]=z_;} } if(MODE==0)asm volatile("":"+v"(negm));
  #define CMASK(P0,P1,t) do{ if(MODE==1){ if((t)>=4) na_mask(P0,P1,(t)-4,na,shm,wid,r32,hi,mhat); else { _Pragma("unroll") for(int r_=0;r_<16;++r_){P0[r_]-=mhat;P1[r_]-=mhat;} } } }while(0)
  bool resc=false;
  #define START(P0,P1) do{ const float rm=rowmax(P0,P1); resc=false; \
    { const float dl=rm; mhat=fadd_s(mhat,dl); \
      _Pragma("unroll") for(int r=0;r<16;++r){P0[r]=fsub_s(P0[r],dl);P1[r]=fsub_s(P1[r],dl);} \
      if(MODE==0){ _Pragma("unroll") for(int r=0;r<16;++r)negm[r]=-mhat; asm volatile("":"+v"(negm)); } } \
    _Pragma("unroll") for(int r=0;r<16;++r)P0[r]=__builtin_amdgcn_exp2f(P0[r]); }while(0)
  #define RESC() do{ if(resc){ asm volatile("s_waitcnt lgkmcnt(0)":::"memory"); \
      _Pragma("unroll") for(int d_=0;d_<2;++d_) _Pragma("unroll") for(int r=0;r<16;++r)o[d_][r]*=wsf[crow(r,hi)]; } }while(0)
  f32x16 pA0,pA1,pB0,pB1;
  int sl_prev=0,sl_cur=0,sl_next=SLOTB;
  #define ROT() do{sl_prev=sl_cur;sl_cur=sl_next;sl_next=(sl_next==(NSLOT-1)*SLOTB)?0:sl_next+SLOTB;}while(0)
  DMA_K(2,2*SLOTB);
  WAIT_BAR(3);
  qkt(pA0,pA1,Kbase,qr,CINIT,r32,hi);asm volatile("s_nop 15\n\ts_nop 7":"+v"(pA0),"+v"(pA1));CMASK(pA0,pA1,0);
  START(pA0,pA1);
  _Pragma("unroll") for(int r=0;r<16;++r)pA1[r]=__builtin_amdgcn_exp2f(pA1[r]);
  WAIT_BAR(0);
  DMA_K(3,0);DMA_V(1,SLOTB);
  ROT();
  kload8(kf,kp0+sl_cur);
  WAIT_BAR(2);
  s16x4 vlo[8],vhi[8]; u32x4 pw0,pw1,pw2,pw3;
  #define PKW(P,B) cvtpk_s(P[B],P[B+1])
  #define PAF(k) __builtin_bit_cast(bf16x8,pw##k)
  #define VFR(i) (bf16x8){vlo[i][0],vlo[i][1],vlo[i][2],vlo[i][3],vhi[i][0],vhi[i][1],vhi[i][2],vhi[i][3]}
  #define PIN(x) asm volatile("":"+v"(x))
  #define MX3(a,b,c) __builtin_fmaxf(__builtin_fmaxf((a),(b)),(c))
  #define GAPA(MF,A0,A1,A2,A3,W0,W1,PW) do{ MF; sacc+=A0; sacc+=A1; sacc+=A2; sacc+=A3; PIN(sacc); W0; W1; PIN(PW); SBAR(); }while(0)
  #define EX(v) __builtin_amdgcn_exp2f(v)
  #define GAPB(MF,X,B) do{ MF; X[B]=EX(X[B]); X[B+1]=EX(X[B+1]); X[B+2]=EX(X[B+2]); X[B+3]=EX(X[B+3]); PIN(X); SBAR(); }while(0)
  #define VRD(i) do{ vlo[i]=vtr(vp_+(((i)>>2)*4096+((i)&3)*1024)); vhi[i]=vtr(vp_+(((i)>>2)*4096+((i)&3)*1024+512)); }while(0)
  #define KRD(G,j) do{ if(G){ kload2(kf,kp0+sl_next,j); SBAR(); } }while(0)
  #define STEP(C0,C1,P0,P1,t,GK,GV,GL) do{ SBAR(); \
    const lds_cptr vp_=vp0+sl_prev; \
    VRD(0); SBAR(); float sacc=(P0[0]+P0[1]); \
    GAPA(C0=__builtin_amdgcn_mfma_f32_32x32x16_bf16(kf[0],qr[0],CINIT,0,0,0), P0[2],P0[3],P0[4],P0[5],     pw0[0]=PKW(P0,0), pw0[1]=PKW(P0,2), pw0); \
    VRD(4); SBAR(); GAPA(C1=__builtin_amdgcn_mfma_f32_32x32x16_bf16(kf[1],qr[0],CINIT,0,0,0), P0[6],P0[7],P0[8],P0[9],     pw0[2]=PKW(P0,4), pw0[3]=PKW(P0,6), pw0); \
    VRD(1); SBAR(); GAPA(C0=__builtin_amdgcn_mfma_f32_32x32x16_bf16(kf[2],qr[1],C0,0,0,0),   P0[10],P0[11],P0[12],P0[13], pw1[0]=PKW(P0,8), pw1[1]=PKW(P0,10), pw1); \
    VRD(5); SBAR(); GAPA(C1=__builtin_amdgcn_mfma_f32_32x32x16_bf16(kf[3],qr[1],C1,0,0,0),   P0[14],P0[15],P1[0],P1[1],   pw1[2]=PKW(P0,12),pw1[3]=PKW(P0,14), pw1); \
    VRD(2); SBAR(); GAPA(C0=__builtin_amdgcn_mfma_f32_32x32x16_bf16(kf[4],qr[2],C0,0,0,0),   P1[2],P1[3],P1[4],P1[5],     pw2[0]=PKW(P1,0), pw2[1]=PKW(P1,2), pw2); \
    VRD(6); SBAR(); GAPA(C1=__builtin_amdgcn_mfma_f32_32x32x16_bf16(kf[5],qr[2],C1,0,0,0),   P1[6],P1[7],P1[8],P1[9],     pw2[2]=PKW(P1,4), pw2[3]=PKW(P1,6), pw2); \
    VRD(3); SBAR(); GAPA(C0=__builtin_amdgcn_mfma_f32_32x32x16_bf16(kf[6],qr[3],C0,0,0,0),   P1[10],P1[11],P1[12],P1[13], pw3[0]=PKW(P1,8), pw3[1]=PKW(P1,10), pw3); \
    VRD(7); SBAR(); GAPA(C1=__builtin_amdgcn_mfma_f32_32x32x16_bf16(kf[7],qr[3],C1,0,0,0),   P1[14],P1[15],0.f,0.f,       pw3[2]=PKW(P1,12),pw3[3]=PKW(P1,14), pw3); \
    l_reg+=sacc; \
    if(GK){DMA_K((t)+3,sl_cur);} if(GV){DMA_V((t)+1,sl_next);} \
    CMASK(C0,C1,t); \
    { float a=MX3(C0[0],C0[1],C1[0]),b=MX3(C0[2],C0[3],C1[1]); a=MX3(a,C1[2],C1[3]); \
      _Pragma("unroll") for(int r=4;r<16;r+=4){a=MX3(a,C0[r],C0[r+1]);b=MX3(b,C0[r+2],C0[r+3]);a=MX3(a,C1[r],C1[r+1]);b=MX3(b,C1[r+2],C1[r+3]);} \
      float rm=__builtin_fmaxf(a,b); { auto rr=__builtin_amdgcn_permlane32_swap(__float_as_uint(rm),__float_as_uint(rm),false,false); rm=__builtin_fmaxf(__uint_as_float(rr[0]),__uint_as_float(rr[1])); } \
      resc=false; \
      if(__builtin_expect(__any(rm>(float)THRL),0)){ const float dl=__builtin_fmaxf(rm,0.f); mhat+=dl; \
        _Pragma("unroll") for(int r=0;r<16;++r){C0[r]-=dl;C1[r]-=dl;} \
        if(MODE==0){ _Pragma("unroll") for(int r=0;r<16;++r)negm[r]=-mhat; asm volatile("":"+v"(negm)); } \
        const float f=__builtin_amdgcn_exp2f(-dl); l_reg*=f; if(hi==0)wsf[r32]=f; resc=true; } } \
    SBAR(); \
    GAPB(o[0]=__builtin_amdgcn_mfma_f32_32x32x16_bf16(PAF(0),VFR(0),o[0],0,0,0), C0,0); \
    GAPB(o[1]=__builtin_amdgcn_mfma_f32_32x32x16_bf16(PAF(0),VFR(4),o[1],0,0,0), C0,4); \
    KRD(GL,0); GAPB(o[0]=__builtin_amdgcn_mfma_f32_32x32x16_bf16(PAF(1),VFR(1),o[0],0,0,0), C0,8); \
    KRD(GL,1); GAPB(o[1]=__builtin_amdgcn_mfma_f32_32x32x16_bf16(PAF(1),VFR(5),o[1],0,0,0), C0,12); \
    KRD(GL,2); GAPB(o[0]=__builtin_amdgcn_mfma_f32_32x32x16_bf16(PAF(2),VFR(2),o[0],0,0,0), C1,0); \
    KRD(GL,3); GAPB(o[1]=__builtin_amdgcn_mfma_f32_32x32x16_bf16(PAF(2),VFR(6),o[1],0,0,0), C1,4); \
    GAPB(o[0]=__builtin_amdgcn_mfma_f32_32x32x16_bf16(PAF(3),VFR(3),o[0],0,0,0), C1,8); \
    GAPB(o[1]=__builtin_amdgcn_mfma_f32_32x32x16_bf16(PAF(3),VFR(7),o[1],0,0,0), C1,12); \
    }while(0)
  int t=1;
  for(;t+5<NT;t+=2){
    STEP(pB0,pB1,pA0,pA1,t,true,true,true);     WAIT_BAR(2); RESC(); ROT();
    STEP(pA0,pA1,pB0,pB1,t+1,true,true,true);   WAIT_BAR(2); RESC(); ROT();
  }
  #define ENDW(tt) do{ if((tt)+3<NT){WAIT_BAR(2);} else if((tt)+2<NT){WAIT_BAR(1);} else {WAIT_BAR(0);} }while(0)
  for(;t+1<NT;t+=2){
    STEP(pB0,pB1,pA0,pA1,t,(t+3<NT),(t+1<NT),(t+1<NT));       ENDW(t);   RESC(); ROT();
    STEP(pA0,pA1,pB0,pB1,t+1,(t+4<NT),(t+2<NT),(t+2<NT));     ENDW(t+1); RESC(); ROT();
  }
  STEP(pB0,pB1,pA0,pA1,NT-1,false,false,false); RESC();
  { float sacc=pB0[0]+pB0[1]; _Pragma("unroll") for(int r=2;r<16;++r)sacc+=pB0[r]; _Pragma("unroll") for(int r=0;r<16;++r)sacc+=pB1[r]; l_reg+=sacc;
    pw0=(u32x4){PKW(pB0,0),PKW(pB0,2),PKW(pB0,4),PKW(pB0,6)};pw1=(u32x4){PKW(pB0,8),PKW(pB0,10),PKW(pB0,12),PKW(pB0,14)};pw2=(u32x4){PKW(pB1,0),PKW(pB1,2),PKW(pB1,4),PKW(pB1,6)};pw3=(u32x4){PKW(pB1,8),PKW(pB1,10),PKW(pB1,12),PKW(pB1,14)};
    SBAR(); pv(o,vb0+sl_cur,PAF(0),PAF(1),PAF(2),PAF(3)); }
  #undef PKW
  #undef PAF
  #undef VFR
  #undef PIN
  #undef MX3
  #undef GAPA
  #undef GAPB
  #undef EX
  #undef VRD
  #undef KRD
  #undef STEP
  #undef ENDW
  {auto rr=__builtin_amdgcn_permlane32_swap(__float_as_uint(l_reg),__float_as_uint(l_reg),false,false);l_reg=__uint_as_float(rr[0])+__uint_as_float(rr[1]);}
  if(hi==0)wsf[32+r32]=l_reg;asm volatile("s_waitcnt lgkmcnt(0)":::"memory");
  float rli[16];
  #pragma unroll
  for(int r=0;r<16;++r)rli[r]=__builtin_amdgcn_rcpf(wsf[32+crow(r,hi)]);
  bf16*Ow=Ou+(long)(wid*QBLK)*OP;
  { bf16*stg=(bf16*)(shm+LDS_OST)+wid*2048;
    #pragma unroll
    for(int r=0;r<16;++r){const int orow=crow(r,hi);
      #pragma unroll
      for(int d0=0;d0<2;++d0)stg[orow*64+d0*32+r32]=(bf16)f2bf(o[d0][r]*rli[r]);}
    asm volatile("s_waitcnt lgkmcnt(0)":::"memory");
    #pragma unroll
    for(int i=0;i<4;++i){const int row=i*8+(lane>>3),ch=lane&7; const u32x4 v=*(const u32x4*)(stg+row*64+ch*8); ATTN_STORE16(Ow+(long)row*OP+ch*8,v);} }
  asm volatile("s_waitcnt lgkmcnt(0)\n\ts_barrier":::"memory");
  #undef DMA_K
  #undef DMA_V
  #undef TROW
  #undef CMASK
  #undef START
  #undef RESC
  #undef ROT
}
#undef SBAR
#undef WAIT_BAR
}

__device__ __forceinline__ void phase_attn_dense(const P& p, char* shm, int vcu, int G, const int wv_) {
    unsigned char* ws = p.ws; asm volatile("" : "+s"(ws));
    const int lane = hw_tid();
    const attn_body::bf16* QKV = (const attn_body::bf16*)(ws + WS_B1);
    attn_body::bf16* O = (attn_body::bf16*)(ws + WS_B2);
    const attn_body::NaArgs na{0, 0, 0, 0};
    for (int L = vcu; L < 1024 + 128; L += G) {
        size_t qo, ko, vo, oo; int ntile;
        if (L < 1024) {
            const int i = L >> 8, v = L & 255, xcd = v >> 5, j = v & 31;
            const int grp = 2 * xcd + (i >> 1), b = grp >> 1, kvh = grp & 1, u = (i & 1) * 32 + j, h = kvh * 4 + (u >> 4), qb = u & 15;
            const size_t rb = (size_t)b * RPB;
            qo = (rb + qb * 256) * 2304 + 64 * h; ko = rb * 2304 + 512 + 64 * kvh; vo = rb * 2304 + 640 + 64 * kvh; oo = (rb + qb * 256) * 1024 + 64 * h; ntile = 68;
        } else {
            const int u = L - 1024, typ = u >> 6, b = (u >> 3) & 7, h = u & 7;
            const size_t rc = (size_t)b * RPB + SEQ;
            const int qcol = typ ? 768 + 64 * h : 64 * h, kcol = typ ? 1280 + 64 * h : 512 + 64 * (h >> 2), vcol = typ ? 1792 + 64 * h : 640 + 64 * (h >> 2), ocol = typ ? 512 + 64 * h : 64 * h;
            qo = rc * 2304 + qcol; ko = rc * 2304 + kcol; vo = rc * 2304 + vcol; oo = rc * 1024 + ocol; ntile = 4;
        }
        attn_body::attn_unit<8, 2304, 1024, 0>(QKV + qo, QKV + ko, QKV + vo, O + oo, ntile, shm, wv_, lane, na);
    }
}

__device__ __forceinline__ void phase_attn_na(const P& p, int layer, char* shm, int vcu, int G, const int wv_) {
    unsigned char* ws = p.ws; asm volatile("" : "+s"(ws));
    const int lane = hw_tid(), tid = (wv_ << 6) | lane;
    const attn_body::bf16* QKV = (const attn_body::bf16*)(ws + WS_B1);
    attn_body::bf16* O = (attn_body::bf16*)(ws + WS_B2);
    float* T = (float*)(shm + attn_body::LDS_NAT_OFF);
    for (int L = vcu; L < 1024; L += G) {
        const int i = L >> 8, v = L & 255, xcd = v >> 5, j = v & 31;
        const int grp = (i * 8 + xcd) * 2 + (j >> 4), rblk = j & 15, b = grp >> 3, h = grp & 7;
        const float* rpb = p.na_rpb + (size_t)((layer >> 1) * 8 + h) * 15 * 31;
        for (int e = tid; e < 15 * 128; e += NTHR) { const int dr = e >> 7, d = (e & 127) - 63; T[e] = (d >= -15 && d <= 15) ? rpb[dr * 31 + d + 15] * 1.4426950408889634f : -INFINITY; }
        const int r0 = rblk * 4; int wr0 = r0 - 4; wr0 = wr0 < 0 ? 0 : (wr0 > 52 ? 52 : wr0);
        const size_t rb = (size_t)b * RPB;
        const attn_body::NaArgs na{SEQ, wr0 * 64, r0, wr0};
        attn_body::attn_unit<8, 2304, 1024, 1>(QKV + (rb + r0 * 64) * 2304 + 768 + 64 * h, QKV + rb * 2304 + 1280 + 64 * h, QKV + rb * 2304 + 1792 + 64 * h, O + (rb + r0 * 64) * 1024 + 512 + 64 * h, 16, shm, wv_, lane, na);
    }
}

__device__ __forceinline__ int gla_o256(int row, int ch) { return row * 256 + ((ch ^ (row & 15)) << 4); }
__device__ __forceinline__ int gla_o128(int row, int ch) { return (row >> 1) * 256 + (((((row & 1) << 3) | ch) ^ ((row >> 1) & 7)) << 4); }
__device__ __forceinline__ int gla_task(int b, int h, int dir, int s) { return ((b * 4 + h) * 2 + dir) * 68 + s; }
__device__ __forceinline__ int gla_rowc(int b, int dir, int s) { return b * RPB + (s < 4 ? SEQ + 64 * (dir ? 3 - s : s) : 64 * (dir ? 67 - s : s - 4)); }

__device__ __forceinline__ void phase_gla_pre(const P& p, int layer, LAS unsigned char* lds, int vcu, int G, const int wv_) {
    unsigned char* ws = p.ws; asm volatile("" : "+s"(ws));
    const int lane = hw_tid(), tid = (wv_ << 6) | lane, fr = lane & 15, fq = lane >> 4;
    constexpr int L_QD = 0, L_KI = 16384, L_KST = 32768, L_A = 49152, L_SB = 57344, SB_BYTES = 36864, SB_K = 16384, SB_Z = 32768, L_CL = RING_BYTES + 8192;
    static_assert(L_SB + 2 * SB_BYTES <= RING_BYTES && L_CL + 512 <= LDS_BYTES, "gla pre LDS map");
    LAS unsigned char* qd = lds + L_QD; LAS unsigned char* ki = lds + L_KI; LAS unsigned char* ksT = lds + L_KST; LAS unsigned char* Al = lds + L_A;
    LAS float* cls = (LAS float*)(lds + L_CL);
    const unsigned lds0 = (unsigned)(size_t)lds;
    const int li = layer >> 1;
    const bf16_t* X = (const bf16_t*)(ws + WS_B1);
    const float* Z = (const float*)(ws + WS_Z);
    const int pd = 16 * wv_ + fr;
#define GLAP_TASK(i_, bhd_, s_) const int bhd_ = ((i_) & 255) >> 2, s_ = 17 * ((i_) & 3) + ((i_) >> 8)
#define GLAP_DMA(i_, buf_) do { GLAP_TASK((i_), bhd__, s__); const int dir__ = bhd__ & 1, h__ = (bhd__ >> 1) & 3, b__ = bhd__ >> 3; const int rc_ = gla_rowc(b__, dir__, s__); \
        const unsigned sb_ = lds0 + L_SB + (unsigned)(buf_) * SB_BYTES; \
        _Pragma("unroll") for (int jj = 0; jj < 4; ++jj) { const int j = 4 * wv_ + jj;        \
            pg8::glds16_s((const char*)(X + (size_t)(rc_ + 4 * (j & 15)) * 3072 + h__ * 128 + (j >> 4) * 512), (unsigned)((lane >> 4) * 6144 + (((lane & 15) ^ (2 * (j & 3))) << 4)), sb_ + (unsigned)j * 1024u); } \
        if (wv_ < 4) pg8::glds16_s((const char*)(Z + (size_t)(rc_ + 16 * wv_) * 32 + dir__ * 16), (unsigned)((lane >> 2) * 128 + (lane & 3) * 16), sb_ + SB_Z + (unsigned)wv_ * 1024u); } while (0)
    int ti = vcu, kk_ = 0;
    if (ti < 4352) GLAP_DMA(ti, 0);
    int bhd_cur = -1; bf16x8 wx1 = (bf16x8){0, 0, 0, 0, 0, 0, 0, 0}, wx2 = wx1; float gbias = 0.f;
    for (; ti < 4352; ti += G, ++kk_) {
        GLAP_TASK(ti, bhd, s_chunk);
        const int dir = bhd & 1, h = (bhd >> 1) & 3, t = bhd * 68 + s_chunk;
        if (bhd != bhd_cur) {
            bhd_cur = bhd;
            const float* gw = (dir ? p.gk_w_b : p.gk_w_f) + (size_t)li * 16 * 512 + h * 128 + pd + (size_t)(8 * (fq & 1)) * 512;
            float wv8[8];
#pragma unroll
            for (int e = 0; e < 8; ++e) wv8[e] = gw[e * 512];
            gbias = ((dir ? p.gk_b_b : p.gk_b_f) + li * 512)[h * 128 + pd];
            unsigned hh[4], ll[4];
#pragma unroll
            for (int e = 0; e < 4; ++e) { hh[e] = pg8::cvt_pk_bf16(wv8[2 * e], wv8[2 * e + 1]);
                ll[e] = pg8::cvt_pk_bf16(wv8[2 * e] - __uint_as_float(hh[e] << 16), wv8[2 * e + 1] - __uint_as_float(hh[e] & 0xffff0000u)); if (fq >= 2) ll[e] = 0u; }
            wx1 = __builtin_bit_cast(bf16x8, (u32x4){hh[0], hh[1], hh[2], hh[3]}); wx2 = __builtin_bit_cast(bf16x8, (u32x4){ll[0], ll[1], ll[2], ll[3]});
        }
        if (kk_ == 0) asm volatile("s_waitcnt vmcnt(0)" ::: "memory"); else asm volatile("s_waitcnt vmcnt(5)" ::: "memory");
        __syncthreads();
        if (ti + G < 4352) GLAP_DMA(ti + G, (kk_ + 1) & 1);
        LAS unsigned char* sb = lds + L_SB + (kk_ & 1) * SB_BYTES;
        {
            float c[16];
#pragma unroll
            for (int T = 0; T < 4; ++T) {
                const LAS f32x4* zp = (const LAS f32x4*)(sb + SB_Z + (16 * T + fr) * 64 + (fq & 1) * 32);
                const f32x4 za = zp[0], zb = zp[1];
                unsigned zy[4];
#pragma unroll
                for (int e = 0; e < 4; ++e) { const float z0 = e < 2 ? za[2 * e] : zb[2 * e - 4], z1 = e < 2 ? za[2 * e + 1] : zb[2 * e - 3];
                    const unsigned hz = pg8::cvt_pk_bf16(z0, z1), lz = pg8::cvt_pk_bf16(z0 - __uint_as_float(hz << 16), z1 - __uint_as_float(hz & 0xffff0000u)); zy[e] = fq < 2 ? hz : lz; }
                const bf16x8 zf = __builtin_bit_cast(bf16x8, (u32x4){zy[0], zy[1], zy[2], zy[3]});
                f32x4 xa = (f32x4){gbias, gbias, gbias, gbias};
                xa = __builtin_amdgcn_mfma_f32_16x16x32_bf16(zf, wx1, xa, 0, 0, 0);
                xa = __builtin_amdgcn_mfma_f32_16x16x32_bf16(zf, wx2, xa, 0, 0, 0);
#pragma unroll
                for (int i = 0; i < 4; ++i) { const float x = xa[i];
                    const float l = __builtin_amdgcn_logf(1.f + __builtin_amdgcn_exp2f(-fabsf(x) * 1.4426950408889634f));
                    c[4 * T + i] = (fminf(x, 0.f) * 1.4426950408889634f - l) * (1.f / 16.f); }
            }
            float cl = 0.f;
            if (dir == 0) {
#pragma unroll
                for (int T = 0; T < 4; ++T) {
                    c[4 * T + 1] += c[4 * T]; c[4 * T + 2] += c[4 * T + 1]; c[4 * T + 3] += c[4 * T + 2];
                    const float R = c[4 * T + 3];
                    const float p1 = swz_xor<16>(R), pair = R + p1;
                    auto rr = __builtin_amdgcn_permlane32_swap(__float_as_uint(pair), __float_as_uint(pair), false, false);
                    const float q = __uint_as_float(fq >= 2 ? rr[0] : rr[1]);
                    const float ex = ((fq & 1) ? p1 : 0.f) + ((fq & 2) ? q : 0.f) + cl;
#pragma unroll
                    for (int i = 0; i < 4; ++i) c[4 * T + i] += ex;
                    cl += pair + q;
                }
            } else {
#pragma unroll
                for (int T = 3; T >= 0; --T) {
                    c[4 * T + 2] += c[4 * T + 3]; c[4 * T + 1] += c[4 * T + 2]; c[4 * T] += c[4 * T + 1];
                    const float R = c[4 * T];
                    const float p1 = swz_xor<16>(R), pair = R + p1;
                    auto rr = __builtin_amdgcn_permlane32_swap(__float_as_uint(pair), __float_as_uint(pair), false, false);
                    const float q = __uint_as_float(fq >= 2 ? rr[0] : rr[1]);
                    const float ex = ((fq & 1) ? 0.f : p1) + ((fq & 2) ? 0.f : q) + cl;
#pragma unroll
                    for (int i = 0; i < 4; ++i) c[4 * T + i] += ex;
                    cl += pair + q;
                }
            }
            if (fq == 0) cls[pd] = cl;
            const float qs = 0.08838834764831845f, ecl = __builtin_amdgcn_exp2f(cl);
            const int dch = pd >> 3, dlo = (pd & 7) * 2;
            const LAS unsigned char* qsrc = sb + fq * 1024 + ((dch ^ (2 * fq)) << 4) + dlo;
#pragma unroll
            for (int T = 0; T < 4; ++T) {
                unsigned kw[2];
#pragma unroll
                for (int i = 0; i < 4; i += 2) {
                    const int n = 4 * T + i;
                    const float c0 = c[n], c1 = c[n + 1];
                    const float e0 = __builtin_amdgcn_exp2f(c0), e1 = __builtin_amdgcn_exp2f(c1);
                    const float r0 = __builtin_amdgcn_rcpf(e0), r1 = __builtin_amdgcn_rcpf(e1);
                    const float q0 = bf2f(*(const LAS bf16_t*)(qsrc + 4096 * T + 256 * i)), q1 = bf2f(*(const LAS bf16_t*)(qsrc + 4096 * T + 256 * (i + 1)));
                    const float k0 = bf2f(*(const LAS bf16_t*)(qsrc + SB_K + 4096 * T + 256 * i)), k1 = bf2f(*(const LAS bf16_t*)(qsrc + SB_K + 4096 * T + 256 * (i + 1)));
                    const int tk0 = 16 * T + 4 * fq + i;
                    const unsigned qq = pg8::cvt_pk_bf16(q0 * qs * e0, q1 * qs * e1), kk2 = pg8::cvt_pk_bf16(k0 * r0, k1 * r1);
                    *(LAS bf16_t*)(qd + gla_o256(tk0, dch) + dlo) = (bf16_t)(qq & 0xffffu); *(LAS bf16_t*)(qd + gla_o256(tk0 + 1, dch) + dlo) = (bf16_t)(qq >> 16);
                    *(LAS bf16_t*)(ki + gla_o256(tk0, dch) + dlo) = (bf16_t)(kk2 & 0xffffu); *(LAS bf16_t*)(ki + gla_o256(tk0 + 1, dch) + dlo) = (bf16_t)(kk2 >> 16);
                    kw[i >> 1] = pg8::cvt_pk_bf16(k0 * (ecl * r0), k1 * (ecl * r1));
                }
                *(LAS u32x2*)(ksT + gla_o128(pd, 2 * T + (fq >> 1)) + (fq & 1) * 8) = (u32x2){kw[0], kw[1]};
            }
        }
        __syncthreads();
        {
            const int it = wv_ >> 1;
            f32x4 a2[2] = {(f32x4){0.f, 0.f, 0.f, 0.f}, (f32x4){0.f, 0.f, 0.f, 0.f}};
#pragma unroll
            for (int kk = 0; kk < 4; ++kk) {
                const bf16x8 xa = *(const LAS bf16x8*)(qd + gla_o256(16 * it + fr, 4 * kk + fq));
#pragma unroll
                for (int jj = 0; jj < 2; ++jj) { const int jt = 2 * (wv_ & 1) + jj;
                    const bf16x8 yb = *(const LAS bf16x8*)(ki + gla_o256(16 * jt + fr, 4 * kk + fq));
                    a2[jj] = __builtin_amdgcn_mfma_f32_16x16x32_bf16(yb, xa, a2[jj], 0, 0, 0); }
            }
#pragma unroll
            for (int jj = 0; jj < 2; ++jj) { const int jt = 2 * (wv_ & 1) + jj; const int i = 16 * it + fr, j0 = 16 * jt + 4 * fq;
                float m4[4];
#pragma unroll
                for (int cc = 0; cc < 4; ++cc) { const int j = j0 + cc; const bool keep = dir ? (j >= i) : (j <= i); m4[cc] = keep ? a2[jj][cc] : 0.f; }
                *(LAS u32x2*)(Al + gla_o128(i, j0 >> 3) + (j0 & 7) * 2) = (u32x2){pg8::cvt_pk_bf16(m4[0], m4[1]), pg8::cvt_pk_bf16(m4[2], m4[3])}; }
        }
        __syncthreads();
        {
            GAS u32x4* gq = (GAS u32x4*)(ws + WS_GQD + (size_t)t * 16384); GAS u32x4* gk = (GAS u32x4*)(ws + WS_GKS + (size_t)t * 16384); GAS u32x4* ga = (GAS u32x4*)(ws + WS_GA + (size_t)t * 8192); GAS u32x4* gc = (GAS u32x4*)(ws + WS_GCL + (size_t)t * 512);
            gq[tid] = *(const LAS u32x4*)(qd + tid * 16); gq[tid + 512] = *(const LAS u32x4*)(qd + (tid + 512) * 16);
            gk[tid] = *(const LAS u32x4*)(ksT + tid * 16); gk[tid + 512] = *(const LAS u32x4*)(ksT + (tid + 512) * 16);
            ga[tid] = *(const LAS u32x4*)(Al + tid * 16);
            if (tid < 32) gc[tid] = *(const LAS u32x4*)((LAS unsigned char*)cls + tid * 16);
        }
        __syncthreads();
    }
    asm volatile("s_waitcnt vmcnt(0)" ::: "memory");
#undef GLAP_DMA
#undef GLAP_TASK
}

__device__ __forceinline__ void phase_gla_scan(const P& p, int layer, LAS unsigned char* lds, int vcu, int G, const int wv_) {
    unsigned char* ws = p.ws; asm volatile("" : "+s"(ws));
    const int lane = hw_tid(), tid = (wv_ << 6) | lane, fr = lane & 15, fq = lane >> 4;
    constexpr int B_QD = 0, B_KST = 16384, B_A = 32768, B_V = 40960, B_CL = 49152, BUF = 50176, L_ST = 2 * BUF;
    static_assert(L_ST + 16384 <= RING_BYTES, "gla scan LDS map");
    LAS unsigned char* ST = lds + L_ST;
    const unsigned lds0 = (unsigned)(size_t)lds;
    const bf16_t* X = (const bf16_t*)(ws + WS_B1);
    for (int u = vcu; u < 256; u += G) {
        const int b = u >> 5, h = (u >> 3) & 3, dir = (u >> 2) & 1, sl = u & 3;
        bf16_t* O = (bf16_t*)(ws + WS_B2) + (dir ? (size_t)68 * MiB / 2 : 0);
        const int tk0 = gla_task(b, h, dir, 0);
        f32x4 sacc[4];
#pragma unroll
        for (int et = 0; et < 4; ++et) sacc[et] = (f32x4){0.f, 0.f, 0.f, 0.f};
        for (int e = tid; e < 4096; e += NTHR) ((LAS unsigned*)ST)[e] = 0u;
#define GLAS_DMA(s_) do { const int s__ = (s_); const unsigned bo_ = lds0 + (unsigned)((s__ & 1) * BUF); const size_t tk_ = (size_t)(tk0 + s__); const unsigned lo_ = (unsigned)lane * 16u; \
            pg8::glds16_s((const char*)(ws + WS_GQD) + tk_ * 16384 + (2 * wv_) * 1024, lo_, bo_ + B_QD + (2 * wv_) * 1024); pg8::glds16_s((const char*)(ws + WS_GQD) + tk_ * 16384 + (2 * wv_ + 1) * 1024, lo_, bo_ + B_QD + (2 * wv_ + 1) * 1024); \
            pg8::glds16_s((const char*)(ws + WS_GKS) + tk_ * 16384 + (2 * wv_) * 1024, lo_, bo_ + B_KST + (2 * wv_) * 1024); pg8::glds16_s((const char*)(ws + WS_GKS) + tk_ * 16384 + (2 * wv_ + 1) * 1024, lo_, bo_ + B_KST + (2 * wv_ + 1) * 1024); \
            pg8::glds16_s((const char*)(ws + WS_GA) + tk_ * 8192 + wv_ * 1024, lo_, bo_ + B_A + wv_ * 1024); \
            pg8::glds16_s((const char*)(X + (size_t)(gla_rowc(b, dir, s__) + 8 * wv_) * 3072 + 1024 + h * 256 + sl * 64), (unsigned)((lane >> 3) * 6144 + (((lane & 7) ^ (2 * (((lane >> 4) & 1) | ((wv_ & 1) << 1)))) << 4)), bo_ + B_V + wv_ * 1024); \
            if (wv_ == 0 && lane < 32) pg8::glds16_s((const char*)(ws + WS_GCL) + tk_ * 512, lo_, bo_ + B_CL); } while (0)
        GLAS_DMA(0); GLAS_DMA(1);
        __syncthreads();
#pragma unroll 1
        for (int s = 0; s < 68; ++s) {
            LAS unsigned char* bq = lds + (s & 1) * BUF;
            const int rowc = gla_rowc(b, dir, s);
            if (s == 0) asm volatile("s_waitcnt vmcnt(6)" ::: "memory");
            else if (s == 1) { if (wv_ == 0) asm volatile("s_waitcnt vmcnt(9)" ::: "memory"); else asm volatile("s_waitcnt vmcnt(8)" ::: "memory"); }
            else if (s + 1 < 68) { if (wv_ == 0) asm volatile("s_waitcnt vmcnt(11)" ::: "memory"); else asm volatile("s_waitcnt vmcnt(10)" ::: "memory"); }
            else asm volatile("s_waitcnt vmcnt(4)" ::: "memory");
            __syncthreads();
            {
                const int it = wv_ >> 1, e0 = 2 * (wv_ & 1);
                bf16x8 fa[2], fq4[4], fv[2][4], fs[4][2], fk[2];
                typedef short s4v __attribute__((ext_vector_type(4)));
                const int tq = fr >> 2, tp = fr & 3, fx = ((tq >> 1) & 1) | ((fq & 1) << 1);
                LAS unsigned char* vb = bq + B_V + (8 * fq + tq) * 128 + tp * 8;
#pragma unroll
                for (int kk = 0; kk < 2; ++kk) { fa[kk] = *(const LAS bf16x8*)(bq + B_A + gla_o128(16 * it + fr, 4 * kk + fq)); fk[kk] = *(const LAS bf16x8*)(bq + B_KST + gla_o128(16 * wv_ + fr, 4 * kk + fq));
#pragma unroll
                    for (int et = 0; et < 4; ++et) { LAS unsigned char* va = vb + kk * 4096 + ((et ^ fx) << 5);
                        const s4v lo4 = __builtin_amdgcn_ds_read_tr16_b64_v4i16((LAS s4v*)va), hi4 = __builtin_amdgcn_ds_read_tr16_b64_v4i16((LAS s4v*)(va + 512));
                        fv[kk][et] = __builtin_shufflevector(lo4, hi4, 0, 1, 2, 3, 4, 5, 6, 7); }
 }
#pragma unroll
                for (int kk = 0; kk < 4; ++kk) { fq4[kk] = *(const LAS bf16x8*)(bq + B_QD + gla_o256(16 * it + fr, 4 * kk + fq));
#pragma unroll
                    for (int jj = 0; jj < 2; ++jj) fs[kk][jj] = *(const LAS bf16x8*)(ST + gla_o256(16 * (e0 + jj) + fr, 4 * kk + fq)); }
                const f32x4 clv = *(const LAS f32x4*)(bq + B_CL + (16 * wv_ + 4 * fq) * 4);
                asm volatile("s_waitcnt lgkmcnt(0)" ::: "memory");
                __syncthreads();
                if (s + 2 < 68) GLAS_DMA(s + 2);
                f32x4 o2[2] = {(f32x4){0.f, 0.f, 0.f, 0.f}, (f32x4){0.f, 0.f, 0.f, 0.f}};
                if (wv_ & 1) {
#pragma unroll
                    for (int kk = 0; kk < 2; ++kk)
#pragma unroll
                        for (int jj = 0; jj < 2; ++jj) o2[jj] = __builtin_amdgcn_mfma_f32_16x16x32_bf16(fv[kk][2 + jj], fa[kk], o2[jj], 0, 0, 0);
                } else {
#pragma unroll
                    for (int kk = 0; kk < 2; ++kk)
#pragma unroll
                        for (int jj = 0; jj < 2; ++jj) o2[jj] = __builtin_amdgcn_mfma_f32_16x16x32_bf16(fv[kk][jj], fa[kk], o2[jj], 0, 0, 0);
                }
#pragma unroll
                for (int kk = 0; kk < 4; ++kk)
#pragma unroll
                    for (int jj = 0; jj < 2; ++jj) o2[jj] = __builtin_amdgcn_mfma_f32_16x16x32_bf16(fs[kk][jj], fq4[kk], o2[jj], 0, 0, 0);
                const f32x4 dec = (f32x4){__builtin_amdgcn_exp2f(clv[0]), __builtin_amdgcn_exp2f(clv[1]), __builtin_amdgcn_exp2f(clv[2]), __builtin_amdgcn_exp2f(clv[3])};
#pragma unroll
                for (int et = 0; et < 4; ++et) sacc[et] = sacc[et] * dec;
#pragma unroll
                for (int kk = 0; kk < 2; ++kk)
#pragma unroll
                    for (int et = 0; et < 4; ++et) sacc[et] = __builtin_amdgcn_mfma_f32_16x16x32_bf16(fk[kk], fv[kk][et], sacc[et], 0, 0, 0);
#pragma unroll
                for (int jj = 0; jj < 2; ++jj) { const int et = e0 + jj;
                    *(GAS u32x2*)(O + (size_t)(rowc + 16 * it + fr) * 1024 + h * 256 + sl * 64 + 16 * et + 4 * fq) = (u32x2){pg8::cvt_pk_bf16(o2[jj][0], o2[jj][1]), pg8::cvt_pk_bf16(o2[jj][2], o2[jj][3])}; }
            }
#pragma unroll
            for (int et = 0; et < 4; ++et) { const int d0 = 16 * wv_ + 4 * fq; *(LAS u32x2*)(ST + gla_o256(16 * et + fr, d0 >> 3) + (d0 & 7) * 2) = (u32x2){pg8::cvt_pk_bf16(sacc[et][0], sacc[et][1]), pg8::cvt_pk_bf16(sacc[et][2], sacc[et][3])}; }
        }
        __syncthreads();
#undef GLAS_DMA
    }
}

__device__ __forceinline__ float half_sum(float v) { v += swz_xor<1>(v); v += swz_xor<2>(v); v += swz_xor<4>(v); v += swz_xor<8>(v); v += swz_xor<16>(v); return v; }
__device__ __forceinline__ void phase_gla_merge(const P& p, int layer, int vcu, int G, const int wv_) {
    unsigned char* ws = p.ws; asm volatile("" : "+s"(ws));
    const int lane = hw_tid(), wave = wv_;
    constexpr int NRW = 4;
    const bf16_t* OF = (const bf16_t*)(ws + WS_B2); const bf16_t* OB = OF + (size_t)68 * MiB / 2; bf16_t* O = (bf16_t*)(ws + WS_B2);
    const bf16_t* X = (const bf16_t*)(ws + WS_B1);
    for (int r0 = (vcu * NWAVES + wave) * NRW; r0 < NR; r0 += G * NWAVES * NRW) {
        const float* gnp = p.gla_o_norm + (layer >> 1) * 256 + (lane & 31) * 8;
        const f32x4 gn0 = *(const GAS f32x4*)gnp, gn1 = *(const GAS f32x4*)(gnp + 4);
        u32x4 a[NRW][2], bb[NRW][2], og[NRW][2];
#pragma unroll
        for (int q = 0; q < NRW; ++q)
#pragma unroll
            for (int hp = 0; hp < 2; ++hp) { const size_t i0 = (size_t)(r0 + q) * 1024 + 8 * (lane + 64 * hp);
                a[q][hp] = __builtin_nontemporal_load((const GAS u32x4*)(OF + i0)); bb[q][hp] = __builtin_nontemporal_load((const GAS u32x4*)(OB + i0)); og[q][hp] = __builtin_nontemporal_load((const GAS u32x4*)(X + (size_t)(r0 + q) * 3072 + 2048 + 8 * (lane + 64 * hp))); }
#pragma unroll
        for (int q = 0; q < NRW; ++q)
#pragma unroll
            for (int hp = 0; hp < 2; ++hp) {
                float x[8]; float sq = 0.f;
#pragma unroll
                for (int w = 0; w < 4; ++w) { const unsigned ua = a[q][hp][w], ub = bb[q][hp][w];
                    x[2 * w] = __uint_as_float(ua << 16) + __uint_as_float(ub << 16); x[2 * w + 1] = __uint_as_float(ua & 0xffff0000u) + __uint_as_float(ub & 0xffff0000u);
                    sq += x[2 * w] * x[2 * w] + x[2 * w + 1] * x[2 * w + 1]; }
                const float rs = rsqrtf(half_sum(sq) * (1.f / 256.f) + EPS);
                unsigned ow[4];
#pragma unroll
                for (int w = 0; w < 4; ++w) { const unsigned ug = og[q][hp][w];
                    const float g0 = (w < 2 ? gn0[2 * w] : gn1[2 * w - 4]), g1 = (w < 2 ? gn0[2 * w + 1] : gn1[2 * w - 3]);
                    ow[w] = pk2(x[2 * w] * rs * g0 * silu_f(__uint_as_float(ug << 16)), x[2 * w + 1] * rs * g1 * silu_f(__uint_as_float(ug & 0xffff0000u))); }
                *(GAS u32x4*)(O + (size_t)(r0 + q) * 1024 + 8 * (lane + 64 * hp)) = (u32x4){ow[0], ow[1], ow[2], ow[3]};
            }
    }
}

__device__ __forceinline__ int wave_sum_i(int v) {
    v += __builtin_amdgcn_ds_swizzle(v, (1 << 10) | 0x1f); v += __builtin_amdgcn_ds_swizzle(v, (2 << 10) | 0x1f); v += __builtin_amdgcn_ds_swizzle(v, (4 << 10) | 0x1f);
    v += __builtin_amdgcn_ds_swizzle(v, (8 << 10) | 0x1f); v += __builtin_amdgcn_ds_swizzle(v, (16 << 10) | 0x1f);
    auto rr = __builtin_amdgcn_permlane32_swap((unsigned)v, (unsigned)v, false, false);
    return (int)(rr[0] + rr[1]);
}
__device__ __forceinline__ void phase_topk(const P& p, LAS unsigned char* lds, int vcu, int G, const int wv_, const int nunits) {
    unsigned char* ws = p.ws; asm volatile("" : "+s"(ws));
    const int lane = hw_tid(), tid = (wv_ << 6) | lane;
    LAS int* red = (LAS int*)lds;
    const float* aff = (const float*)(ws + WS_AFF);
    int* idx = (int*)(ws + WS_IDX); float* gatev = (float*)(ws + WS_GATE); int* pos = (int*)(ws + WS_POS);
    for (int u = vcu; u < nunits; u += G) {
        const int s = u >> 4, e = u & 15, b = s & 7;
        const int n = s < 8 ? SEQ : CTXL, cap = n / 8;
        const int row0 = b * RPB + (s < 8 ? 0 : SEQ);
        unsigned key[8];
        { const float* ak = aff + (s < 8 ? (size_t)(b * 16 + e) * SEQ : (size_t)NB * 16 * SEQ + (size_t)(b * 16 + e) * CTXL) + tid * 8;
          f32x4 k0 = (f32x4){0.f, 0.f, 0.f, 0.f}, k1 = k0; if (tid * 8 < n) { k0 = *(const GAS f32x4*)ak; k1 = *(const GAS f32x4*)(ak + 4); }
#pragma unroll
          for (int k = 0; k < 8; ++k) { const float kv = k < 4 ? k0[k] : k1[k - 4]; key[k] = tid * 8 + k < n ? (__float_as_uint(kv) | 0x80000000u) : 0u; } }
        unsigned T = 0u;
#pragma unroll 1
        for (int lo = 30; lo >= 0; lo -= 2) {
            const unsigned c1 = T | (1u << lo), c2 = T | (2u << lo), c3 = T | (3u << lo);
            int c = 0;
#pragma unroll
            for (int k = 0; k < 8; ++k) c += (key[k] >= c1 ? 1 : 0) + (key[k] >= c2 ? (1 << 10) : 0) + (key[k] >= c3 ? (1 << 20) : 0);
            c = wave_sum_i(c);
            LAS int* rb = red + ((lo >> 1) & 1) * 8;
            if (lane == 0) rb[wv_] = c;
            __syncthreads();
            int t1 = 0, t2 = 0, t3 = 0;
#pragma unroll
            for (int q = 0; q < 8; ++q) { const int v = rb[q]; t1 += v & 1023; t2 += (v >> 10) & 1023; t3 += (v >> 20) & 1023; }
            T = t3 >= cap ? c3 : (t2 >= cap ? c2 : (t1 >= cap ? c1 : T));
        }
        int mine = 0;
#pragma unroll
        for (int k = 0; k < 8; ++k) mine += (key[k] > T ? 1 : 0) + (key[k] == T ? 0x10000 : 0);
        int inc = mine;
#pragma unroll
        for (int o = 1; o < 64; o <<= 1) { const int t2 = __builtin_amdgcn_ds_bpermute(((lane - o) & 63) << 2, inc); if (lane >= o) inc += t2; }
        __syncthreads();
        if (lane == 63) red[16 + wv_] = inc;
        __syncthreads();
        int base = 0, total = 0;
#pragma unroll
        for (int q = 0; q < 8; ++q) { const int t2 = red[16 + q]; total += t2; if (q < wv_) base += t2; }
        int ex = base + inc - mine;
        const int m = total & 0xffff;
        const int slot0 = (s < 8 ? 0 : NSLOT_LAT) + (e * 8 + b) * cap;
#pragma unroll
        for (int k = 0; k < 8; ++k) {
            const int i = tid * 8 + k;
            if (i < n) {
                const int g = ex & 0xffff, q = ex >> 16;
                int sl = -1;
                if (key[k] > T) sl = g; else if (key[k] == T && m + q < cap) sl = m + q;
                const int row = row0 + i;
                if (sl >= 0) { idx[slot0 + sl] = row; gatev[slot0 + sl] = __uint_as_float(key[k] & 0x7fffffffu); }
                pos[(size_t)row * 16 + e] = sl >= 0 ? slot0 + sl : -1;
                ex += (key[k] > T ? 1 : 0) + (key[k] == T ? 0x10000 : 0);
            }
        }
        __syncthreads();
    }
}

constexpr int N_PHASES = 38;
__global__ void __launch_bounds__(NTHR, 2) mega_fwd(P p) {
    extern __shared__ __attribute__((aligned(16))) unsigned char lds_raw[];
    LAS unsigned char* lds = (LAS unsigned char*)lds_raw;
    volatile LAS unsigned* MISC = (volatile LAS unsigned*)(lds + MISC_OFF);
    const int tid = threadIdx.x;
    const int wv0 = __builtin_amdgcn_readfirstlane(tid >> 6);
    const int G = gridDim.x; const int bx0 = blockIdx.x;
    const int vcu0 = (G % 8 == 0) ? (bx0 % 8) * (G / 8) + bx0 / 8 : bx0;
    for (int u = tid; u < (LDS_BYTES - RING_BYTES) / 4; u += NTHR) ((LAS unsigned*)(lds + RING_BYTES))[u] = 0u;
    __syncthreads();
    const int lo = p.ph_lo, hi = p.ph_hi;
    unsigned* barw = (unsigned*)(p.ws + WS_CTL) + 4096 + p.seg * XCD_BAR_WORDS;
    XcdBarrier bar; bar.bar = barw; bar.x = 0; bar.st = MISC + 8;
    if (hi - lo > 1) bar = xcd_barrier_post(barw, MISC + 8);
#define IN(k) (lo <= (k) && (k) < hi)
#define SEAM(k) do { if ((k) + 1 < hi) xcd_barrier(bar, wv0); } while (0)
    if (IN(0)) { for (int rep_ = 0; rep_ < ((DUP_MASK >> 0) & 1) + 1; ++rep_) { phase_prologue(p, lds, vcu0, G, wv0); } SEAM(0); }
#pragma unroll 1
    for (int layer = 0; layer < 4; ++layer) {
        const int base = 1 + 9 * layer, li = layer >> 1;
        int bx = bx0, vcu = vcu0, wv = wv0; unsigned char* ws = p.ws; asm volatile("" : "+s"(bx), "+s"(vcu), "+s"(ws), "+s"(wv));
        if (IN(base + 0)) { if (layer == 0) phase_norm<0>(p, layer, lds, vcu, G, wv); else phase_norm<1>(p, layer, lds, vcu, G, wv); SEAM(base + 0); }
        if ((layer & 1) == 0) {
            if (IN(base + 1)) {
                pg8::Gemm g{(const bf16_t*)(ws + WS_U), (const bf16_t*)(ws + W_ATTN_IN) + (size_t)li * 2304 * 1024, NR, 2304, nullptr, 0};
                pg8::StaticOrder S; S.init(NR, 2304, G, bx);
                pg8::EpiQKV E{(bf16_t*)(ws + WS_B1), (const float*)(ws + WS_ROPE + 16384) + li * 256, (const float*)(ws + WS_ROPE)};
                for (int rep_ = 0; rep_ < ((DUP_MASK >> 1) & 1) + 1; ++rep_) { pg8::gemm_phase<pg8::EpiQKV, false, false>(lds, g, S, E, wv); }
                if (G == 256 && bx >= 200) moe_window(p, lds, layer, 0, bx - 200, wv);
                SEAM(base + 1);
            }
            if (IN(base + 3)) { for (int rep_ = 0; rep_ < ((DUP_MASK >> 2) & 1) + 1; ++rep_) { phase_attn_dense(p, (char*)lds_raw, vcu, G, wv); phase_attn_na(p, layer, (char*)lds_raw, vcu, G, wv); } SEAM(base + 3); }
        } else {
            if (IN(base + 1)) {
                pg8::Gemm g{(const bf16_t*)(ws + WS_U), (const bf16_t*)(ws + W_GLA_IN) + (size_t)li * 3328 * 1024, NR, 3328, nullptr, 0};
                pg8::StaticOrder S; S.init(NR, 3328, G, bx);
                pg8::EpiGlaIn E{(bf16_t*)(ws + WS_B1), (float*)(ws + WS_Z)};
                for (int rep_ = 0; rep_ < ((DUP_MASK >> 1) & 1) + 1; ++rep_) { pg8::gemm_phase<pg8::EpiGlaIn, false, false>(lds, g, S, E, wv); }
                if (G == 256 && bx >= 232) moe_window(p, lds, layer, 0, bx - 232, wv);
                SEAM(base + 1);
            }
            if (IN(base + 2)) { for (int rep_ = 0; rep_ < ((DUP_MASK >> 3) & 1) + 1; ++rep_) { phase_gla_pre(p, layer, lds, vcu, G, wv); } xcd_barrier(bar, wv0); phase_gla_scan(p, layer, lds, vcu, G, wv); SEAM(base + 2); }
            if (IN(base + 3)) { for (int rep_ = 0; rep_ < ((DUP_MASK >> 4) & 1) + 1; ++rep_) { phase_gla_merge(p, layer, vcu, G, wv); } SEAM(base + 3); }
        }
        if (IN(base + 4)) {
            const bf16_t* A = (const bf16_t*)(ws + WS_B2);
            const bf16_t* Bt = (layer & 1) ? (const bf16_t*)(ws + W_GLA_OUT) + (size_t)li * 1024 * 1024 : (const bf16_t*)(ws + W_ATTN_OUT) + (size_t)li * 1024 * 1024;
            pg8::Gemm g{A, Bt, NR, 1024, nullptr, 0};
            pg8::StaticOrder S; if (layer == 3) S.init(NB * SEQ, 1024, G, bx, 1); else S.init(NR, 1024, G, bx);
            pg8::EpiResid E{(bf16_t*)(ws + WS_HB), (const float*)(ws + WS_MODS) + (size_t)layer * 9 * 6144, layer == 0 ? p.x : nullptr, layer == 0 ? p.ctx : nullptr};
            pg8::gemm_phase<pg8::EpiResid, false, false>(lds, g, S, E, wv);
            if (layer < 3 && G == 256 && bx >= 32) moe_window(p, lds, layer, 1, bx - 32, wv);
            SEAM(base + 4);
        }
        if (IN(base + 5)) { for (int rep_ = 0; rep_ < ((DUP_MASK >> 5) & 1) + 1; ++rep_) { phase_norm<2>(p, layer, lds, vcu, G, wv, layer == 3); } SEAM(base + 5); }
        if (IN(base + 6)) { for (int rep_ = 0; rep_ < ((DUP_MASK >> 6) & 1) + 1; ++rep_) { phase_topk(p, lds, vcu, G, wv, layer == 3 ? 128 : 256); }
            if (G == 256 && vcu >= 128) moe_window(p, lds, layer, 2, vcu - 128, wv);        SEAM(base + 6); }
        if (IN(base + 7)) {
            pg8::Gemm g{(const bf16_t*)(ws + WS_U), (const bf16_t*)(ws + W_MOE_UP) + (size_t)layer * 16 * 2048 * 1024, NSLOT, 2048, (const int*)(ws + WS_IDX), (size_t)2048 * 1024 * 2};
            pg8::StaticOrder S; S.init(layer == 3 ? NSLOT_LAT : NSLOT, 2048, G, bx);
            pg8::EpiSwiGLU E{(bf16_t*)(ws + WS_B1)};
            for (int rep_ = 0; rep_ < ((DUP_MASK >> 7) & 1) + 1; ++rep_) { pg8::gemm_phase<pg8::EpiSwiGLU, true, true>(lds, g, S, E, wv); }
            if (layer < 3 && G == 256 && bx >= 128) moe_window(p, lds, layer, 3, bx - 128, wv);
            SEAM(base + 7);
        }
        if (IN(base + 8)) {
            pg8::Gemm g{(const bf16_t*)(ws + WS_B1), (const bf16_t*)(ws + W_MOE_DN) + (size_t)layer * 16 * 1024 * 1024, NSLOT, 1024, nullptr, (size_t)1024 * 1024 * 2};
            pg8::StaticOrder S; S.init(layer == 3 ? NSLOT_LAT : NSLOT, 1024, G, bx);
            pg8::EpiBf16 E{(bf16_t*)(ws + WS_B2), 1024, (const float*)(ws + WS_GATE)};
            for (int rep_ = 0; rep_ < ((DUP_MASK >> 8) & 1) + 1; ++rep_) { pg8::gemm_phase<pg8::EpiBf16, false, true>(lds, g, S, E, wv); }
            if (layer < 3 && G == 256 && bx >= 64) moe_window(p, lds, layer, 4, bx - 64, wv);
            SEAM(base + 8);
        }
    }
    if (IN(37)) phase_norm<3>(p, 3, lds, vcu0, G, wv0);
#undef IN
#undef SEAM
}
}

extern "C" void kernel_launch(void* const* d_in, const int* in_sizes, int n_in, void* d_out, int out_size, void* d_ws, size_t ws_size, hipStream_t stream) {
    static int grid = 0;
    if (grid == 0) {
        if (ws_size < WS_END) { fprintf(stderr, "kernel_launch: workspace too small: %zu < %zu\n", ws_size, (size_t)WS_END); grid = -1; return; }
        int dev = 0, cus = 0;
        if (hipGetDevice(&dev) != hipSuccess || hipDeviceGetAttribute(&cus, hipDeviceAttributeMultiprocessorCount, dev) != hipSuccess) { grid = -1; return; }
        if (hipFuncSetAttribute((const void*)mega_fwd, hipFuncAttributeMaxDynamicSharedMemorySize, LDS_BYTES) != hipSuccess) { fprintf(stderr, "kernel_launch: hipFuncSetAttribute failed\n"); grid = -1; return; }
        int per_cu = 0;
        if (hipOccupancyMaxActiveBlocksPerMultiprocessor(&per_cu, (const void*)mega_fwd, NTHR, LDS_BYTES) != hipSuccess || per_cu < 1) fprintf(stderr, "kernel_launch: occupancy query reports %d\n", per_cu);
        (void)hipGetLastError();
        grid = cus;
    }
    if (grid < 0) return;
    (void)hipMemsetAsync((char*)d_ws + WS_CTL, 0, CTL_ZERO_BYTES, stream);
    P p{};
    const float** pp = (const float**)&p;
    for (int i = 0; i < 26; ++i) pp[i] = (const float*)d_in[i];
    p.out = (float*)d_out; p.ws = (unsigned char*)d_ws;
    p.ph_lo = 0; p.ph_hi = N_PHASES; p.seg = 0;
    hipLaunchKernelGGL(mega_fwd, dim3(grid), dim3(NTHR), LDS_BYTES, stream, p);
}
```
